# Optimizing an MI355X kernel written in HIP

```python
import math
import jax, jax.numpy as jnp
from jax import lax
import numpy as np

D_MODEL = 2048
BATCH = 4
SEQ = 2048
DEPTH = 1

PLE_DIM = 256
POOL_WIDTH = 1024
POOL_GROUPS = 4
POOL_GROUP_DIM = POOL_WIDTH // POOL_GROUPS
POOL_WINDOWS = (2, 4, 8, 16)
N_HEADS = 16
N_KV_HEADS = 2
HEAD_DIM = 64
ATTN_WIDTH = N_HEADS * HEAD_DIM
KV_WIDTH = N_KV_HEADS * HEAD_DIM
MIX_WIDTH = POOL_WIDTH + ATTN_WIDTH
IN_WIDTH = POOL_WIDTH + ATTN_WIDTH + 2 * KV_WIDTH
WINDOW = 128
ATTN_BLOCK = 128
RPE_BUCKETS = 32
RPE_MAX_EXACT = RPE_BUCKETS // 2
RPE_MAX_DISTANCE = 128
N_EXPERTS = 64
TOP_K = 8
N_EXPERT_GROUPS = 8
EXPERTS_PER_GROUP = N_EXPERTS // N_EXPERT_GROUPS
TOPK_GROUPS = 4
EXPERT_FF = 512
SHARED_FF = 512
ROUTED_SCALE = 2.5
MOE_ROW_BLOCK = 128
EPS = 1e-6

kernel_name = "hybrid_pool_swa_moe_block"


def rms_norm(x, g):
    xf = x.astype(jnp.float32)
    y = xf * lax.rsqrt(jnp.mean(xf * xf, axis=-1, keepdims=True) + EPS)
    return (y * g.astype(jnp.float32)).astype(x.dtype)


def pool_mixer(u, w_pool, scale):
    B, S, _ = u.shape
    uf = u.astype(jnp.float32).reshape(B, S, POOL_GROUPS, POOL_GROUP_DIM)
    t = jnp.arange(S)
    outs = []
    for gi, w in enumerate(POOL_WINDOWS):
        ug = uf[:, :, gi]
        c = lax.cumsum(ug, axis=1)
        c_shift = jnp.pad(c, ((0, 0), (w, 0), (0, 0)))[:, :S]
        count = jnp.minimum(t + 1, w).astype(jnp.float32)[None, :, None]
        pooled = (c - c_shift) / count - ug
        outs.append(jnp.einsum('bsc,cd->bsd', pooled.astype(u.dtype), w_pool[gi]))
    return jnp.concatenate(outs, axis=-1) * scale


def t5_causal_bucket(dist):
    n = jnp.maximum(dist, 0)
    nf = jnp.maximum(n, 1).astype(jnp.float32)
    large = RPE_MAX_EXACT + (jnp.log(nf / RPE_MAX_EXACT) / math.log(RPE_MAX_DISTANCE / RPE_MAX_EXACT)
                             * (RPE_BUCKETS - RPE_MAX_EXACT)).astype(jnp.int32)
    large = jnp.minimum(large, RPE_BUCKETS - 1)
    return jnp.where(n < RPE_MAX_EXACT, n, large)


def swa_attention(q, k, v, sinks, rpe_table):
    B, S, _ = q.shape
    NB = S // ATTN_BLOCK
    G = N_HEADS // N_KV_HEADS
    L = ATTN_BLOCK
    qb = q.astype(jnp.float32).reshape(B, NB, L, N_KV_HEADS, G, HEAD_DIM) * (HEAD_DIM ** -0.5)
    kb = k.astype(jnp.float32).reshape(B, NB, L, N_KV_HEADS, HEAD_DIM)
    vb = v.astype(jnp.float32).reshape(B, NB, L, N_KV_HEADS, HEAD_DIM)

    def band(a):
        prev = jnp.concatenate([jnp.zeros_like(a[:, :1]), a[:, :-1]], axis=1)
        return jnp.concatenate([prev, a], axis=2)

    kband, vband = band(kb), band(vb)
    logits = jnp.einsum('bnqkgd,bnskd->bnkgqs', qb, kband)

    dist = jnp.arange(L)[:, None] + L - jnp.arange(2 * L)[None, :]
    key_pos = jnp.arange(NB)[:, None] * L - L + jnp.arange(2 * L)[None, :]
    valid = ((dist >= 0) & (dist < WINDOW))[None] & (key_pos >= 0)[:, None, :]
    bias = rpe_table.astype(jnp.float32)[t5_causal_bucket(dist)]
    bias = bias.transpose(2, 0, 1).reshape(N_KV_HEADS, G, L, 2 * L)
    logits = jnp.where(valid[None, :, None, None], logits + bias[None, None], -jnp.inf)

    sink = sinks.astype(jnp.float32).reshape(N_KV_HEADS, G)[None, None, :, :, None, None]
    m = jnp.maximum(jnp.max(logits, axis=-1, keepdims=True), sink)
    pr = jnp.exp(logits - m)
    denom = jnp.sum(pr, axis=-1, keepdims=True) + jnp.exp(sink - m)
    out = jnp.einsum('bnkgqs,bnskd->bnqkgd', pr / denom, vband)
    return out.reshape(B, S, ATTN_WIDTH).astype(q.dtype)


def moe(h, w_router, router_bias, w_gate, w_up, w_down, ws_gate, ws_up, ws_down):
    B, S, D = h.shape
    T = B * S
    xf = h.reshape(T, D)
    scores = jax.nn.sigmoid(jnp.dot(xf.astype(jnp.float32), w_router.astype(jnp.float32)))
    biased = scores + router_bias.astype(jnp.float32)
    grouped = biased.reshape(T, N_EXPERT_GROUPS, EXPERTS_PER_GROUP)
    group_score = jnp.sum(lax.top_k(grouped, 2)[0], axis=-1)
    _, top_groups = lax.top_k(group_score, TOPK_GROUPS)
    group_mask = jnp.any(top_groups[:, :, None] == jnp.arange(N_EXPERT_GROUPS)[None, None, :], axis=1)
    masked = jnp.where(jnp.repeat(group_mask, EXPERTS_PER_GROUP, axis=1), biased, -jnp.inf)
    _, top_idx = lax.top_k(masked, TOP_K)
    top_w = jnp.take_along_axis(scores, top_idx, axis=-1)
    top_w = top_w / jnp.sum(top_w, axis=-1, keepdims=True) * ROUTED_SCALE

    A = T * TOP_K
    RB = MOE_ROW_BLOCK
    flat_e = top_idx.reshape(A)
    flat_tok = jnp.arange(A, dtype=jnp.int32) // TOP_K
    flat_w = top_w.reshape(A)
    order = jnp.argsort(flat_e)
    se = flat_e[order]
    counts = jnp.bincount(flat_e, length=N_EXPERTS)
    padded = (counts + RB - 1) // RB * RB
    offsets = jnp.cumsum(counts) - counts
    pad_ends = jnp.cumsum(padded)
    pad_offsets = pad_ends - padded
    dest = pad_offsets[se] + jnp.arange(A) - offsets[se]
    n_rows = A + N_EXPERTS * RB
    n_blocks = n_rows // RB
    row_tok = jnp.full((n_rows,), T, jnp.int32).at[dest].set(flat_tok[order])
    row_w = jnp.zeros((n_rows,), jnp.float32).at[dest].set(flat_w[order])
    block_e = jnp.minimum(jnp.searchsorted(pad_ends, jnp.arange(n_blocks) * RB, side='right'), N_EXPERTS - 1)
    x_pad = jnp.concatenate([xf, jnp.zeros((1, D), xf.dtype)], axis=0)

    def expert_block(args):
        tok, w, e = args
        xb = x_pad[tok]
        hb = jax.nn.silu(xb @ w_gate[e]) * (xb @ w_up[e])
        return (hb @ w_down[e]) * w[:, None].astype(xb.dtype)

    y_rows = lax.map(expert_block, (row_tok.reshape(n_blocks, RB), row_w.reshape(n_blocks, RB), block_e))
    routed = jax.ops.segment_sum(y_rows.reshape(n_rows, D), row_tok, num_segments=T + 1)[:T]
    shared = (jax.nn.silu(xf @ ws_gate) * (xf @ ws_up)) @ ws_down
    return (routed + shared).reshape(B, S, D)


def setup_inputs(seed: int = 0) -> dict:
    key = jax.random.key(seed)
    ks = jax.random.split(key, 24)
    f32 = jnp.float32
    nrm = lambda k, shape, s: jax.random.normal(k, shape, f32) * s
    L = DEPTH
    return {
        "x": nrm(ks[0], (BATCH, SEQ, D_MODEL), 1.0),
        "p": nrm(ks[1], (DEPTH, BATCH, SEQ, PLE_DIM), 1.0),
        "g_mix": 1.0 + nrm(ks[2], (L, D_MODEL), 0.02),
        "w_in": nrm(ks[3], (L, D_MODEL, IN_WIDTH), D_MODEL ** -0.5),
        "w_pool": nrm(ks[4], (L, POOL_GROUPS, POOL_GROUP_DIM, POOL_GROUP_DIM), POOL_GROUP_DIM ** -0.5),
        "pool_scale": 1.0 + nrm(ks[5], (L, POOL_WIDTH), 0.1),
        "attn_sinks": nrm(ks[6], (L, N_HEADS), 1.0),
        "rpe_table": nrm(ks[7], (RPE_BUCKETS, N_HEADS), 0.5),
        "w_out": nrm(ks[8], (L, MIX_WIDTH, D_MODEL), MIX_WIDTH ** -0.5),
        "g_ffn": 1.0 + nrm(ks[9], (L, D_MODEL), 0.02),
        "w_router": nrm(ks[10], (L, D_MODEL, N_EXPERTS), D_MODEL ** -0.5),
        "router_bias": nrm(ks[11], (L, N_EXPERTS), 0.01),
        "w_gate": nrm(ks[12], (L, N_EXPERTS, D_MODEL, EXPERT_FF), D_MODEL ** -0.5),
        "w_up": nrm(ks[13], (L, N_EXPERTS, D_MODEL, EXPERT_FF), D_MODEL ** -0.5),
        "w_down": nrm(ks[14], (L, N_EXPERTS, EXPERT_FF, D_MODEL), EXPERT_FF ** -0.5),
        "ws_gate": nrm(ks[15], (L, D_MODEL, SHARED_FF), D_MODEL ** -0.5),
        "ws_up": nrm(ks[16], (L, D_MODEL, SHARED_FF), D_MODEL ** -0.5),
        "ws_down": nrm(ks[17], (L, SHARED_FF, D_MODEL), SHARED_FF ** -0.5),
        "w_ple_proj": nrm(ks[18], (L, PLE_DIM, D_MODEL), PLE_DIM ** -0.5),
        "g_ple": 1.0 + nrm(ks[19], (L, D_MODEL), 0.02),
        "w_ple_gate": nrm(ks[20], (L, D_MODEL, D_MODEL), D_MODEL ** -0.5),
        "g_final": 1.0 + nrm(ks[21], (D_MODEL,), 0.02),
    }


def reference(x, p, g_mix, w_in, w_pool, pool_scale, attn_sinks, rpe_table, w_out, g_ffn,
              w_router, router_bias, w_gate, w_up, w_down, ws_gate, ws_up, ws_down,
              w_ple_proj, g_ple, w_ple_gate, g_final):
    h = x
    split_at = [POOL_WIDTH, POOL_WIDTH + ATTN_WIDTH, POOL_WIDTH + ATTN_WIDTH + KV_WIDTH]
    for i in range(DEPTH):
        a = rms_norm(h, g_mix[i])
        z = a @ w_in[i]
        u, q, k, v = jnp.split(z, split_at, axis=-1)
        y_pool = pool_mixer(u, w_pool[i], pool_scale[i])
        y_attn = swa_attention(q, k, v, attn_sinks[i], rpe_table)
        h = h + jnp.concatenate([y_pool, y_attn], axis=-1) @ w_out[i]
        h = h + moe(rms_norm(h, g_ffn[i]), w_router[i], router_bias[i], w_gate[i], w_up[i], w_down[i],
                    ws_gate[i], ws_up[i], ws_down[i])
        gate = jax.nn.sigmoid(h @ w_ple_gate[i])
        h = h + gate * rms_norm(p[i] @ w_ple_proj[i], g_ple[i])
    return rms_norm(h, g_final)
```

```cpp
#include <hip/hip_runtime.h>
#include <cstdio>
#include <cstdint>

#ifndef MK_N_LAUNCHES
#define MK_N_LAUNCHES 1
#endif

namespace pg8 {
#define PG8_LAS __attribute__((address_space(3)))
typedef unsigned short bf16_t;
typedef short bf16x8 __attribute__((ext_vector_type(8)));
typedef float f32x4 __attribute__((ext_vector_type(4)));
typedef unsigned u32x4 __attribute__((ext_vector_type(4)));
typedef unsigned u32x2 __attribute__((ext_vector_type(2)));
constexpr int BM = 256, BK = 64, HALF = 128, HTB = HALF * BK * 2  , STAGE_BYTES = 8 * HTB, NXCD = 8, WGM = 8;

__host__ __device__ __forceinline__ int lds_byte(int r, int c) { const int st = (r >> 4) * 2 + (c >> 5), rr = r & 15, cc = c & 31, ob = rr * 64 + cc * 2; return st * 1024 + (ob ^ (((ob >> 9) & 1) << 5)); }
__host__ __device__ __forceinline__ void stage_rc(int b, int& R, int& C) { const int st = b / 1024, sb = b % 1024, swz = sb ^ (((sb >> 9) & 1) << 5); R = (st >> 1) * 16 + swz / 64; C = (st & 1) * 32 + (swz % 64) / 2; }
__host__ __device__ __forceinline__ int perm32(int rho) { const int n = rho >> 4, i = rho & 15; return 8 * (i >> 2) + 4 * n + (i & 3); }

struct Unit { int pm, pn, e, lt; };
struct Gemm { const bf16_t* A; const bf16_t* Bt; int lda, ldb, K; };

struct StaticOrder {
    int nM, nN, nwg, G, c;
    __host__ __device__ void init(int M, int N, int G_, int c_) { nM = M / BM; nN = N / BM; nwg = nM * nN; G = G_; c = c_; }
    __host__ __device__ bool next(int i, Unit& u) const {
        const long L = (long)i * G + c; if (L >= nwg) return false;
        int wgid = (int)L; { const int q = nwg / NXCD, r = nwg % NXCD, xcd = wgid % NXCD, off = wgid / NXCD; wgid = (xcd < r ? xcd * (q + 1) : r * (q + 1) + (xcd - r) * q) + off; }
        const int nig = WGM * nN, gid = wgid / nig, fm = gid * WGM, gsz = (nM - fm) < WGM ? (nM - fm) : WGM;
        u.pm = fm + ((wgid % nig) % gsz); u.pn = (wgid % nig) / gsz; u.e = 0; u.lt = 0; return true;
    }
    __device__ __forceinline__ int arow(const Unit&, int r) const { return r; }
};
struct SingleOrder {
    int pm, pn;
    __device__ bool next(int i, Unit& u) const { if (i > 0) return false; u.pm = pm; u.pn = pn; u.e = 0; u.lt = 0; return true; }
    __device__ __forceinline__ int arow(const Unit&, int r) const { return r; }
};

__device__ __forceinline__ int lane_id() { int l; asm volatile("v_mbcnt_lo_u32_b32 %0, -1, 0\n\tv_mbcnt_hi_u32_b32 %0, -1, %0" : "=v"(l)); return l; }
__device__ __forceinline__ unsigned cvt_pk_bf16(float lo, float hi) { unsigned r; asm volatile("v_cvt_pk_bf16_f32 %0, %1, %2" : "=v"(r) : "v"(lo), "v"(hi)); return r; }

template <class Epi, class Sched, bool GATHER, bool ALIGN_EPI = true>
__device__ __forceinline__ void gemm_phase(PG8_LAS unsigned char* lds, const Gemm g, const Sched& S, const Epi& E, int wid) {
    const int lane = lane_id(), tid = wid * 64 + lane, wr = wid >> 2, wc = wid & 3, fr = lane & 15, fq = lane >> 4;
    const int K = g.K, nt = K / BK;
    int Ra[2], Ca[2]; unsigned voffB[2];
#pragma unroll
    for (int i = 0; i < 2; ++i) { int R, C; stage_rc(tid * 16 + i * 8192, R, C); const int Rb = Epi::PERM ? ((R & ~31) + perm32(R & 31)) : R;
        Ra[i] = R; Ca[i] = C; voffB[i] = (unsigned)(Rb * g.ldb + C) * 2u; }
    const size_t kstep = (size_t)(BK * 2);
    const size_t hstepB = (size_t)HALF * g.ldb * 2, tstepB = 2 * hstepB;
    const size_t tstepA = (size_t)BM * g.lda * 2;
    const unsigned ldsw = (unsigned)wid * 1024u;
    const int aoff = lds_byte(wr * 64 + fr, fq * 8), boff = lds_byte(wc * 32 + fr, fq * 8);
#define PG8_SA(b, h) (((b) * 2 + (h)) * HTB)
#define PG8_SB(b, h) ((4 + (b) * 2 + (h)) * HTB)
#define PG8_STAGE(bufoff, gbase, v0, v1) do { \
        __builtin_amdgcn_global_load_lds((const unsigned*)((const char*)(gbase) + (v0)), (PG8_LAS unsigned*)(lds + (bufoff) + ldsw), 16, 0, 0); \
        __builtin_amdgcn_global_load_lds((const unsigned*)((const char*)(gbase) + (v1)), (PG8_LAS unsigned*)(lds + (bufoff) + ldsw + 8192), 16, 0, 0); } while (0)
#define PG8_STAGE_A0(bufoff, gbase, p0, p1) PG8_STAGE(bufoff, gbase, p0, p1)
#define PG8_STAGE_A1(bufoff, gbase, p0, p1, q0, q1) do { if constexpr (GATHER) { PG8_STAGE(bufoff, gbase, q0, q1); } else { PG8_STAGE(bufoff, (gbase) + hstepA, p0, p1); } } while (0)
#define PG8_LDA(dst, b, h) do { _Pragma("unroll") for (int m = 0; m < 4; ++m) _Pragma("unroll") for (int k = 0; k < 2; ++k) dst[m][k] = *(const PG8_LAS bf16x8*)(lds + PG8_SA(b, h) + aoff + m * 2048 + k * 1024); } while (0)
#define PG8_LDB(dst, b, h) do { _Pragma("unroll") for (int n = 0; n < 2; ++n) _Pragma("unroll") for (int k = 0; k < 2; ++k) dst[n][k] = *(const PG8_LAS bf16x8*)(lds + PG8_SB(b, h) + boff + n * 2048 + k * 1024); } while (0)
#define PG8_MMA(ai, bj, At, Bt) do { __builtin_amdgcn_s_setprio(1); _Pragma("unroll") for (int m = 0; m < 4; ++m) _Pragma("unroll") for (int n = 0; n < 2; ++n) _Pragma("unroll") for (int k = 0; k < 2; ++k) \
        acc[ai][bj][m][n] = __builtin_amdgcn_mfma_f32_16x16x32_bf16(Bt[n][k], At[m][k], acc[ai][bj][m][n], 0, 0, 0); __builtin_amdgcn_s_setprio(0); } while (0)
#define PG8_WAIT_V(n) asm volatile("s_waitcnt vmcnt(" #n ")" ::: "memory")
#define PG8_WAIT_L(n) asm volatile("s_waitcnt lgkmcnt(" #n ")" ::: "memory")
#define PG8_BAR __builtin_amdgcn_s_barrier()
#define PG8_SCHED __builtin_amdgcn_sched_barrier(0)
    Unit cur, nxt; int ui = 0;
    if (!S.next(0, cur)) return;
    f32x4 acc[2][2][4][2];
#pragma unroll
    for (int a = 0; a < 2; ++a)
#pragma unroll
        for (int b = 0; b < 2; ++b)
#pragma unroll
            for (int m = 0; m < 4; ++m)
#pragma unroll
                for (int n = 0; n < 2; ++n) acc[a][b][m][n] = (f32x4){0.f, 0.f, 0.f, 0.f};
    bf16x8 At[4][2], B0[2][2], B1[2][2];
    unsigned vA00, vA01, vA10, vA11, nA00, nA01, nA10, nA11;
    const size_t hstepA = GATHER ? (size_t)0 : (size_t)HALF * g.lda * 2;
    if constexpr (GATHER) {
        vA00 = (unsigned)(S.arow(cur, Ra[0]) * g.lda + Ca[0]) * 2u; vA01 = (unsigned)(S.arow(cur, Ra[1]) * g.lda + Ca[1]) * 2u;
        vA10 = (unsigned)(S.arow(cur, HALF + Ra[0]) * g.lda + Ca[0]) * 2u; vA11 = (unsigned)(S.arow(cur, HALF + Ra[1]) * g.lda + Ca[1]) * 2u;
    } else {
        vA00 = (unsigned)(Ra[0] * g.lda + Ca[0]) * 2u; vA01 = (unsigned)(Ra[1] * g.lda + Ca[1]) * 2u; vA10 = 0; vA11 = 0;
    }
    nA00 = vA00; nA01 = vA01; nA10 = vA10; nA11 = vA11;
    const char* cA = (const char*)g.A + (GATHER ? (size_t)0 : (size_t)cur.pm * tstepA); const char* cB = (const char*)g.Bt + (size_t)cur.pn * tstepB;
    PG8_STAGE(PG8_SB(0, 0), cB, voffB[0], voffB[1]); PG8_STAGE(PG8_SB(0, 1), cB + hstepB, voffB[0], voffB[1]); PG8_STAGE_A0(PG8_SA(0, 0), cA, vA00, vA01); PG8_STAGE_A1(PG8_SA(0, 1), cA, vA00, vA01, vA10, vA11);
    if (wr == 1) PG8_BAR;
    PG8_WAIT_V(2); PG8_BAR;
    PG8_STAGE(PG8_SB(1, 0), cB + kstep, voffB[0], voffB[1]); PG8_STAGE_A0(PG8_SA(1, 0), cA + kstep, vA00, vA01); PG8_STAGE(PG8_SB(1, 1), cB + hstepB + kstep, voffB[0], voffB[1]);
    PG8_WAIT_V(6); PG8_BAR;
    for (;;) {
        const bool has_next = S.next(ui + 1, nxt);
        const char* nA = has_next ? (const char*)g.A + (GATHER ? (size_t)0 : (size_t)nxt.pm * tstepA) : cA; const char* nB = has_next ? (const char*)g.Bt + (size_t)nxt.pn * tstepB : cB;
        if constexpr (GATHER) {
            if (has_next) {
                nA00 = (unsigned)(S.arow(nxt, Ra[0]) * g.lda + Ca[0]) * 2u; nA01 = (unsigned)(S.arow(nxt, Ra[1]) * g.lda + Ca[1]) * 2u;
                nA10 = (unsigned)(S.arow(nxt, HALF + Ra[0]) * g.lda + Ca[0]) * 2u; nA11 = (unsigned)(S.arow(nxt, HALF + Ra[1]) * g.lda + Ca[1]) * 2u;
            } else { nA00 = vA00; nA01 = vA01; nA10 = vA10; nA11 = vA11; }
        }
        for (int t = 0; t < nt; t += 2) {
            const bool last = (t == nt - 2);
            const char* a1 = cA + (size_t)(t + 1) * kstep;
            const char* a2 = last ? nA : cA + (size_t)(t + 2) * kstep; const char* b2 = last ? nB : cB + (size_t)(t + 2) * kstep;
            const char* a3 = a2 + kstep; const char* b3 = b2 + kstep;
            unsigned x00 = vA00, x01 = vA01, x10 = vA10, x11 = vA11;
            if constexpr (GATHER) { if (last) { x00 = nA00; x01 = nA01; x10 = nA10; x11 = nA11; } }
            PG8_LDB(B0, 0, 0); PG8_LDB(B1, 0, 1); PG8_SCHED; PG8_LDA(At, 0, 0); PG8_STAGE_A1(PG8_SA(1, 1), a1, vA00, vA01, vA10, vA11);
            PG8_WAIT_V(8); PG8_WAIT_L(0); PG8_BAR; PG8_MMA(0, 0, At, B0); PG8_MMA(0, 1, At, B1); PG8_BAR; PG8_SCHED;
            PG8_LDA(At, 0, 1); PG8_STAGE(PG8_SB(0, 0), b2, voffB[0], voffB[1]); PG8_STAGE(PG8_SB(0, 1), b2 + hstepB, voffB[0], voffB[1]); PG8_STAGE_A0(PG8_SA(0, 0), a2, x00, x01);
            PG8_WAIT_V(8); PG8_WAIT_L(0); PG8_BAR; PG8_MMA(1, 0, At, B0); PG8_MMA(1, 1, At, B1); PG8_BAR; PG8_SCHED;
            PG8_LDB(B0, 1, 0); PG8_LDB(B1, 1, 1); PG8_SCHED; PG8_LDA(At, 1, 0); PG8_STAGE_A1(PG8_SA(0, 1), a2, x00, x01, x10, x11);
            PG8_WAIT_V(8); PG8_WAIT_L(0); PG8_BAR; PG8_MMA(0, 0, At, B0); PG8_MMA(0, 1, At, B1); PG8_BAR; PG8_SCHED;
            PG8_LDA(At, 1, 1); PG8_STAGE(PG8_SB(1, 0), b3, voffB[0], voffB[1]); PG8_STAGE(PG8_SB(1, 1), b3 + hstepB, voffB[0], voffB[1]); PG8_STAGE_A0(PG8_SA(1, 0), a3, x00, x01);
            PG8_WAIT_V(8); PG8_WAIT_L(0); PG8_BAR; PG8_MMA(1, 0, At, B0); PG8_MMA(1, 1, At, B1); PG8_BAR; PG8_SCHED;
        }
        if constexpr (ALIGN_EPI) { if (wr == 0) PG8_BAR; }
        E(acc, cur, wr, wc, fr, fq);
        if (!has_next) break;
#pragma unroll
        for (int a = 0; a < 2; ++a)
#pragma unroll
            for (int b = 0; b < 2; ++b)
#pragma unroll
                for (int m = 0; m < 4; ++m)
#pragma unroll
                    for (int n = 0; n < 2; ++n) acc[a][b][m][n] = (f32x4){0.f, 0.f, 0.f, 0.f};
        cur = nxt; cA = nA; cB = nB; ++ui;
        if constexpr (GATHER) { vA00 = nA00; vA01 = nA01; vA10 = nA10; vA11 = nA11; }
        if constexpr (ALIGN_EPI) { if (wr == 1) PG8_BAR; }
    }
    PG8_WAIT_V(0);
    if constexpr (!ALIGN_EPI) { if (wr == 0) PG8_BAR; }
    PG8_BAR;
#undef PG8_SA
#undef PG8_SB
#undef PG8_STAGE
#undef PG8_LDA
#undef PG8_STAGE_A0
#undef PG8_STAGE_A1
#undef PG8_LDB
#undef PG8_MMA
#undef PG8_WAIT_V
#undef PG8_WAIT_L
#undef PG8_BAR
#undef PG8_SCHED
}
}

constexpr int NWAVES = 8;
constexpr int T = 8192, SEQ = 2048, NB = 4, D = 2048, INW = 2304, POOLW = 1024, NH = 16, NKV = 2, HD = 64, KVW = 128;
constexpr int NE = 64, TOPK = 8, EFF = 512, PLE = 256;
constexpr int SH_ROW0 = T * TOPK + NE * 256;
constexpr int NROWS = SH_ROW0 + T;
constexpr float EPS = 1e-6f;
constexpr int N_PHASES = 10;
constexpr int N_LAUNCHES = MK_N_LAUNCHES;

constexpr size_t MiB = 1u << 20;
constexpr size_t WS_CTL = 0, CTL_ZERO_BYTES = 64 * 1024;
constexpr size_t WS_MISC = 1 * MiB;
constexpr size_t WS_TOKLIST = WS_MISC;
constexpr size_t WS_WLIST = WS_TOKLIST + (size_t)NE * T * 4;
constexpr size_t WS_REC = WS_WLIST + (size_t)NE * T * 4;
constexpr size_t WS_RSTDP = WS_REC + (size_t)T * TOPK * 4;
constexpr size_t WS_PBF = 6 * MiB;
constexpr size_t WS_WIN = 12 * MiB;
constexpr size_t WS_WPOOL = WS_WIN + (size_t)INW * D * 2;
constexpr size_t WS_WOUT = WS_WPOOL + (size_t)4 * 256 * 256 * 2;
constexpr size_t WS_WPP = WS_WOUT + (size_t)D * D * 2;
constexpr size_t WS_WPG = WS_WPP + (size_t)D * PLE * 2;
constexpr size_t WS_WGU = WS_WPG + (size_t)D * D * 2;
constexpr size_t WS_WD = WS_WGU + (size_t)65 * 1024 * D * 2;
constexpr size_t WS_XN = WS_WD + (size_t)65 * D * EFF * 2;
constexpr size_t WS_PPROJ = WS_XN + (size_t)T * D * 2;
constexpr size_t WS_ACT = WS_PPROJ + (size_t)T * D * 2;
constexpr size_t WS_H2BF = WS_ACT;
constexpr size_t WS_Y = WS_ACT + (size_t)NROWS * EFF * 2;
constexpr size_t WS_ABF = WS_Y;
constexpr size_t WS_UBF = WS_ABF + (size_t)T * D * 2;
constexpr size_t WS_QBF = WS_UBF + (size_t)T * POOLW * 2;
constexpr size_t WS_KV = WS_QBF + (size_t)T * 1024 * 2;
constexpr size_t WS_POOLED = WS_KV + (size_t)T * 2 * KVW * 2;
constexpr size_t WS_MIX = WS_POOLED + (size_t)T * POOLW * 2;
constexpr size_t WS_END = WS_Y + (size_t)NROWS * D * 2;
static_assert(WS_MIX + (size_t)T * D * 2 <= WS_END, "early activations fit under Y");
static_assert(WS_RSTDP + (size_t)T * 4 <= WS_PBF && WS_PBF + (size_t)T * PLE * 2 <= WS_WIN, "misc fits");
static_assert(WS_END <= (size_t)1024 * MiB, "workspace must fit 1 GiB");
constexpr int CW_BAR = 1024;
constexpr int CW_CNT = 8192;
static_assert((CW_CNT + 32 * NE) * 4 <= (int)CTL_ZERO_BYTES, "CTL words inside the memset region");

constexpr int RING_OFF = 0, RING_BYTES = 131072;
constexpr int LDS_BYTES = 149504;
constexpr int MISC_OFF = LDS_BYTES - 512;
constexpr int TAB_OFF = RING_BYTES;
constexpr int TB_CNT = 0, TB_PAD = 80, TB_XCUM = 160;

#define GAS __attribute__((address_space(1)))
#define LAS __attribute__((address_space(3)))
typedef unsigned short bf16;
typedef unsigned v4u __attribute__((ext_vector_type(4)));
typedef unsigned v2u __attribute__((ext_vector_type(2)));
typedef float f32x4 __attribute__((ext_vector_type(4)));
typedef short bf16x8 __attribute__((ext_vector_type(8)));
typedef GAS unsigned gu32;
#define RLX_AGENT __ATOMIC_RELAXED, __HIP_MEMORY_SCOPE_AGENT
#define LDS_WAIT() asm volatile("s_waitcnt lgkmcnt(0)" ::: "memory")
#define VM_WAIT() asm volatile("s_waitcnt vmcnt(0)" ::: "memory")
__device__ __forceinline__ unsigned pk2(float lo, float hi) { return pg8::cvt_pk_bf16(lo, hi); }
__device__ __forceinline__ float bf_lo(unsigned w) { return __builtin_bit_cast(float, w << 16); }
__device__ __forceinline__ float bf_hi(unsigned w) { return __builtin_bit_cast(float, w & 0xffff0000u); }

#define XB_TMO      128
#define XB_XCNT(j)  (256  + 64 * (j))
#define XB_XSUB(j)  (1280 + 64 * (j))
#define XB_XGEN(j)  (2304 + 64 * (j))
#define XB_TOP      3328
#define XB_TOPGEN   3392
#define XCD_BAR_WORDS 3456
#define XB_SPIN_CAP (1u << 18)
__device__ __forceinline__ unsigned xb_ld(unsigned* p)              { return __hip_atomic_load(p, __ATOMIC_RELAXED, __HIP_MEMORY_SCOPE_AGENT); }
__device__ __forceinline__ unsigned xb_add(unsigned* p, unsigned v) { return __hip_atomic_fetch_add(p, v, __ATOMIC_RELAXED, __HIP_MEMORY_SCOPE_AGENT); }
__device__ __forceinline__ unsigned xb_xcc_id() { return (unsigned)__builtin_amdgcn_s_getreg((3 << 11) | 20) & 0xFu; }
#define XB_SPIN(cond, bar) do { unsigned _sp = 0; while (cond) { __builtin_amdgcn_s_sleep(1); \
    if ((++_sp & 255u) == 0u) { if (xb_ld(&(bar)[XB_TMO])) break; if (_sp > XB_SPIN_CAP) { atomicAdd(&(bar)[XB_TMO], 1u); break; } } } } while (0)
struct XcdBarrier { unsigned* bar; unsigned x; volatile LAS unsigned* st; };
__device__ __forceinline__ XcdBarrier xcd_barrier_post(unsigned* bar, volatile LAS unsigned* st) {
    XcdBarrier b; b.bar = bar; b.x = xb_xcc_id(); b.st = st;
    if (threadIdx.x == 0) (void)xb_add(&bar[XB_XCNT(b.x)], 1u);
    return b;
}
__device__ __forceinline__ void xcd_barrier_complete(unsigned* bar, unsigned x, unsigned& nloc, unsigned& nx) {
    const unsigned G = gridDim.x * gridDim.y * gridDim.z;
    unsigned sum, cnt, mine, sp = 0u;
    for (;;) {
        sum = 0u; cnt = 0u; mine = 0u;
#pragma unroll
        for (unsigned j = 0; j < 16; ++j) { const unsigned c = xb_ld(&bar[XB_XCNT(j)]); sum += c; cnt += (c > 0u) ? 1u : 0u; mine = (j == x) ? c : mine; }
        if (sum == G) break;
        __builtin_amdgcn_s_sleep(1);
        if ((++sp & 255u) == 0u) { if (xb_ld(&bar[XB_TMO])) break; if (sp > XB_SPIN_CAP) { atomicAdd(&bar[XB_TMO], 1u); break; } }
    }
    nloc = mine > 0u ? mine : 1u; nx = cnt > 0u ? cnt : 1u;
}
__device__ __forceinline__ void xcd_barrier(const XcdBarrier& b) {
    asm volatile("s_waitcnt vmcnt(0)" ::: "memory");
    __syncthreads();
    if (threadIdx.x == 0) {
        unsigned* bar = b.bar;
        __builtin_amdgcn_s_waitcnt(0);
        unsigned nloc = b.st[0], nx = b.st[1];
        if (nloc == 0u) { xcd_barrier_complete(bar, b.x, nloc, nx); b.st[0] = nloc; b.st[1] = nx; }
        const unsigned old = xb_add(&bar[XB_XSUB(b.x)], 1u);
        const unsigned gen = old / nloc;
        if (old + 1u == (gen + 1u) * nloc) {
            __builtin_amdgcn_fence(__ATOMIC_RELEASE, "agent");
            asm volatile("s_waitcnt vmcnt(0)" ::: "memory");
            const unsigned og = xb_add(&bar[XB_TOP], 1u);
            const unsigned tg = og / nx;
            if (og + 1u == (tg + 1u) * nx) xb_add(&bar[XB_TOPGEN], 1u);
            else XB_SPIN(xb_ld(&bar[XB_TOPGEN]) == tg, bar);
            __builtin_amdgcn_fence(__ATOMIC_ACQUIRE, "agent");
            xb_add(&bar[XB_XGEN(b.x)], 1u);
            asm volatile("s_waitcnt vmcnt(0)" ::: "memory");
        } else {
            XB_SPIN(xb_ld(&bar[XB_XGEN(b.x)]) == gen, bar);
            __builtin_amdgcn_fence(__ATOMIC_ACQUIRE, "agent");
            asm volatile("s_waitcnt vmcnt(0)" ::: "memory");
        }
    }
    __syncthreads();
}

struct Args { const float* in[22]; float* out; unsigned char* ws; int ph_lo, ph_hi, li, pad; };
struct Frame {
    LAS unsigned char* lds;
    volatile LAS unsigned* MISC;
    gu32* ctl;
    unsigned char* ws;
    int wave, G, bx;
    float* out;
};
__device__ __forceinline__ const float* fin(const Frame& F, int i) {
    const unsigned long long v = ((const LAS unsigned long long*)(F.lds + MISC_OFF + 256))[i];
    const unsigned lo = __builtin_amdgcn_readfirstlane((unsigned)v), hi = __builtin_amdgcn_readfirstlane((unsigned)(v >> 32));
    return (const float*)(const GAS float*)(((unsigned long long)hi << 32) | lo);
}
enum { I_X = 0, I_P, I_GMIX, I_WIN, I_WPOOL, I_PSCALE, I_SINKS, I_RPE, I_WOUT, I_GFFN, I_WROUTER, I_RBIAS, I_WGATE, I_WUP, I_WDOWN, I_WSGATE, I_WSUP, I_WSDOWN, I_WPLEPROJ, I_GPLE, I_WPLEGATE, I_GFINAL };

__device__ __forceinline__ float wave_sum(float v) {
#pragma unroll
    for (int o = 1; o < 64; o <<= 1) v += __shfl_xor(v, o);
    return v;
}

using pg8::Unit;
struct EpiInProj {
    static constexpr bool PERM = true;
    unsigned char* ws;
    __device__ __forceinline__ void operator()(const f32x4 (&acc)[2][2][4][2], const Unit& u, int wr, int wc, int fr, int fq) const {
        const int row0 = u.pm * 256 + wr * 64 + fr;
        const size_t boff = WS_UBF + (size_t)(u.pn >= 4 ? 1 : 0) * (WS_QBF - WS_UBF) + (size_t)(u.pn >= 8 ? 1 : 0) * (WS_KV - WS_QBF);
        bf16* base = (bf16*)(ws + boff); const int ldc = (u.pn < 8) ? 1024 : 256; const int col0 = (u.pn & 3) * 256 + wc * 32 + 8 * fq;
#pragma unroll
        for (int ai = 0; ai < 2; ++ai)
#pragma unroll
            for (int m = 0; m < 4; ++m) { bf16* rowp = base + (size_t)(row0 + ai * 128 + m * 16) * ldc + col0;
#pragma unroll
                for (int bj = 0; bj < 2; ++bj) { const f32x4 v0 = acc[ai][bj][m][0], v1 = acc[ai][bj][m][1];
                    v4u w; w.x = pk2(v0[0], v0[1]); w.y = pk2(v0[2], v0[3]); w.z = pk2(v1[0], v1[1]); w.w = pk2(v1[2], v1[3]);
                    *(v4u*)(rowp + bj * 128) = w; } }
    }
};
struct EpiBf16Plain {
    static constexpr bool PERM = true;
    bf16* O; int ldc; int col_off; const float* scale;
    __device__ __forceinline__ void operator()(const f32x4 (&acc)[2][2][4][2], const Unit& u, int wr, int wc, int fr, int fq) const {
        const int row0 = u.pm * 256 + wr * 64 + fr, colt = u.pn * 256 + wc * 32 + 8 * fq;
        f32x4 sv[2][2];
#pragma unroll
        for (int bj = 0; bj < 2; ++bj)
#pragma unroll
            for (int n = 0; n < 2; ++n) sv[bj][n] = scale ? *(const f32x4*)(scale + col_off + colt + bj * 128 + 4 * n) : (f32x4){1.f, 1.f, 1.f, 1.f};
#pragma unroll
        for (int ai = 0; ai < 2; ++ai)
#pragma unroll
            for (int m = 0; m < 4; ++m) { bf16* rowp = O + (size_t)(row0 + ai * 128 + m * 16) * ldc + col_off + colt;
#pragma unroll
                for (int bj = 0; bj < 2; ++bj) { const f32x4 v0 = acc[ai][bj][m][0] * sv[bj][0], v1 = acc[ai][bj][m][1] * sv[bj][1];
                    v4u w; w.x = pk2(v0[0], v0[1]); w.y = pk2(v0[2], v0[3]); w.z = pk2(v1[0], v1[1]); w.w = pk2(v1[2], v1[3]);
                    *(v4u*)(rowp + bj * 128) = w; } }
    }
};
struct EpiResF32 {
    static constexpr bool PERM = false;
    const float* base; float* C;
    __device__ __forceinline__ void operator()(const f32x4 (&acc)[2][2][4][2], const Unit& u, int wr, int wc, int fr, int fq) const {
        const int row0 = u.pm * 256 + wr * 64 + fr, col0 = u.pn * 256 + wc * 32 + 4 * fq;
#pragma unroll
        for (int ai = 0; ai < 2; ++ai)
#pragma unroll
            for (int m = 0; m < 4; ++m) { const size_t ro = (size_t)(row0 + ai * 128 + m * 16) * D + col0;
#pragma unroll
                for (int bj = 0; bj < 2; ++bj)
#pragma unroll
                    for (int n = 0; n < 2; ++n) { const f32x4 xb = *(const f32x4*)(base + ro + bj * 128 + n * 16); *(f32x4*)(C + ro + bj * 128 + n * 16) = xb + acc[ai][bj][m][n]; } }
    }
};
__device__ __forceinline__ float sigmoid_f(float v) { return __builtin_amdgcn_rcpf(1.0f + __expf(-v)); }
struct EpiGateUp {
    static constexpr bool PERM = true;
    bf16* ACT;
    __device__ __forceinline__ void operator()(const f32x4 (&acc)[2][2][4][2], const Unit& u, int wr, int wc, int fr, int fq) const {
        const int row0 = u.pm * 256 + wr * 64 + fr, col0 = (u.pn & 3) * 128 + wc * 32 + 8 * fq;
#pragma unroll
        for (int ai = 0; ai < 2; ++ai)
#pragma unroll
            for (int m = 0; m < 4; ++m) { float o[8];
#pragma unroll
                for (int n = 0; n < 2; ++n)
#pragma unroll
                    for (int j = 0; j < 4; ++j) { const float gte = acc[ai][0][m][n][j], up = acc[ai][1][m][n][j]; o[4 * n + j] = gte * sigmoid_f(gte) * up; }
                v4u w; w.x = pk2(o[0], o[1]); w.y = pk2(o[2], o[3]); w.z = pk2(o[4], o[5]); w.w = pk2(o[6], o[7]);
                *(v4u*)(ACT + (size_t)(row0 + ai * 128 + m * 16) * EFF + col0) = w; }
    }
};
struct EpiDown {
    static constexpr bool PERM = true;
    bf16* Y; const float* wlist; const LAS int* tab;
    __device__ __forceinline__ void operator()(const f32x4 (&acc)[2][2][4][2], const Unit& u, int wr, int wc, int fr, int fq) const {
        const int row0 = u.pm * 256 + wr * 64 + fr, col0 = (u.pn & 7) * 256 + wc * 32 + 8 * fq;
        const int cnt = tab[TB_CNT + u.e]; const int lr0 = u.lt * 256 + wr * 64 + fr;
#pragma unroll
        for (int ai = 0; ai < 2; ++ai)
#pragma unroll
            for (int m = 0; m < 4; ++m) { const int lr = lr0 + ai * 128 + m * 16;
                const float rw = (u.e == NE) ? 1.0f : ((lr < cnt) ? wlist[(size_t)u.e * T + lr] : 0.0f);
                bf16* rowp = Y + (size_t)(row0 + ai * 128 + m * 16) * D + col0;
#pragma unroll
                for (int bj = 0; bj < 2; ++bj) { const f32x4 v0 = acc[ai][bj][m][0] * rw, v1 = acc[ai][bj][m][1] * rw;
                    v4u w; w.x = pk2(v0[0], v0[1]); w.y = pk2(v0[2], v0[3]); w.z = pk2(v1[0], v1[1]); w.w = pk2(v1[2], v1[3]);
                    *(v4u*)(rowp + bj * 128) = w; } }
    }
};
struct EpiPleGate {
    static constexpr bool PERM = false;
    float* H; const bf16* PP; const float* rstdp; const float* gple;
    __device__ __forceinline__ void operator()(const f32x4 (&acc)[2][2][4][2], const Unit& u, int wr, int wc, int fr, int fq) const {
        const int row0 = u.pm * 256 + wr * 64 + fr, col0 = u.pn * 256 + wc * 32 + 4 * fq;
        f32x4 gv[2][2];
#pragma unroll
        for (int bj = 0; bj < 2; ++bj)
#pragma unroll
            for (int n = 0; n < 2; ++n) gv[bj][n] = *(const f32x4*)(gple + col0 + bj * 128 + n * 16);
#pragma unroll
        for (int ai = 0; ai < 2; ++ai)
#pragma unroll
            for (int m = 0; m < 4; ++m) { const int row = row0 + ai * 128 + m * 16; const size_t ro = (size_t)row * D + col0; const float rs = rstdp[row];
#pragma unroll
                for (int bj = 0; bj < 2; ++bj)
#pragma unroll
                    for (int n = 0; n < 2; ++n) { const size_t o = ro + bj * 128 + n * 16; const f32x4 h = *(const f32x4*)(H + o); const v2u pw = *(const v2u*)(PP + o);
                        const f32x4 a = acc[ai][bj][m][n]; const f32x4 g4 = gv[bj][n] * rs; f32x4 r;
                        r[0] = h[0] + sigmoid_f(a[0]) * bf_lo(pw.x) * g4[0]; r[1] = h[1] + sigmoid_f(a[1]) * bf_hi(pw.x) * g4[1];
                        r[2] = h[2] + sigmoid_f(a[2]) * bf_lo(pw.y) * g4[2]; r[3] = h[3] + sigmoid_f(a[3]) * bf_hi(pw.y) * g4[3];
                        *(f32x4*)(H + o) = r; } }
    }
};

struct MoeOrder {
    const LAS int* tab; const int* toklist; int x, r, npn, stride;
    __device__ __forceinline__ bool next(int i, Unit& u) const {
        const int L = i * stride + r; const int tl = L / npn, pn = L - tl * npn;
        if (tl >= tab[TB_XCUM + 9]) return false;
        int s = 0;
#pragma unroll
        for (int q = 1; q <= 8; ++q) s += (tl >= tab[TB_XCUM + q]) ? 1 : 0;
        int lt = tl - tab[TB_XCUM + s], e, row0;
        if (s < 8) { e = x + 8 * s; row0 = tab[TB_PAD + e] + 256 * lt; } else { e = NE; lt = x + 8 * lt; row0 = SH_ROW0 + 256 * lt; }
        u.pm = __builtin_amdgcn_readfirstlane(row0 >> 8); u.pn = __builtin_amdgcn_readfirstlane(e * npn + pn); u.e = __builtin_amdgcn_readfirstlane(e); u.lt = __builtin_amdgcn_readfirstlane(lt); return true;
    }
    __device__ __forceinline__ int arow(const Unit& u, int r_) const {
        const int lr = u.lt * 256 + r_;
        const int ee = (u.e < NE) ? u.e : 0;
        const int tk = toklist[(size_t)ee * T + (lr < T - 1 ? lr : T - 1)];
        return (u.e == NE) ? lr : ((lr < tab[TB_CNT + ee]) ? tk : 0);
    }
};
__device__ __forceinline__ void moe_tables(Frame& F) {
    const int LANE_ = pg8::lane_id(), TID_ = F.wave * 64 + LANE_; (void)TID_;
    LAS int* tab = (LAS int*)(F.lds + TAB_OFF);
    if (TID_ < NE) tab[TB_CNT + TID_] = (int)__hip_atomic_load(F.ctl + CW_CNT + 32 * TID_, RLX_AGENT);
    if (TID_ == NE) tab[TB_CNT + NE] = T;
    __syncthreads();
    if (TID_ == 0) {
        int off = 0;
        for (int e = 0; e < NE; ++e) { tab[TB_PAD + e] = off; off += ((tab[TB_CNT + e] + 255) >> 8) << 8; }
        tab[TB_PAD + NE] = off;
        const int x = F.bx & 7; int c = 0; tab[TB_XCUM] = 0;
        for (int s = 0; s < 8; ++s) { c += (tab[TB_CNT + x + 8 * s] + 255) >> 8; tab[TB_XCUM + s + 1] = c; }
        tab[TB_XCUM + 9] = c + 4;
    }
    __syncthreads();
}

__device__ __forceinline__ void conv_item(const float* W, int N, bf16* WT, int ldk, int mode, int item, int lane) {
    const int nblk = N >> 6, kb = item / nblk, nb = item - kb * nblk, k0 = 32 * kb, n0 = 64 * nb;
    const int c = lane >> 4, n4 = lane & 15;
    const float* src = W + (size_t)(k0 + 8 * c) * N + n0 + 4 * n4;
    f32x4 v[8];
#pragma unroll
    for (int i = 0; i < 8; ++i) v[i] = __builtin_nontemporal_load((const f32x4*)(src + (size_t)i * N));
#pragma unroll
    for (int j = 0; j < 4; ++j) { const int n = n0 + 4 * n4 + j; int dr = n;
        if (mode == 1) dr = ((n >> 7) << 8) + (n & 127); else if (mode == 2) dr = ((n >> 7) << 8) + 128 + (n & 127);
        v4u o; o.x = pk2(v[0][j], v[1][j]); o.y = pk2(v[2][j], v[3][j]); o.z = pk2(v[4][j], v[5][j]); o.w = pk2(v[6][j], v[7][j]);
        *(v4u*)(WT + (size_t)dr * ldk + k0 + 8 * c) = o; }
}
__device__ __forceinline__ void rms_row_to_bf16(const float* xrow, const float* g, bf16* orow, int lane) {
    f32x4 v[8]; float s = 0.f;
#pragma unroll
    for (int j = 0; j < 4; ++j) { v[2 * j] = *(const f32x4*)(xrow + 512 * j + 8 * lane); v[2 * j + 1] = *(const f32x4*)(xrow + 512 * j + 8 * lane + 4); }
#pragma unroll
    for (int j = 0; j < 8; ++j) s += (v[j][0] * v[j][0] + v[j][1] * v[j][1]) + (v[j][2] * v[j][2] + v[j][3] * v[j][3]);
    const float rstd = 1.0f / sqrtf(wave_sum(s) * (1.0f / D) + EPS);
#pragma unroll
    for (int j = 0; j < 4; ++j) { const f32x4 g0 = *(const f32x4*)(g + 512 * j + 8 * lane), g1 = *(const f32x4*)(g + 512 * j + 8 * lane + 4);
        const f32x4 a = v[2 * j] * rstd * g0, b = v[2 * j + 1] * rstd * g1;
        v4u o; o.x = pk2(a[0], a[1]); o.y = pk2(a[2], a[3]); o.z = pk2(b[0], b[1]); o.w = pk2(b[2], b[3]);
        *(v4u*)(orow + 512 * j + 8 * lane) = o; }
}
__device__ __forceinline__ void p0_prologue(Frame& F) {
    const int LANE_ = pg8::lane_id(), TID_ = F.wave * 64 + LANE_; (void)TID_;
    const int gw = F.bx * NWAVES + F.wave, NGW = F.G * NWAVES;
    bf16* WIN = (bf16*)(F.ws + WS_WIN); bf16* WPOOL = (bf16*)(F.ws + WS_WPOOL); bf16* WOUT = (bf16*)(F.ws + WS_WOUT); bf16* WPP = (bf16*)(F.ws + WS_WPP); bf16* WPG = (bf16*)(F.ws + WS_WPG);
    bf16* WGU = (bf16*)(F.ws + WS_WGU); bf16* WDN = (bf16*)(F.ws + WS_WD);
    constexpr int I_IN = (D / 32) * (INW / 64), I_PL = 4 * (256 / 32) * (256 / 64), I_OUT = (D / 32) * (D / 64), I_PP = (PLE / 32) * (D / 64), I_PG = (D / 32) * (D / 64);
    constexpr int I_G1 = (D / 32) * (EFF / 64)  , I_D1 = (EFF / 32) * (D / 64)  ;
    constexpr int I_SMALL = I_IN + I_PL + I_OUT + I_PP + I_PG, I_G = 65 * I_G1, I_DN = 65 * I_D1;
    constexpr int NITEMS = I_SMALL + 2 * I_G + I_DN;
    for (int it = gw; it < NITEMS; it += NGW) {
        int r = it;
        if (r < I_SMALL) {
            if (r < I_IN) { conv_item(fin(F, I_WIN), INW, WIN, D, 0, r, LANE_); continue; } r -= I_IN;
            if (r < I_PL) { const int gq = r >> 5; conv_item(fin(F, I_WPOOL) + (size_t)gq * 65536, 256, WPOOL + (size_t)gq * 65536, 256, 0, r & 31, LANE_); continue; } r -= I_PL;
            if (r < I_OUT) { conv_item(fin(F, I_WOUT), D, WOUT, D, 0, r, LANE_); continue; } r -= I_OUT;
            if (r < I_PP) { conv_item(fin(F, I_WPLEPROJ), D, WPP, PLE, 0, r, LANE_); continue; } r -= I_PP;
            conv_item(fin(F, I_WPLEGATE), D, WPG, D, 0, r, LANE_); continue;
        }
        r -= I_SMALL;
        if (r < I_G) { const int e = r / I_G1, li = r - e * I_G1; const float* src = (e < NE) ? fin(F, I_WGATE) + (size_t)e * D * EFF : fin(F, I_WSGATE);
            conv_item(src, EFF, WGU + (size_t)e * 1024 * D, D, 1, li, LANE_); continue; } r -= I_G;
        if (r < I_G) { const int e = r / I_G1, li = r - e * I_G1; const float* src = (e < NE) ? fin(F, I_WUP) + (size_t)e * D * EFF : fin(F, I_WSUP);
            conv_item(src, EFF, WGU + (size_t)e * 1024 * D, D, 2, li, LANE_); continue; } r -= I_G;
        { const int e = r / I_D1, li = r - e * I_D1; const float* src = (e < NE) ? fin(F, I_WDOWN) + (size_t)e * EFF * D : fin(F, I_WSDOWN);
            conv_item(src, D, WDN + (size_t)e * D * EFF, EFF, 0, li, LANE_); }
    }
    { const float* P = fin(F, I_P); bf16* PB = (bf16*)(F.ws + WS_PBF);
      for (int i = gw * 64 + LANE_; i < T * PLE / 8; i += NGW * 64) { const f32x4 a = *(const f32x4*)(P + (size_t)i * 8), b = *(const f32x4*)(P + (size_t)i * 8 + 4);
          v4u o; o.x = pk2(a[0], a[1]); o.y = pk2(a[2], a[3]); o.z = pk2(b[0], b[1]); o.w = pk2(b[2], b[3]); *(v4u*)(PB + (size_t)i * 8) = o; } }
    bf16* ABF = (bf16*)(F.ws + WS_ABF);
    for (int m = gw; m < T; m += NGW) rms_row_to_bf16(fin(F, I_X) + (size_t)m * D, fin(F, I_GMIX), ABF + (size_t)m * D, LANE_);
}

__device__ __forceinline__ int t5_bucket(int n) {
    if (n < 16) return n;
    const int large = 16 + (int)(logf((float)n * (1.0f / 16.0f)) / logf(8.0f) * 16.0f);
    return large < 31 ? large : 31;
}
constexpr int VT_LD = 216, VT_KEYS = 208;
__device__ __forceinline__ void attn_task(Frame& F, const LAS float* btab, const LAS bf16* vtl, int b, int kvh, int hg, int qt) {
    const int LANE_ = pg8::lane_id();
    const bf16* Q = (const bf16*)(F.ws + WS_QBF); const bf16* Kb = (const bf16*)(F.ws + WS_KV); bf16* MIX = (bf16*)(F.ws + WS_MIX);
    const int lane = LANE_, qi = lane & 15, g = lane >> 4, h = kvh * 8 + hg;
    const int q0 = qt * 16, tok0 = b * SEQ;
    bf16x8 qf[2];
#pragma unroll
    for (int ks = 0; ks < 2; ++ks) qf[ks] = *(const bf16x8*)(Q + (size_t)(tok0 + q0 + qi) * 1024 + h * 64 + 32 * ks + 8 * g);
    f32x4 s[5][2];
#pragma unroll
    for (int kb = 0; kb < 5; ++kb)
#pragma unroll
        for (int t = 0; t < 2; ++t) {
            int key = q0 - 128 + 32 * kb + 8 * (qi >> 2) + 4 * t + (qi & 3); key = key < 0 ? 0 : (key > SEQ - 1 ? SEQ - 1 : key);
            const bf16* kp = Kb + (size_t)(tok0 + key) * (2 * KVW) + kvh * 64 + 8 * g;
            const bf16x8 k0f = *(const bf16x8*)(kp), k1f = *(const bf16x8*)(kp + 32);
            f32x4 a = (f32x4){0.f, 0.f, 0.f, 0.f};
            a = __builtin_amdgcn_mfma_f32_16x16x32_bf16(k0f, qf[0], a, 0, 0, 0);
            a = __builtin_amdgcn_mfma_f32_16x16x32_bf16(k1f, qf[1], a, 0, 0, 0);
            s[kb][t] = a;
        }
    const float sink = fin(F, I_SINKS)[h];
    const LAS float* bt = btab + hg * 128;
    float mx = sink;
#pragma unroll
    for (int kb = 0; kb < 5; ++kb)
#pragma unroll
        for (int t = 0; t < 2; ++t)
#pragma unroll
            for (int r = 0; r < 4; ++r) {
                const int key = q0 - 128 + 32 * kb + 8 * g + 4 * t + r, dist = q0 + qi - key;
                const bool valid = (dist >= 0) && (dist < 128) && (key >= 0);
                const float lg = valid ? s[kb][t][r] * 0.125f + bt[dist & 127] : -3.0e38f;
                s[kb][t][r] = lg; mx = fmaxf(mx, lg);
            }
    mx = fmaxf(mx, __shfl_xor(mx, 16)); mx = fmaxf(mx, __shfl_xor(mx, 32));
    float sum = 0.f;
#pragma unroll
    for (int kb = 0; kb < 5; ++kb)
#pragma unroll
        for (int t = 0; t < 2; ++t)
#pragma unroll
            for (int r = 0; r < 4; ++r) { const float lg = s[kb][t][r]; const float p = (lg > -1.0e38f) ? __expf(lg - mx) : 0.f; s[kb][t][r] = p; sum += p; }
    sum += __shfl_xor(sum, 16); sum += __shfl_xor(sum, 32);
    const float inv = 1.0f / (sum + __expf(sink - mx));
    f32x4 o[4];
#pragma unroll
    for (int dt = 0; dt < 4; ++dt) o[dt] = (f32x4){0.f, 0.f, 0.f, 0.f};
#pragma unroll
    for (int kb = 0; kb < 5; ++kb) {
        v4u pw; pw.x = pk2(s[kb][0][0], s[kb][0][1]); pw.y = pk2(s[kb][0][2], s[kb][0][3]); pw.z = pk2(s[kb][1][0], s[kb][1][1]); pw.w = pk2(s[kb][1][2], s[kb][1][3]);
        const bf16x8 pf = __builtin_bit_cast(bf16x8, pw);
        const int kkl = 16 * (qt & 3) + 32 * kb + 8 * g;
#pragma unroll
        for (int dt = 0; dt < 4; ++dt) {
            const bf16x8 vf = *(const LAS bf16x8*)(vtl + (16 * dt + qi) * VT_LD + kkl);
            o[dt] = __builtin_amdgcn_mfma_f32_16x16x32_bf16(vf, pf, o[dt], 0, 0, 0);
        }
    }
    bf16* op = MIX + (size_t)(tok0 + q0 + qi) * D + POOLW + h * 64 + 4 * g;
#pragma unroll
    for (int dt = 0; dt < 4; ++dt) { v2u w; w.x = pk2(o[dt][0] * inv, o[dt][1] * inv); w.y = pk2(o[dt][2] * inv, o[dt][3] * inv); *(v2u*)(op + 16 * dt) = w; }
}

__device__ __forceinline__ void pool_task(Frame& F, int mt, int gq) {
    const int LANE_ = pg8::lane_id(), TID_ = F.wave * 64 + LANE_; (void)TID_;
    const bf16* U = (const bf16*)(F.ws + WS_UBF); bf16* PO = (bf16*)(F.ws + WS_POOLED);
    const int w = 2 << gq;
    const int ch = gq * 256 + (TID_ & 31) * 8, tr0 = mt * 256 + (TID_ >> 5) * 16;
    const int pos0 = tr0 & (SEQ - 1);
    float run[8];
#pragma unroll
    for (int c = 0; c < 8; ++c) run[c] = 0.f;
    for (int j = 1; j < w; ++j) { if (pos0 - j >= 0) { const v4u x = *(const v4u*)(U + (size_t)(tr0 - j) * POOLW + ch);
        run[0] += bf_lo(x.x); run[1] += bf_hi(x.x); run[2] += bf_lo(x.y); run[3] += bf_hi(x.y); run[4] += bf_lo(x.z); run[5] += bf_hi(x.z); run[6] += bf_lo(x.w); run[7] += bf_hi(x.w); } }
    for (int i = 0; i < 16; ++i) {
        const int pos = pos0 + i; const v4u x = *(const v4u*)(U + (size_t)(tr0 + i) * POOLW + ch);
        float uv[8] = {bf_lo(x.x), bf_hi(x.x), bf_lo(x.y), bf_hi(x.y), bf_lo(x.z), bf_hi(x.z), bf_lo(x.w), bf_hi(x.w)};
        const float ic = 1.0f / (float)((pos + 1) < w ? (pos + 1) : w);
        float o[8];
#pragma unroll
        for (int c = 0; c < 8; ++c) { run[c] += uv[c]; o[c] = run[c] * ic - uv[c]; }
        v4u ow; ow.x = pk2(o[0], o[1]); ow.y = pk2(o[2], o[3]); ow.z = pk2(o[4], o[5]); ow.w = pk2(o[6], o[7]);
        *(v4u*)(PO + (size_t)(tr0 + i) * POOLW + ch) = ow;
        if (pos - w + 1 >= 0) { const v4u y = *(const v4u*)(U + (size_t)(tr0 + i - w + 1) * POOLW + ch);
            run[0] -= bf_lo(y.x); run[1] -= bf_hi(y.x); run[2] -= bf_lo(y.y); run[3] -= bf_hi(y.y); run[4] -= bf_lo(y.z); run[5] -= bf_hi(y.z); run[6] -= bf_lo(y.w); run[7] -= bf_hi(y.w); }
    }
    VM_WAIT(); __syncthreads();
    pg8::Gemm g{(const bf16*)PO + gq * 256, (const bf16*)(F.ws + WS_WPOOL) + (size_t)gq * 65536, POOLW, 256, 256};
    pg8::SingleOrder S{mt, 0};
    EpiBf16Plain E{(bf16*)(F.ws + WS_MIX), D, gq * 256, fin(F, I_PSCALE)};
    pg8::gemm_phase<EpiBf16Plain, pg8::SingleOrder, false>(F.lds + RING_OFF, g, S, E, F.wave);
}

constexpr int XS_STRIDE = 2052;
constexpr int P4_XS = 0, P4_PART = 16 * XS_STRIDE * 4, P4_SELE = P4_PART + 2 * 16 * 64 * 4, P4_SELW = P4_SELE + 32 * 8 * 4, P4_SELL = P4_SELW + 32 * 8 * 4, P4_HIST = P4_SELL + 32 * 8 * 4, P4_BASE = P4_HIST + 256, P4_END = P4_BASE + 256;
static_assert(P4_END <= MISC_OFF, "P4 LDS map");
__device__ __forceinline__ void p4_route(Frame& F) {
    const int LANE_ = pg8::lane_id(), TID_ = F.wave * 64 + LANE_; (void)TID_;
    LAS float* XS = (LAS float*)(F.lds + P4_XS); LAS float* PART = (LAS float*)(F.lds + P4_PART);
    LAS int* SELE = (LAS int*)(F.lds + P4_SELE); LAS float* SELW = (LAS float*)(F.lds + P4_SELW); LAS int* SELL = (LAS int*)(F.lds + P4_SELL);
    LAS int* HIST = (LAS int*)(F.lds + P4_HIST); LAS int* BASE = (LAS int*)(F.lds + P4_BASE);
    const float* H1 = F.out; bf16* XN = (bf16*)(F.ws + WS_XN); const float* gf = fin(F, I_GFFN); const float* wr_ = fin(F, I_WROUTER); const float* rb = fin(F, I_RBIAS);
    const int lane = LANE_, wave = F.wave;
    if (TID_ < 64) HIST[TID_] = 0;
    for (int tile = F.bx; tile < T / 32; tile += F.G) {
    for (int pass = 0; pass < 2; ++pass) {
        const int tokp = tile * 32 + pass * 16;
#pragma unroll 1
        for (int q = 0; q < 2; ++q) {
            const int tl = 2 * wave + q; const float* xrow = H1 + (size_t)(tokp + tl) * D;
            f32x4 v[8]; float s = 0.f;
#pragma unroll
            for (int j = 0; j < 4; ++j) { v[2 * j] = *(const f32x4*)(xrow + 512 * j + 8 * lane); v[2 * j + 1] = *(const f32x4*)(xrow + 512 * j + 8 * lane + 4); }
#pragma unroll
            for (int j = 0; j < 8; ++j) s += (v[j][0] * v[j][0] + v[j][1] * v[j][1]) + (v[j][2] * v[j][2] + v[j][3] * v[j][3]);
            const float rstd = 1.0f / sqrtf(wave_sum(s) * (1.0f / D) + EPS);
#pragma unroll
            for (int j = 0; j < 4; ++j) { const f32x4 g0 = *(const f32x4*)(gf + 512 * j + 8 * lane), g1 = *(const f32x4*)(gf + 512 * j + 8 * lane + 4);
                const f32x4 a = v[2 * j] * rstd * g0, b = v[2 * j + 1] * rstd * g1;
                *(LAS f32x4*)(XS + tl * XS_STRIDE + 512 * j + 8 * lane) = a; *(LAS f32x4*)(XS + tl * XS_STRIDE + 512 * j + 8 * lane + 4) = b;
                v4u o; o.x = pk2(a[0], a[1]); o.y = pk2(a[2], a[3]); o.z = pk2(b[0], b[1]); o.w = pk2(b[2], b[3]);
                *(v4u*)(XN + (size_t)(tokp + tl) * D + 512 * j + 8 * lane) = o; }
        }
        __syncthreads();
        {
            const int et = wave & 3, kh = wave >> 2, ti = lane & 15, kk = lane >> 4;
            f32x4 acc = (f32x4){0.f, 0.f, 0.f, 0.f};
            const LAS float* xa = XS + ti * XS_STRIDE + 1024 * kh + kk;
            const float* wb = wr_ + (size_t)(1024 * kh + kk) * NE + 16 * et + ti;
#pragma unroll 8
            for (int ks = 0; ks < 256; ++ks) acc = __builtin_amdgcn_mfma_f32_16x16x4f32(xa[4 * ks], wb[(size_t)4 * ks * NE], acc, 0, 0, 0);
#pragma unroll
            for (int r = 0; r < 4; ++r) PART[(kh * 16 + 4 * kk + r) * 64 + 16 * et + ti] = acc[r];
        }
        __syncthreads();
#pragma unroll 1
        for (int q = 0; q < 2; ++q) {
            const int tl = 2 * wave + q, tw = pass * 16 + tl;
            const float lg = PART[tl * 64 + lane] + PART[(16 + tl) * 64 + lane];
            const float score = 1.0f / (1.0f + expf(-lg)), biased = score + rb[lane];
            const int grp = lane >> 3;
            float m1 = biased; m1 = fmaxf(m1, __shfl_xor(m1, 1)); m1 = fmaxf(m1, __shfl_xor(m1, 2)); m1 = fmaxf(m1, __shfl_xor(m1, 4));
            const unsigned long long bm = __ballot(biased == m1); const unsigned gb = (unsigned)(bm >> (8 * grp)) & 0xffu; const int first = __builtin_ctz(gb);
            float v2 = ((lane & 7) == first) ? -3.0e38f : biased; float m2 = v2; m2 = fmaxf(m2, __shfl_xor(m2, 1)); m2 = fmaxf(m2, __shfl_xor(m2, 2)); m2 = fmaxf(m2, __shfl_xor(m2, 4));
            const float gs = m1 + m2;
            int grank = 0;
#pragma unroll
            for (int j = 0; j < 8; ++j) { const float gj = __shfl(gs, 8 * j); grank += ((gj > gs) || (gj == gs && j < grp)) ? 1 : 0; }
            const bool gsel = grank < 4;
            const float masked = gsel ? biased : -3.0e38f;
            int rank = 0;
#pragma unroll
            for (int j = 0; j < 64; ++j) { const float vj = __shfl(masked, j); rank += ((vj > masked) || (vj == masked && j < lane)) ? 1 : 0; }
            const bool sel = gsel && (rank < 8);
            const float wsum = wave_sum(sel ? score : 0.f);
            const unsigned long long sm = __ballot(sel);
            if (sel) { const int k = __popcll(sm & ((1ull << lane) - 1ull)); const int li = atomicAdd((int*)&HIST[lane], 1);
                SELE[tw * 8 + k] = lane; SELW[tw * 8 + k] = score / wsum * 2.5f; SELL[tw * 8 + k] = li; }
        }
        __syncthreads();
    }
    if (TID_ < 64) BASE[TID_] = (int)__hip_atomic_fetch_add(F.ctl + CW_CNT + 32 * TID_, (unsigned)HIST[TID_], RLX_AGENT);
    __syncthreads();
    if (TID_ < 256) { const int e = SELE[TID_], pos = BASE[e] + SELL[TID_], tok = tile * 32 + (TID_ >> 3);
        ((int*)(F.ws + WS_TOKLIST))[(size_t)e * T + pos] = tok; ((float*)(F.ws + WS_WLIST))[(size_t)e * T + pos] = SELW[TID_]; ((int*)(F.ws + WS_REC))[tok * 8 + (TID_ & 7)] = e * T + pos; }
    __syncthreads();
    if (TID_ < 64) HIST[TID_] = 0;
    __syncthreads();
    }
}

__device__ __forceinline__ void p7_combine(Frame& F) {
    const int LANE_ = pg8::lane_id(), TID_ = F.wave * 64 + LANE_; (void)TID_;
    const LAS int* tab = (const LAS int*)(F.lds + TAB_OFF);
    const bf16* Y = (const bf16*)(F.ws + WS_Y); const bf16* PP = (const bf16*)(F.ws + WS_PPROJ); const int* rec = (const int*)(F.ws + WS_REC);
    float* H = F.out; bf16* H2 = (bf16*)(F.ws + WS_H2BF); float* rstdp = (float*)(F.ws + WS_RSTDP);
    const int gw = F.bx * NWAVES + F.wave, NGW = F.G * NWAVES, lane = LANE_;
    for (int t = gw; t < T; t += NGW) {
        int rows[9];
#pragma unroll
        for (int k = 0; k < 8; ++k) { const int rc = rec[t * 8 + k]; const int e = rc >> 13, pos = rc & (T - 1); rows[k] = tab[TB_PAD + e] + pos; }
        rows[8] = SH_ROW0 + t;
        float ps = 0.f;
#pragma unroll
        for (int j = 0; j < 4; ++j) {
            const int c0 = 512 * j + 8 * lane;
            f32x4 a = *(const f32x4*)(H + (size_t)t * D + c0), b = *(const f32x4*)(H + (size_t)t * D + c0 + 4);
#pragma unroll
            for (int k = 0; k < 9; ++k) { const v4u y = *(const v4u*)(Y + (size_t)rows[k] * D + c0);
                a[0] += bf_lo(y.x); a[1] += bf_hi(y.x); a[2] += bf_lo(y.y); a[3] += bf_hi(y.y); b[0] += bf_lo(y.z); b[1] += bf_hi(y.z); b[2] += bf_lo(y.w); b[3] += bf_hi(y.w); }
            *(f32x4*)(H + (size_t)t * D + c0) = a; *(f32x4*)(H + (size_t)t * D + c0 + 4) = b;
            v4u o; o.x = pk2(a[0], a[1]); o.y = pk2(a[2], a[3]); o.z = pk2(b[0], b[1]); o.w = pk2(b[2], b[3]);
            *(v4u*)(H2 + (size_t)t * D + c0) = o;
            const v4u pw = *(const v4u*)(PP + (size_t)t * D + c0);
            const float p0 = bf_lo(pw.x), p1 = bf_hi(pw.x), p2 = bf_lo(pw.y), p3 = bf_hi(pw.y), p4 = bf_lo(pw.z), p5 = bf_hi(pw.z), p6 = bf_lo(pw.w), p7 = bf_hi(pw.w);
            ps += (p0 * p0 + p1 * p1) + (p2 * p2 + p3 * p3) + (p4 * p4 + p5 * p5) + (p6 * p6 + p7 * p7);
        }
        ps = wave_sum(ps);
        if (lane == 0) rstdp[t] = 1.0f / sqrtf(ps * (1.0f / D) + EPS);
    }
}
__device__ __forceinline__ void p9_final(Frame& F) {
    const int LANE_ = pg8::lane_id(), TID_ = F.wave * 64 + LANE_; (void)TID_;
    const int gw = F.bx * NWAVES + F.wave, NGW = F.G * NWAVES, lane = LANE_; const float* g = fin(F, I_GFINAL);
    for (int t = gw; t < T; t += NGW) {
        float* row = F.out + (size_t)t * D; f32x4 v[8]; float s = 0.f;
#pragma unroll
        for (int j = 0; j < 4; ++j) { v[2 * j] = *(const f32x4*)(row + 512 * j + 8 * lane); v[2 * j + 1] = *(const f32x4*)(row + 512 * j + 8 * lane + 4); }
#pragma unroll
        for (int j = 0; j < 8; ++j) s += (v[j][0] * v[j][0] + v[j][1] * v[j][1]) + (v[j][2] * v[j][2] + v[j][3] * v[j][3]);
        const float rstd = 1.0f / sqrtf(wave_sum(s) * (1.0f / D) + EPS);
#pragma unroll
        for (int j = 0; j < 4; ++j) { const f32x4 g0 = *(const f32x4*)(g + 512 * j + 8 * lane), g1 = *(const f32x4*)(g + 512 * j + 8 * lane + 4);
            *(f32x4*)(row + 512 * j + 8 * lane) = v[2 * j] * rstd * g0; *(f32x4*)(row + 512 * j + 8 * lane + 4) = v[2 * j + 1] * rstd * g1; }
    }
}

__global__ void __launch_bounds__(NWAVES * 64, 2) fwd_kernel(Args args) {
    extern __shared__ __attribute__((aligned(16))) unsigned char lds[];
    Frame F;
    F.lds = (LAS unsigned char*)lds;
    F.MISC = (volatile LAS unsigned*)(F.lds + MISC_OFF);
    F.wave = __builtin_amdgcn_readfirstlane(threadIdx.x >> 6);
    F.G = gridDim.x; F.bx = blockIdx.x;
    F.ws = args.ws; F.ctl = (gu32*)(args.ws + WS_CTL); F.out = args.out;
    { const int TID_ = threadIdx.x;
    if (TID_ < 64) F.MISC[TID_] = 0u;
    if (TID_ >= 64 && TID_ < 64 + 22) ((LAS unsigned long long*)(F.lds + MISC_OFF + 256))[TID_ - 64] = ((const unsigned long long*)&args)[TID_ - 64]; }
    __syncthreads();
    XcdBarrier bar; bar.bar = (unsigned*)(F.ctl + CW_BAR); bar.x = 0; bar.st = nullptr;
    if (N_LAUNCHES == 1) bar = xcd_barrier_post((unsigned*)(F.ctl + CW_BAR), F.MISC + 8);
#define GRID_BAR() do { if (N_LAUNCHES == 1) xcd_barrier(bar); } while (0)
    const int lo = args.ph_lo, hi = args.ph_hi;
#ifndef PH_MASK
#define PH_MASK 0x3ff
#endif
#define IN(k) ((((PH_MASK) >> (k)) & 1) && lo <= (k) && (k) < hi)
#define BOTH(k) (IN(k) && IN((k) + 1))

    if (IN(0)) { p0_prologue(F); if (BOTH(0)) GRID_BAR(); }

    if (IN(1)) {
        { pg8::Gemm g{(const bf16*)(F.ws + WS_ABF), (const bf16*)(F.ws + WS_WIN), D, D, D}; pg8::StaticOrder S; S.init(T, INW, F.G, F.bx);
          EpiInProj E{F.ws};
          pg8::gemm_phase<EpiInProj, pg8::StaticOrder, false>(F.lds + RING_OFF, g, S, E, F.wave); }
        { pg8::Gemm g{(const bf16*)(F.ws + WS_PBF), (const bf16*)(F.ws + WS_WPP), PLE, PLE, PLE}; pg8::StaticOrder S; S.init(T, D, F.G, F.bx);
          EpiBf16Plain E{(bf16*)(F.ws + WS_PPROJ), D, 0, nullptr};
          pg8::gemm_phase<EpiBf16Plain, pg8::StaticOrder, false>(F.lds + RING_OFF, g, S, E, F.wave); }
        if (BOTH(1)) GRID_BAR();
    }

    if (IN(2)) {
        LAS float* btab = (LAS float*)(F.lds + TAB_OFF + 2048);
        const int TID_ = F.wave * 64 + pg8::lane_id();
        for (int blk = F.bx; blk < 256; blk += F.G) {
            const int b = blk >> 6, kvh = (blk >> 5) & 1, qg = blk & 31;
            __syncthreads();
            for (int i = TID_; i < 1024; i += NWAVES * 64) { const int hg = i >> 7, dist = i & 127; btab[i] = fin(F, I_RPE)[t5_bucket(dist) * NH + kvh * 8 + hg]; }
            { LAS bf16* vtl = (LAS bf16*)(F.lds + RING_OFF); const bf16* KVp = (const bf16*)(F.ws + WS_KV);
              for (int idx = TID_; idx < VT_KEYS * 8; idx += NWAVES * 64) { const int kl = idx >> 3, c = idx & 7, key = 64 * qg - 128 + kl;
                  v4u v = (v4u){0u, 0u, 0u, 0u}; if (key >= 0 && key < SEQ) v = *(const v4u*)(KVp + (size_t)(b * SEQ + key) * (2 * KVW) + KVW + kvh * 64 + 8 * c);
                  LAS bf16* d0 = vtl + (8 * c) * VT_LD + kl;
                  d0[0 * VT_LD] = (bf16)(v.x & 0xffffu); d0[1 * VT_LD] = (bf16)(v.x >> 16); d0[2 * VT_LD] = (bf16)(v.y & 0xffffu); d0[3 * VT_LD] = (bf16)(v.y >> 16);
                  d0[4 * VT_LD] = (bf16)(v.z & 0xffffu); d0[5 * VT_LD] = (bf16)(v.z >> 16); d0[6 * VT_LD] = (bf16)(v.w & 0xffffu); d0[7 * VT_LD] = (bf16)(v.w >> 16); } }
            __syncthreads();
#pragma unroll 1
            for (int i = 0; i < 4; ++i) attn_task(F, btab, (const LAS bf16*)(F.lds + RING_OFF), b, kvh, F.wave, 4 * qg + i);
        }
        for (int p = F.bx; p < 128; p += F.G) { __syncthreads(); pool_task(F, p >> 2, p & 3); }
        if (BOTH(2)) GRID_BAR();
    }

    if (IN(3)) {
        pg8::Gemm g{(const bf16*)(F.ws + WS_MIX), (const bf16*)(F.ws + WS_WOUT), D, D, D}; pg8::StaticOrder S; S.init(T, D, F.G, F.bx);
        EpiResF32 E{fin(F, I_X), F.out};
        pg8::gemm_phase<EpiResF32, pg8::StaticOrder, false>(F.lds + RING_OFF, g, S, E, F.wave);
        if (BOTH(3)) GRID_BAR();
    }

    if (IN(4)) { p4_route(F); if (BOTH(4)) GRID_BAR(); }

    if (IN(5)) {
        moe_tables(F);
        pg8::Gemm g{(const bf16*)(F.ws + WS_XN), (const bf16*)(F.ws + WS_WGU), D, D, D};
        MoeOrder S{(const LAS int*)(F.lds + TAB_OFF), (const int*)(F.ws + WS_TOKLIST), F.bx & 7, F.bx >> 3, 4, F.G >> 3};
        EpiGateUp E{(bf16*)(F.ws + WS_ACT)};
        pg8::gemm_phase<EpiGateUp, MoeOrder, true>(F.lds + RING_OFF, g, S, E, F.wave);
        if (BOTH(5)) GRID_BAR();
    }

    if (IN(6)) {
        if (!IN(5)) moe_tables(F);
        pg8::Gemm g{(const bf16*)(F.ws + WS_ACT), (const bf16*)(F.ws + WS_WD), EFF, EFF, EFF};
        MoeOrder S{(const LAS int*)(F.lds + TAB_OFF), (const int*)(F.ws + WS_TOKLIST), F.bx & 7, F.bx >> 3, 8, F.G >> 3};
        EpiDown E{(bf16*)(F.ws + WS_Y), (const float*)(F.ws + WS_WLIST), (const LAS int*)(F.lds + TAB_OFF)};
        pg8::gemm_phase<EpiDown, MoeOrder, false>(F.lds + RING_OFF, g, S, E, F.wave);
        if (BOTH(6)) GRID_BAR();
    }

    if (IN(7)) { if (!IN(6)) moe_tables(F); p7_combine(F); if (BOTH(7)) GRID_BAR(); }

    if (IN(8)) {
        pg8::Gemm g{(const bf16*)(F.ws + WS_H2BF), (const bf16*)(F.ws + WS_WPG), D, D, D}; pg8::StaticOrder S; S.init(T, D, F.G, F.bx);
        EpiPleGate E{F.out, (const bf16*)(F.ws + WS_PPROJ), (const float*)(F.ws + WS_RSTDP), fin(F, I_GPLE)};
        pg8::gemm_phase<EpiPleGate, pg8::StaticOrder, false>(F.lds + RING_OFF, g, S, E, F.wave);
        if (BOTH(8)) GRID_BAR();
    }

    if (IN(9)) p9_final(F);
#undef IN
#undef BOTH
}

extern "C" void kernel_launch(void* const* d_in, const int* in_sizes, int n_in, void* d_out, int out_size, void* d_ws, size_t ws_size, hipStream_t stream) {
    static int grid = 0;
    if (grid == 0) {
        if (n_in != 22 || out_size != T * D || ws_size < WS_END) { fprintf(stderr, "kernel_launch: unexpected sizes n_in %d out %d ws %zu (need %zu)\n", n_in, out_size, ws_size, (size_t)WS_END); grid = -1; return; }
        int dev = 0, cus = 0, per_cu = 0;
        if (hipGetDevice(&dev) != hipSuccess || hipDeviceGetAttribute(&cus, hipDeviceAttributeMultiprocessorCount, dev) != hipSuccess) { grid = -1; return; }
        if (hipFuncSetAttribute((const void*)fwd_kernel, hipFuncAttributeMaxDynamicSharedMemorySize, LDS_BYTES) != hipSuccess) { fprintf(stderr, "kernel_launch: hipFuncSetAttribute failed\n"); grid = -1; return; }
        if (hipOccupancyMaxActiveBlocksPerMultiprocessor(&per_cu, (const void*)fwd_kernel, NWAVES * 64, LDS_BYTES) != hipSuccess || per_cu < 1) fprintf(stderr, "kernel_launch: occupancy query reports %d\n", per_cu);
        (void)hipGetLastError();
        grid = cus > 256 ? 256 : cus;
    }
    if (grid < 0) return;
    if (hipMemsetAsync((char*)d_ws + WS_CTL, 0, CTL_ZERO_BYTES, stream) != hipSuccess) return;
    Args a{};
    for (int i = 0; i < 22; ++i) a.in[i] = (const float*)d_in[i];
    a.out = (float*)d_out; a.ws = (unsigned char*)d_ws;
    for (int li = 0; li < N_LAUNCHES; ++li) {
        a.ph_lo = (N_LAUNCHES == 1) ? 0 : li; a.ph_hi = (N_LAUNCHES == 1) ? N_PHASES : li + 1; a.li = li;
        hipLaunchKernelGGL(fwd_kernel, dim3(grid), dim3(NWAVES * 64), LDS_BYTES, stream, a);
    }
}
```

```cpp
#include <hip/hip_runtime.h>
#include <cstdio>
#include <cstdint>

#ifndef MK_N_LAUNCHES
#define MK_N_LAUNCHES 1
#endif

namespace pg8 {
#define PG8_LAS __attribute__((address_space(3)))
typedef unsigned short bf16_t;
typedef short bf16x8 __attribute__((ext_vector_type(8)));
typedef float f32x4 __attribute__((ext_vector_type(4)));
typedef unsigned u32x4 __attribute__((ext_vector_type(4)));
typedef unsigned u32x2 __attribute__((ext_vector_type(2)));
constexpr int BM = 256, BK = 64, HALF = 128, HTB = HALF * BK * 2  , STAGE_BYTES = 8 * HTB, NXCD = 8, WGM = 8;

__host__ __device__ __forceinline__ int lds_byte(int r, int c) { const int st = (r >> 4) * 2 + (c >> 5), rr = r & 15, cc = c & 31, ob = rr * 64 + cc * 2; return st * 1024 + (ob ^ (((ob >> 9) & 1) << 5)); }
__host__ __device__ __forceinline__ void stage_rc(int b, int& R, int& C) { const int st = b / 1024, sb = b % 1024, swz = sb ^ (((sb >> 9) & 1) << 5); R = (st >> 1) * 16 + swz / 64; C = (st & 1) * 32 + (swz % 64) / 2; }
__host__ __device__ __forceinline__ int perm32(int rho) { const int n = rho >> 4, i = rho & 15; return 8 * (i >> 2) + 4 * n + (i & 3); }

struct Unit { int pm, pn, e, lt; };
struct Gemm { const void* A; const void* Bt; int lda, ldb, K; };
typedef int i32x8 __attribute__((ext_vector_type(8)));
typedef int i32x4 __attribute__((ext_vector_type(4)));
__device__ __forceinline__ i32x8 cat8(bf16x8 lo, bf16x8 hi) { const i32x4 a = __builtin_bit_cast(i32x4, lo), b = __builtin_bit_cast(i32x4, hi); return __builtin_shufflevector(a, b, 0, 1, 2, 3, 4, 5, 6, 7); }

struct StaticOrder {
    int nM, nN, nwg, G, c;
    __host__ __device__ void init(int M, int N, int G_, int c_) { nM = M / BM; nN = N / BM; nwg = nM * nN; G = G_; c = c_; }
    __host__ __device__ bool next(int i, Unit& u) const {
        const long L = (long)i * G + c; if (L >= nwg) return false;
        int wgid = (int)L; { const int q = nwg / NXCD, r = nwg % NXCD, xcd = wgid % NXCD, off = wgid / NXCD; wgid = (xcd < r ? xcd * (q + 1) : r * (q + 1) + (xcd - r) * q) + off; }
        const int nig = WGM * nN, gid = wgid / nig, fm = gid * WGM, gsz = (nM - fm) < WGM ? (nM - fm) : WGM;
        u.pm = fm + ((wgid % nig) % gsz); u.pn = (wgid % nig) / gsz; u.e = 0; u.lt = 0; return true;
    }
    __device__ __forceinline__ int arow(const Unit&, int r) const { return r; }
};
struct SingleOrder {
    int pm, pn;
    __device__ bool next(int i, Unit& u) const { if (i > 0) return false; u.pm = pm; u.pn = pn; u.e = 0; u.lt = 0; return true; }
    __device__ __forceinline__ int arow(const Unit&, int r) const { return r; }
};

__device__ __forceinline__ int lane_id() { int l; asm volatile("v_mbcnt_lo_u32_b32 %0, -1, 0\n\tv_mbcnt_hi_u32_b32 %0, -1, %0" : "=v"(l)); return l; }
__device__ __forceinline__ unsigned cvt_pk_bf16(float lo, float hi) { unsigned r; asm volatile("v_cvt_pk_bf16_f32 %0, %1, %2" : "=v"(r) : "v"(lo), "v"(hi)); return r; }

template <class Epi, class Sched, bool GATHER, int ESZ = 2, bool ALIGN_EPI = true>
__device__ __forceinline__ void gemm_phase(PG8_LAS unsigned char* lds, const Gemm g, const Sched& S, const Epi& E, int wid) {
    const int lane = lane_id(), tid = wid * 64 + lane, wr = wid >> 2, wc = wid & 3, fr = lane & 15, fq = lane >> 4;
    const int nt = (g.K * ESZ) / 128;
    int Ra[2], Ca[2]; unsigned voffB[2];
#pragma unroll
    for (int i = 0; i < 2; ++i) { int R, C; stage_rc(tid * 16 + i * 8192, R, C); const int Rb = Epi::PERM ? ((R & ~31) + perm32(R & 31)) : R;
        Ra[i] = R; Ca[i] = C; voffB[i] = (unsigned)(Rb * g.ldb * ESZ + C * 2); }
    const size_t kstep = (size_t)(BK * 2);
    const size_t hstepB = (size_t)HALF * g.ldb * ESZ, tstepB = 2 * hstepB;
    const size_t tstepA = (size_t)BM * g.lda * ESZ;
    const unsigned ldsw = (unsigned)wid * 1024u;
    const int aoff = lds_byte(wr * 64 + fr, fq * 8), boff = lds_byte(wc * 32 + fr, fq * 8);
#define PG8_SA(b, h) (((b) * 2 + (h)) * HTB)
#define PG8_SB(b, h) ((4 + (b) * 2 + (h)) * HTB)
#define PG8_STAGE(bufoff, gbase, v0, v1) do { \
        __builtin_amdgcn_global_load_lds((const unsigned*)((const char*)(gbase) + (v0)), (PG8_LAS unsigned*)(lds + (bufoff) + ldsw), 16, 0, 0); \
        __builtin_amdgcn_global_load_lds((const unsigned*)((const char*)(gbase) + (v1)), (PG8_LAS unsigned*)(lds + (bufoff) + ldsw + 8192), 16, 0, 0); } while (0)
#define PG8_STAGE_A0(bufoff, gbase, p0, p1) PG8_STAGE(bufoff, gbase, p0, p1)
#define PG8_STAGE_A1(bufoff, gbase, p0, p1, q0, q1) do { if constexpr (GATHER) { PG8_STAGE(bufoff, gbase, q0, q1); } else { PG8_STAGE(bufoff, (gbase) + hstepA, p0, p1); } } while (0)
#define PG8_LD16(off) (*(const PG8_LAS i32x4*)(lds + (off)))
#define PG8_LDA(dst, b, h) do { if constexpr (ESZ == 2) { _Pragma("unroll") for (int m = 0; m < 4; ++m) _Pragma("unroll") for (int k = 0; k < 2; ++k) dst[m][k] = *(const PG8_LAS bf16x8*)(lds + PG8_SA(b, h) + aoff + m * 2048 + k * 1024); } \
        else { _Pragma("unroll") for (int m = 0; m < 4; ++m) dst##8[m] = __builtin_shufflevector(PG8_LD16(PG8_SA(b, h) + aoff + m * 2048), PG8_LD16(PG8_SA(b, h) + aoff + m * 2048 + 1024), 0, 1, 2, 3, 4, 5, 6, 7); } } while (0)
#define PG8_LDB(dst, b, h) do { if constexpr (ESZ == 2) { _Pragma("unroll") for (int n = 0; n < 2; ++n) _Pragma("unroll") for (int k = 0; k < 2; ++k) dst[n][k] = *(const PG8_LAS bf16x8*)(lds + PG8_SB(b, h) + boff + n * 2048 + k * 1024); } \
        else { _Pragma("unroll") for (int n = 0; n < 2; ++n) dst##8[n] = __builtin_shufflevector(PG8_LD16(PG8_SB(b, h) + boff + n * 2048), PG8_LD16(PG8_SB(b, h) + boff + n * 2048 + 1024), 0, 1, 2, 3, 4, 5, 6, 7); } } while (0)
#define PG8_MMA(ai, bj, At, Bt) do { __builtin_amdgcn_s_setprio(1); \
        if constexpr (ESZ == 2) { _Pragma("unroll") for (int m = 0; m < 4; ++m) _Pragma("unroll") for (int n = 0; n < 2; ++n) _Pragma("unroll") for (int k = 0; k < 2; ++k) \
            acc[ai][bj][m][n] = __builtin_amdgcn_mfma_f32_16x16x32_bf16(Bt[n][k], At[m][k], acc[ai][bj][m][n], 0, 0, 0); } \
        else { _Pragma("unroll") for (int m = 0; m < 4; ++m) _Pragma("unroll") for (int n = 0; n < 2; ++n) \
            asm volatile("v_mfma_scale_f32_16x16x128_f8f6f4 %0, %1, %2, %0, %3, %3 op_sel_hi:[0,0,0]" : "+v"(acc[ai][bj][m][n]) : "v"(Bt##8[n]), "v"(At##8[m]), "v"(sc1)); } \
        __builtin_amdgcn_s_setprio(0); } while (0)
#define PG8_WAIT_V(n) asm volatile("s_waitcnt vmcnt(" #n ")" ::: "memory")
#define PG8_WAIT_L(n) asm volatile("s_waitcnt lgkmcnt(" #n ")" ::: "memory")
#define PG8_BAR __builtin_amdgcn_s_barrier()
#define PG8_SCHED __builtin_amdgcn_sched_barrier(0)
    Unit cur, nxt; int ui = 0;
    if (!S.next(0, cur)) return;
    f32x4 acc[2][2][4][2];
#pragma unroll
    for (int a = 0; a < 2; ++a)
#pragma unroll
        for (int b = 0; b < 2; ++b)
#pragma unroll
            for (int m = 0; m < 4; ++m)
#pragma unroll
                for (int n = 0; n < 2; ++n) acc[a][b][m][n] = (f32x4){0.f, 0.f, 0.f, 0.f};
    const int sc1 = 0x7F7F7F7F;
    bf16x8 At[4][2], B0[2][2], B1[2][2]; i32x8 At8[4], B08[2], B18[2];
    unsigned vA00, vA01, vA10, vA11, nA00, nA01, nA10, nA11;
    const size_t hstepA = GATHER ? (size_t)0 : (size_t)HALF * g.lda * ESZ;
    if constexpr (GATHER) {
        vA00 = (unsigned)(S.arow(cur, Ra[0]) * g.lda * ESZ + Ca[0] * 2); vA01 = (unsigned)(S.arow(cur, Ra[1]) * g.lda * ESZ + Ca[1] * 2);
        vA10 = (unsigned)(S.arow(cur, HALF + Ra[0]) * g.lda * ESZ + Ca[0] * 2); vA11 = (unsigned)(S.arow(cur, HALF + Ra[1]) * g.lda * ESZ + Ca[1] * 2);
    } else {
        vA00 = (unsigned)(Ra[0] * g.lda * ESZ + Ca[0] * 2); vA01 = (unsigned)(Ra[1] * g.lda * ESZ + Ca[1] * 2); vA10 = 0; vA11 = 0;
    }
    nA00 = vA00; nA01 = vA01; nA10 = vA10; nA11 = vA11;
    const char* cA = (const char*)g.A + (GATHER ? (size_t)0 : (size_t)cur.pm * tstepA); const char* cB = (const char*)g.Bt + (size_t)cur.pn * tstepB;
    PG8_STAGE(PG8_SB(0, 0), cB, voffB[0], voffB[1]); PG8_STAGE(PG8_SB(0, 1), cB + hstepB, voffB[0], voffB[1]); PG8_STAGE_A0(PG8_SA(0, 0), cA, vA00, vA01); PG8_STAGE_A1(PG8_SA(0, 1), cA, vA00, vA01, vA10, vA11);
    if (wr == 1) PG8_BAR;
    PG8_WAIT_V(2); PG8_BAR;
    PG8_STAGE(PG8_SB(1, 0), cB + kstep, voffB[0], voffB[1]); PG8_STAGE_A0(PG8_SA(1, 0), cA + kstep, vA00, vA01); PG8_STAGE(PG8_SB(1, 1), cB + hstepB + kstep, voffB[0], voffB[1]);
    PG8_WAIT_V(6); PG8_BAR;
    for (;;) {
        const bool has_next = S.next(ui + 1, nxt);
        const char* nA = has_next ? (const char*)g.A + (GATHER ? (size_t)0 : (size_t)nxt.pm * tstepA) : cA; const char* nB = has_next ? (const char*)g.Bt + (size_t)nxt.pn * tstepB : cB;
        if constexpr (GATHER) {
            if (has_next) {
                nA00 = (unsigned)(S.arow(nxt, Ra[0]) * g.lda * ESZ + Ca[0] * 2); nA01 = (unsigned)(S.arow(nxt, Ra[1]) * g.lda * ESZ + Ca[1] * 2);
                nA10 = (unsigned)(S.arow(nxt, HALF + Ra[0]) * g.lda * ESZ + Ca[0] * 2); nA11 = (unsigned)(S.arow(nxt, HALF + Ra[1]) * g.lda * ESZ + Ca[1] * 2);
            } else { nA00 = vA00; nA01 = vA01; nA10 = vA10; nA11 = vA11; }
        }
#pragma nounroll
        for (int t = 0; t < nt; t += 2) {
            const bool last = (t == nt - 2);
            const char* a1 = cA + (size_t)(t + 1) * kstep;
            const char* a2 = last ? nA : cA + (size_t)(t + 2) * kstep; const char* b2 = last ? nB : cB + (size_t)(t + 2) * kstep;
            const char* a3 = a2 + kstep; const char* b3 = b2 + kstep;
            asm volatile("" : "+v"(voffB[0]), "+v"(voffB[1]), "+v"(vA00), "+v"(vA01));
            if constexpr (GATHER) asm volatile("" : "+v"(vA10), "+v"(vA11));
            unsigned x00 = vA00, x01 = vA01, x10 = vA10, x11 = vA11;
            if constexpr (GATHER) { if (last) { x00 = nA00; x01 = nA01; x10 = nA10; x11 = nA11; } }
            PG8_LDB(B0, 0, 0); PG8_LDB(B1, 0, 1); PG8_SCHED; PG8_LDA(At, 0, 0); PG8_STAGE_A1(PG8_SA(1, 1), a1, vA00, vA01, vA10, vA11);
            PG8_WAIT_V(8); PG8_WAIT_L(0); PG8_BAR; PG8_MMA(0, 0, At, B0); PG8_MMA(0, 1, At, B1); PG8_BAR; PG8_SCHED;
            PG8_LDA(At, 0, 1); PG8_STAGE(PG8_SB(0, 0), b2, voffB[0], voffB[1]); PG8_STAGE(PG8_SB(0, 1), b2 + hstepB, voffB[0], voffB[1]); PG8_STAGE_A0(PG8_SA(0, 0), a2, x00, x01);
            PG8_WAIT_V(8); PG8_WAIT_L(0); PG8_BAR; PG8_MMA(1, 0, At, B0); PG8_MMA(1, 1, At, B1); PG8_BAR; PG8_SCHED;
            PG8_LDB(B0, 1, 0); PG8_LDB(B1, 1, 1); PG8_SCHED; PG8_LDA(At, 1, 0); PG8_STAGE_A1(PG8_SA(0, 1), a2, x00, x01, x10, x11);
            PG8_WAIT_V(8); PG8_WAIT_L(0); PG8_BAR; PG8_MMA(0, 0, At, B0); PG8_MMA(0, 1, At, B1); PG8_BAR; PG8_SCHED;
            PG8_LDA(At, 1, 1); PG8_STAGE(PG8_SB(1, 0), b3, voffB[0], voffB[1]); PG8_STAGE(PG8_SB(1, 1), b3 + hstepB, voffB[0], voffB[1]); PG8_STAGE_A0(PG8_SA(1, 0), a3, x00, x01);
            PG8_WAIT_V(8); PG8_WAIT_L(0); PG8_BAR; PG8_MMA(1, 0, At, B0); PG8_MMA(1, 1, At, B1); PG8_BAR; PG8_SCHED;
        }
        if constexpr (ALIGN_EPI) { if (wr == 0) PG8_BAR; }
        if constexpr (ESZ == 1) asm volatile("s_nop 15\n\ts_nop 15" ::: "memory");
        E(acc, cur, wr, wc, fr, fq);
        if (!has_next) break;
#pragma unroll
        for (int a = 0; a < 2; ++a)
#pragma unroll
            for (int b = 0; b < 2; ++b)
#pragma unroll
                for (int m = 0; m < 4; ++m)
#pragma unroll
                    for (int n = 0; n < 2; ++n) acc[a][b][m][n] = (f32x4){0.f, 0.f, 0.f, 0.f};
        cur = nxt; cA = nA; cB = nB; ++ui;
        if constexpr (GATHER) { vA00 = nA00; vA01 = nA01; vA10 = nA10; vA11 = nA11; }
        if constexpr (ALIGN_EPI) { if (wr == 1) PG8_BAR; }
    }
    PG8_WAIT_V(0);
    if constexpr (!ALIGN_EPI) { if (wr == 0) PG8_BAR; }
    PG8_BAR;
#undef PG8_SA
#undef PG8_SB
#undef PG8_STAGE
#undef PG8_LDA
#undef PG8_LD16
#undef PG8_STAGE_A0
#undef PG8_STAGE_A1
#undef PG8_LDB
#undef PG8_MMA
#undef PG8_WAIT_V
#undef PG8_WAIT_L
#undef PG8_BAR
#undef PG8_SCHED
}
}

constexpr int NWAVES = 8;
constexpr int T = 8192, SEQ = 2048, NB = 4, D = 2048, INW = 2304, POOLW = 1024, NH = 16, NKV = 2, HD = 64, KVW = 128;
constexpr int NE = 64, TOPK = 8, EFF = 512, PLE = 256;
constexpr int SH_ROW0 = T * TOPK + NE * 256;
constexpr int NROWS = SH_ROW0 + T;
constexpr float EPS = 1e-6f;
constexpr float SW1 = 32.0f, SW2 = 16.0f, SA = 4.0f;
constexpr int N_PHASES = 10;
constexpr int N_LAUNCHES = MK_N_LAUNCHES;

constexpr size_t MiB = 1u << 20;
constexpr size_t WS_CTL = 0, CTL_ZERO_BYTES = 64 * 1024;
constexpr size_t WS_MISC = 1 * MiB;
constexpr size_t WS_TOKLIST = WS_MISC;
constexpr size_t WS_REC = WS_TOKLIST + (size_t)NE * T * 4;
constexpr size_t WS_WREC = WS_REC + (size_t)T * TOPK * 4;
constexpr size_t WS_RSTDP = WS_WREC + (size_t)T * TOPK * 4;
constexpr size_t WS_PBF = 6 * MiB;
constexpr size_t WS_WIN = 12 * MiB;
constexpr size_t WS_WPOOL = WS_WIN + (size_t)INW * D * 2;
constexpr size_t WS_WOUT = WS_WPOOL + (size_t)4 * 256 * 256 * 2;
constexpr size_t WS_WPP = WS_WOUT + (size_t)D * D * 2;
constexpr size_t WS_WPG = WS_WPP + (size_t)D * PLE * 2;
constexpr size_t WS_WGU = WS_WPG + (size_t)D * D * 2;
constexpr size_t WS_WD = WS_WGU + (size_t)65 * 1024 * D;
constexpr size_t WS_XN = WS_WD + (size_t)65 * D * EFF;
constexpr size_t WS_PPROJ = WS_XN + (size_t)T * D * 2;
constexpr size_t WS_ACT = WS_PPROJ + (size_t)T * D * 2;
constexpr size_t WS_H2BF = WS_ACT;
constexpr size_t WS_Y = WS_ACT + (size_t)NROWS * EFF * 2;
constexpr size_t WS_ABF = WS_Y;
constexpr size_t WS_UBF = WS_ABF + (size_t)T * D * 2;
constexpr size_t WS_QBF = WS_UBF + (size_t)T * POOLW * 2;
constexpr size_t WS_KV = WS_QBF + (size_t)T * 1024 * 2;
constexpr size_t WS_POOLED = WS_KV + (size_t)T * 2 * KVW * 2;
constexpr size_t WS_MIX = WS_POOLED + (size_t)T * POOLW * 2;
constexpr size_t WS_END = WS_Y + (size_t)NROWS * D * 2;
static_assert(WS_MIX + (size_t)T * D * 2 <= WS_END, "early activations fit under Y");
static_assert(WS_RSTDP + (size_t)T * 4 <= WS_PBF && WS_PBF + (size_t)T * PLE * 2 <= WS_WIN, "misc fits");
static_assert(WS_END <= (size_t)1024 * MiB, "workspace must fit 1 GiB");
constexpr int CW_BAR = 1024;
constexpr int CW_CNT = 8192;
static_assert((CW_CNT + 32 * NE) * 4 <= (int)CTL_ZERO_BYTES, "CTL words inside the memset region");

constexpr int RING_OFF = 0, RING_BYTES = 131072;
constexpr int LDS_BYTES = 163840;
constexpr int MISC_OFF = LDS_BYTES - 512;
constexpr int TAB_OFF = RING_BYTES;
constexpr int TB_CNT = 0, TB_PAD = 80, TB_XCUM = 160;

#define GAS __attribute__((address_space(1)))
#define LAS __attribute__((address_space(3)))
typedef unsigned short bf16;
typedef unsigned v4u __attribute__((ext_vector_type(4)));
typedef unsigned v2u __attribute__((ext_vector_type(2)));
typedef float f32x4 __attribute__((ext_vector_type(4)));
typedef short bf16x8 __attribute__((ext_vector_type(8)));
typedef GAS unsigned gu32;
#define RLX_AGENT __ATOMIC_RELAXED, __HIP_MEMORY_SCOPE_AGENT
#define LDS_WAIT() asm volatile("s_waitcnt lgkmcnt(0)" ::: "memory")
#define VM_WAIT() asm volatile("s_waitcnt vmcnt(0)" ::: "memory")
__device__ __forceinline__ unsigned pk2(float lo, float hi) { return pg8::cvt_pk_bf16(lo, hi); }
__device__ __forceinline__ float bf_lo(unsigned w) { return __builtin_bit_cast(float, w << 16); }
__device__ __forceinline__ float bf_hi(unsigned w) { return __builtin_bit_cast(float, w & 0xffff0000u); }

#define XB_TMO      128
#define XB_XCNT(j)  (256  + 64 * (j))
#define XB_XSUB(j)  (1280 + 64 * (j))
#define XB_XGEN(j)  (2304 + 64 * (j))
#define XB_TOP      3328
#define XB_TOPGEN   3392
#define XCD_BAR_WORDS 3456
#define XB_SPIN_CAP (1u << 18)
__device__ __forceinline__ unsigned xb_ld(unsigned* p)              { return __hip_atomic_load(p, __ATOMIC_RELAXED, __HIP_MEMORY_SCOPE_AGENT); }
__device__ __forceinline__ unsigned xb_add(unsigned* p, unsigned v) { return __hip_atomic_fetch_add(p, v, __ATOMIC_RELAXED, __HIP_MEMORY_SCOPE_AGENT); }
__device__ __forceinline__ unsigned xb_xcc_id() { return (unsigned)__builtin_amdgcn_s_getreg((3 << 11) | 20) & 0xFu; }
#define XB_SPIN(cond, bar) do { unsigned _sp = 0; while (cond) { __builtin_amdgcn_s_sleep(1); \
    if ((++_sp & 255u) == 0u) { if (xb_ld(&(bar)[XB_TMO])) break; if (_sp > XB_SPIN_CAP) { atomicAdd(&(bar)[XB_TMO], 1u); break; } } } } while (0)
struct XcdBarrier { unsigned* bar; unsigned x; volatile LAS unsigned* st; };
__device__ __forceinline__ XcdBarrier xcd_barrier_post(unsigned* bar, volatile LAS unsigned* st) {
    XcdBarrier b; b.bar = bar; b.x = xb_xcc_id(); b.st = st;
    if (threadIdx.x == 0) (void)xb_add(&bar[XB_XCNT(b.x)], 1u);
    return b;
}
__device__ __forceinline__ void xcd_barrier_complete(unsigned* bar, unsigned x, unsigned& nloc, unsigned& nx) {
    const unsigned G = gridDim.x * gridDim.y * gridDim.z;
    unsigned sum, cnt, mine, sp = 0u;
    for (;;) {
        sum = 0u; cnt = 0u; mine = 0u;
#pragma unroll
        for (unsigned j = 0; j < 16; ++j) { const unsigned c = xb_ld(&bar[XB_XCNT(j)]); sum += c; cnt += (c > 0u) ? 1u : 0u; mine = (j == x) ? c : mine; }
        if (sum == G) break;
        __builtin_amdgcn_s_sleep(1);
        if ((++sp & 255u) == 0u) { if (xb_ld(&bar[XB_TMO])) break; if (sp > XB_SPIN_CAP) { atomicAdd(&bar[XB_TMO], 1u); break; } }
    }
    nloc = mine > 0u ? mine : 1u; nx = cnt > 0u ? cnt : 1u;
}
__device__ __forceinline__ void xcd_barrier(const XcdBarrier& b) {
    asm volatile("s_waitcnt vmcnt(0)" ::: "memory");
    __syncthreads();
    if (threadIdx.x == 0) {
        unsigned* bar = b.bar;
        __builtin_amdgcn_s_waitcnt(0);
        unsigned nloc = b.st[0], nx = b.st[1];
        if (nloc == 0u) { xcd_barrier_complete(bar, b.x, nloc, nx); b.st[0] = nloc; b.st[1] = nx; }
        const unsigned old = xb_add(&bar[XB_XSUB(b.x)], 1u);
        const unsigned gen = old / nloc;
        if (old + 1u == (gen + 1u) * nloc) {
            __builtin_amdgcn_fence(__ATOMIC_RELEASE, "agent");
            asm volatile("s_waitcnt vmcnt(0)" ::: "memory");
            const unsigned og = xb_add(&bar[XB_TOP], 1u);
            const unsigned tg = og / nx;
            if (og + 1u == (tg + 1u) * nx) xb_add(&bar[XB_TOPGEN], 1u);
            else XB_SPIN(xb_ld(&bar[XB_TOPGEN]) == tg, bar);
            __builtin_amdgcn_fence(__ATOMIC_ACQUIRE, "agent");
            xb_add(&bar[XB_XGEN(b.x)], 1u);
            asm volatile("s_waitcnt vmcnt(0)" ::: "memory");
        } else {
            XB_SPIN(xb_ld(&bar[XB_XGEN(b.x)]) == gen, bar);
            __builtin_amdgcn_fence(__ATOMIC_ACQUIRE, "agent");
            asm volatile("s_waitcnt vmcnt(0)" ::: "memory");
        }
    }
    __syncthreads();
}

struct Args { const float* in[22]; float* out; unsigned char* ws; int ph_lo, ph_hi, li, pad; };
struct Frame {
    LAS unsigned char* lds;
    volatile LAS unsigned* MISC;
    gu32* ctl;
    unsigned char* ws;
    int wave, G, bx;
    float* out;
};
__device__ __forceinline__ const float* fin(const Frame& F, int i) {
    const unsigned long long v = ((const LAS unsigned long long*)(F.lds + MISC_OFF + 256))[i];
    const unsigned lo = __builtin_amdgcn_readfirstlane((unsigned)v), hi = __builtin_amdgcn_readfirstlane((unsigned)(v >> 32));
    return (const float*)(const GAS float*)(((unsigned long long)hi << 32) | lo);
}
enum { I_X = 0, I_P, I_GMIX, I_WIN, I_WPOOL, I_PSCALE, I_SINKS, I_RPE, I_WOUT, I_GFFN, I_WROUTER, I_RBIAS, I_WGATE, I_WUP, I_WDOWN, I_WSGATE, I_WSUP, I_WSDOWN, I_WPLEPROJ, I_GPLE, I_WPLEGATE, I_GFINAL };

__device__ __forceinline__ float wave_sum(float v) {
#pragma unroll
    for (int o = 1; o < 64; o <<= 1) v += __shfl_xor(v, o);
    return v;
}

using pg8::Unit;
struct EpiInProj {
    static constexpr bool PERM = true;
    unsigned char* ws;
    __device__ __forceinline__ void operator()(const f32x4 (&acc)[2][2][4][2], const Unit& u, int wr, int wc, int fr, int fq) const {
        const int row0 = u.pm * 256 + wr * 64 + fr;
        const size_t boff = WS_UBF + (size_t)(u.pn >= 4 ? 1 : 0) * (WS_QBF - WS_UBF) + (size_t)(u.pn >= 8 ? 1 : 0) * (WS_KV - WS_QBF);
        bf16* base = (bf16*)(ws + boff); const int ldc = (u.pn < 8) ? 1024 : 256; const int col0 = (u.pn & 3) * 256 + wc * 32 + 8 * fq;
#pragma unroll
        for (int ai = 0; ai < 2; ++ai)
#pragma unroll
            for (int m = 0; m < 4; ++m) { bf16* rowp = base + (size_t)(row0 + ai * 128 + m * 16) * ldc + col0;
#pragma unroll
                for (int bj = 0; bj < 2; ++bj) { const f32x4 v0 = acc[ai][bj][m][0], v1 = acc[ai][bj][m][1];
                    v4u w; w.x = pk2(v0[0], v0[1]); w.y = pk2(v0[2], v0[3]); w.z = pk2(v1[0], v1[1]); w.w = pk2(v1[2], v1[3]);
                    *(v4u*)(rowp + bj * 128) = w; } }
    }
};
struct EpiBf16Plain {
    static constexpr bool PERM = true;
    bf16* O; int ldc; int col_off; const float* scale;
    __device__ __forceinline__ void operator()(const f32x4 (&acc)[2][2][4][2], const Unit& u, int wr, int wc, int fr, int fq) const {
        const int row0 = u.pm * 256 + wr * 64 + fr, colt = u.pn * 256 + wc * 32 + 8 * fq;
        f32x4 sv[2][2];
#pragma unroll
        for (int bj = 0; bj < 2; ++bj)
#pragma unroll
            for (int n = 0; n < 2; ++n) sv[bj][n] = scale ? *(const f32x4*)(scale + col_off + colt + bj * 128 + 4 * n) : (f32x4){1.f, 1.f, 1.f, 1.f};
#pragma unroll
        for (int ai = 0; ai < 2; ++ai)
#pragma unroll
            for (int m = 0; m < 4; ++m) { bf16* rowp = O + (size_t)(row0 + ai * 128 + m * 16) * ldc + col_off + colt;
#pragma unroll
                for (int bj = 0; bj < 2; ++bj) { const f32x4 v0 = acc[ai][bj][m][0] * sv[bj][0], v1 = acc[ai][bj][m][1] * sv[bj][1];
                    v4u w; w.x = pk2(v0[0], v0[1]); w.y = pk2(v0[2], v0[3]); w.z = pk2(v1[0], v1[1]); w.w = pk2(v1[2], v1[3]);
                    *(v4u*)(rowp + bj * 128) = w; } }
    }
};
struct EpiResF32 {
    static constexpr bool PERM = false;
    const float* base; float* C;
    __device__ __forceinline__ void operator()(const f32x4 (&acc)[2][2][4][2], const Unit& u, int wr, int wc, int fr, int fq) const {
        const int row0 = u.pm * 256 + wr * 64 + fr, col0 = u.pn * 256 + wc * 32 + 4 * fq;
#pragma unroll
        for (int ai = 0; ai < 2; ++ai)
#pragma unroll
            for (int m = 0; m < 4; ++m) { const size_t ro = (size_t)(row0 + ai * 128 + m * 16) * D + col0;
#pragma unroll
                for (int bj = 0; bj < 2; ++bj)
#pragma unroll
                    for (int n = 0; n < 2; ++n) { const f32x4 xb = *(const f32x4*)(base + ro + bj * 128 + n * 16); *(f32x4*)(C + ro + bj * 128 + n * 16) = xb + acc[ai][bj][m][n]; } }
    }
};
__device__ __forceinline__ float sigmoid_f(float v) { return __builtin_amdgcn_rcpf(1.0f + __expf(-v)); }
__device__ __forceinline__ unsigned pk4_fp8(float a, float b, float c, float d) { int w = 0; w = __builtin_amdgcn_cvt_pk_fp8_f32(a, b, w, false); w = __builtin_amdgcn_cvt_pk_fp8_f32(c, d, w, true); return (unsigned)w; }
struct EpiGateUp {
    static constexpr bool PERM = true;
    unsigned char* ACT;
    __device__ __forceinline__ void operator()(const f32x4 (&acc)[2][2][4][2], const Unit& u, int wr, int wc, int fr, int fq) const {
        const int row0 = u.pm * 256 + wr * 64 + fr, col0 = (u.pn & 3) * 128 + wc * 32 + 8 * fq;
        constexpr float IS = 1.0f / SW1;
#pragma unroll
        for (int ai = 0; ai < 2; ++ai)
#pragma unroll
            for (int m = 0; m < 4; ++m) { float o[8];
#pragma unroll
                for (int n = 0; n < 2; ++n)
#pragma unroll
                    for (int j = 0; j < 4; ++j) { const float gte = acc[ai][0][m][n][j] * IS, up = acc[ai][1][m][n][j] * (IS * SA); o[4 * n + j] = gte * sigmoid_f(gte) * up; }
                v2u w; w.x = pk4_fp8(o[0], o[1], o[2], o[3]); w.y = pk4_fp8(o[4], o[5], o[6], o[7]);
                *(v2u*)(ACT + (size_t)(row0 + ai * 128 + m * 16) * EFF + col0) = w; }
    }
};
struct EpiDown {
    static constexpr bool PERM = true;
    bf16* Y;
    __device__ __forceinline__ void operator()(const f32x4 (&acc)[2][2][4][2], const Unit& u, int wr, int wc, int fr, int fq) const {
        const int row0 = u.pm * 256 + wr * 64 + fr, col0 = (u.pn & 7) * 256 + wc * 32 + 8 * fq;
        constexpr float IS = 1.0f / (SA * SW2);
#pragma unroll
        for (int ai = 0; ai < 2; ++ai)
#pragma unroll
            for (int m = 0; m < 4; ++m) { bf16* rowp = Y + (size_t)(row0 + ai * 128 + m * 16) * D + col0;
#pragma unroll
                for (int bj = 0; bj < 2; ++bj) { const f32x4 v0 = acc[ai][bj][m][0] * IS, v1 = acc[ai][bj][m][1] * IS;
                    v4u w; w.x = pk2(v0[0], v0[1]); w.y = pk2(v0[2], v0[3]); w.z = pk2(v1[0], v1[1]); w.w = pk2(v1[2], v1[3]);
                    *(v4u*)(rowp + bj * 128) = w; } }
    }
};
struct EpiPleGate {
    static constexpr bool PERM = false;
    float* H; const bf16* PP; const float* rstdp; const float* gple;
    __device__ __forceinline__ void operator()(const f32x4 (&acc)[2][2][4][2], const Unit& u, int wr, int wc, int fr, int fq) const {
        const int row0 = u.pm * 256 + wr * 64 + fr, col0 = u.pn * 256 + wc * 32 + 4 * fq;
        f32x4 gv[2][2];
#pragma unroll
        for (int bj = 0; bj < 2; ++bj)
#pragma unroll
            for (int n = 0; n < 2; ++n) gv[bj][n] = *(const f32x4*)(gple + col0 + bj * 128 + n * 16);
#pragma unroll
        for (int ai = 0; ai < 2; ++ai)
#pragma unroll
            for (int m = 0; m < 4; ++m) { const int row = row0 + ai * 128 + m * 16; const size_t ro = (size_t)row * D + col0; const float rs = rstdp[row];
#pragma unroll
                for (int bj = 0; bj < 2; ++bj)
#pragma unroll
                    for (int n = 0; n < 2; ++n) { const size_t o = ro + bj * 128 + n * 16; const f32x4 h = *(const f32x4*)(H + o); const v2u pw = *(const v2u*)(PP + o);
                        const f32x4 a = acc[ai][bj][m][n]; const f32x4 g4 = gv[bj][n] * rs; f32x4 r;
                        r[0] = h[0] + sigmoid_f(a[0]) * bf_lo(pw.x) * g4[0]; r[1] = h[1] + sigmoid_f(a[1]) * bf_hi(pw.x) * g4[1];
                        r[2] = h[2] + sigmoid_f(a[2]) * bf_lo(pw.y) * g4[2]; r[3] = h[3] + sigmoid_f(a[3]) * bf_hi(pw.y) * g4[3];
                        *(f32x4*)(H + o) = r; } }
    }
};

struct MoeOrder {
    const LAS int* tab; const int* toklist; int x, r, npn, stride;
    __device__ __forceinline__ bool next(int i, Unit& u) const {
        const int L = i * stride + r; const int tl = L / npn, pn = L - tl * npn;
        if (tl >= tab[TB_XCUM + 9]) return false;
        int s = 0;
#pragma unroll
        for (int q = 1; q <= 8; ++q) s += (tl >= tab[TB_XCUM + q]) ? 1 : 0;
        int lt = tl - tab[TB_XCUM + s], e, row0;
        if (s < 8) { e = x + 8 * s; row0 = tab[TB_PAD + e] + 256 * lt; } else { e = NE; lt = x + 8 * lt; row0 = SH_ROW0 + 256 * lt; }
        u.pm = __builtin_amdgcn_readfirstlane(row0 >> 8); u.pn = __builtin_amdgcn_readfirstlane(e * npn + pn); u.e = __builtin_amdgcn_readfirstlane(e); u.lt = __builtin_amdgcn_readfirstlane(lt); return true;
    }
    __device__ __forceinline__ int arow(const Unit& u, int r_) const {
        const int lr = u.lt * 256 + r_;
        const int ee = (u.e < NE) ? u.e : 0;
        const int tk = toklist[(size_t)ee * T + (lr < T - 1 ? lr : T - 1)];
        return (u.e == NE) ? lr : ((lr < tab[TB_CNT + ee]) ? tk : 0);
    }
};
__device__ __forceinline__ void moe_tables(Frame& F) {
    const int LANE_ = pg8::lane_id(), TID_ = F.wave * 64 + LANE_; (void)TID_;
    LAS int* tab = (LAS int*)(F.lds + TAB_OFF);
    if (TID_ < NE) tab[TB_CNT + TID_] = (int)__hip_atomic_load(F.ctl + CW_CNT + 32 * TID_, RLX_AGENT);
    if (TID_ == NE) tab[TB_CNT + NE] = T;
    __syncthreads();
    if (TID_ == 0) {
        int off = 0;
        for (int e = 0; e < NE; ++e) { tab[TB_PAD + e] = off; off += ((tab[TB_CNT + e] + 255) >> 8) << 8; }
        tab[TB_PAD + NE] = off;
        const int x = F.bx & 7; int c = 0; tab[TB_XCUM] = 0;
        for (int s = 0; s < 8; ++s) { c += (tab[TB_CNT + x + 8 * s] + 255) >> 8; tab[TB_XCUM + s + 1] = c; }
        tab[TB_XCUM + 9] = c + 4;
    }
    __syncthreads();
}

struct ConvJob { const float* src; bf16* dst; int N, ldk, mode, item; };
__device__ __forceinline__ void conv_item_fp8(const ConvJob& j, int lane, float scale) {
    const int nblk = j.N >> 5, kb = j.item / nblk, nb = j.item - kb * nblk, k0 = 128 * kb, n0 = 32 * nb;
    const float* src = j.src + (size_t)(k0 + 16 * (lane >> 3)) * j.N + n0 + 4 * (lane & 7);
    f32x4 v[16];
#pragma unroll
    for (int i = 0; i < 16; ++i) v[i] = __builtin_nontemporal_load((const f32x4*)(src + (size_t)i * j.N));
    unsigned char* dst = (unsigned char*)j.dst;
#pragma unroll
    for (int q = 0; q < 4; ++q) { const int n = n0 + 4 * (lane & 7) + q; int dr = n;
        if (j.mode == 5) dr = ((n >> 7) << 8) + (n & 127); else if (j.mode == 6) dr = ((n >> 7) << 8) + 128 + (n & 127);
        v4u o; o.x = pk4_fp8(v[0][q] * scale, v[1][q] * scale, v[2][q] * scale, v[3][q] * scale); o.y = pk4_fp8(v[4][q] * scale, v[5][q] * scale, v[6][q] * scale, v[7][q] * scale);
        o.z = pk4_fp8(v[8][q] * scale, v[9][q] * scale, v[10][q] * scale, v[11][q] * scale); o.w = pk4_fp8(v[12][q] * scale, v[13][q] * scale, v[14][q] * scale, v[15][q] * scale);
        *(v4u*)(dst + (size_t)dr * j.ldk + k0 + 16 * (lane >> 3)) = o; }
}
__device__ __forceinline__ void conv_load(const ConvJob& j, int lane, f32x4 (&v)[8]) {
    const int nblk = j.N >> 5, kb = j.item / nblk, nb = j.item - kb * nblk, k0 = 64 * kb, n0 = 32 * nb;
    const float* src = j.src + (size_t)(k0 + 8 * (lane >> 3)) * j.N + n0 + 4 * (lane & 7);
#pragma unroll
    for (int i = 0; i < 8; ++i) v[i] = __builtin_nontemporal_load((const f32x4*)(src + (size_t)i * j.N));
}
__device__ __forceinline__ void conv_store(const ConvJob& j, int lane, const f32x4 (&v)[8]) {
    const int nblk = j.N >> 5, kb = j.item / nblk, nb = j.item - kb * nblk, k0 = 64 * kb, n0 = 32 * nb;
#pragma unroll
    for (int q = 0; q < 4; ++q) { const int n = n0 + 4 * (lane & 7) + q; int dr = n;
        if (j.mode == 1) dr = ((n >> 7) << 8) + (n & 127); else if (j.mode == 2) dr = ((n >> 7) << 8) + 128 + (n & 127);
        v4u o; o.x = pk2(v[0][q], v[1][q]); o.y = pk2(v[2][q], v[3][q]); o.z = pk2(v[4][q], v[5][q]); o.w = pk2(v[6][q], v[7][q]);
        *(v4u*)(j.dst + (size_t)dr * j.ldk + k0 + 8 * (lane >> 3)) = o; }
}
__device__ __forceinline__ void rms_row_to_bf16(const float* xrow, const float* g, bf16* orow, int lane) {
    f32x4 v[8]; float s = 0.f;
#pragma unroll
    for (int j = 0; j < 4; ++j) { v[2 * j] = *(const f32x4*)(xrow + 512 * j + 8 * lane); v[2 * j + 1] = *(const f32x4*)(xrow + 512 * j + 8 * lane + 4); }
#pragma unroll
    for (int j = 0; j < 8; ++j) s += (v[j][0] * v[j][0] + v[j][1] * v[j][1]) + (v[j][2] * v[j][2] + v[j][3] * v[j][3]);
    const float rstd = 1.0f / sqrtf(wave_sum(s) * (1.0f / D) + EPS);
#pragma unroll
    for (int j = 0; j < 4; ++j) { const f32x4 g0 = *(const f32x4*)(g + 512 * j + 8 * lane), g1 = *(const f32x4*)(g + 512 * j + 8 * lane + 4);
        const f32x4 a = v[2 * j] * rstd * g0, b = v[2 * j + 1] * rstd * g1;
        v4u o; o.x = pk2(a[0], a[1]); o.y = pk2(a[2], a[3]); o.z = pk2(b[0], b[1]); o.w = pk2(b[2], b[3]);
        *(v4u*)(orow + 512 * j + 8 * lane) = o; }
}
__device__ __forceinline__ void p0_prologue(Frame& F) {
    const int LANE_ = pg8::lane_id(), TID_ = F.wave * 64 + LANE_; (void)TID_;
    const int gw = F.bx * NWAVES + F.wave, NGW = F.G * NWAVES;
    bf16* WIN = (bf16*)(F.ws + WS_WIN); bf16* WPOOL = (bf16*)(F.ws + WS_WPOOL); bf16* WOUT = (bf16*)(F.ws + WS_WOUT); bf16* WPP = (bf16*)(F.ws + WS_WPP); bf16* WPG = (bf16*)(F.ws + WS_WPG);
    constexpr int I_IN = (D / 64) * (INW / 32), I_PL = 4 * (256 / 64) * (256 / 32), I_OUT = (D / 64) * (D / 32), I_PP = (PLE / 64) * (D / 32), I_PG = (D / 64) * (D / 32);
    constexpr int I_SMALL = I_IN + I_PL + I_OUT + I_PP + I_PG;
    auto decode = [&](int it) -> ConvJob {
        int r = it;
        if (r < I_IN) return ConvJob{fin(F, I_WIN), WIN, INW, D, 0, r}; r -= I_IN;
        if (r < I_PL) { const int gq = r >> 5; return ConvJob{fin(F, I_WPOOL) + (size_t)gq * 65536, WPOOL + (size_t)gq * 65536, 256, 256, 0, r & 31}; } r -= I_PL;
        if (r < I_OUT) return ConvJob{fin(F, I_WOUT), WOUT, D, D, 0, r}; r -= I_OUT;
        if (r < I_PP) return ConvJob{fin(F, I_WPLEPROJ), WPP, D, PLE, 0, r}; r -= I_PP;
        return ConvJob{fin(F, I_WPLEGATE), WPG, D, D, 0, r};
    };
    for (int it = gw; it < I_SMALL; it += 2 * NGW) {
        const ConvJob j0 = decode(it); const bool two = (it + NGW) < I_SMALL; const ConvJob j1 = decode(two ? it + NGW : it);
        f32x4 v0[8], v1[8];
        conv_load(j0, LANE_, v0); conv_load(j1, LANE_, v1);
        conv_store(j0, LANE_, v0); if (two) conv_store(j1, LANE_, v1);
    }
    constexpr int I_G1 = (D / 128) * (EFF / 32)  , I_D1 = (EFF / 128) * (D / 32)  ;
    constexpr int I_G = 65 * I_G1, I_DN = 65 * I_D1, NITEMS8 = 2 * I_G + I_DN;
    unsigned char* WGU8 = F.ws + WS_WGU; unsigned char* WDN8 = F.ws + WS_WD;
    for (int it = gw; it < NITEMS8; it += NGW) {
        int r = it;
        if (r < I_G) { const int e = r / I_G1, li = r - e * I_G1; const float* src = (e < NE) ? fin(F, I_WGATE) + (size_t)e * D * EFF : fin(F, I_WSGATE);
            conv_item_fp8(ConvJob{src, (bf16*)(WGU8 + (size_t)e * 1024 * D), EFF, D, 5, li}, LANE_, SW1); continue; } r -= I_G;
        if (r < I_G) { const int e = r / I_G1, li = r - e * I_G1; const float* src = (e < NE) ? fin(F, I_WUP) + (size_t)e * D * EFF : fin(F, I_WSUP);
            conv_item_fp8(ConvJob{src, (bf16*)(WGU8 + (size_t)e * 1024 * D), EFF, D, 6, li}, LANE_, SW1); continue; } r -= I_G;
        { const int e = r / I_D1, li = r - e * I_D1; const float* src = (e < NE) ? fin(F, I_WDOWN) + (size_t)e * EFF * D : fin(F, I_WSDOWN);
            conv_item_fp8(ConvJob{src, (bf16*)(WDN8 + (size_t)e * D * EFF), D, EFF, 4, li}, LANE_, SW2); }
    }
    { const float* P = fin(F, I_P); bf16* PB = (bf16*)(F.ws + WS_PBF);
      for (int i = gw * 64 + LANE_; i < T * PLE / 8; i += NGW * 64) { const f32x4 a = *(const f32x4*)(P + (size_t)i * 8), b = *(const f32x4*)(P + (size_t)i * 8 + 4);
          v4u o; o.x = pk2(a[0], a[1]); o.y = pk2(a[2], a[3]); o.z = pk2(b[0], b[1]); o.w = pk2(b[2], b[3]); *(v4u*)(PB + (size_t)i * 8) = o; } }
    bf16* ABF = (bf16*)(F.ws + WS_ABF);
    for (int m = gw; m < T; m += NGW) rms_row_to_bf16(fin(F, I_X) + (size_t)m * D, fin(F, I_GMIX), ABF + (size_t)m * D, LANE_);
}

__device__ __forceinline__ int t5_bucket(int n) {
    if (n < 16) return n;
    const int large = 16 + (int)(logf((float)n * (1.0f / 16.0f)) / logf(8.0f) * 16.0f);
    return large < 31 ? large : 31;
}
constexpr int VT_LD = 216, VT_KEYS = 208;
__device__ __forceinline__ void attn_task(Frame& F, const LAS float* btab, const LAS bf16* vtl, int b, int kvh, int hg, int qt) {
    const int LANE_ = pg8::lane_id();
    const bf16* Q = (const bf16*)(F.ws + WS_QBF); const bf16* Kb = (const bf16*)(F.ws + WS_KV); bf16* MIX = (bf16*)(F.ws + WS_MIX);
    const int lane = LANE_, qi = lane & 15, g = lane >> 4, h = kvh * 8 + hg;
    const int q0 = qt * 16, tok0 = b * SEQ;
    bf16x8 qf[2];
#pragma unroll
    for (int ks = 0; ks < 2; ++ks) qf[ks] = *(const bf16x8*)(Q + (size_t)(tok0 + q0 + qi) * 1024 + h * 64 + 32 * ks + 8 * g);
    f32x4 s[5][2];
#pragma unroll
    for (int kb = 0; kb < 5; ++kb)
#pragma unroll
        for (int t = 0; t < 2; ++t) {
            int key = q0 - 128 + 32 * kb + 8 * (qi >> 2) + 4 * t + (qi & 3); key = key < 0 ? 0 : (key > SEQ - 1 ? SEQ - 1 : key);
            const bf16* kp = Kb + (size_t)(tok0 + key) * (2 * KVW) + kvh * 64 + 8 * g;
            const bf16x8 k0f = *(const bf16x8*)(kp), k1f = *(const bf16x8*)(kp + 32);
            f32x4 a = (f32x4){0.f, 0.f, 0.f, 0.f};
            a = __builtin_amdgcn_mfma_f32_16x16x32_bf16(k0f, qf[0], a, 0, 0, 0);
            a = __builtin_amdgcn_mfma_f32_16x16x32_bf16(k1f, qf[1], a, 0, 0, 0);
            s[kb][t] = a;
        }
    const float sink = fin(F, I_SINKS)[h];
    const LAS float* bt = btab + hg * 128;
    float mx = sink;
#pragma unroll
    for (int kb = 0; kb < 5; ++kb)
#pragma unroll
        for (int t = 0; t < 2; ++t)
#pragma unroll
            for (int r = 0; r < 4; ++r) {
                const int key = q0 - 128 + 32 * kb + 8 * g + 4 * t + r, dist = q0 + qi - key;
                const bool valid = (dist >= 0) && (dist < 128) && (key >= 0);
                const float lg = valid ? s[kb][t][r] * 0.125f + bt[dist & 127] : -3.0e38f;
                s[kb][t][r] = lg; mx = fmaxf(mx, lg);
            }
    mx = fmaxf(mx, __shfl_xor(mx, 16)); mx = fmaxf(mx, __shfl_xor(mx, 32));
    float sum = 0.f;
#pragma unroll
    for (int kb = 0; kb < 5; ++kb)
#pragma unroll
        for (int t = 0; t < 2; ++t)
#pragma unroll
            for (int r = 0; r < 4; ++r) { const float lg = s[kb][t][r]; const float p = (lg > -1.0e38f) ? __expf(lg - mx) : 0.f; s[kb][t][r] = p; sum += p; }
    sum += __shfl_xor(sum, 16); sum += __shfl_xor(sum, 32);
    const float inv = 1.0f / (sum + __expf(sink - mx));
    f32x4 o[4];
#pragma unroll
    for (int dt = 0; dt < 4; ++dt) o[dt] = (f32x4){0.f, 0.f, 0.f, 0.f};
#pragma unroll
    for (int kb = 0; kb < 5; ++kb) {
        v4u pw; pw.x = pk2(s[kb][0][0], s[kb][0][1]); pw.y = pk2(s[kb][0][2], s[kb][0][3]); pw.z = pk2(s[kb][1][0], s[kb][1][1]); pw.w = pk2(s[kb][1][2], s[kb][1][3]);
        const bf16x8 pf = __builtin_bit_cast(bf16x8, pw);
        const int kkl = 16 * (qt & 3) + 32 * kb + 8 * g;
#pragma unroll
        for (int dt = 0; dt < 4; ++dt) {
            const bf16x8 vf = *(const LAS bf16x8*)(vtl + (16 * dt + qi) * VT_LD + kkl);
            o[dt] = __builtin_amdgcn_mfma_f32_16x16x32_bf16(vf, pf, o[dt], 0, 0, 0);
        }
    }
    bf16* op = MIX + (size_t)(tok0 + q0 + qi) * D + POOLW + h * 64 + 4 * g;
#pragma unroll
    for (int dt = 0; dt < 4; ++dt) { v2u w; w.x = pk2(o[dt][0] * inv, o[dt][1] * inv); w.y = pk2(o[dt][2] * inv, o[dt][3] * inv); *(v2u*)(op + 16 * dt) = w; }
}

__device__ __forceinline__ void pool_task(Frame& F, int mt, int gq) {
    const int LANE_ = pg8::lane_id(), TID_ = F.wave * 64 + LANE_; (void)TID_;
    const bf16* U = (const bf16*)(F.ws + WS_UBF); bf16* PO = (bf16*)(F.ws + WS_POOLED);
    const int w = 2 << gq;
    const int ch = gq * 256 + (TID_ & 31) * 8, tr0 = mt * 256 + (TID_ >> 5) * 16;
    const int pos0 = tr0 & (SEQ - 1);
    float run[8];
#pragma unroll
    for (int c = 0; c < 8; ++c) run[c] = 0.f;
    for (int j = 1; j < w; ++j) { if (pos0 - j >= 0) { const v4u x = *(const v4u*)(U + (size_t)(tr0 - j) * POOLW + ch);
        run[0] += bf_lo(x.x); run[1] += bf_hi(x.x); run[2] += bf_lo(x.y); run[3] += bf_hi(x.y); run[4] += bf_lo(x.z); run[5] += bf_hi(x.z); run[6] += bf_lo(x.w); run[7] += bf_hi(x.w); } }
    for (int i = 0; i < 16; ++i) {
        const int pos = pos0 + i; const v4u x = *(const v4u*)(U + (size_t)(tr0 + i) * POOLW + ch);
        float uv[8] = {bf_lo(x.x), bf_hi(x.x), bf_lo(x.y), bf_hi(x.y), bf_lo(x.z), bf_hi(x.z), bf_lo(x.w), bf_hi(x.w)};
        const float ic = 1.0f / (float)((pos + 1) < w ? (pos + 1) : w);
        float o[8];
#pragma unroll
        for (int c = 0; c < 8; ++c) { run[c] += uv[c]; o[c] = run[c] * ic - uv[c]; }
        v4u ow; ow.x = pk2(o[0], o[1]); ow.y = pk2(o[2], o[3]); ow.z = pk2(o[4], o[5]); ow.w = pk2(o[6], o[7]);
        *(v4u*)(PO + (size_t)(tr0 + i) * POOLW + ch) = ow;
        if (pos - w + 1 >= 0) { const v4u y = *(const v4u*)(U + (size_t)(tr0 + i - w + 1) * POOLW + ch);
            run[0] -= bf_lo(y.x); run[1] -= bf_hi(y.x); run[2] -= bf_lo(y.y); run[3] -= bf_hi(y.y); run[4] -= bf_lo(y.z); run[5] -= bf_hi(y.z); run[6] -= bf_lo(y.w); run[7] -= bf_hi(y.w); }
    }
    VM_WAIT(); __syncthreads();
    pg8::Gemm g{(const bf16*)PO + gq * 256, (const bf16*)(F.ws + WS_WPOOL) + (size_t)gq * 65536, POOLW, 256, 256};
    pg8::SingleOrder S{mt, 0};
    EpiBf16Plain E{(bf16*)(F.ws + WS_MIX), D, gq * 256, fin(F, I_PSCALE)};
    pg8::gemm_phase<EpiBf16Plain, pg8::SingleOrder, false>(F.lds + RING_OFF, g, S, E, F.wave);
}

constexpr int XS_STRIDE = 2052;
constexpr int P4_XS = 0, P4_PART = 16 * XS_STRIDE * 4, P4_SELE = P4_PART + 4 * 16 * 64 * 4, P4_SELW = P4_SELE + 32 * 8 * 4, P4_SELL = P4_SELW + 32 * 8 * 4, P4_HIST = P4_SELL + 32 * 8 * 4, P4_BASE = P4_HIST + 256, P4_END = P4_BASE + 256;
static_assert(P4_END <= MISC_OFF, "P4 LDS map");
__device__ __forceinline__ void p4_route(Frame& F) {
    const int LANE_ = pg8::lane_id(), TID_ = F.wave * 64 + LANE_; (void)TID_;
    LAS float* XS = (LAS float*)(F.lds + P4_XS); LAS float* PART = (LAS float*)(F.lds + P4_PART);
    LAS int* SELE = (LAS int*)(F.lds + P4_SELE); LAS float* SELW = (LAS float*)(F.lds + P4_SELW); LAS int* SELL = (LAS int*)(F.lds + P4_SELL);
    LAS int* HIST = (LAS int*)(F.lds + P4_HIST); LAS int* BASE = (LAS int*)(F.lds + P4_BASE);
    const float* H1 = F.out; unsigned char* XN = F.ws + WS_XN; const float* gf = fin(F, I_GFFN); const float* wr_ = fin(F, I_WROUTER); const float* rb = fin(F, I_RBIAS);
    const int lane = LANE_, wave = F.wave;
    if (TID_ < 64) HIST[TID_] = 0;
    for (int tile = F.bx; tile < T / 32; tile += F.G) {
    for (int pass = 0; pass < 2; ++pass) {
        const int tokp = tile * 32 + pass * 16;
#pragma unroll 1
        for (int q = 0; q < 2; ++q) {
            const int tl = 2 * wave + q; const float* xrow = H1 + (size_t)(tokp + tl) * D;
            f32x4 v[8]; float s = 0.f;
#pragma unroll
            for (int j = 0; j < 4; ++j) { v[2 * j] = *(const f32x4*)(xrow + 512 * j + 8 * lane); v[2 * j + 1] = *(const f32x4*)(xrow + 512 * j + 8 * lane + 4); }
#pragma unroll
            for (int j = 0; j < 8; ++j) s += (v[j][0] * v[j][0] + v[j][1] * v[j][1]) + (v[j][2] * v[j][2] + v[j][3] * v[j][3]);
            const float rstd = 1.0f / sqrtf(wave_sum(s) * (1.0f / D) + EPS);
#pragma unroll
            for (int j = 0; j < 4; ++j) { const f32x4 g0 = *(const f32x4*)(gf + 512 * j + 8 * lane), g1 = *(const f32x4*)(gf + 512 * j + 8 * lane + 4);
                const f32x4 a = v[2 * j] * rstd * g0, b = v[2 * j + 1] * rstd * g1;
                *(LAS f32x4*)(XS + tl * XS_STRIDE + 512 * j + 8 * lane) = a; *(LAS f32x4*)(XS + tl * XS_STRIDE + 512 * j + 8 * lane + 4) = b;
                v2u o; o.x = pk4_fp8(a[0], a[1], a[2], a[3]); o.y = pk4_fp8(b[0], b[1], b[2], b[3]);
                *(v2u*)(XN + (size_t)(tokp + tl) * D + 512 * j + 8 * lane) = o; }
        }
        __syncthreads();
        {
            const int ti = lane & 15, kk = lane >> 4;
            f32x4 acc[4];
#pragma unroll
            for (int et = 0; et < 4; ++et) acc[et] = (f32x4){0.f, 0.f, 0.f, 0.f};
            const LAS float* xa = XS + ti * XS_STRIDE + 256 * wave + kk;
            const float* wb = wr_ + (size_t)(256 * wave + kk) * NE + 4 * ti;
#pragma unroll 16
            for (int ks = 0; ks < 64; ++ks) { const float a = xa[4 * ks]; const f32x4 bw = *(const f32x4*)(wb + (size_t)4 * ks * NE);
#pragma unroll
                for (int et = 0; et < 4; ++et) acc[et] = __builtin_amdgcn_mfma_f32_16x16x4f32(a, bw[et], acc[et], 0, 0, 0); }
            if (wave >= 4) {
#pragma unroll
                for (int r = 0; r < 4; ++r) *(LAS f32x4*)(PART + (wave - 4) * 1024 + (4 * kk + r) * 64 + 4 * ti) = (f32x4){acc[0][r], acc[1][r], acc[2][r], acc[3][r]};
            }
            __syncthreads();
            if (wave < 4) {
#pragma unroll
                for (int r = 0; r < 4; ++r) { LAS f32x4* pp = (LAS f32x4*)(PART + wave * 1024 + (4 * kk + r) * 64 + 4 * ti); const f32x4 o = *pp;
                    *pp = (f32x4){o[0] + acc[0][r], o[1] + acc[1][r], o[2] + acc[2][r], o[3] + acc[3][r]}; }
            }
        }
        __syncthreads();
#pragma unroll 1
        for (int q = 0; q < 2; ++q) {
            const int tl = 2 * wave + q, tw = pass * 16 + tl;
            const float lg = (PART[tl * 64 + lane] + PART[1024 + tl * 64 + lane]) + (PART[2048 + tl * 64 + lane] + PART[3072 + tl * 64 + lane]);
            const float score = 1.0f / (1.0f + expf(-lg)), biased = score + rb[lane];
            const int grp = lane >> 3;
            float m1 = biased; m1 = fmaxf(m1, __shfl_xor(m1, 1)); m1 = fmaxf(m1, __shfl_xor(m1, 2)); m1 = fmaxf(m1, __shfl_xor(m1, 4));
            const unsigned long long bm = __ballot(biased == m1); const unsigned gb = (unsigned)(bm >> (8 * grp)) & 0xffu; const int first = __builtin_ctz(gb);
            float v2 = ((lane & 7) == first) ? -3.0e38f : biased; float m2 = v2; m2 = fmaxf(m2, __shfl_xor(m2, 1)); m2 = fmaxf(m2, __shfl_xor(m2, 2)); m2 = fmaxf(m2, __shfl_xor(m2, 4));
            const float gs = m1 + m2;
            int grank = 0;
#pragma unroll
            for (int j = 0; j < 8; ++j) { const float gj = __shfl(gs, 8 * j); grank += ((gj > gs) || (gj == gs && j < grp)) ? 1 : 0; }
            const bool gsel = grank < 4;
            const float masked = gsel ? biased : -3.0e38f;
            int rank = 0;
#pragma unroll
            for (int j = 0; j < 64; ++j) { const float vj = __shfl(masked, j); rank += ((vj > masked) || (vj == masked && j < lane)) ? 1 : 0; }
            const bool sel = gsel && (rank < 8);
            const float wsum = wave_sum(sel ? score : 0.f);
            const unsigned long long sm = __ballot(sel);
            if (sel) { const int k = __popcll(sm & ((1ull << lane) - 1ull)); const int li = atomicAdd((int*)&HIST[lane], 1);
                SELE[tw * 8 + k] = lane; SELW[tw * 8 + k] = score / wsum * 2.5f; SELL[tw * 8 + k] = li; }
        }
        __syncthreads();
    }
    if (TID_ < 64) BASE[TID_] = (int)__hip_atomic_fetch_add(F.ctl + CW_CNT + 32 * TID_, (unsigned)HIST[TID_], RLX_AGENT);
    __syncthreads();
    if (TID_ < 256) { const int e = SELE[TID_], pos = BASE[e] + SELL[TID_], tok = tile * 32 + (TID_ >> 3);
        ((int*)(F.ws + WS_TOKLIST))[(size_t)e * T + pos] = tok; ((float*)(F.ws + WS_WREC))[tok * 8 + (TID_ & 7)] = SELW[TID_]; ((int*)(F.ws + WS_REC))[tok * 8 + (TID_ & 7)] = e * T + pos; }
    __syncthreads();
    if (TID_ < 64) HIST[TID_] = 0;
    __syncthreads();
    }
}

__device__ __forceinline__ void p7_combine(Frame& F, bool dry) {
    const int LANE_ = pg8::lane_id(), TID_ = F.wave * 64 + LANE_; (void)TID_;
    const LAS int* tab = (const LAS int*)(F.lds + TAB_OFF);
    const bf16* Y = (const bf16*)(F.ws + WS_Y); const bf16* PP = (const bf16*)(F.ws + WS_PPROJ); const int* rec = (const int*)(F.ws + WS_REC); const float* wrec = (const float*)(F.ws + WS_WREC);
    const float* H = F.out; float* HO = dry ? (float*)(F.ws + WS_WGU) : F.out; bf16* H2 = dry ? (bf16*)(F.ws + WS_WGU + 64 * MiB) : (bf16*)(F.ws + WS_H2BF); float* rstdp = dry ? (float*)(F.ws + WS_WGU + 100 * MiB) : (float*)(F.ws + WS_RSTDP);
    const int gw = F.bx * NWAVES + F.wave, NGW = F.G * NWAVES, lane = LANE_;
    for (int t = gw; t < T; t += NGW) {
        int rows[9]; float rwt[9];
#pragma unroll
        for (int k = 0; k < 8; ++k) { const int rc = rec[t * 8 + k]; const int e = rc >> 13, pos = rc & (T - 1); rows[k] = tab[TB_PAD + e] + pos; rwt[k] = wrec[t * 8 + k]; }
        rows[8] = SH_ROW0 + t; rwt[8] = 1.0f;
        float ps = 0.f;
#pragma unroll
        for (int jh = 0; jh < 2; ++jh) {
            v4u y[2][9]; f32x4 ha[2], hb[2]; v4u pw[2];
#pragma unroll
            for (int jj = 0; jj < 2; ++jj) { const int c0 = 512 * (2 * jh + jj) + 8 * lane;
                ha[jj] = *(const f32x4*)(H + (size_t)t * D + c0); hb[jj] = *(const f32x4*)(H + (size_t)t * D + c0 + 4); pw[jj] = *(const v4u*)(PP + (size_t)t * D + c0);
#pragma unroll
                for (int k = 0; k < 9; ++k) y[jj][k] = *(const v4u*)(Y + (size_t)rows[k] * D + c0); }
#pragma unroll
            for (int jj = 0; jj < 2; ++jj) { const int c0 = 512 * (2 * jh + jj) + 8 * lane; f32x4 a = ha[jj], b = hb[jj];
#pragma unroll
                for (int k = 0; k < 9; ++k) { const v4u yy = y[jj][k]; const float w = rwt[k];
                    a[0] += w * bf_lo(yy.x); a[1] += w * bf_hi(yy.x); a[2] += w * bf_lo(yy.y); a[3] += w * bf_hi(yy.y); b[0] += w * bf_lo(yy.z); b[1] += w * bf_hi(yy.z); b[2] += w * bf_lo(yy.w); b[3] += w * bf_hi(yy.w); }
                *(f32x4*)(HO + (size_t)t * D + c0) = a; *(f32x4*)(HO + (size_t)t * D + c0 + 4) = b;
                v4u o; o.x = pk2(a[0], a[1]); o.y = pk2(a[2], a[3]); o.z = pk2(b[0], b[1]); o.w = pk2(b[2], b[3]);
                *(v4u*)(H2 + (size_t)t * D + c0) = o;
                const float p0 = bf_lo(pw[jj].x), p1 = bf_hi(pw[jj].x), p2 = bf_lo(pw[jj].y), p3 = bf_hi(pw[jj].y), p4 = bf_lo(pw[jj].z), p5 = bf_hi(pw[jj].z), p6 = bf_lo(pw[jj].w), p7 = bf_hi(pw[jj].w);
                ps += (p0 * p0 + p1 * p1) + (p2 * p2 + p3 * p3) + (p4 * p4 + p5 * p5) + (p6 * p6 + p7 * p7); }
        }
        ps = wave_sum(ps);
        if (lane == 0) rstdp[t] = 1.0f / sqrtf(ps * (1.0f / D) + EPS);
    }
}
__device__ __forceinline__ void p9_final(Frame& F, bool dry) {
    const int LANE_ = pg8::lane_id(), TID_ = F.wave * 64 + LANE_; (void)TID_;
    const int gw = F.bx * NWAVES + F.wave, NGW = F.G * NWAVES, lane = LANE_; const float* g = fin(F, I_GFINAL);
    for (int t = gw; t < T; t += NGW) {
        const float* row = F.out + (size_t)t * D; float* orow = (dry ? (float*)(F.ws + WS_WGU) : F.out) + (size_t)t * D; f32x4 v[8]; float s = 0.f;
#pragma unroll
        for (int j = 0; j < 4; ++j) { v[2 * j] = *(const f32x4*)(row + 512 * j + 8 * lane); v[2 * j + 1] = *(const f32x4*)(row + 512 * j + 8 * lane + 4); }
#pragma unroll
        for (int j = 0; j < 8; ++j) s += (v[j][0] * v[j][0] + v[j][1] * v[j][1]) + (v[j][2] * v[j][2] + v[j][3] * v[j][3]);
        const float rstd = 1.0f / sqrtf(wave_sum(s) * (1.0f / D) + EPS);
#pragma unroll
        for (int j = 0; j < 4; ++j) { const f32x4 g0 = *(const f32x4*)(g + 512 * j + 8 * lane), g1 = *(const f32x4*)(g + 512 * j + 8 * lane + 4);
            *(f32x4*)(orow + 512 * j + 8 * lane) = v[2 * j] * rstd * g0; *(f32x4*)(orow + 512 * j + 8 * lane + 4) = v[2 * j + 1] * rstd * g1; }
    }
}

__global__ void __launch_bounds__(NWAVES * 64, 2) fwd_kernel(Args args) {
    extern __shared__ __attribute__((aligned(16))) unsigned char lds[];
    Frame F;
    F.lds = (LAS unsigned char*)lds;
    F.MISC = (volatile LAS unsigned*)(F.lds + MISC_OFF);
    F.wave = __builtin_amdgcn_readfirstlane(threadIdx.x >> 6);
    F.G = gridDim.x; F.bx = blockIdx.x;
    F.ws = args.ws; F.ctl = (gu32*)(args.ws + WS_CTL); F.out = args.out;
    { const int TID_ = threadIdx.x;
    if (TID_ < 64) F.MISC[TID_] = 0u;
    if (TID_ >= 64 && TID_ < 64 + 22) ((LAS unsigned long long*)(F.lds + MISC_OFF + 256))[TID_ - 64] = ((const unsigned long long*)&args)[TID_ - 64]; }
    __syncthreads();
    XcdBarrier bar; bar.bar = (unsigned*)(F.ctl + CW_BAR); bar.x = 0; bar.st = nullptr;
    if (N_LAUNCHES == 1) bar = xcd_barrier_post((unsigned*)(F.ctl + CW_BAR), F.MISC + 8);
#define GRID_BAR() do { if (N_LAUNCHES == 1) xcd_barrier(bar); } while (0)
    const int lo = args.ph_lo, hi = args.ph_hi;
#ifndef PH_MASK
#define PH_MASK 0x3ff
#endif
#ifndef DUP_PHASE
#define DUP_PHASE -1
#endif
#define REPS(k) ((DUP_PHASE == (k)) ? 2 : 1)
#define IN(k) ((((PH_MASK) >> (k)) & 1) && lo <= (k) && (k) < hi)
#define BOTH(k) (IN(k) && IN((k) + 1))

    if (IN(0)) { _Pragma("unroll") for (int rep = 0; rep < REPS(0); ++rep) { p0_prologue(F); if (BOTH(0)) GRID_BAR(); } }

    if (IN(1)) { _Pragma("unroll") for (int rep = 0; rep < REPS(1); ++rep) {
        { pg8::Gemm g{(const bf16*)(F.ws + WS_ABF), (const bf16*)(F.ws + WS_WIN), D, D, D}; pg8::StaticOrder S; S.init(T, INW, F.G, F.bx);
          EpiInProj E{F.ws};
          pg8::gemm_phase<EpiInProj, pg8::StaticOrder, false>(F.lds + RING_OFF, g, S, E, F.wave); }
        { pg8::Gemm g{(const bf16*)(F.ws + WS_PBF), (const bf16*)(F.ws + WS_WPP), PLE, PLE, PLE}; pg8::StaticOrder S; S.init(T, D, F.G, F.bx);
          EpiBf16Plain E{(bf16*)(F.ws + WS_PPROJ), D, 0, nullptr};
          pg8::gemm_phase<EpiBf16Plain, pg8::StaticOrder, false>(F.lds + RING_OFF, g, S, E, F.wave); }
        if (BOTH(1)) GRID_BAR();
    } }

    if (IN(2)) { _Pragma("unroll") for (int rep = 0; rep < REPS(2); ++rep) {
        LAS float* btab = (LAS float*)(F.lds + TAB_OFF + 2048);
        const int TID_ = F.wave * 64 + pg8::lane_id();
        for (int blk = F.bx; blk < 256; blk += F.G) {
            const int b = blk >> 6, kvh = (blk >> 5) & 1, qg = blk & 31;
            __syncthreads();
            for (int i = TID_; i < 1024; i += NWAVES * 64) { const int hg = i >> 7, dist = i & 127; btab[i] = fin(F, I_RPE)[t5_bucket(dist) * NH + kvh * 8 + hg]; }
            { LAS bf16* vtl = (LAS bf16*)(F.lds + RING_OFF); const bf16* KVp = (const bf16*)(F.ws + WS_KV);
              for (int idx = TID_; idx < VT_KEYS * 8; idx += NWAVES * 64) { const int kl = idx >> 3, c = idx & 7, key = 64 * qg - 128 + kl;
                  v4u v = (v4u){0u, 0u, 0u, 0u}; if (key >= 0 && key < SEQ) v = *(const v4u*)(KVp + (size_t)(b * SEQ + key) * (2 * KVW) + KVW + kvh * 64 + 8 * c);
                  LAS bf16* d0 = vtl + (8 * c) * VT_LD + kl;
                  d0[0 * VT_LD] = (bf16)(v.x & 0xffffu); d0[1 * VT_LD] = (bf16)(v.x >> 16); d0[2 * VT_LD] = (bf16)(v.y & 0xffffu); d0[3 * VT_LD] = (bf16)(v.y >> 16);
                  d0[4 * VT_LD] = (bf16)(v.z & 0xffffu); d0[5 * VT_LD] = (bf16)(v.z >> 16); d0[6 * VT_LD] = (bf16)(v.w & 0xffffu); d0[7 * VT_LD] = (bf16)(v.w >> 16); } }
            __syncthreads();
#pragma unroll 1
            for (int i = 0; i < 4; ++i) attn_task(F, btab, (const LAS bf16*)(F.lds + RING_OFF), b, kvh, F.wave, 4 * qg + i);
        }
        for (int p = F.bx; p < 128; p += F.G) { __syncthreads(); pool_task(F, p >> 2, p & 3); }
        if (BOTH(2)) GRID_BAR();
    } }

    if (IN(3)) { _Pragma("unroll") for (int rep = 0; rep < REPS(3); ++rep) {
        pg8::Gemm g{(const bf16*)(F.ws + WS_MIX), (const bf16*)(F.ws + WS_WOUT), D, D, D}; pg8::StaticOrder S; S.init(T, D, F.G, F.bx);
        EpiResF32 E{fin(F, I_X), F.out};
        pg8::gemm_phase<EpiResF32, pg8::StaticOrder, false>(F.lds + RING_OFF, g, S, E, F.wave);
        if (BOTH(3)) GRID_BAR();
    } }

    if (IN(4)) { p4_route(F); if (BOTH(4)) GRID_BAR(); }

    if (IN(5)) { _Pragma("unroll") for (int rep = 0; rep < REPS(5); ++rep) {
        moe_tables(F);
        pg8::Gemm g{F.ws + WS_XN, F.ws + WS_WGU, D, D, D};
        MoeOrder S{(const LAS int*)(F.lds + TAB_OFF), (const int*)(F.ws + WS_TOKLIST), F.bx & 7, F.bx >> 3, 4, F.G >> 3};
        EpiGateUp E{F.ws + WS_ACT};
        pg8::gemm_phase<EpiGateUp, MoeOrder, true, 1>(F.lds + RING_OFF, g, S, E, F.wave);
        if (BOTH(5)) GRID_BAR();
    } }

    if (IN(6)) { _Pragma("unroll") for (int rep = 0; rep < REPS(6); ++rep) {
        if (!IN(5)) moe_tables(F);
        pg8::Gemm g{F.ws + WS_ACT, F.ws + WS_WD, EFF, EFF, EFF};
        MoeOrder S{(const LAS int*)(F.lds + TAB_OFF), (const int*)(F.ws + WS_TOKLIST), F.bx & 7, F.bx >> 3, 8, F.G >> 3};
        EpiDown E{(bf16*)(F.ws + WS_Y)};
        pg8::gemm_phase<EpiDown, MoeOrder, false, 1>(F.lds + RING_OFF, g, S, E, F.wave);
        if (BOTH(6)) GRID_BAR();
    } }

    if (IN(7)) { if (!IN(6)) moe_tables(F); if (DUP_PHASE == 7) { p7_combine(F, true); GRID_BAR(); } p7_combine(F, false); if (BOTH(7)) GRID_BAR(); }

    if (IN(8)) {
        pg8::Gemm g{(const bf16*)(F.ws + WS_H2BF), (const bf16*)(F.ws + WS_WPG), D, D, D}; pg8::StaticOrder S; S.init(T, D, F.G, F.bx);
        EpiPleGate E{F.out, (const bf16*)(F.ws + WS_PPROJ), (const float*)(F.ws + WS_RSTDP), fin(F, I_GPLE)};
        pg8::gemm_phase<EpiPleGate, pg8::StaticOrder, false>(F.lds + RING_OFF, g, S, E, F.wave);
        if (BOTH(8)) GRID_BAR();
    }

    if (IN(9)) { if (DUP_PHASE == 9) { p9_final(F, true); GRID_BAR(); } p9_final(F, false); }
#undef IN
#undef BOTH
}

extern "C" void kernel_launch(void* const* d_in, const int* in_sizes, int n_in, void* d_out, int out_size, void* d_ws, size_t ws_size, hipStream_t stream) {
    static int grid = 0;
    if (grid == 0) {
        if (n_in != 22 || out_size != T * D || ws_size < WS_END) { fprintf(stderr, "kernel_launch: unexpected sizes n_in %d out %d ws %zu (need %zu)\n", n_in, out_size, ws_size, (size_t)WS_END); grid = -1; return; }
        int dev = 0, cus = 0, per_cu = 0;
        if (hipGetDevice(&dev) != hipSuccess || hipDeviceGetAttribute(&cus, hipDeviceAttributeMultiprocessorCount, dev) != hipSuccess) { grid = -1; return; }
        if (hipFuncSetAttribute((const void*)fwd_kernel, hipFuncAttributeMaxDynamicSharedMemorySize, LDS_BYTES) != hipSuccess) { fprintf(stderr, "kernel_launch: hipFuncSetAttribute failed\n"); grid = -1; return; }
        if (hipOccupancyMaxActiveBlocksPerMultiprocessor(&per_cu, (const void*)fwd_kernel, NWAVES * 64, LDS_BYTES) != hipSuccess || per_cu < 1) fprintf(stderr, "kernel_launch: occupancy query reports %d\n", per_cu);
        (void)hipGetLastError();
        grid = cus > 256 ? 256 : cus;
    }
    if (grid < 0) return;
    if (hipMemsetAsync((char*)d_ws + WS_CTL, 0, CTL_ZERO_BYTES, stream) != hipSuccess) return;
    Args a{};
    for (int i = 0; i < 22; ++i) a.in[i] = (const float*)d_in[i];
    a.out = (float*)d_out; a.ws = (unsigned char*)d_ws;
    for (int li = 0; li < N_LAUNCHES; ++li) {
        a.ph_lo = (N_LAUNCHES == 1) ? 0 : li; a.ph_hi = (N_LAUNCHES == 1) ? N_PHASES : li + 1; a.li = li;
        hipLaunchKernelGGL(fwd_kernel, dim3(grid), dim3(NWAVES * 64), LDS_BYTES, stream, a);
    }
}
```

```cpp
#include <hip/hip_runtime.h>
#include <cstdio>
#include <cstdint>

#ifndef MK_N_LAUNCHES
#define MK_N_LAUNCHES 1
#endif

namespace pg8 {
#define PG8_LAS __attribute__((address_space(3)))
typedef unsigned short bf16_t;
typedef short bf16x8 __attribute__((ext_vector_type(8)));
typedef float f32x4 __attribute__((ext_vector_type(4)));
typedef unsigned u32x4 __attribute__((ext_vector_type(4)));
typedef unsigned u32x2 __attribute__((ext_vector_type(2)));
constexpr int BM = 256, BK = 64, HALF = 128, HTB = HALF * BK * 2  , STAGE_BYTES = 8 * HTB, NXCD = 8, WGM = 8;

__host__ __device__ __forceinline__ int lds_byte(int r, int c) { const int st = (r >> 4) * 2 + (c >> 5), rr = r & 15, cc = c & 31, ob = rr * 64 + cc * 2; return st * 1024 + (ob ^ (((ob >> 9) & 1) << 5)); }
__host__ __device__ __forceinline__ void stage_rc(int b, int& R, int& C) { const int st = b / 1024, sb = b % 1024, swz = sb ^ (((sb >> 9) & 1) << 5); R = (st >> 1) * 16 + swz / 64; C = (st & 1) * 32 + (swz % 64) / 2; }
__host__ __device__ __forceinline__ int perm32(int rho) { const int n = rho >> 4, i = rho & 15; return 8 * (i >> 2) + 4 * n + (i & 3); }

struct Unit { int pm, pn, e, lt; };
struct Gemm { const void* A; const void* Bt; int lda, ldb, K; };
typedef int i32x8 __attribute__((ext_vector_type(8)));
typedef int i32x4 __attribute__((ext_vector_type(4)));
__device__ __forceinline__ i32x8 cat8(bf16x8 lo, bf16x8 hi) { const i32x4 a = __builtin_bit_cast(i32x4, lo), b = __builtin_bit_cast(i32x4, hi); return __builtin_shufflevector(a, b, 0, 1, 2, 3, 4, 5, 6, 7); }

struct StaticOrder {
    int nM, nN, nwg, G, c;
    __host__ __device__ void init(int M, int N, int G_, int c_) { nM = M / BM; nN = N / BM; nwg = nM * nN; G = G_; c = c_; }
    __host__ __device__ bool next(int i, Unit& u) const {
        const long L = (long)i * G + c; if (L >= nwg) return false;
        int wgid = (int)L; { const int q = nwg / NXCD, r = nwg % NXCD, xcd = wgid % NXCD, off = wgid / NXCD; wgid = (xcd < r ? xcd * (q + 1) : r * (q + 1) + (xcd - r) * q) + off; }
        const int nig = WGM * nN, gid = wgid / nig, fm = gid * WGM, gsz = (nM - fm) < WGM ? (nM - fm) : WGM;
        u.pm = fm + ((wgid % nig) % gsz); u.pn = (wgid % nig) / gsz; u.e = 0; u.lt = 0; return true;
    }
    __device__ __forceinline__ int arow(const Unit&, int r) const { return r; }
};
struct SingleOrder {
    int pm, pn;
    __device__ bool next(int i, Unit& u) const { if (i > 0) return false; u.pm = pm; u.pn = pn; u.e = 0; u.lt = 0; return true; }
    __device__ __forceinline__ int arow(const Unit&, int r) const { return r; }
};

__device__ __forceinline__ int lane_id() { int l; asm volatile("v_mbcnt_lo_u32_b32 %0, -1, 0\n\tv_mbcnt_hi_u32_b32 %0, -1, %0" : "=v"(l)); return l; }
__device__ __forceinline__ unsigned cvt_pk_bf16(float lo, float hi) { unsigned r; asm volatile("v_cvt_pk_bf16_f32 %0, %1, %2" : "=v"(r) : "v"(lo), "v"(hi)); return r; }

template <class Epi, class Sched, bool GATHER, int ESZ = 2, bool ALIGN_EPI = true>
__device__ __forceinline__ void gemm_phase(PG8_LAS unsigned char* lds, const Gemm g, const Sched& S, const Epi& E, int wid) {
    const int lane = lane_id(), tid = wid * 64 + lane, wr = wid >> 2, wc = wid & 3, fr = lane & 15, fq = lane >> 4;
    const int nt = (g.K * ESZ) / 128;
    int Ra[2], Ca[2]; unsigned voffB[2];
#pragma unroll
    for (int i = 0; i < 2; ++i) { int R, C; stage_rc(tid * 16 + i * 8192, R, C); const int Rb = Epi::PERM ? ((R & ~31) + perm32(R & 31)) : R;
        Ra[i] = R; Ca[i] = C; voffB[i] = (unsigned)(Rb * g.ldb * ESZ + C * 2); }
    const size_t kstep = (size_t)(BK * 2);
    const size_t hstepB = (size_t)HALF * g.ldb * ESZ, tstepB = 2 * hstepB;
    const size_t tstepA = (size_t)BM * g.lda * ESZ;
    const unsigned ldsw = (unsigned)wid * 1024u;
    const int aoff = lds_byte(wr * 64 + fr, fq * 8), boff = lds_byte(wc * 32 + fr, fq * 8);
#define PG8_SA(b, h) (((b) * 2 + (h)) * HTB)
#define PG8_SB(b, h) ((4 + (b) * 2 + (h)) * HTB)
#define PG8_STAGE(bufoff, gbase, v0, v1) do { \
        __builtin_amdgcn_global_load_lds((const unsigned*)((const char*)(gbase) + (v0)), (PG8_LAS unsigned*)(lds + (bufoff) + ldsw), 16, 0, 0); \
        __builtin_amdgcn_global_load_lds((const unsigned*)((const char*)(gbase) + (v1)), (PG8_LAS unsigned*)(lds + (bufoff) + ldsw + 8192), 16, 0, 0); } while (0)
#define PG8_STAGE_A0(bufoff, gbase, p0, p1) PG8_STAGE(bufoff, gbase, p0, p1)
#define PG8_STAGE_A1(bufoff, gbase, p0, p1, q0, q1) do { if constexpr (GATHER) { PG8_STAGE(bufoff, gbase, q0, q1); } else { PG8_STAGE(bufoff, (gbase) + hstepA, p0, p1); } } while (0)
#define PG8_LD16(off) (*(const PG8_LAS i32x4*)(lds + (off)))
#define PG8_LDA(dst, b, h) do { if constexpr (ESZ == 2) { _Pragma("unroll") for (int m = 0; m < 4; ++m) _Pragma("unroll") for (int k = 0; k < 2; ++k) dst[m][k] = *(const PG8_LAS bf16x8*)(lds + PG8_SA(b, h) + aoff + m * 2048 + k * 1024); } \
        else { _Pragma("unroll") for (int m = 0; m < 4; ++m) dst##8[m] = __builtin_shufflevector(PG8_LD16(PG8_SA(b, h) + aoff + m * 2048), PG8_LD16(PG8_SA(b, h) + aoff + m * 2048 + 1024), 0, 1, 2, 3, 4, 5, 6, 7); } } while (0)
#define PG8_LDB(dst, b, h) do { if constexpr (ESZ == 2) { _Pragma("unroll") for (int n = 0; n < 2; ++n) _Pragma("unroll") for (int k = 0; k < 2; ++k) dst[n][k] = *(const PG8_LAS bf16x8*)(lds + PG8_SB(b, h) + boff + n * 2048 + k * 1024); } \
        else { _Pragma("unroll") for (int n = 0; n < 2; ++n) dst##8[n] = __builtin_shufflevector(PG8_LD16(PG8_SB(b, h) + boff + n * 2048), PG8_LD16(PG8_SB(b, h) + boff + n * 2048 + 1024), 0, 1, 2, 3, 4, 5, 6, 7); } } while (0)
#define PG8_MMA(ai, bj, At, Bt) do { __builtin_amdgcn_s_setprio(1); \
        if constexpr (ESZ == 2) { _Pragma("unroll") for (int m = 0; m < 4; ++m) _Pragma("unroll") for (int n = 0; n < 2; ++n) _Pragma("unroll") for (int k = 0; k < 2; ++k) \
            acc[ai][bj][m][n] = __builtin_amdgcn_mfma_f32_16x16x32_bf16(Bt[n][k], At[m][k], acc[ai][bj][m][n], 0, 0, 0); } \
        else { _Pragma("unroll") for (int m = 0; m < 4; ++m) _Pragma("unroll") for (int n = 0; n < 2; ++n) \
            asm volatile("v_mfma_scale_f32_16x16x128_f8f6f4 %0, %1, %2, %0, %3, %3 op_sel_hi:[0,0,0]" : "+v"(acc[ai][bj][m][n]) : "v"(Bt##8[n]), "v"(At##8[m]), "v"(sc1)); } \
        __builtin_amdgcn_s_setprio(0); } while (0)
#define PG8_WAIT_V(n) asm volatile("s_waitcnt vmcnt(" #n ")" ::: "memory")
#define PG8_WAIT_L(n) asm volatile("s_waitcnt lgkmcnt(" #n ")" ::: "memory")
#define PG8_BAR __builtin_amdgcn_s_barrier()
#define PG8_SCHED __builtin_amdgcn_sched_barrier(0)
    Unit cur, nxt; int ui = 0;
    if (!S.next(0, cur)) return;
    f32x4 acc[2][2][4][2];
#pragma unroll
    for (int a = 0; a < 2; ++a)
#pragma unroll
        for (int b = 0; b < 2; ++b)
#pragma unroll
            for (int m = 0; m < 4; ++m)
#pragma unroll
                for (int n = 0; n < 2; ++n) acc[a][b][m][n] = (f32x4){0.f, 0.f, 0.f, 0.f};
    const int sc1 = 0x7F7F7F7F;
    bf16x8 At[4][2], B0[2][2], B1[2][2]; i32x8 At8[4], B08[2], B18[2];
    unsigned vA00, vA01, vA10, vA11, nA00, nA01, nA10, nA11;
    const size_t hstepA = GATHER ? (size_t)0 : (size_t)HALF * g.lda * ESZ;
    if constexpr (GATHER) {
        vA00 = (unsigned)(S.arow(cur, Ra[0]) * g.lda * ESZ + Ca[0] * 2); vA01 = (unsigned)(S.arow(cur, Ra[1]) * g.lda * ESZ + Ca[1] * 2);
        vA10 = (unsigned)(S.arow(cur, HALF + Ra[0]) * g.lda * ESZ + Ca[0] * 2); vA11 = (unsigned)(S.arow(cur, HALF + Ra[1]) * g.lda * ESZ + Ca[1] * 2);
    } else {
        vA00 = (unsigned)(Ra[0] * g.lda * ESZ + Ca[0] * 2); vA01 = (unsigned)(Ra[1] * g.lda * ESZ + Ca[1] * 2); vA10 = 0; vA11 = 0;
    }
    nA00 = vA00; nA01 = vA01; nA10 = vA10; nA11 = vA11;
    const char* cA = (const char*)g.A + (GATHER ? (size_t)0 : (size_t)cur.pm * tstepA); const char* cB = (const char*)g.Bt + (size_t)cur.pn * tstepB;
    PG8_STAGE(PG8_SB(0, 0), cB, voffB[0], voffB[1]); PG8_STAGE(PG8_SB(0, 1), cB + hstepB, voffB[0], voffB[1]); PG8_STAGE_A0(PG8_SA(0, 0), cA, vA00, vA01); PG8_STAGE_A1(PG8_SA(0, 1), cA, vA00, vA01, vA10, vA11);
    if (wr == 1) PG8_BAR;
    PG8_WAIT_V(2); PG8_BAR;
    PG8_STAGE(PG8_SB(1, 0), cB + kstep, voffB[0], voffB[1]); PG8_STAGE_A0(PG8_SA(1, 0), cA + kstep, vA00, vA01); PG8_STAGE(PG8_SB(1, 1), cB + hstepB + kstep, voffB[0], voffB[1]);
    PG8_WAIT_V(6); PG8_BAR;
    for (;;) {
        const bool has_next = S.next(ui + 1, nxt);
        const char* nA = has_next ? (const char*)g.A + (GATHER ? (size_t)0 : (size_t)nxt.pm * tstepA) : cA; const char* nB = has_next ? (const char*)g.Bt + (size_t)nxt.pn * tstepB : cB;
        if constexpr (GATHER) {
            if (has_next) {
                nA00 = (unsigned)(S.arow(nxt, Ra[0]) * g.lda * ESZ + Ca[0] * 2); nA01 = (unsigned)(S.arow(nxt, Ra[1]) * g.lda * ESZ + Ca[1] * 2);
                nA10 = (unsigned)(S.arow(nxt, HALF + Ra[0]) * g.lda * ESZ + Ca[0] * 2); nA11 = (unsigned)(S.arow(nxt, HALF + Ra[1]) * g.lda * ESZ + Ca[1] * 2);
            } else { nA00 = vA00; nA01 = vA01; nA10 = vA10; nA11 = vA11; }
        }
#pragma nounroll
        for (int t = 0; t < nt; t += 2) {
            const bool last = (t == nt - 2);
            const char* a1 = cA + (size_t)(t + 1) * kstep;
            const char* a2 = last ? nA : cA + (size_t)(t + 2) * kstep; const char* b2 = last ? nB : cB + (size_t)(t + 2) * kstep;
            const char* a3 = a2 + kstep; const char* b3 = b2 + kstep;
            asm volatile("" : "+v"(voffB[0]), "+v"(voffB[1]), "+v"(vA00), "+v"(vA01));
            if constexpr (GATHER) asm volatile("" : "+v"(vA10), "+v"(vA11));
            unsigned x00 = vA00, x01 = vA01, x10 = vA10, x11 = vA11;
            if constexpr (GATHER) { if (last) { x00 = nA00; x01 = nA01; x10 = nA10; x11 = nA11; } }
            PG8_LDB(B0, 0, 0); PG8_LDB(B1, 0, 1); PG8_SCHED; PG8_LDA(At, 0, 0); PG8_STAGE_A1(PG8_SA(1, 1), a1, vA00, vA01, vA10, vA11);
            PG8_WAIT_V(8); PG8_WAIT_L(0); PG8_BAR; PG8_MMA(0, 0, At, B0); PG8_MMA(0, 1, At, B1); PG8_BAR; PG8_SCHED;
            PG8_LDA(At, 0, 1); PG8_STAGE(PG8_SB(0, 0), b2, voffB[0], voffB[1]); PG8_STAGE(PG8_SB(0, 1), b2 + hstepB, voffB[0], voffB[1]); PG8_STAGE_A0(PG8_SA(0, 0), a2, x00, x01);
            PG8_WAIT_V(8); PG8_WAIT_L(0); PG8_BAR; PG8_MMA(1, 0, At, B0); PG8_MMA(1, 1, At, B1); PG8_BAR; PG8_SCHED;
            PG8_LDB(B0, 1, 0); PG8_LDB(B1, 1, 1); PG8_SCHED; PG8_LDA(At, 1, 0); PG8_STAGE_A1(PG8_SA(0, 1), a2, x00, x01, x10, x11);
            PG8_WAIT_V(8); PG8_WAIT_L(0); PG8_BAR; PG8_MMA(0, 0, At, B0); PG8_MMA(0, 1, At, B1); PG8_BAR; PG8_SCHED;
            PG8_LDA(At, 1, 1); PG8_STAGE(PG8_SB(1, 0), b3, voffB[0], voffB[1]); PG8_STAGE(PG8_SB(1, 1), b3 + hstepB, voffB[0], voffB[1]); PG8_STAGE_A0(PG8_SA(1, 0), a3, x00, x01);
            PG8_WAIT_V(8); PG8_WAIT_L(0); PG8_BAR; PG8_MMA(1, 0, At, B0); PG8_MMA(1, 1, At, B1); PG8_BAR; PG8_SCHED;
        }
        if constexpr (ALIGN_EPI) { if (wr == 0) PG8_BAR; }
        if constexpr (ESZ == 1) asm volatile("s_nop 15\n\ts_nop 15" ::: "memory");
        E(acc, cur, wr, wc, fr, fq);
        if (!has_next) break;
#pragma unroll
        for (int a = 0; a < 2; ++a)
#pragma unroll
            for (int b = 0; b < 2; ++b)
#pragma unroll
                for (int m = 0; m < 4; ++m)
#pragma unroll
                    for (int n = 0; n < 2; ++n) acc[a][b][m][n] = (f32x4){0.f, 0.f, 0.f, 0.f};
        cur = nxt; cA = nA; cB = nB; ++ui;
        if constexpr (GATHER) { vA00 = nA00; vA01 = nA01; vA10 = nA10; vA11 = nA11; }
        if constexpr (ALIGN_EPI) { if (wr == 1) PG8_BAR; }
    }
    PG8_WAIT_V(0);
    if constexpr (!ALIGN_EPI) { if (wr == 0) PG8_BAR; }
    PG8_BAR;
#undef PG8_SA
#undef PG8_SB
#undef PG8_STAGE
#undef PG8_LDA
#undef PG8_LD16
#undef PG8_STAGE_A0
#undef PG8_STAGE_A1
#undef PG8_LDB
#undef PG8_MMA
#undef PG8_WAIT_V
#undef PG8_WAIT_L
#undef PG8_BAR
#undef PG8_SCHED
}
}

constexpr int NWAVES = 8;
constexpr int T = 8192, SEQ = 2048, NB = 4, D = 2048, INW = 2304, POOLW = 1024, NH = 16, NKV = 2, HD = 64, KVW = 128;
constexpr int NE = 64, TOPK = 8, EFF = 512, PLE = 256;
constexpr int SH_ROW0 = T * TOPK + NE * 256;
constexpr int NROWS = SH_ROW0 + T;
constexpr float EPS = 1e-6f;
constexpr float SW1 = 32.0f, SW2 = 16.0f, SA = 4.0f, SY = 16.0f, SW3 = 32.0f;
constexpr int N_PHASES = 10;
constexpr int N_LAUNCHES = MK_N_LAUNCHES;

constexpr size_t MiB = 1u << 20;
constexpr size_t WS_CTL = 0, CTL_ZERO_BYTES = 64 * 1024;
constexpr size_t WS_MISC = 1 * MiB;
constexpr size_t WS_TOKLIST = WS_MISC;
constexpr size_t WS_REC = WS_TOKLIST + (size_t)NE * T * 4;
constexpr size_t WS_WREC = WS_REC + (size_t)T * TOPK * 4;
constexpr size_t WS_RSTDP = WS_WREC + (size_t)T * TOPK * 4;
constexpr size_t WS_PBF = 6 * MiB;
constexpr size_t WS_WIN = 12 * MiB;
constexpr size_t WS_WPOOL = WS_WIN + (size_t)INW * D * 2;
constexpr size_t WS_WOUT = WS_WPOOL + (size_t)4 * 256 * 256 * 2;
constexpr size_t WS_WPP = WS_WOUT + (size_t)D * D * 2;
constexpr size_t WS_WPG = WS_WPP + (size_t)D * PLE * 2;
constexpr size_t WS_WGU = WS_WPG + (size_t)D * D * 2;
constexpr size_t WS_WD = WS_WGU + (size_t)65 * 1024 * D;
constexpr size_t WS_XN = WS_WD + (size_t)65 * D * EFF;
constexpr size_t WS_PPROJ = WS_XN + (size_t)T * D * 2;
constexpr size_t WS_ACT = WS_PPROJ + (size_t)T * D * 2;
constexpr size_t WS_H2F8 = WS_ACT;
constexpr size_t WS_GBUF = WS_XN;
constexpr size_t WS_Y = WS_ACT + (size_t)NROWS * EFF * 2;
constexpr size_t WS_ABF = WS_Y;
constexpr size_t WS_UBF = WS_ABF + (size_t)T * D * 2;
constexpr size_t WS_QBF = WS_UBF + (size_t)T * POOLW * 2;
constexpr size_t WS_KV = WS_QBF + (size_t)T * 1024 * 2;
constexpr size_t WS_POOLED = WS_KV + (size_t)T * 2 * KVW * 2;
constexpr size_t WS_MIX = WS_POOLED + (size_t)T * POOLW * 2;
constexpr size_t WS_END = WS_Y + (size_t)NROWS * D * 2;
static_assert(WS_MIX + (size_t)T * D * 2 <= WS_END, "early activations fit under Y");
static_assert(WS_RSTDP + (size_t)T * 4 <= WS_PBF && WS_PBF + (size_t)T * PLE * 2 <= WS_WIN, "misc fits");
static_assert(WS_END <= (size_t)1024 * MiB, "workspace must fit 1 GiB");
constexpr int CW_BAR = 1024;
constexpr int CW_CNT = 8192;
static_assert((CW_CNT + 32 * NE) * 4 <= (int)CTL_ZERO_BYTES, "CTL words inside the memset region");

constexpr int RING_OFF = 0, RING_BYTES = 131072;
constexpr int LDS_BYTES = 163840;
constexpr int MISC_OFF = LDS_BYTES - 512;
constexpr int TAB_OFF = RING_BYTES;
constexpr int TB_CNT = 0, TB_PAD = 80, TB_XCUM = 160;

#define GAS __attribute__((address_space(1)))
#define LAS __attribute__((address_space(3)))
typedef unsigned short bf16;
typedef unsigned v4u __attribute__((ext_vector_type(4)));
typedef unsigned v2u __attribute__((ext_vector_type(2)));
typedef float f32x4 __attribute__((ext_vector_type(4)));
typedef short bf16x8 __attribute__((ext_vector_type(8)));
typedef GAS unsigned gu32;
#define RLX_AGENT __ATOMIC_RELAXED, __HIP_MEMORY_SCOPE_AGENT
#define LDS_WAIT() asm volatile("s_waitcnt lgkmcnt(0)" ::: "memory")
#define VM_WAIT() asm volatile("s_waitcnt vmcnt(0)" ::: "memory")
__device__ __forceinline__ unsigned pk2(float lo, float hi) { return pg8::cvt_pk_bf16(lo, hi); }
__device__ __forceinline__ float bf_lo(unsigned w) { return __builtin_bit_cast(float, w << 16); }
__device__ __forceinline__ float bf_hi(unsigned w) { return __builtin_bit_cast(float, w & 0xffff0000u); }

#define XB_TMO      128
#define XB_XCNT(j)  (256  + 64 * (j))
#define XB_XSUB(j)  (1280 + 64 * (j))
#define XB_XGEN(j)  (2304 + 64 * (j))
#define XB_TOP      3328
#define XB_TOPGEN   3392
#define XCD_BAR_WORDS 3456
#define XB_SPIN_CAP (1u << 18)
__device__ __forceinline__ unsigned xb_ld(unsigned* p)              { return __hip_atomic_load(p, __ATOMIC_RELAXED, __HIP_MEMORY_SCOPE_AGENT); }
__device__ __forceinline__ unsigned xb_add(unsigned* p, unsigned v) { return __hip_atomic_fetch_add(p, v, __ATOMIC_RELAXED, __HIP_MEMORY_SCOPE_AGENT); }
__device__ __forceinline__ unsigned xb_xcc_id() { return (unsigned)__builtin_amdgcn_s_getreg((3 << 11) | 20) & 0xFu; }
#define XB_SPIN(cond, bar) do { unsigned _sp = 0; while (cond) { __builtin_amdgcn_s_sleep(1); \
    if ((++_sp & 255u) == 0u) { if (xb_ld(&(bar)[XB_TMO])) break; if (_sp > XB_SPIN_CAP) { atomicAdd(&(bar)[XB_TMO], 1u); break; } } } } while (0)
struct XcdBarrier { unsigned* bar; unsigned x; volatile LAS unsigned* st; };
__device__ __forceinline__ XcdBarrier xcd_barrier_post(unsigned* bar, volatile LAS unsigned* st) {
    XcdBarrier b; b.bar = bar; b.x = xb_xcc_id(); b.st = st;
    if (threadIdx.x == 0) (void)xb_add(&bar[XB_XCNT(b.x)], 1u);
    return b;
}
__device__ __forceinline__ void xcd_barrier_complete(unsigned* bar, unsigned x, unsigned& nloc, unsigned& nx) {
    const unsigned G = gridDim.x * gridDim.y * gridDim.z;
    unsigned sum, cnt, mine, sp = 0u;
    for (;;) {
        sum = 0u; cnt = 0u; mine = 0u;
#pragma unroll
        for (unsigned j = 0; j < 16; ++j) { const unsigned c = xb_ld(&bar[XB_XCNT(j)]); sum += c; cnt += (c > 0u) ? 1u : 0u; mine = (j == x) ? c : mine; }
        if (sum == G) break;
        __builtin_amdgcn_s_sleep(1);
        if ((++sp & 255u) == 0u) { if (xb_ld(&bar[XB_TMO])) break; if (sp > XB_SPIN_CAP) { atomicAdd(&bar[XB_TMO], 1u); break; } }
    }
    nloc = mine > 0u ? mine : 1u; nx = cnt > 0u ? cnt : 1u;
}
__device__ __forceinline__ void xcd_barrier(const XcdBarrier& b) {
    asm volatile("s_waitcnt vmcnt(0)" ::: "memory");
    __syncthreads();
    if (threadIdx.x == 0) {
        unsigned* bar = b.bar;
        __builtin_amdgcn_s_waitcnt(0);
        unsigned nloc = b.st[0], nx = b.st[1];
        if (nloc == 0u) { xcd_barrier_complete(bar, b.x, nloc, nx); b.st[0] = nloc; b.st[1] = nx; }
        const unsigned old = xb_add(&bar[XB_XSUB(b.x)], 1u);
        const unsigned gen = old / nloc;
        if (old + 1u == (gen + 1u) * nloc) {
            __builtin_amdgcn_fence(__ATOMIC_RELEASE, "agent");
            asm volatile("s_waitcnt vmcnt(0)" ::: "memory");
            const unsigned og = xb_add(&bar[XB_TOP], 1u);
            const unsigned tg = og / nx;
            if (og + 1u == (tg + 1u) * nx) xb_add(&bar[XB_TOPGEN], 1u);
            else XB_SPIN(xb_ld(&bar[XB_TOPGEN]) == tg, bar);
            __builtin_amdgcn_fence(__ATOMIC_ACQUIRE, "agent");
            xb_add(&bar[XB_XGEN(b.x)], 1u);
            asm volatile("s_waitcnt vmcnt(0)" ::: "memory");
        } else {
            XB_SPIN(xb_ld(&bar[XB_XGEN(b.x)]) == gen, bar);
            __builtin_amdgcn_fence(__ATOMIC_ACQUIRE, "agent");
            asm volatile("s_waitcnt vmcnt(0)" ::: "memory");
        }
    }
    __syncthreads();
}

struct Args { const float* in[22]; float* out; unsigned char* ws; int ph_lo, ph_hi, li, pad; };
struct Frame {
    LAS unsigned char* lds;
    volatile LAS unsigned* MISC;
    gu32* ctl;
    unsigned char* ws;
    int wave, G, bx;
    float* out;
};
__device__ __forceinline__ const float* fin(const Frame& F, int i) {
    const unsigned long long v = ((const LAS unsigned long long*)(F.lds + MISC_OFF + 256))[i];
    const unsigned lo = __builtin_amdgcn_readfirstlane((unsigned)v), hi = __builtin_amdgcn_readfirstlane((unsigned)(v >> 32));
    return (const float*)(const GAS float*)(((unsigned long long)hi << 32) | lo);
}
enum { I_X = 0, I_P, I_GMIX, I_WIN, I_WPOOL, I_PSCALE, I_SINKS, I_RPE, I_WOUT, I_GFFN, I_WROUTER, I_RBIAS, I_WGATE, I_WUP, I_WDOWN, I_WSGATE, I_WSUP, I_WSDOWN, I_WPLEPROJ, I_GPLE, I_WPLEGATE, I_GFINAL };

__device__ __forceinline__ float wave_sum(float v) {
#pragma unroll
    for (int o = 1; o < 64; o <<= 1) v += __shfl_xor(v, o);
    return v;
}

using pg8::Unit;
struct EpiInProj {
    static constexpr bool PERM = true;
    unsigned char* ws;
    __device__ __forceinline__ void operator()(const f32x4 (&acc)[2][2][4][2], const Unit& u, int wr, int wc, int fr, int fq) const {
        const int row0 = u.pm * 256 + wr * 64 + fr;
        const size_t boff = WS_UBF + (size_t)(u.pn >= 4 ? 1 : 0) * (WS_QBF - WS_UBF) + (size_t)(u.pn >= 8 ? 1 : 0) * (WS_KV - WS_QBF);
        bf16* base = (bf16*)(ws + boff); const int ldc = (u.pn < 8) ? 1024 : 256; const int col0 = (u.pn & 3) * 256 + wc * 32 + 8 * fq;
#pragma unroll
        for (int ai = 0; ai < 2; ++ai)
#pragma unroll
            for (int m = 0; m < 4; ++m) { bf16* rowp = base + (size_t)(row0 + ai * 128 + m * 16) * ldc + col0;
#pragma unroll
                for (int bj = 0; bj < 2; ++bj) { const f32x4 v0 = acc[ai][bj][m][0], v1 = acc[ai][bj][m][1];
                    v4u w; w.x = pk2(v0[0], v0[1]); w.y = pk2(v0[2], v0[3]); w.z = pk2(v1[0], v1[1]); w.w = pk2(v1[2], v1[3]);
                    *(v4u*)(rowp + bj * 128) = w; } }
    }
};
struct EpiBf16Plain {
    static constexpr bool PERM = true;
    bf16* O; int ldc; int col_off; const float* scale;
    __device__ __forceinline__ void operator()(const f32x4 (&acc)[2][2][4][2], const Unit& u, int wr, int wc, int fr, int fq) const {
        const int row0 = u.pm * 256 + wr * 64 + fr, colt = u.pn * 256 + wc * 32 + 8 * fq;
        f32x4 sv[2][2];
#pragma unroll
        for (int bj = 0; bj < 2; ++bj)
#pragma unroll
            for (int n = 0; n < 2; ++n) sv[bj][n] = scale ? *(const f32x4*)(scale + col_off + colt + bj * 128 + 4 * n) : (f32x4){1.f, 1.f, 1.f, 1.f};
#pragma unroll
        for (int ai = 0; ai < 2; ++ai)
#pragma unroll
            for (int m = 0; m < 4; ++m) { bf16* rowp = O + (size_t)(row0 + ai * 128 + m * 16) * ldc + col_off + colt;
#pragma unroll
                for (int bj = 0; bj < 2; ++bj) { const f32x4 v0 = acc[ai][bj][m][0] * sv[bj][0], v1 = acc[ai][bj][m][1] * sv[bj][1];
                    v4u w; w.x = pk2(v0[0], v0[1]); w.y = pk2(v0[2], v0[3]); w.z = pk2(v1[0], v1[1]); w.w = pk2(v1[2], v1[3]);
                    *(v4u*)(rowp + bj * 128) = w; } }
    }
};
struct EpiResF32 {
    static constexpr bool PERM = false;
    const float* base; float* C;
    __device__ __forceinline__ void operator()(const f32x4 (&acc)[2][2][4][2], const Unit& u, int wr, int wc, int fr, int fq) const {
        const int row0 = u.pm * 256 + wr * 64 + fr, col0 = u.pn * 256 + wc * 32 + 4 * fq;
#pragma unroll
        for (int ai = 0; ai < 2; ++ai)
#pragma unroll
            for (int m = 0; m < 4; ++m) { const size_t ro = (size_t)(row0 + ai * 128 + m * 16) * D + col0;
#pragma unroll
                for (int bj = 0; bj < 2; ++bj)
#pragma unroll
                    for (int n = 0; n < 2; ++n) { const f32x4 xb = *(const f32x4*)(base + ro + bj * 128 + n * 16); *(f32x4*)(C + ro + bj * 128 + n * 16) = xb + acc[ai][bj][m][n]; } }
    }
};
__device__ __forceinline__ float sigmoid_f(float v) { return __builtin_amdgcn_rcpf(1.0f + __expf(-v)); }
__device__ __forceinline__ unsigned pk4_fp8(float a, float b, float c, float d) { int w = 0; w = __builtin_amdgcn_cvt_pk_fp8_f32(a, b, w, false); w = __builtin_amdgcn_cvt_pk_fp8_f32(c, d, w, true); return (unsigned)w; }
typedef float f32x2_ __attribute__((ext_vector_type(2)));
__device__ __forceinline__ void fp8x4_to_f32(unsigned w, float (&o)[4]) { const f32x2_ lo = __builtin_amdgcn_cvt_pk_f32_fp8((int)w, false), hi = __builtin_amdgcn_cvt_pk_f32_fp8((int)w, true); o[0] = lo[0]; o[1] = lo[1]; o[2] = hi[0]; o[3] = hi[1]; }
struct EpiGateUp {
    static constexpr bool PERM = true;
    unsigned char* ACT;
    __device__ __forceinline__ void operator()(const f32x4 (&acc)[2][2][4][2], const Unit& u, int wr, int wc, int fr, int fq) const {
        const int row0 = u.pm * 256 + wr * 64 + fr, col0 = (u.pn & 3) * 128 + wc * 32 + 8 * fq;
        constexpr float IS = 1.0f / SW1;
#pragma unroll
        for (int ai = 0; ai < 2; ++ai)
#pragma unroll
            for (int m = 0; m < 4; ++m) { float o[8];
#pragma unroll
                for (int n = 0; n < 2; ++n)
#pragma unroll
                    for (int j = 0; j < 4; ++j) { const float gte = acc[ai][0][m][n][j] * IS, up = acc[ai][1][m][n][j] * (IS * SA); o[4 * n + j] = gte * sigmoid_f(gte) * up; }
                v2u w; w.x = pk4_fp8(o[0], o[1], o[2], o[3]); w.y = pk4_fp8(o[4], o[5], o[6], o[7]);
                *(v2u*)(ACT + (size_t)(row0 + ai * 128 + m * 16) * EFF + col0) = w; }
    }
};
struct EpiDown {
    static constexpr bool PERM = true;
    unsigned char* Y;
    __device__ __forceinline__ void operator()(const f32x4 (&acc)[2][2][4][2], const Unit& u, int wr, int wc, int fr, int fq) const {
        const int row0 = u.pm * 256 + wr * 64 + fr, col0 = (u.pn & 7) * 256 + wc * 32 + 8 * fq;
        constexpr float IS = SY / (SA * SW2);
#pragma unroll
        for (int ai = 0; ai < 2; ++ai)
#pragma unroll
            for (int m = 0; m < 4; ++m) { unsigned char* rowp = Y + (size_t)(row0 + ai * 128 + m * 16) * D + col0;
#pragma unroll
                for (int bj = 0; bj < 2; ++bj) { const f32x4 v0 = acc[ai][bj][m][0] * IS, v1 = acc[ai][bj][m][1] * IS;
                    v2u w; w.x = pk4_fp8(v0[0], v0[1], v0[2], v0[3]); w.y = pk4_fp8(v1[0], v1[1], v1[2], v1[3]);
                    *(v2u*)(rowp + bj * 128) = w; } }
    }
};
struct EpiBf16Mul {
    static constexpr bool PERM = true;
    bf16* O; float mul;
    __device__ __forceinline__ void operator()(const f32x4 (&acc)[2][2][4][2], const Unit& u, int wr, int wc, int fr, int fq) const {
        const int row0 = u.pm * 256 + wr * 64 + fr, colt = u.pn * 256 + wc * 32 + 8 * fq;
#pragma unroll
        for (int ai = 0; ai < 2; ++ai)
#pragma unroll
            for (int m = 0; m < 4; ++m) { bf16* rowp = O + (size_t)(row0 + ai * 128 + m * 16) * D + colt;
#pragma unroll
                for (int bj = 0; bj < 2; ++bj) { const f32x4 v0 = acc[ai][bj][m][0] * mul, v1 = acc[ai][bj][m][1] * mul;
                    v4u w; w.x = pk2(v0[0], v0[1]); w.y = pk2(v0[2], v0[3]); w.z = pk2(v1[0], v1[1]); w.w = pk2(v1[2], v1[3]);
                    *(v4u*)(rowp + bj * 128) = w; } }
    }
};
struct MoeOrder {
    const LAS int* tab; const int* toklist; int x, r, npn, stride;
    __device__ __forceinline__ bool next(int i, Unit& u) const {
        const int L = i * stride + r; const int tl = L / npn, pn = L - tl * npn;
        if (tl >= tab[TB_XCUM + 9]) return false;
        int s = 0;
#pragma unroll
        for (int q = 1; q <= 8; ++q) s += (tl >= tab[TB_XCUM + q]) ? 1 : 0;
        int lt = tl - tab[TB_XCUM + s], e, row0;
        if (s < 8) { e = x + 8 * s; row0 = tab[TB_PAD + e] + 256 * lt; } else { e = NE; lt = x + 8 * lt; row0 = SH_ROW0 + 256 * lt; }
        u.pm = __builtin_amdgcn_readfirstlane(row0 >> 8); u.pn = __builtin_amdgcn_readfirstlane(e * npn + pn); u.e = __builtin_amdgcn_readfirstlane(e); u.lt = __builtin_amdgcn_readfirstlane(lt); return true;
    }
    __device__ __forceinline__ int arow(const Unit& u, int r_) const {
        const int lr = u.lt * 256 + r_;
        const int ee = (u.e < NE) ? u.e : 0;
        const int tk = toklist[(size_t)ee * T + (lr < T - 1 ? lr : T - 1)];
        return (u.e == NE) ? lr : ((lr < tab[TB_CNT + ee]) ? tk : 0);
    }
};
__device__ __forceinline__ void moe_tables(Frame& F) {
    const int LANE_ = pg8::lane_id(), TID_ = F.wave * 64 + LANE_; (void)TID_;
    LAS int* tab = (LAS int*)(F.lds + TAB_OFF);
    if (TID_ < NE) tab[TB_CNT + TID_] = (int)__hip_atomic_load(F.ctl + CW_CNT + 32 * TID_, RLX_AGENT);
    if (TID_ == NE) tab[TB_CNT + NE] = T;
    __syncthreads();
    if (TID_ == 0) {
        int off = 0;
        for (int e = 0; e < NE; ++e) { tab[TB_PAD + e] = off; off += ((tab[TB_CNT + e] + 255) >> 8) << 8; }
        tab[TB_PAD + NE] = off;
        const int x = F.bx & 7; int c = 0; tab[TB_XCUM] = 0;
        for (int s = 0; s < 8; ++s) { c += (tab[TB_CNT + x + 8 * s] + 255) >> 8; tab[TB_XCUM + s + 1] = c; }
        tab[TB_XCUM + 9] = c + 4;
    }
    __syncthreads();
}

struct ConvJob { const float* src; bf16* dst; int N, ldk, mode, item; };
struct ConvJob8 { const float* src; unsigned char* dst; int N, ldk, mode, item; float scale; };
__device__ __forceinline__ void conv8_load(const ConvJob8& j, int lane, f32x4 (&v)[16]) {
    const int nblk = j.N >> 5, kb = j.item / nblk, nb = j.item - kb * nblk, k0 = 128 * kb, n0 = 32 * nb;
    const float* src = j.src + (size_t)(k0 + 16 * (lane >> 3)) * j.N + n0 + 4 * (lane & 7);
#pragma unroll
    for (int i = 0; i < 16; ++i) v[i] = __builtin_nontemporal_load((const f32x4*)(src + (size_t)i * j.N));
}
__device__ __forceinline__ void conv8_store(const ConvJob8& j, int lane, const f32x4 (&v)[16]) {
    const int nblk = j.N >> 5, kb = j.item / nblk, nb = j.item - kb * nblk, k0 = 128 * kb, n0 = 32 * nb; const float scale = j.scale;
#pragma unroll
    for (int q = 0; q < 4; ++q) { const int n = n0 + 4 * (lane & 7) + q; int dr = n;
        if (j.mode == 5) dr = ((n >> 7) << 8) + (n & 127); else if (j.mode == 6) dr = ((n >> 7) << 8) + 128 + (n & 127);
        v4u o; o.x = pk4_fp8(v[0][q] * scale, v[1][q] * scale, v[2][q] * scale, v[3][q] * scale); o.y = pk4_fp8(v[4][q] * scale, v[5][q] * scale, v[6][q] * scale, v[7][q] * scale);
        o.z = pk4_fp8(v[8][q] * scale, v[9][q] * scale, v[10][q] * scale, v[11][q] * scale); o.w = pk4_fp8(v[12][q] * scale, v[13][q] * scale, v[14][q] * scale, v[15][q] * scale);
        __builtin_nontemporal_store(o, (v4u*)(j.dst + (size_t)dr * j.ldk + k0 + 16 * (lane >> 3))); }
}
__device__ __forceinline__ void conv_load(const ConvJob& j, int lane, f32x4 (&v)[8]) {
    const int nblk = j.N >> 5, kb = j.item / nblk, nb = j.item - kb * nblk, k0 = 64 * kb, n0 = 32 * nb;
    const float* src = j.src + (size_t)(k0 + 8 * (lane >> 3)) * j.N + n0 + 4 * (lane & 7);
#pragma unroll
    for (int i = 0; i < 8; ++i) v[i] = __builtin_nontemporal_load((const f32x4*)(src + (size_t)i * j.N));
}
__device__ __forceinline__ void conv_store(const ConvJob& j, int lane, const f32x4 (&v)[8]) {
    const int nblk = j.N >> 5, kb = j.item / nblk, nb = j.item - kb * nblk, k0 = 64 * kb, n0 = 32 * nb;
#pragma unroll
    for (int q = 0; q < 4; ++q) { const int n = n0 + 4 * (lane & 7) + q; int dr = n;
        if (j.mode == 1) dr = ((n >> 7) << 8) + (n & 127); else if (j.mode == 2) dr = ((n >> 7) << 8) + 128 + (n & 127);
        v4u o; o.x = pk2(v[0][q], v[1][q]); o.y = pk2(v[2][q], v[3][q]); o.z = pk2(v[4][q], v[5][q]); o.w = pk2(v[6][q], v[7][q]);
        *(v4u*)(j.dst + (size_t)dr * j.ldk + k0 + 8 * (lane >> 3)) = o; }
}
__device__ __forceinline__ void rms_row_to_bf16(const float* xrow, const float* g, bf16* orow, int lane) {
    f32x4 v[8]; float s = 0.f;
#pragma unroll
    for (int j = 0; j < 4; ++j) { v[2 * j] = *(const f32x4*)(xrow + 512 * j + 8 * lane); v[2 * j + 1] = *(const f32x4*)(xrow + 512 * j + 8 * lane + 4); }
#pragma unroll
    for (int j = 0; j < 8; ++j) s += (v[j][0] * v[j][0] + v[j][1] * v[j][1]) + (v[j][2] * v[j][2] + v[j][3] * v[j][3]);
    const float rstd = 1.0f / sqrtf(wave_sum(s) * (1.0f / D) + EPS);
#pragma unroll
    for (int j = 0; j < 4; ++j) { const f32x4 g0 = *(const f32x4*)(g + 512 * j + 8 * lane), g1 = *(const f32x4*)(g + 512 * j + 8 * lane + 4);
        const f32x4 a = v[2 * j] * rstd * g0, b = v[2 * j + 1] * rstd * g1;
        v4u o; o.x = pk2(a[0], a[1]); o.y = pk2(a[2], a[3]); o.z = pk2(b[0], b[1]); o.w = pk2(b[2], b[3]);
        *(v4u*)(orow + 512 * j + 8 * lane) = o; }
}
constexpr int CV_G1 = (D / 128) * (EFF / 32), CV_D1 = (EFF / 128) * (D / 32), CV_G = 65 * CV_G1, CV_DN = 65 * CV_D1, CV_PG = (D / 128) * (D / 32), CV_TOTAL = 2 * CV_G + CV_DN + CV_PG;
constexpr int CONV_B = 896 * 16, CONV_C = 1024 * 20, CONV_A = CV_TOTAL - CONV_B - CONV_C;
__device__ __forceinline__ ConvJob8 conv8_decode(Frame& F, int it) {
    unsigned char* WGU8 = F.ws + WS_WGU; unsigned char* WDN8 = F.ws + WS_WD;
    int r = it;
    if (r < CV_G) { const int e = r / CV_G1, li = r - e * CV_G1; const float* src = (e < NE) ? fin(F, I_WGATE) + (size_t)e * D * EFF : fin(F, I_WSGATE);
        return ConvJob8{src, WGU8 + (size_t)e * 1024 * D, EFF, D, 5, li, SW1}; } r -= CV_G;
    if (r < CV_G) { const int e = r / CV_G1, li = r - e * CV_G1; const float* src = (e < NE) ? fin(F, I_WUP) + (size_t)e * D * EFF : fin(F, I_WSUP);
        return ConvJob8{src, WGU8 + (size_t)e * 1024 * D, EFF, D, 6, li, SW1}; } r -= CV_G;
    if (r < CV_DN) { const int e = r / CV_D1, li = r - e * CV_D1; const float* src = (e < NE) ? fin(F, I_WDOWN) + (size_t)e * EFF * D : fin(F, I_WSDOWN);
        return ConvJob8{src, WDN8 + (size_t)e * D * EFF, D, EFF, 4, li, SW2}; } r -= CV_DN;
    return ConvJob8{fin(F, I_WPLEGATE), F.ws + WS_WPG, D, D, 4, r, SW3};
}
__device__ __forceinline__ void conv_fp8_items(Frame& F, int lo, int hi, int rank, int nranks) {
    const int LANE_ = pg8::lane_id();
    int it0 = lo + rank; if (it0 >= hi) return;
    f32x4 va[16], vb[16];
    ConvJob8 j0 = conv8_decode(F, it0), j1 = j0; conv8_load(j0, LANE_, va);
    for (;;) {
        const int it1 = it0 + nranks; const bool has1 = it1 < hi;
        if (has1) { j1 = conv8_decode(F, it1); conv8_load(j1, LANE_, vb); }
        conv8_store(j0, LANE_, va);
        if (!has1) break;
        it0 = it1 + nranks; const bool has0 = it0 < hi;
        if (has0) { j0 = conv8_decode(F, it0); conv8_load(j0, LANE_, va); }
        conv8_store(j1, LANE_, vb);
        if (!has0) break;
    }
}
__device__ __forceinline__ void p0_prologue(Frame& F) {
    const int LANE_ = pg8::lane_id(), TID_ = F.wave * 64 + LANE_; (void)TID_;
    const int gw = F.bx * NWAVES + F.wave, NGW = F.G * NWAVES;
    bf16* WIN = (bf16*)(F.ws + WS_WIN); bf16* WPOOL = (bf16*)(F.ws + WS_WPOOL); bf16* WOUT = (bf16*)(F.ws + WS_WOUT); bf16* WPP = (bf16*)(F.ws + WS_WPP);
    constexpr int I_IN = (D / 64) * (INW / 32), I_PL = 4 * (256 / 64) * (256 / 32), I_OUT = (D / 64) * (D / 32), I_PP = (PLE / 64) * (D / 32), I_PG = (D / 64) * (D / 32);
    constexpr int I_SMALL = I_IN + I_PL + I_OUT + I_PP; (void)I_PG;
    auto decode = [&](int it) -> ConvJob {
        int r = it;
        if (r < I_IN) return ConvJob{fin(F, I_WIN), WIN, INW, D, 0, r}; r -= I_IN;
        if (r < I_PL) { const int gq = r >> 5; return ConvJob{fin(F, I_WPOOL) + (size_t)gq * 65536, WPOOL + (size_t)gq * 65536, 256, 256, 0, r & 31}; } r -= I_PL;
        if (r < I_OUT) return ConvJob{fin(F, I_WOUT), WOUT, D, D, 0, r}; r -= I_OUT;
        return ConvJob{fin(F, I_WPLEPROJ), WPP, D, PLE, 0, r};
    };
    for (int it = gw; it < I_SMALL; it += 2 * NGW) {
        const ConvJob j0 = decode(it); const bool two = (it + NGW) < I_SMALL; const ConvJob j1 = decode(two ? it + NGW : it);
        f32x4 v0[8], v1[8];
        conv_load(j0, LANE_, v0); conv_load(j1, LANE_, v1);
        conv_store(j0, LANE_, v0); if (two) conv_store(j1, LANE_, v1);
    }
    conv_fp8_items(F, 0, CONV_A, gw, NGW);
    { const float* P = fin(F, I_P); bf16* PB = (bf16*)(F.ws + WS_PBF);
      for (int i = gw * 64 + LANE_; i < T * PLE / 8; i += NGW * 64) { const f32x4 a = *(const f32x4*)(P + (size_t)i * 8), b = *(const f32x4*)(P + (size_t)i * 8 + 4);
          v4u o; o.x = pk2(a[0], a[1]); o.y = pk2(a[2], a[3]); o.z = pk2(b[0], b[1]); o.w = pk2(b[2], b[3]); *(v4u*)(PB + (size_t)i * 8) = o; } }
    bf16* ABF = (bf16*)(F.ws + WS_ABF);
    for (int m = gw; m < T; m += NGW) rms_row_to_bf16(fin(F, I_X) + (size_t)m * D, fin(F, I_GMIX), ABF + (size_t)m * D, LANE_);
}

__device__ __forceinline__ int t5_bucket(int n) {
    if (n < 16) return n;
    const int large = 16 + (int)(logf((float)n * (1.0f / 16.0f)) / logf(8.0f) * 16.0f);
    return large < 31 ? large : 31;
}
constexpr int VT_LD = 216, VT_KEYS = 208;
__device__ __forceinline__ void attn_task(Frame& F, const LAS float* btab, const LAS bf16* vtl, int b, int kvh, int hg, int qt) {
    const int LANE_ = pg8::lane_id();
    const bf16* Q = (const bf16*)(F.ws + WS_QBF); const bf16* Kb = (const bf16*)(F.ws + WS_KV); bf16* MIX = (bf16*)(F.ws + WS_MIX);
    const int lane = LANE_, qi = lane & 15, g = lane >> 4, h = kvh * 8 + hg;
    const int q0 = qt * 16, tok0 = b * SEQ;
    bf16x8 qf[2];
#pragma unroll
    for (int ks = 0; ks < 2; ++ks) qf[ks] = *(const bf16x8*)(Q + (size_t)(tok0 + q0 + qi) * 1024 + h * 64 + 32 * ks + 8 * g);
    f32x4 s[5][2];
#pragma unroll
    for (int kb = 0; kb < 5; ++kb)
#pragma unroll
        for (int t = 0; t < 2; ++t) {
            int key = q0 - 128 + 32 * kb + 8 * (qi >> 2) + 4 * t + (qi & 3); key = key < 0 ? 0 : (key > SEQ - 1 ? SEQ - 1 : key);
            const bf16* kp = Kb + (size_t)(tok0 + key) * (2 * KVW) + kvh * 64 + 8 * g;
            const bf16x8 k0f = *(const bf16x8*)(kp), k1f = *(const bf16x8*)(kp + 32);
            f32x4 a = (f32x4){0.f, 0.f, 0.f, 0.f};
            a = __builtin_amdgcn_mfma_f32_16x16x32_bf16(k0f, qf[0], a, 0, 0, 0);
            a = __builtin_amdgcn_mfma_f32_16x16x32_bf16(k1f, qf[1], a, 0, 0, 0);
            s[kb][t] = a;
        }
    const float sink = fin(F, I_SINKS)[h];
    const LAS float* bt = btab + hg * 128;
    float mx = sink;
#pragma unroll
    for (int kb = 0; kb < 5; ++kb)
#pragma unroll
        for (int t = 0; t < 2; ++t)
#pragma unroll
            for (int r = 0; r < 4; ++r) {
                const int key = q0 - 128 + 32 * kb + 8 * g + 4 * t + r, dist = q0 + qi - key;
                const bool valid = (dist >= 0) && (dist < 128) && (key >= 0);
                const float lg = valid ? s[kb][t][r] * 0.125f + bt[dist & 127] : -3.0e38f;
                s[kb][t][r] = lg; mx = fmaxf(mx, lg);
            }
    mx = fmaxf(mx, __shfl_xor(mx, 16)); mx = fmaxf(mx, __shfl_xor(mx, 32));
    float sum = 0.f;
#pragma unroll
    for (int kb = 0; kb < 5; ++kb)
#pragma unroll
        for (int t = 0; t < 2; ++t)
#pragma unroll
            for (int r = 0; r < 4; ++r) { const float lg = s[kb][t][r]; const float p = (lg > -1.0e38f) ? __expf(lg - mx) : 0.f; s[kb][t][r] = p; sum += p; }
    sum += __shfl_xor(sum, 16); sum += __shfl_xor(sum, 32);
    const float inv = 1.0f / (sum + __expf(sink - mx));
    f32x4 o[4];
#pragma unroll
    for (int dt = 0; dt < 4; ++dt) o[dt] = (f32x4){0.f, 0.f, 0.f, 0.f};
#pragma unroll
    for (int kb = 0; kb < 5; ++kb) {
        v4u pw; pw.x = pk2(s[kb][0][0], s[kb][0][1]); pw.y = pk2(s[kb][0][2], s[kb][0][3]); pw.z = pk2(s[kb][1][0], s[kb][1][1]); pw.w = pk2(s[kb][1][2], s[kb][1][3]);
        const bf16x8 pf = __builtin_bit_cast(bf16x8, pw);
        const int kkl = 16 * (qt & 3) + 32 * kb + 8 * g;
#pragma unroll
        for (int dt = 0; dt < 4; ++dt) {
            const bf16x8 vf = *(const LAS bf16x8*)(vtl + (16 * dt + qi) * VT_LD + kkl);
            o[dt] = __builtin_amdgcn_mfma_f32_16x16x32_bf16(vf, pf, o[dt], 0, 0, 0);
        }
    }
    bf16* op = MIX + (size_t)(tok0 + q0 + qi) * D + POOLW + h * 64 + 4 * g;
#pragma unroll
    for (int dt = 0; dt < 4; ++dt) { v2u w; w.x = pk2(o[dt][0] * inv, o[dt][1] * inv); w.y = pk2(o[dt][2] * inv, o[dt][3] * inv); *(v2u*)(op + 16 * dt) = w; }
}

__device__ __forceinline__ void pool_task(Frame& F, int mt, int gq) {
    const int LANE_ = pg8::lane_id(), TID_ = F.wave * 64 + LANE_; (void)TID_;
    const bf16* U = (const bf16*)(F.ws + WS_UBF); bf16* PO = (bf16*)(F.ws + WS_POOLED);
    const int w = 2 << gq;
    const int ch = gq * 256 + (TID_ & 31) * 8, tr0 = mt * 256 + (TID_ >> 5) * 16;
    const int pos0 = tr0 & (SEQ - 1);
    float run[8];
#pragma unroll
    for (int c = 0; c < 8; ++c) run[c] = 0.f;
    for (int j = 1; j < w; ++j) { if (pos0 - j >= 0) { const v4u x = *(const v4u*)(U + (size_t)(tr0 - j) * POOLW + ch);
        run[0] += bf_lo(x.x); run[1] += bf_hi(x.x); run[2] += bf_lo(x.y); run[3] += bf_hi(x.y); run[4] += bf_lo(x.z); run[5] += bf_hi(x.z); run[6] += bf_lo(x.w); run[7] += bf_hi(x.w); } }
    for (int i = 0; i < 16; ++i) {
        const int pos = pos0 + i; const v4u x = *(const v4u*)(U + (size_t)(tr0 + i) * POOLW + ch);
        float uv[8] = {bf_lo(x.x), bf_hi(x.x), bf_lo(x.y), bf_hi(x.y), bf_lo(x.z), bf_hi(x.z), bf_lo(x.w), bf_hi(x.w)};
        const float ic = 1.0f / (float)((pos + 1) < w ? (pos + 1) : w);
        float o[8];
#pragma unroll
        for (int c = 0; c < 8; ++c) { run[c] += uv[c]; o[c] = run[c] * ic - uv[c]; }
        v4u ow; ow.x = pk2(o[0], o[1]); ow.y = pk2(o[2], o[3]); ow.z = pk2(o[4], o[5]); ow.w = pk2(o[6], o[7]);
        *(v4u*)(PO + (size_t)(tr0 + i) * POOLW + ch) = ow;
        if (pos - w + 1 >= 0) { const v4u y = *(const v4u*)(U + (size_t)(tr0 + i - w + 1) * POOLW + ch);
            run[0] -= bf_lo(y.x); run[1] -= bf_hi(y.x); run[2] -= bf_lo(y.y); run[3] -= bf_hi(y.y); run[4] -= bf_lo(y.z); run[5] -= bf_hi(y.z); run[6] -= bf_lo(y.w); run[7] -= bf_hi(y.w); }
    }
    VM_WAIT(); __syncthreads();
    pg8::Gemm g{(const bf16*)PO + gq * 256, (const bf16*)(F.ws + WS_WPOOL) + (size_t)gq * 65536, POOLW, 256, 256};
    pg8::SingleOrder S{mt, 0};
    EpiBf16Plain E{(bf16*)(F.ws + WS_MIX), D, gq * 256, fin(F, I_PSCALE)};
    pg8::gemm_phase<EpiBf16Plain, pg8::SingleOrder, false>(F.lds + RING_OFF, g, S, E, F.wave);
}

constexpr int XS_STRIDE = 2052;
constexpr int P4_XS = 0, P4_PART = 16 * XS_STRIDE * 4, P4_SELE = P4_PART + 4 * 16 * 64 * 4, P4_SELW = P4_SELE + 32 * 8 * 4, P4_SELL = P4_SELW + 32 * 8 * 4, P4_HIST = P4_SELL + 32 * 8 * 4, P4_BASE = P4_HIST + 256, P4_END = P4_BASE + 256;
static_assert(P4_END <= MISC_OFF, "P4 LDS map");
__device__ __forceinline__ void p4_route(Frame& F) {
    const int LANE_ = pg8::lane_id(), TID_ = F.wave * 64 + LANE_; (void)TID_;
    LAS float* XS = (LAS float*)(F.lds + P4_XS); LAS float* PART = (LAS float*)(F.lds + P4_PART);
    LAS int* SELE = (LAS int*)(F.lds + P4_SELE); LAS float* SELW = (LAS float*)(F.lds + P4_SELW); LAS int* SELL = (LAS int*)(F.lds + P4_SELL);
    LAS int* HIST = (LAS int*)(F.lds + P4_HIST); LAS int* BASE = (LAS int*)(F.lds + P4_BASE);
    const float* H1 = F.out; unsigned char* XN = F.ws + WS_XN; const float* gf = fin(F, I_GFFN); const float* wr_ = fin(F, I_WROUTER); const float* rb = fin(F, I_RBIAS);
    const int lane = LANE_, wave = F.wave;
    if (TID_ < 64) HIST[TID_] = 0;
    for (int tile = F.bx; tile < T / 32; tile += F.G) {
    for (int pass = 0; pass < 2; ++pass) {
        const int tokp = tile * 32 + pass * 16;
#pragma unroll 1
        for (int q = 0; q < 2; ++q) {
            const int tl = 2 * wave + q; const float* xrow = H1 + (size_t)(tokp + tl) * D;
            f32x4 v[8]; float s = 0.f;
#pragma unroll
            for (int j = 0; j < 4; ++j) { v[2 * j] = *(const f32x4*)(xrow + 512 * j + 8 * lane); v[2 * j + 1] = *(const f32x4*)(xrow + 512 * j + 8 * lane + 4); }
#pragma unroll
            for (int j = 0; j < 8; ++j) s += (v[j][0] * v[j][0] + v[j][1] * v[j][1]) + (v[j][2] * v[j][2] + v[j][3] * v[j][3]);
            const float rstd = 1.0f / sqrtf(wave_sum(s) * (1.0f / D) + EPS);
#pragma unroll
            for (int j = 0; j < 4; ++j) { const f32x4 g0 = *(const f32x4*)(gf + 512 * j + 8 * lane), g1 = *(const f32x4*)(gf + 512 * j + 8 * lane + 4);
                const f32x4 a = v[2 * j] * rstd * g0, b = v[2 * j + 1] * rstd * g1;
                *(LAS f32x4*)(XS + tl * XS_STRIDE + 512 * j + 8 * lane) = a; *(LAS f32x4*)(XS + tl * XS_STRIDE + 512 * j + 8 * lane + 4) = b;
                v2u o; o.x = pk4_fp8(a[0], a[1], a[2], a[3]); o.y = pk4_fp8(b[0], b[1], b[2], b[3]);
                *(v2u*)(XN + (size_t)(tokp + tl) * D + 512 * j + 8 * lane) = o; }
        }
        __syncthreads();
        {
            const int ti = lane & 15, kk = lane >> 4;
            f32x4 acc[4];
#pragma unroll
            for (int et = 0; et < 4; ++et) acc[et] = (f32x4){0.f, 0.f, 0.f, 0.f};
            const LAS float* xa = XS + ti * XS_STRIDE + 256 * wave + kk;
            const float* wb = wr_ + (size_t)(256 * wave + kk) * NE + 4 * ti;
#pragma unroll 16
            for (int ks = 0; ks < 64; ++ks) { const float a = xa[4 * ks]; const f32x4 bw = *(const f32x4*)(wb + (size_t)4 * ks * NE);
#pragma unroll
                for (int et = 0; et < 4; ++et) acc[et] = __builtin_amdgcn_mfma_f32_16x16x4f32(a, bw[et], acc[et], 0, 0, 0); }
            if (wave >= 4) {
#pragma unroll
                for (int r = 0; r < 4; ++r) *(LAS f32x4*)(PART + (wave - 4) * 1024 + (4 * kk + r) * 64 + 4 * ti) = (f32x4){acc[0][r], acc[1][r], acc[2][r], acc[3][r]};
            }
            __syncthreads();
            if (wave < 4) {
#pragma unroll
                for (int r = 0; r < 4; ++r) { LAS f32x4* pp = (LAS f32x4*)(PART + wave * 1024 + (4 * kk + r) * 64 + 4 * ti); const f32x4 o = *pp;
                    *pp = (f32x4){o[0] + acc[0][r], o[1] + acc[1][r], o[2] + acc[2][r], o[3] + acc[3][r]}; }
            }
        }
        __syncthreads();
#pragma unroll 1
        for (int q = 0; q < 2; ++q) {
            const int tl = 2 * wave + q, tw = pass * 16 + tl;
            const float lg = (PART[tl * 64 + lane] + PART[1024 + tl * 64 + lane]) + (PART[2048 + tl * 64 + lane] + PART[3072 + tl * 64 + lane]);
            const float score = 1.0f / (1.0f + expf(-lg)), biased = score + rb[lane];
            const int grp = lane >> 3;
            float m1 = biased; m1 = fmaxf(m1, __shfl_xor(m1, 1)); m1 = fmaxf(m1, __shfl_xor(m1, 2)); m1 = fmaxf(m1, __shfl_xor(m1, 4));
            const unsigned long long bm = __ballot(biased == m1); const unsigned gb = (unsigned)(bm >> (8 * grp)) & 0xffu; const int first = __builtin_ctz(gb);
            float v2 = ((lane & 7) == first) ? -3.0e38f : biased; float m2 = v2; m2 = fmaxf(m2, __shfl_xor(m2, 1)); m2 = fmaxf(m2, __shfl_xor(m2, 2)); m2 = fmaxf(m2, __shfl_xor(m2, 4));
            const float gs = m1 + m2;
            int grank = 0;
#pragma unroll
            for (int j = 0; j < 8; ++j) { const float gj = __shfl(gs, 8 * j); grank += ((gj > gs) || (gj == gs && j < grp)) ? 1 : 0; }
            const bool gsel = grank < 4;
            const float masked = gsel ? biased : -3.0e38f;
            int rank = 0;
#pragma unroll
            for (int j = 0; j < 64; ++j) { const float vj = __shfl(masked, j); rank += ((vj > masked) || (vj == masked && j < lane)) ? 1 : 0; }
            const bool sel = gsel && (rank < 8);
            const float wsum = wave_sum(sel ? score : 0.f);
            const unsigned long long sm = __ballot(sel);
            if (sel) { const int k = __popcll(sm & ((1ull << lane) - 1ull)); const int li = atomicAdd((int*)&HIST[lane], 1);
                SELE[tw * 8 + k] = lane; SELW[tw * 8 + k] = score / wsum * 2.5f; SELL[tw * 8 + k] = li; }
        }
        __syncthreads();
    }
    if (TID_ < 64) BASE[TID_] = (int)__hip_atomic_fetch_add(F.ctl + CW_CNT + 32 * TID_, (unsigned)HIST[TID_], RLX_AGENT);
    __syncthreads();
    if (TID_ < 256) { const int e = SELE[TID_], pos = BASE[e] + SELL[TID_], tok = tile * 32 + (TID_ >> 3);
        ((int*)(F.ws + WS_TOKLIST))[(size_t)e * T + pos] = tok; ((float*)(F.ws + WS_WREC))[tok * 8 + (TID_ & 7)] = SELW[TID_]; ((int*)(F.ws + WS_REC))[tok * 8 + (TID_ & 7)] = e * T + pos; }
    __syncthreads();
    if (TID_ < 64) HIST[TID_] = 0;
    __syncthreads();
    }
}

__device__ __forceinline__ void p7_combine(Frame& F, bool dry) {
    const int LANE_ = pg8::lane_id();
    const LAS int* tab = (const LAS int*)(F.lds + TAB_OFF);
    const unsigned char* Y = F.ws + WS_Y; const int* rec = (const int*)(F.ws + WS_REC); const float* wrec = (const float*)(F.ws + WS_WREC);
    const float* H = F.out; float* HO = dry ? (float*)(F.ws + WS_WGU) : F.out; unsigned char* H2 = dry ? (F.ws + WS_WGU + 64 * MiB) : (F.ws + WS_H2F8);
    const int gw = F.bx * NWAVES + F.wave, NGW = F.G * NWAVES, lane = LANE_;
    for (int t = gw; t < T; t += NGW) {
        int rows[9]; float rwt[9];
#pragma unroll
        for (int k = 0; k < 8; ++k) { const int rc = rec[t * 8 + k]; const int e = rc >> 13, pos = rc & (T - 1); rows[k] = tab[TB_PAD + e] + pos; rwt[k] = wrec[t * 8 + k] * (1.0f / SY); }
        rows[8] = SH_ROW0 + t; rwt[8] = 1.0f / SY;
        v4u y[2][9]; f32x4 h[2][4];
#pragma unroll
        for (int j = 0; j < 2; ++j) { const int c0 = 1024 * j + 16 * lane;
#pragma unroll
            for (int q = 0; q < 4; ++q) h[j][q] = *(const f32x4*)(H + (size_t)t * D + c0 + 4 * q);
#pragma unroll
            for (int k = 0; k < 9; ++k) y[j][k] = *(const v4u*)(Y + (size_t)rows[k] * D + c0); }
#pragma unroll
        for (int j = 0; j < 2; ++j) { const int c0 = 1024 * j + 16 * lane;
#pragma unroll
            for (int k = 0; k < 9; ++k) { const float w = rwt[k]; float f[4];
                fp8x4_to_f32(y[j][k].x, f); h[j][0][0] += w * f[0]; h[j][0][1] += w * f[1]; h[j][0][2] += w * f[2]; h[j][0][3] += w * f[3];
                fp8x4_to_f32(y[j][k].y, f); h[j][1][0] += w * f[0]; h[j][1][1] += w * f[1]; h[j][1][2] += w * f[2]; h[j][1][3] += w * f[3];
                fp8x4_to_f32(y[j][k].z, f); h[j][2][0] += w * f[0]; h[j][2][1] += w * f[1]; h[j][2][2] += w * f[2]; h[j][2][3] += w * f[3];
                fp8x4_to_f32(y[j][k].w, f); h[j][3][0] += w * f[0]; h[j][3][1] += w * f[1]; h[j][3][2] += w * f[2]; h[j][3][3] += w * f[3]; }
#pragma unroll
            for (int q = 0; q < 4; ++q) *(f32x4*)(HO + (size_t)t * D + c0 + 4 * q) = h[j][q];
            v4u o; o.x = pk4_fp8(h[j][0][0], h[j][0][1], h[j][0][2], h[j][0][3]); o.y = pk4_fp8(h[j][1][0], h[j][1][1], h[j][1][2], h[j][1][3]);
            o.z = pk4_fp8(h[j][2][0], h[j][2][1], h[j][2][2], h[j][2][3]); o.w = pk4_fp8(h[j][3][0], h[j][3][1], h[j][3][2], h[j][3][3]);
            *(v4u*)(H2 + (size_t)t * D + c0) = o; }
    }
}
__device__ __forceinline__ void p9_final(Frame& F, bool dry) {
    const int LANE_ = pg8::lane_id();
    const int gw = F.bx * NWAVES + F.wave, NGW = F.G * NWAVES, lane = LANE_; const float* g = fin(F, I_GFINAL); const float* gp = fin(F, I_GPLE);
    const bf16* G = (const bf16*)(F.ws + WS_GBUF); const bf16* PP = (const bf16*)(F.ws + WS_PPROJ);
    for (int t = gw; t < T; t += NGW) {
        const float* row = F.out + (size_t)t * D; float* orow = (dry ? (float*)(F.ws + WS_WGU) : F.out) + (size_t)t * D; f32x4 v[8]; v4u gg[4], pw[4];
#pragma unroll
        for (int j = 0; j < 4; ++j) { v[2 * j] = *(const f32x4*)(row + 512 * j + 8 * lane); v[2 * j + 1] = *(const f32x4*)(row + 512 * j + 8 * lane + 4);
            gg[j] = *(const v4u*)(G + (size_t)t * D + 512 * j + 8 * lane); pw[j] = *(const v4u*)(PP + (size_t)t * D + 512 * j + 8 * lane); }
        float pf[4][8]; float ps = 0.f;
#pragma unroll
        for (int j = 0; j < 4; ++j) { pf[j][0] = bf_lo(pw[j].x); pf[j][1] = bf_hi(pw[j].x); pf[j][2] = bf_lo(pw[j].y); pf[j][3] = bf_hi(pw[j].y); pf[j][4] = bf_lo(pw[j].z); pf[j][5] = bf_hi(pw[j].z); pf[j][6] = bf_lo(pw[j].w); pf[j][7] = bf_hi(pw[j].w);
#pragma unroll
            for (int q = 0; q < 8; ++q) ps += pf[j][q] * pf[j][q]; }
        const float rsp = 1.0f / sqrtf(wave_sum(ps) * (1.0f / D) + EPS);
        float s = 0.f;
#pragma unroll
        for (int j = 0; j < 4; ++j) { const f32x4 g0 = *(const f32x4*)(gp + 512 * j + 8 * lane), g1 = *(const f32x4*)(gp + 512 * j + 8 * lane + 4);
            const float gl[8] = {bf_lo(gg[j].x), bf_hi(gg[j].x), bf_lo(gg[j].y), bf_hi(gg[j].y), bf_lo(gg[j].z), bf_hi(gg[j].z), bf_lo(gg[j].w), bf_hi(gg[j].w)};
#pragma unroll
            for (int q = 0; q < 4; ++q) { v[2 * j][q] += sigmoid_f(gl[q]) * pf[j][q] * rsp * g0[q]; v[2 * j + 1][q] += sigmoid_f(gl[4 + q]) * pf[j][4 + q] * rsp * g1[q]; }
            s += (v[2 * j][0] * v[2 * j][0] + v[2 * j][1] * v[2 * j][1]) + (v[2 * j][2] * v[2 * j][2] + v[2 * j][3] * v[2 * j][3]);
            s += (v[2 * j + 1][0] * v[2 * j + 1][0] + v[2 * j + 1][1] * v[2 * j + 1][1]) + (v[2 * j + 1][2] * v[2 * j + 1][2] + v[2 * j + 1][3] * v[2 * j + 1][3]); }
        const float rstd = 1.0f / sqrtf(wave_sum(s) * (1.0f / D) + EPS);
#pragma unroll
        for (int j = 0; j < 4; ++j) { const f32x4 g0 = *(const f32x4*)(g + 512 * j + 8 * lane), g1 = *(const f32x4*)(g + 512 * j + 8 * lane + 4);
            *(f32x4*)(orow + 512 * j + 8 * lane) = v[2 * j] * rstd * g0; *(f32x4*)(orow + 512 * j + 8 * lane + 4) = v[2 * j + 1] * rstd * g1; }
    }
}
__global__ void __launch_bounds__(NWAVES * 64, 2) fwd_kernel(Args args) {
    extern __shared__ __attribute__((aligned(16))) unsigned char lds[];
    Frame F;
    F.lds = (LAS unsigned char*)lds;
    F.MISC = (volatile LAS unsigned*)(F.lds + MISC_OFF);
    F.wave = __builtin_amdgcn_readfirstlane(threadIdx.x >> 6);
    F.G = gridDim.x; F.bx = blockIdx.x;
    F.ws = args.ws; F.ctl = (gu32*)(args.ws + WS_CTL); F.out = args.out;
    { const int TID_ = threadIdx.x;
    if (TID_ < 64) F.MISC[TID_] = 0u;
    if (TID_ >= 64 && TID_ < 64 + 22) ((LAS unsigned long long*)(F.lds + MISC_OFF + 256))[TID_ - 64] = ((const unsigned long long*)&args)[TID_ - 64]; }
    __syncthreads();
    XcdBarrier bar; bar.bar = (unsigned*)(F.ctl + CW_BAR); bar.x = 0; bar.st = nullptr;
    if (N_LAUNCHES == 1) bar = xcd_barrier_post((unsigned*)(F.ctl + CW_BAR), F.MISC + 8);
#define GRID_BAR() do { if (N_LAUNCHES == 1) xcd_barrier(bar); } while (0)
    const int lo = args.ph_lo, hi = args.ph_hi;
#ifndef PH_MASK
#define PH_MASK 0x3ff
#endif
#ifndef DUP_PHASE
#define DUP_PHASE -1
#endif
#define REPS(k) ((DUP_PHASE == (k)) ? 2 : 1)
#define IN(k) ((((PH_MASK) >> (k)) & 1) && lo <= (k) && (k) < hi)
#define BOTH(k) (IN(k) && IN((k) + 1))

    if (IN(0)) { _Pragma("unroll") for (int rep = 0; rep < REPS(0); ++rep) { p0_prologue(F); if (BOTH(0)) GRID_BAR(); } }

    if (IN(1)) { _Pragma("unroll") for (int rep = 0; rep < REPS(1); ++rep) {
        constexpr int G1 = 144;
        if (F.G == 256 && F.bx >= G1) {
            { pg8::Gemm g{(const bf16*)(F.ws + WS_PBF), (const bf16*)(F.ws + WS_WPP), PLE, PLE, PLE}; pg8::StaticOrder S; S.init(T, D, F.G - G1, F.bx - G1);
              EpiBf16Plain E{(bf16*)(F.ws + WS_PPROJ), D, 0, nullptr};
              pg8::gemm_phase<EpiBf16Plain, pg8::StaticOrder, false>(F.lds + RING_OFF, g, S, E, F.wave); }
            conv_fp8_items(F, CONV_A, CONV_A + CONV_B, (F.bx - G1) * NWAVES + F.wave, (F.G - G1) * NWAVES);
        } else {
            const int gg = (F.G == 256) ? G1 : F.G;
            { pg8::Gemm g{(const bf16*)(F.ws + WS_ABF), (const bf16*)(F.ws + WS_WIN), D, D, D}; pg8::StaticOrder S; S.init(T, INW, gg, F.bx);
              EpiInProj E{F.ws};
              pg8::gemm_phase<EpiInProj, pg8::StaticOrder, false>(F.lds + RING_OFF, g, S, E, F.wave); }
            if (F.G != 256) {
                { pg8::Gemm g{(const bf16*)(F.ws + WS_PBF), (const bf16*)(F.ws + WS_WPP), PLE, PLE, PLE}; pg8::StaticOrder S; S.init(T, D, F.G, F.bx);
                  EpiBf16Plain E{(bf16*)(F.ws + WS_PPROJ), D, 0, nullptr};
                  pg8::gemm_phase<EpiBf16Plain, pg8::StaticOrder, false>(F.lds + RING_OFF, g, S, E, F.wave); }
                conv_fp8_items(F, CONV_A, CONV_A + CONV_B, F.bx * NWAVES + F.wave, F.G * NWAVES);
            }
        }
        if (BOTH(1)) GRID_BAR();
    } }

    if (IN(2)) { _Pragma("unroll") for (int rep = 0; rep < REPS(2); ++rep) {
        LAS float* btab = (LAS float*)(F.lds + TAB_OFF + 2048);
        const int TID_ = F.wave * 64 + pg8::lane_id();
        for (int blk = F.bx; blk < 256; blk += F.G) {
            const int b = blk >> 6, kvh = (blk >> 5) & 1, qg = blk & 31;
            __syncthreads();
            for (int i = TID_; i < 1024; i += NWAVES * 64) { const int hg = i >> 7, dist = i & 127; btab[i] = fin(F, I_RPE)[t5_bucket(dist) * NH + kvh * 8 + hg]; }
            { LAS bf16* vtl = (LAS bf16*)(F.lds + RING_OFF); const bf16* KVp = (const bf16*)(F.ws + WS_KV);
              for (int idx = TID_; idx < VT_KEYS * 8; idx += NWAVES * 64) { const int kl = idx >> 3, c = idx & 7, key = 64 * qg - 128 + kl;
                  v4u v = (v4u){0u, 0u, 0u, 0u}; if (key >= 0 && key < SEQ) v = *(const v4u*)(KVp + (size_t)(b * SEQ + key) * (2 * KVW) + KVW + kvh * 64 + 8 * c);
                  LAS bf16* d0 = vtl + (8 * c) * VT_LD + kl;
                  d0[0 * VT_LD] = (bf16)(v.x & 0xffffu); d0[1 * VT_LD] = (bf16)(v.x >> 16); d0[2 * VT_LD] = (bf16)(v.y & 0xffffu); d0[3 * VT_LD] = (bf16)(v.y >> 16);
                  d0[4 * VT_LD] = (bf16)(v.z & 0xffffu); d0[5 * VT_LD] = (bf16)(v.z >> 16); d0[6 * VT_LD] = (bf16)(v.w & 0xffffu); d0[7 * VT_LD] = (bf16)(v.w >> 16); } }
            __syncthreads();
#pragma unroll 1
            for (int i = 0; i < 4; ++i) attn_task(F, btab, (const LAS bf16*)(F.lds + RING_OFF), b, kvh, F.wave, 4 * qg + i);
        }
        for (int p = F.bx; p < 128; p += F.G) { __syncthreads(); pool_task(F, p >> 2, p & 3); }
        if (BOTH(2)) GRID_BAR();
    } }

    if (IN(3)) { _Pragma("unroll") for (int rep = 0; rep < REPS(3); ++rep) {
        constexpr int G3 = 128;
        if (F.G == 256 && F.bx >= G3) conv_fp8_items(F, CONV_A + CONV_B, CV_TOTAL, (F.bx - G3) * NWAVES + F.wave, (F.G - G3) * NWAVES);
        else {
            pg8::Gemm g{(const bf16*)(F.ws + WS_MIX), (const bf16*)(F.ws + WS_WOUT), D, D, D}; pg8::StaticOrder S; S.init(T, D, (F.G == 256) ? G3 : F.G, F.bx);
            EpiResF32 E{fin(F, I_X), F.out};
            pg8::gemm_phase<EpiResF32, pg8::StaticOrder, false>(F.lds + RING_OFF, g, S, E, F.wave);
            if (F.G != 256) conv_fp8_items(F, CONV_A + CONV_B, CV_TOTAL, F.bx * NWAVES + F.wave, F.G * NWAVES);
        }
        if (BOTH(3)) GRID_BAR();
    } }

    if (IN(4)) { p4_route(F); if (BOTH(4)) GRID_BAR(); }

    if (IN(5)) { _Pragma("unroll") for (int rep = 0; rep < REPS(5); ++rep) {
        moe_tables(F);
        pg8::Gemm g{F.ws + WS_XN, F.ws + WS_WGU, D, D, D};
        MoeOrder S{(const LAS int*)(F.lds + TAB_OFF), (const int*)(F.ws + WS_TOKLIST), F.bx & 7, F.bx >> 3, 4, F.G >> 3};
        EpiGateUp E{F.ws + WS_ACT};
        pg8::gemm_phase<EpiGateUp, MoeOrder, true, 1>(F.lds + RING_OFF, g, S, E, F.wave);
        if (BOTH(5)) GRID_BAR();
    } }

    if (IN(6)) { _Pragma("unroll") for (int rep = 0; rep < REPS(6); ++rep) {
        if (!IN(5)) moe_tables(F);
        pg8::Gemm g{F.ws + WS_ACT, F.ws + WS_WD, EFF, EFF, EFF};
        MoeOrder S{(const LAS int*)(F.lds + TAB_OFF), (const int*)(F.ws + WS_TOKLIST), F.bx & 7, F.bx >> 3, 8, F.G >> 3};
        EpiDown E{F.ws + WS_Y};
        pg8::gemm_phase<EpiDown, MoeOrder, false, 1>(F.lds + RING_OFF, g, S, E, F.wave);
        if (BOTH(6)) GRID_BAR();
    } }

    if (IN(7)) { if (!IN(6)) moe_tables(F); if (DUP_PHASE == 7) { p7_combine(F, true); GRID_BAR(); } p7_combine(F, false); if (BOTH(7)) GRID_BAR(); }

    if (IN(8)) {
        pg8::Gemm g{F.ws + WS_H2F8, F.ws + WS_WPG, D, D, D}; pg8::StaticOrder S; S.init(T, D, F.G, F.bx);
        EpiBf16Mul E{(bf16*)(F.ws + WS_GBUF), 1.0f / SW3};
        pg8::gemm_phase<EpiBf16Mul, pg8::StaticOrder, false, 1>(F.lds + RING_OFF, g, S, E, F.wave);
        if (BOTH(8)) GRID_BAR();
    }

    if (IN(9)) { if (DUP_PHASE == 9) { p9_final(F, true); GRID_BAR(); } p9_final(F, false); }
#undef IN
#undef BOTH
}

extern "C" void kernel_launch(void* const* d_in, const int* in_sizes, int n_in, void* d_out, int out_size, void* d_ws, size_t ws_size, hipStream_t stream) {
    static int grid = 0;
    if (grid == 0) {
        if (n_in != 22 || out_size != T * D || ws_size < WS_END) { fprintf(stderr, "kernel_launch: unexpected sizes n_in %d out %d ws %zu (need %zu)\n", n_in, out_size, ws_size, (size_t)WS_END); grid = -1; return; }
        int dev = 0, cus = 0, per_cu = 0;
        if (hipGetDevice(&dev) != hipSuccess || hipDeviceGetAttribute(&cus, hipDeviceAttributeMultiprocessorCount, dev) != hipSuccess) { grid = -1; return; }
        if (hipFuncSetAttribute((const void*)fwd_kernel, hipFuncAttributeMaxDynamicSharedMemorySize, LDS_BYTES) != hipSuccess) { fprintf(stderr, "kernel_launch: hipFuncSetAttribute failed\n"); grid = -1; return; }
        if (hipOccupancyMaxActiveBlocksPerMultiprocessor(&per_cu, (const void*)fwd_kernel, NWAVES * 64, LDS_BYTES) != hipSuccess || per_cu < 1) fprintf(stderr, "kernel_launch: occupancy query reports %d\n", per_cu);
        (void)hipGetLastError();
        grid = cus > 256 ? 256 : cus;
    }
    if (grid < 0) return;
    if (hipMemsetAsync((char*)d_ws + WS_CTL, 0, CTL_ZERO_BYTES, stream) != hipSuccess) return;
    Args a{};
    for (int i = 0; i < 22; ++i) a.in[i] = (const float*)d_in[i];
    a.out = (float*)d_out; a.ws = (unsigned char*)d_ws;
    for (int li = 0; li < N_LAUNCHES; ++li) {
        a.ph_lo = (N_LAUNCHES == 1) ? 0 : li; a.ph_hi = (N_LAUNCHES == 1) ? N_PHASES : li + 1; a.li = li;
        hipLaunchKernelGGL(fwd_kernel, dim3(grid), dim3(NWAVES * 64), LDS_BYTES, stream, a);
    }
}
```

```cpp
#include <hip/hip_runtime.h>
#include <cstdio>
#include <cstdint>

#ifndef MK_N_LAUNCHES
#define MK_N_LAUNCHES 1
#endif

namespace pg8 {
#define PG8_LAS __attribute__((address_space(3)))
typedef unsigned short bf16_t;
typedef short bf16x8 __attribute__((ext_vector_type(8)));
typedef float f32x4 __attribute__((ext_vector_type(4)));
typedef unsigned u32x4 __attribute__((ext_vector_type(4)));
typedef unsigned u32x2 __attribute__((ext_vector_type(2)));
constexpr int BM = 256, BK = 64, HALF = 128, HTB = HALF * BK * 2  , STAGE_BYTES = 8 * HTB, NXCD = 8, WGM = 8;

__host__ __device__ __forceinline__ int lds_byte(int r, int c) { const int st = (r >> 4) * 2 + (c >> 5), rr = r & 15, cc = c & 31, ob = rr * 64 + cc * 2; return st * 1024 + (ob ^ (((ob >> 9) & 1) << 5)); }
__host__ __device__ __forceinline__ void stage_rc(int b, int& R, int& C) { const int st = b / 1024, sb = b % 1024, swz = sb ^ (((sb >> 9) & 1) << 5); R = (st >> 1) * 16 + swz / 64; C = (st & 1) * 32 + (swz % 64) / 2; }
__host__ __device__ __forceinline__ int perm32(int rho) { const int n = rho >> 4, i = rho & 15; return 8 * (i >> 2) + 4 * n + (i & 3); }

struct Unit { int pm, pn, e, lt; };
struct Gemm { const void* A; const void* Bt; int lda, ldb, K; };
typedef int i32x8 __attribute__((ext_vector_type(8)));
typedef int i32x4 __attribute__((ext_vector_type(4)));
__device__ __forceinline__ i32x8 cat8(bf16x8 lo, bf16x8 hi) { const i32x4 a = __builtin_bit_cast(i32x4, lo), b = __builtin_bit_cast(i32x4, hi); return __builtin_shufflevector(a, b, 0, 1, 2, 3, 4, 5, 6, 7); }

struct StaticOrder {
    int nM, nN, nwg, G, c;
    __host__ __device__ void init(int M, int N, int G_, int c_) { nM = M / BM; nN = N / BM; nwg = nM * nN; G = G_; c = c_; }
    __host__ __device__ bool next(int i, Unit& u) const {
        const long L = (long)i * G + c; if (L >= nwg) return false;
        int wgid = (int)L; { const int q = nwg / NXCD, r = nwg % NXCD, xcd = wgid % NXCD, off = wgid / NXCD; wgid = (xcd < r ? xcd * (q + 1) : r * (q + 1) + (xcd - r) * q) + off; }
        const int nig = WGM * nN, gid = wgid / nig, fm = gid * WGM, gsz = (nM - fm) < WGM ? (nM - fm) : WGM;
        u.pm = fm + ((wgid % nig) % gsz); u.pn = (wgid % nig) / gsz; u.e = 0; u.lt = 0; return true;
    }
    __device__ __forceinline__ int arow(const Unit&, int r) const { return r; }
};
struct SingleOrder {
    int pm, pn;
    __device__ bool next(int i, Unit& u) const { if (i > 0) return false; u.pm = pm; u.pn = pn; u.e = 0; u.lt = 0; return true; }
    __device__ __forceinline__ int arow(const Unit&, int r) const { return r; }
};

__device__ __forceinline__ int lane_id() { int l; asm volatile("v_mbcnt_lo_u32_b32 %0, -1, 0\n\tv_mbcnt_hi_u32_b32 %0, -1, %0" : "=v"(l)); return l; }
__device__ __forceinline__ unsigned cvt_pk_bf16(float lo, float hi) { unsigned r; asm volatile("v_cvt_pk_bf16_f32 %0, %1, %2" : "=v"(r) : "v"(lo), "v"(hi)); return r; }

template <class Epi, class Sched, bool GATHER, int ESZ = 2, bool ALIGN_EPI = true>
__device__ __forceinline__ void gemm_phase(PG8_LAS unsigned char* lds, const Gemm g, const Sched& S, const Epi& E, int wid) {
    const int lane = lane_id(), tid = wid * 64 + lane, wr = wid >> 2, wc = wid & 3, fr = lane & 15, fq = lane >> 4;
    const int nt = (g.K * ESZ) / 128;
    int Ra[2], Ca[2]; unsigned voffB[2];
#pragma unroll
    for (int i = 0; i < 2; ++i) { int R, C; stage_rc(tid * 16 + i * 8192, R, C); const int Rb = Epi::PERM ? ((R & ~31) + perm32(R & 31)) : R;
        Ra[i] = R; Ca[i] = C; voffB[i] = (unsigned)(Rb * g.ldb * ESZ + C * 2); }
    const size_t kstep = (size_t)(BK * 2);
    const size_t hstepB = (size_t)HALF * g.ldb * ESZ, tstepB = 2 * hstepB;
    const size_t tstepA = (size_t)BM * g.lda * ESZ;
    const unsigned ldsw = (unsigned)wid * 1024u;
    const int aoff = lds_byte(wr * 64 + fr, fq * 8), boff = lds_byte(wc * 32 + fr, fq * 8);
#define PG8_SA(b, h) (((b) * 2 + (h)) * HTB)
#define PG8_SB(b, h) ((4 + (b) * 2 + (h)) * HTB)
#define PG8_STAGE(bufoff, gbase, v0, v1) do { \
        __builtin_amdgcn_global_load_lds((const unsigned*)((const char*)(gbase) + (v0)), (PG8_LAS unsigned*)(lds + (bufoff) + ldsw), 16, 0, 0); \
        __builtin_amdgcn_global_load_lds((const unsigned*)((const char*)(gbase) + (v1)), (PG8_LAS unsigned*)(lds + (bufoff) + ldsw + 8192), 16, 0, 0); } while (0)
#define PG8_STAGE_A0(bufoff, gbase, p0, p1) PG8_STAGE(bufoff, gbase, p0, p1)
#define PG8_STAGE_A1(bufoff, gbase, p0, p1, q0, q1) do { if constexpr (GATHER) { PG8_STAGE(bufoff, gbase, q0, q1); } else { PG8_STAGE(bufoff, (gbase) + hstepA, p0, p1); } } while (0)
#define PG8_LD16(off) (*(const PG8_LAS i32x4*)(lds + (off)))
#define PG8_LDA(dst, b, h) do { if constexpr (ESZ == 2) { _Pragma("unroll") for (int m = 0; m < 4; ++m) _Pragma("unroll") for (int k = 0; k < 2; ++k) dst[m][k] = *(const PG8_LAS bf16x8*)(lds + PG8_SA(b, h) + aoff + m * 2048 + k * 1024); } \
        else { _Pragma("unroll") for (int m = 0; m < 4; ++m) dst##8[m] = __builtin_shufflevector(PG8_LD16(PG8_SA(b, h) + aoff + m * 2048), PG8_LD16(PG8_SA(b, h) + aoff + m * 2048 + 1024), 0, 1, 2, 3, 4, 5, 6, 7); } } while (0)
#define PG8_LDB(dst, b, h) do { if constexpr (ESZ == 2) { _Pragma("unroll") for (int n = 0; n < 2; ++n) _Pragma("unroll") for (int k = 0; k < 2; ++k) dst[n][k] = *(const PG8_LAS bf16x8*)(lds + PG8_SB(b, h) + boff + n * 2048 + k * 1024); } \
        else { _Pragma("unroll") for (int n = 0; n < 2; ++n) dst##8[n] = __builtin_shufflevector(PG8_LD16(PG8_SB(b, h) + boff + n * 2048), PG8_LD16(PG8_SB(b, h) + boff + n * 2048 + 1024), 0, 1, 2, 3, 4, 5, 6, 7); } } while (0)
#define PG8_MMA(ai, bj, At, Bt) do { __builtin_amdgcn_s_setprio(1); \
        if constexpr (ESZ == 2) { _Pragma("unroll") for (int m = 0; m < 4; ++m) _Pragma("unroll") for (int n = 0; n < 2; ++n) _Pragma("unroll") for (int k = 0; k < 2; ++k) \
            acc[ai][bj][m][n] = __builtin_amdgcn_mfma_f32_16x16x32_bf16(Bt[n][k], At[m][k], acc[ai][bj][m][n], 0, 0, 0); } \
        else { _Pragma("unroll") for (int m = 0; m < 4; ++m) _Pragma("unroll") for (int n = 0; n < 2; ++n) \
            asm volatile("v_mfma_scale_f32_16x16x128_f8f6f4 %0, %1, %2, %0, %3, %3 op_sel_hi:[0,0,0]" : "+v"(acc[ai][bj][m][n]) : "v"(Bt##8[n]), "v"(At##8[m]), "v"(sc1)); } \
        __builtin_amdgcn_s_setprio(0); } while (0)
#define PG8_WAIT_V(n) asm volatile("s_waitcnt vmcnt(" #n ")" ::: "memory")
#define PG8_WAIT_L(n) asm volatile("s_waitcnt lgkmcnt(" #n ")" ::: "memory")
#define PG8_BAR __builtin_amdgcn_s_barrier()
#define PG8_SCHED __builtin_amdgcn_sched_barrier(0)
    Unit cur, nxt; int ui = 0;
    if (!S.next(0, cur)) return;
    f32x4 acc[2][2][4][2];
#pragma unroll
    for (int a = 0; a < 2; ++a)
#pragma unroll
        for (int b = 0; b < 2; ++b)
#pragma unroll
            for (int m = 0; m < 4; ++m)
#pragma unroll
                for (int n = 0; n < 2; ++n) acc[a][b][m][n] = (f32x4){0.f, 0.f, 0.f, 0.f};
    const int sc1 = 0x7F7F7F7F;
    bf16x8 At[4][2], B0[2][2], B1[2][2]; i32x8 At8[4], B08[2], B18[2];
    unsigned vA00, vA01, vA10, vA11, nA00, nA01, nA10, nA11;
    const size_t hstepA = GATHER ? (size_t)0 : (size_t)HALF * g.lda * ESZ;
    if constexpr (GATHER) {
        vA00 = (unsigned)(S.arow(cur, Ra[0]) * g.lda * ESZ + Ca[0] * 2); vA01 = (unsigned)(S.arow(cur, Ra[1]) * g.lda * ESZ + Ca[1] * 2);
        vA10 = (unsigned)(S.arow(cur, HALF + Ra[0]) * g.lda * ESZ + Ca[0] * 2); vA11 = (unsigned)(S.arow(cur, HALF + Ra[1]) * g.lda * ESZ + Ca[1] * 2);
    } else {
        vA00 = (unsigned)(Ra[0] * g.lda * ESZ + Ca[0] * 2); vA01 = (unsigned)(Ra[1] * g.lda * ESZ + Ca[1] * 2); vA10 = 0; vA11 = 0;
    }
    nA00 = vA00; nA01 = vA01; nA10 = vA10; nA11 = vA11;
    const char* cA = (const char*)g.A + (GATHER ? (size_t)0 : (size_t)cur.pm * tstepA); const char* cB = (const char*)g.Bt + (size_t)cur.pn * tstepB;
    PG8_STAGE(PG8_SB(0, 0), cB, voffB[0], voffB[1]); PG8_STAGE(PG8_SB(0, 1), cB + hstepB, voffB[0], voffB[1]); PG8_STAGE_A0(PG8_SA(0, 0), cA, vA00, vA01); PG8_STAGE_A1(PG8_SA(0, 1), cA, vA00, vA01, vA10, vA11);
    if (wr == 1) PG8_BAR;
    PG8_WAIT_V(2); PG8_BAR;
    PG8_STAGE(PG8_SB(1, 0), cB + kstep, voffB[0], voffB[1]); PG8_STAGE_A0(PG8_SA(1, 0), cA + kstep, vA00, vA01); PG8_STAGE(PG8_SB(1, 1), cB + hstepB + kstep, voffB[0], voffB[1]);
    PG8_WAIT_V(6); PG8_BAR;
    for (;;) {
        const bool has_next = S.next(ui + 1, nxt);
        const char* nA = has_next ? (const char*)g.A + (GATHER ? (size_t)0 : (size_t)nxt.pm * tstepA) : cA; const char* nB = has_next ? (const char*)g.Bt + (size_t)nxt.pn * tstepB : cB;
        if constexpr (GATHER) {
            if (has_next) {
                nA00 = (unsigned)(S.arow(nxt, Ra[0]) * g.lda * ESZ + Ca[0] * 2); nA01 = (unsigned)(S.arow(nxt, Ra[1]) * g.lda * ESZ + Ca[1] * 2);
                nA10 = (unsigned)(S.arow(nxt, HALF + Ra[0]) * g.lda * ESZ + Ca[0] * 2); nA11 = (unsigned)(S.arow(nxt, HALF + Ra[1]) * g.lda * ESZ + Ca[1] * 2);
            } else { nA00 = vA00; nA01 = vA01; nA10 = vA10; nA11 = vA11; }
        }
#pragma nounroll
        for (int t = 0; t < nt; t += 2) {
            const bool last = (t == nt - 2);
            const char* a1 = cA + (size_t)(t + 1) * kstep;
            const char* a2 = last ? nA : cA + (size_t)(t + 2) * kstep; const char* b2 = last ? nB : cB + (size_t)(t + 2) * kstep;
            const char* a3 = a2 + kstep; const char* b3 = b2 + kstep;
            asm volatile("" : "+v"(voffB[0]), "+v"(voffB[1]), "+v"(vA00), "+v"(vA01));
            if constexpr (GATHER) asm volatile("" : "+v"(vA10), "+v"(vA11));
            unsigned x00 = vA00, x01 = vA01, x10 = vA10, x11 = vA11;
            if constexpr (GATHER) { if (last) { x00 = nA00; x01 = nA01; x10 = nA10; x11 = nA11; } }
            PG8_LDB(B0, 0, 0); PG8_LDB(B1, 0, 1); PG8_SCHED; PG8_LDA(At, 0, 0); PG8_STAGE_A1(PG8_SA(1, 1), a1, vA00, vA01, vA10, vA11);
            PG8_WAIT_V(8); PG8_WAIT_L(0); PG8_BAR; PG8_MMA(0, 0, At, B0); PG8_MMA(0, 1, At, B1); PG8_BAR; PG8_SCHED;
            PG8_LDA(At, 0, 1); PG8_STAGE(PG8_SB(0, 0), b2, voffB[0], voffB[1]); PG8_STAGE(PG8_SB(0, 1), b2 + hstepB, voffB[0], voffB[1]); PG8_STAGE_A0(PG8_SA(0, 0), a2, x00, x01);
            PG8_WAIT_V(8); PG8_WAIT_L(0); PG8_BAR; PG8_MMA(1, 0, At, B0); PG8_MMA(1, 1, At, B1); PG8_BAR; PG8_SCHED;
            PG8_LDB(B0, 1, 0); PG8_LDB(B1, 1, 1); PG8_SCHED; PG8_LDA(At, 1, 0); PG8_STAGE_A1(PG8_SA(0, 1), a2, x00, x01, x10, x11);
            PG8_WAIT_V(8); PG8_WAIT_L(0); PG8_BAR; PG8_MMA(0, 0, At, B0); PG8_MMA(0, 1, At, B1); PG8_BAR; PG8_SCHED;
            PG8_LDA(At, 1, 1); PG8_STAGE(PG8_SB(1, 0), b3, voffB[0], voffB[1]); PG8_STAGE(PG8_SB(1, 1), b3 + hstepB, voffB[0], voffB[1]); PG8_STAGE_A0(PG8_SA(1, 0), a3, x00, x01);
            PG8_WAIT_V(8); PG8_WAIT_L(0); PG8_BAR; PG8_MMA(1, 0, At, B0); PG8_MMA(1, 1, At, B1); PG8_BAR; PG8_SCHED;
        }
        if constexpr (ALIGN_EPI) { if (wr == 0) PG8_BAR; }
        if constexpr (ESZ == 1) asm volatile("s_nop 15\n\ts_nop 15" ::: "memory");
        E(acc, cur, wr, wc, fr, fq);
        if (!has_next) break;
#pragma unroll
        for (int a = 0; a < 2; ++a)
#pragma unroll
            for (int b = 0; b < 2; ++b)
#pragma unroll
                for (int m = 0; m < 4; ++m)
#pragma unroll
                    for (int n = 0; n < 2; ++n) acc[a][b][m][n] = (f32x4){0.f, 0.f, 0.f, 0.f};
        cur = nxt; cA = nA; cB = nB; ++ui;
        if constexpr (GATHER) { vA00 = nA00; vA01 = nA01; vA10 = nA10; vA11 = nA11; }
        if constexpr (ALIGN_EPI) { if (wr == 1) PG8_BAR; }
    }
    PG8_WAIT_V(0);
    if constexpr (!ALIGN_EPI) { if (wr == 0) PG8_BAR; }
    PG8_BAR;
#undef PG8_SA
#undef PG8_SB
#undef PG8_STAGE
#undef PG8_LDA
#undef PG8_LD16
#undef PG8_STAGE_A0
#undef PG8_STAGE_A1
#undef PG8_LDB
#undef PG8_MMA
#undef PG8_WAIT_V
#undef PG8_WAIT_L
#undef PG8_BAR
#undef PG8_SCHED
}
}

constexpr int NWAVES = 8;
constexpr int T = 8192, SEQ = 2048, NB = 4, D = 2048, INW = 2304, POOLW = 1024, NH = 16, NKV = 2, HD = 64, KVW = 128;
constexpr int NE = 64, TOPK = 8, EFF = 512, PLE = 256;
constexpr int SH_ROW0 = T * TOPK + NE * 256;
constexpr int NROWS = SH_ROW0 + T;
constexpr float EPS = 1e-6f;
constexpr float SW1 = 32.0f, SW2 = 16.0f, SA = 4.0f, SY = 16.0f, SW3 = 32.0f;
constexpr int N_PHASES = 10;
constexpr int N_LAUNCHES = MK_N_LAUNCHES;

constexpr size_t MiB = 1u << 20;
constexpr size_t WS_CTL = 0, CTL_ZERO_BYTES = 64 * 1024;
constexpr size_t WS_MISC = 1 * MiB;
constexpr size_t WS_TOKLIST = WS_MISC;
constexpr size_t WS_REC = WS_TOKLIST + (size_t)NE * T * 4;
constexpr size_t WS_WREC = WS_REC + (size_t)T * TOPK * 4;
constexpr size_t WS_RSTDP = WS_WREC + (size_t)T * TOPK * 4;
constexpr size_t WS_PBF = 6 * MiB;
constexpr size_t WS_WIN = 12 * MiB;
constexpr size_t WS_WPOOL = WS_WIN + (size_t)INW * D * 2;
constexpr size_t WS_WOUT = WS_WPOOL + (size_t)4 * 256 * 256 * 2;
constexpr size_t WS_WPP = WS_WOUT + (size_t)D * D * 2;
constexpr size_t WS_WPG = WS_WPP + (size_t)D * PLE * 2;
constexpr size_t WS_WGU = WS_WPG + (size_t)D * D * 2;
constexpr size_t WS_WD = WS_WGU + (size_t)65 * 1024 * D;
constexpr size_t WS_XN = WS_WD + (size_t)65 * D * EFF;
constexpr size_t WS_PPROJ = WS_XN + (size_t)T * D * 2;
constexpr size_t WS_ACT = WS_PPROJ + (size_t)T * D * 2;
constexpr size_t WS_H2F8 = WS_ACT;
constexpr size_t WS_GBUF = WS_XN;
constexpr size_t WS_Y = WS_ACT + (size_t)NROWS * EFF * 2;
constexpr size_t WS_ABF = WS_Y;
constexpr size_t WS_UBF = WS_ABF + (size_t)T * D * 2;
constexpr size_t WS_QBF = WS_UBF + (size_t)T * POOLW * 2;
constexpr size_t WS_KV = WS_QBF + (size_t)T * 1024 * 2;
constexpr size_t WS_POOLED = WS_KV + (size_t)T * 2 * KVW * 2;
constexpr size_t WS_MIX = WS_POOLED + (size_t)T * POOLW * 2;
constexpr size_t WS_END = WS_Y + (size_t)NROWS * D * 2;
static_assert(WS_MIX + (size_t)T * D * 2 <= WS_END, "early activations fit under Y");
static_assert(WS_RSTDP + (size_t)T * 4 <= WS_PBF && WS_PBF + (size_t)T * PLE * 2 <= WS_WIN, "misc fits");
static_assert(WS_END <= (size_t)1024 * MiB, "workspace must fit 1 GiB");
constexpr int CW_BAR = 1024;
constexpr int CW_CNT = 8192;
static_assert((CW_CNT + 32 * NE) * 4 <= (int)CTL_ZERO_BYTES, "CTL words inside the memset region");

constexpr int RING_OFF = 0, RING_BYTES = 131072;
constexpr int LDS_BYTES = 163840;
constexpr int MISC_OFF = LDS_BYTES - 512;
constexpr int TAB_OFF = RING_BYTES;
constexpr int TB_CNT = 0, TB_PAD = 80, TB_XCUM = 160;

#define GAS __attribute__((address_space(1)))
#define LAS __attribute__((address_space(3)))
typedef unsigned short bf16;
typedef unsigned v4u __attribute__((ext_vector_type(4)));
typedef unsigned v2u __attribute__((ext_vector_type(2)));
typedef float f32x4 __attribute__((ext_vector_type(4)));
typedef short bf16x8 __attribute__((ext_vector_type(8)));
typedef GAS unsigned gu32;
#define RLX_AGENT __ATOMIC_RELAXED, __HIP_MEMORY_SCOPE_AGENT
#define LDS_WAIT() asm volatile("s_waitcnt lgkmcnt(0)" ::: "memory")
#define VM_WAIT() asm volatile("s_waitcnt vmcnt(0)" ::: "memory")
__device__ __forceinline__ unsigned pk2(float lo, float hi) { return pg8::cvt_pk_bf16(lo, hi); }
__device__ __forceinline__ float bf_lo(unsigned w) { return __builtin_bit_cast(float, w << 16); }
__device__ __forceinline__ float bf_hi(unsigned w) { return __builtin_bit_cast(float, w & 0xffff0000u); }

#define XB_TMO      128
#define XB_XCNT(j)  (256  + 64 * (j))
#define XB_XSUB(j)  (1280 + 64 * (j))
#define XB_XGEN(j)  (2304 + 64 * (j))
#define XB_TOP      3328
#define XB_TOPGEN   3392
#define XCD_BAR_WORDS 3456
#define XB_SPIN_CAP (1u << 18)
__device__ __forceinline__ unsigned xb_ld(unsigned* p)              { return __hip_atomic_load(p, __ATOMIC_RELAXED, __HIP_MEMORY_SCOPE_AGENT); }
__device__ __forceinline__ unsigned xb_add(unsigned* p, unsigned v) { return __hip_atomic_fetch_add(p, v, __ATOMIC_RELAXED, __HIP_MEMORY_SCOPE_AGENT); }
__device__ __forceinline__ unsigned xb_xcc_id() { return (unsigned)__builtin_amdgcn_s_getreg((3 << 11) | 20) & 0xFu; }
#define XB_SPIN(cond, bar) do { unsigned _sp = 0; while (cond) { __builtin_amdgcn_s_sleep(1); \
    if ((++_sp & 255u) == 0u) { if (xb_ld(&(bar)[XB_TMO])) break; if (_sp > XB_SPIN_CAP) { atomicAdd(&(bar)[XB_TMO], 1u); break; } } } } while (0)
struct XcdBarrier { unsigned* bar; unsigned x; volatile LAS unsigned* st; };
__device__ __forceinline__ XcdBarrier xcd_barrier_post(unsigned* bar, volatile LAS unsigned* st) {
    XcdBarrier b; b.bar = bar; b.x = xb_xcc_id(); b.st = st;
    if (threadIdx.x == 0) (void)xb_add(&bar[XB_XCNT(b.x)], 1u);
    return b;
}
__device__ __forceinline__ void xcd_barrier_complete(unsigned* bar, unsigned x, unsigned& nloc, unsigned& nx) {
    const unsigned G = gridDim.x * gridDim.y * gridDim.z;
    unsigned sum, cnt, mine, sp = 0u;
    for (;;) {
        sum = 0u; cnt = 0u; mine = 0u;
#pragma unroll
        for (unsigned j = 0; j < 16; ++j) { const unsigned c = xb_ld(&bar[XB_XCNT(j)]); sum += c; cnt += (c > 0u) ? 1u : 0u; mine = (j == x) ? c : mine; }
        if (sum == G) break;
        __builtin_amdgcn_s_sleep(1);
        if ((++sp & 255u) == 0u) { if (xb_ld(&bar[XB_TMO])) break; if (sp > XB_SPIN_CAP) { atomicAdd(&bar[XB_TMO], 1u); break; } }
    }
    nloc = mine > 0u ? mine : 1u; nx = cnt > 0u ? cnt : 1u;
}
__device__ __forceinline__ void xcd_barrier(const XcdBarrier& b) {
    asm volatile("s_waitcnt vmcnt(0)" ::: "memory");
    __syncthreads();
    if (threadIdx.x == 0) {
        unsigned* bar = b.bar;
        __builtin_amdgcn_s_waitcnt(0);
        unsigned nloc = b.st[0], nx = b.st[1];
        if (nloc == 0u) { xcd_barrier_complete(bar, b.x, nloc, nx); b.st[0] = nloc; b.st[1] = nx; }
        const unsigned old = xb_add(&bar[XB_XSUB(b.x)], 1u);
        const unsigned gen = old / nloc;
        if (old + 1u == (gen + 1u) * nloc) {
            __builtin_amdgcn_fence(__ATOMIC_RELEASE, "agent");
            asm volatile("s_waitcnt vmcnt(0)" ::: "memory");
            const unsigned og = xb_add(&bar[XB_TOP], 1u);
            const unsigned tg = og / nx;
            if (og + 1u == (tg + 1u) * nx) xb_add(&bar[XB_TOPGEN], 1u);
            else XB_SPIN(xb_ld(&bar[XB_TOPGEN]) == tg, bar);
            __builtin_amdgcn_fence(__ATOMIC_ACQUIRE, "agent");
            xb_add(&bar[XB_XGEN(b.x)], 1u);
            asm volatile("s_waitcnt vmcnt(0)" ::: "memory");
        } else {
            XB_SPIN(xb_ld(&bar[XB_XGEN(b.x)]) == gen, bar);
            __builtin_amdgcn_fence(__ATOMIC_ACQUIRE, "agent");
            asm volatile("s_waitcnt vmcnt(0)" ::: "memory");
        }
    }
    __syncthreads();
}

struct Args { const float* in[22]; float* out; unsigned char* ws; int ph_lo, ph_hi, li, pad; };
struct Frame {
    LAS unsigned char* lds;
    volatile LAS unsigned* MISC;
    gu32* ctl;
    unsigned char* ws;
    int wave, G, bx;
    float* out;
};
__device__ __forceinline__ const float* fin(const Frame& F, int i) {
    const unsigned long long v = ((const LAS unsigned long long*)(F.lds + MISC_OFF + 256))[i];
    const unsigned lo = __builtin_amdgcn_readfirstlane((unsigned)v), hi = __builtin_amdgcn_readfirstlane((unsigned)(v >> 32));
    return (const float*)(const GAS float*)(((unsigned long long)hi << 32) | lo);
}
enum { I_X = 0, I_P, I_GMIX, I_WIN, I_WPOOL, I_PSCALE, I_SINKS, I_RPE, I_WOUT, I_GFFN, I_WROUTER, I_RBIAS, I_WGATE, I_WUP, I_WDOWN, I_WSGATE, I_WSUP, I_WSDOWN, I_WPLEPROJ, I_GPLE, I_WPLEGATE, I_GFINAL };

__device__ __forceinline__ float wave_sum(float v) {
#pragma unroll
    for (int o = 1; o < 64; o <<= 1) v += __shfl_xor(v, o);
    return v;
}

using pg8::Unit;
struct EpiInProj {
    static constexpr bool PERM = true;
    unsigned char* ws;
    __device__ __forceinline__ void operator()(const f32x4 (&acc)[2][2][4][2], const Unit& u, int wr, int wc, int fr, int fq) const {
        const int row0 = u.pm * 256 + wr * 64 + fr;
        const size_t boff = WS_UBF + (size_t)(u.pn >= 4 ? 1 : 0) * (WS_QBF - WS_UBF) + (size_t)(u.pn >= 8 ? 1 : 0) * (WS_KV - WS_QBF);
        bf16* base = (bf16*)(ws + boff); const int ldc = (u.pn < 8) ? 1024 : 256; const int col0 = (u.pn & 3) * 256 + wc * 32 + 8 * fq;
#pragma unroll
        for (int ai = 0; ai < 2; ++ai)
#pragma unroll
            for (int m = 0; m < 4; ++m) { bf16* rowp = base + (size_t)(row0 + ai * 128 + m * 16) * ldc + col0;
#pragma unroll
                for (int bj = 0; bj < 2; ++bj) { const f32x4 v0 = acc[ai][bj][m][0], v1 = acc[ai][bj][m][1];
                    v4u w; w.x = pk2(v0[0], v0[1]); w.y = pk2(v0[2], v0[3]); w.z = pk2(v1[0], v1[1]); w.w = pk2(v1[2], v1[3]);
                    *(v4u*)(rowp + bj * 128) = w; } }
    }
};
struct EpiBf16Plain {
    static constexpr bool PERM = true;
    bf16* O; int ldc; int col_off; const float* scale;
    __device__ __forceinline__ void operator()(const f32x4 (&acc)[2][2][4][2], const Unit& u, int wr, int wc, int fr, int fq) const {
        const int row0 = u.pm * 256 + wr * 64 + fr, colt = u.pn * 256 + wc * 32 + 8 * fq;
        f32x4 sv[2][2];
#pragma unroll
        for (int bj = 0; bj < 2; ++bj)
#pragma unroll
            for (int n = 0; n < 2; ++n) sv[bj][n] = scale ? *(const f32x4*)(scale + col_off + colt + bj * 128 + 4 * n) : (f32x4){1.f, 1.f, 1.f, 1.f};
#pragma unroll
        for (int ai = 0; ai < 2; ++ai)
#pragma unroll
            for (int m = 0; m < 4; ++m) { bf16* rowp = O + (size_t)(row0 + ai * 128 + m * 16) * ldc + col_off + colt;
#pragma unroll
                for (int bj = 0; bj < 2; ++bj) { const f32x4 v0 = acc[ai][bj][m][0] * sv[bj][0], v1 = acc[ai][bj][m][1] * sv[bj][1];
                    v4u w; w.x = pk2(v0[0], v0[1]); w.y = pk2(v0[2], v0[3]); w.z = pk2(v1[0], v1[1]); w.w = pk2(v1[2], v1[3]);
                    *(v4u*)(rowp + bj * 128) = w; } }
    }
};
struct EpiResF32 {
    static constexpr bool PERM = false;
    const float* base; float* C;
    __device__ __forceinline__ void operator()(const f32x4 (&acc)[2][2][4][2], const Unit& u, int wr, int wc, int fr, int fq) const {
        const int row0 = u.pm * 256 + wr * 64 + fr, col0 = u.pn * 256 + wc * 32 + 4 * fq;
#pragma unroll
        for (int ai = 0; ai < 2; ++ai)
#pragma unroll
            for (int mp = 0; mp < 2; ++mp) { f32x4 xb[2][2][2];
#pragma unroll
                for (int mm = 0; mm < 2; ++mm) { const size_t ro = (size_t)(row0 + ai * 128 + (2 * mp + mm) * 16) * D + col0;
#pragma unroll
                    for (int bj = 0; bj < 2; ++bj)
#pragma unroll
                        for (int n = 0; n < 2; ++n) xb[mm][bj][n] = *(const f32x4*)(base + ro + bj * 128 + n * 16); }
#pragma unroll
                for (int mm = 0; mm < 2; ++mm) { const size_t ro = (size_t)(row0 + ai * 128 + (2 * mp + mm) * 16) * D + col0;
#pragma unroll
                    for (int bj = 0; bj < 2; ++bj)
#pragma unroll
                        for (int n = 0; n < 2; ++n) *(f32x4*)(C + ro + bj * 128 + n * 16) = xb[mm][bj][n] + acc[ai][bj][2 * mp + mm][n]; } }
    }
};
__device__ __forceinline__ float sigmoid_f(float v) { return __builtin_amdgcn_rcpf(1.0f + __expf(-v)); }
__device__ __forceinline__ unsigned pk4_fp8(float a, float b, float c, float d) { int w = 0; w = __builtin_amdgcn_cvt_pk_fp8_f32(a, b, w, false); w = __builtin_amdgcn_cvt_pk_fp8_f32(c, d, w, true); return (unsigned)w; }
typedef float f32x2_ __attribute__((ext_vector_type(2)));
__device__ __forceinline__ void fp8x4_to_f32(unsigned w, float (&o)[4]) { const f32x2_ lo = __builtin_amdgcn_cvt_pk_f32_fp8((int)w, false), hi = __builtin_amdgcn_cvt_pk_f32_fp8((int)w, true); o[0] = lo[0]; o[1] = lo[1]; o[2] = hi[0]; o[3] = hi[1]; }
struct EpiGateUp {
    static constexpr bool PERM = true;
    unsigned char* ACT;
    __device__ __forceinline__ void operator()(const f32x4 (&acc)[2][2][4][2], const Unit& u, int wr, int wc, int fr, int fq) const {
        const int row0 = u.pm * 256 + wr * 64 + fr, col0 = (u.pn & 3) * 128 + wc * 32 + 8 * fq;
        constexpr float IS = 1.0f / SW1;
#pragma unroll
        for (int ai = 0; ai < 2; ++ai)
#pragma unroll
            for (int m = 0; m < 4; ++m) { float o[8];
#pragma unroll
                for (int n = 0; n < 2; ++n)
#pragma unroll
                    for (int j = 0; j < 4; ++j) { const float gte = acc[ai][0][m][n][j] * IS, up = acc[ai][1][m][n][j] * (IS * SA); o[4 * n + j] = gte * sigmoid_f(gte) * up; }
                v2u w; w.x = pk4_fp8(o[0], o[1], o[2], o[3]); w.y = pk4_fp8(o[4], o[5], o[6], o[7]);
                *(v2u*)(ACT + (size_t)(row0 + ai * 128 + m * 16) * EFF + col0) = w; }
    }
};
struct EpiDown {
    static constexpr bool PERM = true;
    unsigned char* Y;
    __device__ __forceinline__ void operator()(const f32x4 (&acc)[2][2][4][2], const Unit& u, int wr, int wc, int fr, int fq) const {
        const int row0 = u.pm * 256 + wr * 64 + fr, col0 = (u.pn & 7) * 256 + wc * 32 + 8 * fq;
        constexpr float IS = SY / (SA * SW2);
#pragma unroll
        for (int ai = 0; ai < 2; ++ai)
#pragma unroll
            for (int m = 0; m < 4; ++m) { unsigned char* rowp = Y + (size_t)(row0 + ai * 128 + m * 16) * D + col0;
#pragma unroll
                for (int bj = 0; bj < 2; ++bj) { const f32x4 v0 = acc[ai][bj][m][0] * IS, v1 = acc[ai][bj][m][1] * IS;
                    v2u w; w.x = pk4_fp8(v0[0], v0[1], v0[2], v0[3]); w.y = pk4_fp8(v1[0], v1[1], v1[2], v1[3]);
                    *(v2u*)(rowp + bj * 128) = w; } }
    }
};
struct EpiBf16Mul {
    static constexpr bool PERM = true;
    bf16* O; float mul;
    __device__ __forceinline__ void operator()(const f32x4 (&acc)[2][2][4][2], const Unit& u, int wr, int wc, int fr, int fq) const {
        const int row0 = u.pm * 256 + wr * 64 + fr, colt = u.pn * 256 + wc * 32 + 8 * fq;
#pragma unroll
        for (int ai = 0; ai < 2; ++ai)
#pragma unroll
            for (int m = 0; m < 4; ++m) { bf16* rowp = O + (size_t)(row0 + ai * 128 + m * 16) * D + colt;
#pragma unroll
                for (int bj = 0; bj < 2; ++bj) { const f32x4 v0 = acc[ai][bj][m][0] * mul, v1 = acc[ai][bj][m][1] * mul;
                    v4u w; w.x = pk2(v0[0], v0[1]); w.y = pk2(v0[2], v0[3]); w.z = pk2(v1[0], v1[1]); w.w = pk2(v1[2], v1[3]);
                    *(v4u*)(rowp + bj * 128) = w; } }
    }
};
struct MoeOrder {
    const LAS int* tab; const int* toklist; int x, r, npn, stride;
    __device__ __forceinline__ bool next(int i, Unit& u) const {
        const int L = i * stride + r; const int tl = L / npn, pn = L - tl * npn;
        if (tl >= tab[TB_XCUM + 9]) return false;
        int s = 0;
#pragma unroll
        for (int q = 1; q <= 8; ++q) s += (tl >= tab[TB_XCUM + q]) ? 1 : 0;
        int lt = tl - tab[TB_XCUM + s], e, row0;
        if (s < 8) { e = x + 8 * s; row0 = tab[TB_PAD + e] + 256 * lt; } else { e = NE; lt = x + 8 * lt; row0 = SH_ROW0 + 256 * lt; }
        u.pm = __builtin_amdgcn_readfirstlane(row0 >> 8); u.pn = __builtin_amdgcn_readfirstlane(e * npn + pn); u.e = __builtin_amdgcn_readfirstlane(e); u.lt = __builtin_amdgcn_readfirstlane(lt); return true;
    }
    __device__ __forceinline__ int arow(const Unit& u, int r_) const {
        const int lr = u.lt * 256 + r_;
        const int ee = (u.e < NE) ? u.e : 0;
        const int tk = toklist[(size_t)ee * T + (lr < T - 1 ? lr : T - 1)];
        return (u.e == NE) ? lr : ((lr < tab[TB_CNT + ee]) ? tk : 0);
    }
};
__device__ __forceinline__ void moe_tables(Frame& F) {
    const int LANE_ = pg8::lane_id(), TID_ = F.wave * 64 + LANE_; (void)TID_;
    LAS int* tab = (LAS int*)(F.lds + TAB_OFF);
    if (TID_ < NE) tab[TB_CNT + TID_] = (int)__hip_atomic_load(F.ctl + CW_CNT + 32 * TID_, RLX_AGENT);
    if (TID_ == NE) tab[TB_CNT + NE] = T;
    __syncthreads();
    if (TID_ == 0) {
        int off = 0;
        for (int e = 0; e < NE; ++e) { tab[TB_PAD + e] = off; off += ((tab[TB_CNT + e] + 255) >> 8) << 8; }
        tab[TB_PAD + NE] = off;
        const int x = F.bx & 7; int c = 0; tab[TB_XCUM] = 0;
        for (int s = 0; s < 8; ++s) { c += (tab[TB_CNT + x + 8 * s] + 255) >> 8; tab[TB_XCUM + s + 1] = c; }
        tab[TB_XCUM + 9] = c + 4;
    }
    __syncthreads();
}

struct ConvJob { const float* src; bf16* dst; int N, ldk, mode, item; };
struct ConvJob8 { const float* src; unsigned char* dst; int N, ldk, mode, item; float scale; };
__device__ __forceinline__ void conv8_load(const ConvJob8& j, int lane, f32x4 (&v)[16]) {
    const int nblk = j.N >> 5, kb = j.item / nblk, nb = j.item - kb * nblk, k0 = 128 * kb, n0 = 32 * nb;
    const float* src = j.src + (size_t)(k0 + 16 * (lane >> 3)) * j.N + n0 + 4 * (lane & 7);
#pragma unroll
    for (int i = 0; i < 16; ++i) v[i] = __builtin_nontemporal_load((const f32x4*)(src + (size_t)i * j.N));
}
__device__ __forceinline__ void conv8_store(const ConvJob8& j, int lane, const f32x4 (&v)[16]) {
    const int nblk = j.N >> 5, kb = j.item / nblk, nb = j.item - kb * nblk, k0 = 128 * kb, n0 = 32 * nb; const float scale = j.scale;
#pragma unroll
    for (int q = 0; q < 4; ++q) { const int n = n0 + 4 * (lane & 7) + q; int dr = n;
        if (j.mode == 5) dr = ((n >> 7) << 8) + (n & 127); else if (j.mode == 6) dr = ((n >> 7) << 8) + 128 + (n & 127);
        v4u o; o.x = pk4_fp8(v[0][q] * scale, v[1][q] * scale, v[2][q] * scale, v[3][q] * scale); o.y = pk4_fp8(v[4][q] * scale, v[5][q] * scale, v[6][q] * scale, v[7][q] * scale);
        o.z = pk4_fp8(v[8][q] * scale, v[9][q] * scale, v[10][q] * scale, v[11][q] * scale); o.w = pk4_fp8(v[12][q] * scale, v[13][q] * scale, v[14][q] * scale, v[15][q] * scale);
        __builtin_nontemporal_store(o, (v4u*)(j.dst + (size_t)dr * j.ldk + k0 + 16 * (lane >> 3))); }
}
__device__ __forceinline__ void conv_load(const ConvJob& j, int lane, f32x4 (&v)[8]) {
    const int nblk = j.N >> 5, kb = j.item / nblk, nb = j.item - kb * nblk, k0 = 64 * kb, n0 = 32 * nb;
    const float* src = j.src + (size_t)(k0 + 8 * (lane >> 3)) * j.N + n0 + 4 * (lane & 7);
#pragma unroll
    for (int i = 0; i < 8; ++i) v[i] = __builtin_nontemporal_load((const f32x4*)(src + (size_t)i * j.N));
}
__device__ __forceinline__ void conv_store(const ConvJob& j, int lane, const f32x4 (&v)[8]) {
    const int nblk = j.N >> 5, kb = j.item / nblk, nb = j.item - kb * nblk, k0 = 64 * kb, n0 = 32 * nb;
#pragma unroll
    for (int q = 0; q < 4; ++q) { const int n = n0 + 4 * (lane & 7) + q; int dr = n;
        if (j.mode == 1) dr = ((n >> 7) << 8) + (n & 127); else if (j.mode == 2) dr = ((n >> 7) << 8) + 128 + (n & 127);
        v4u o; o.x = pk2(v[0][q], v[1][q]); o.y = pk2(v[2][q], v[3][q]); o.z = pk2(v[4][q], v[5][q]); o.w = pk2(v[6][q], v[7][q]);
        *(v4u*)(j.dst + (size_t)dr * j.ldk + k0 + 8 * (lane >> 3)) = o; }
}
__device__ __forceinline__ void rms_row_to_bf16(const float* xrow, const float* g, bf16* orow, int lane) {
    f32x4 v[8]; float s = 0.f;
#pragma unroll
    for (int j = 0; j < 4; ++j) { v[2 * j] = *(const f32x4*)(xrow + 512 * j + 8 * lane); v[2 * j + 1] = *(const f32x4*)(xrow + 512 * j + 8 * lane + 4); }
#pragma unroll
    for (int j = 0; j < 8; ++j) s += (v[j][0] * v[j][0] + v[j][1] * v[j][1]) + (v[j][2] * v[j][2] + v[j][3] * v[j][3]);
    const float rstd = 1.0f / sqrtf(wave_sum(s) * (1.0f / D) + EPS);
#pragma unroll
    for (int j = 0; j < 4; ++j) { const f32x4 g0 = *(const f32x4*)(g + 512 * j + 8 * lane), g1 = *(const f32x4*)(g + 512 * j + 8 * lane + 4);
        const f32x4 a = v[2 * j] * rstd * g0, b = v[2 * j + 1] * rstd * g1;
        v4u o; o.x = pk2(a[0], a[1]); o.y = pk2(a[2], a[3]); o.z = pk2(b[0], b[1]); o.w = pk2(b[2], b[3]);
        *(v4u*)(orow + 512 * j + 8 * lane) = o; }
}
constexpr int CV_G1 = (D / 128) * (EFF / 32), CV_D1 = (EFF / 128) * (D / 32), CV_G = 65 * CV_G1, CV_DN = 65 * CV_D1, CV_PG = (D / 128) * (D / 32), CV_TOTAL = 2 * CV_G + CV_DN + CV_PG;
constexpr int CONV_B = 896 * 16, CONV_C = 1024 * 20, CONV_A = CV_TOTAL - CONV_B - CONV_C;
__device__ __forceinline__ ConvJob8 conv8_decode(Frame& F, int it) {
    unsigned char* WGU8 = F.ws + WS_WGU; unsigned char* WDN8 = F.ws + WS_WD;
    int r = it;
    if (r < CV_G) { const int e = r / CV_G1, li = r - e * CV_G1; const float* src = (e < NE) ? fin(F, I_WGATE) + (size_t)e * D * EFF : fin(F, I_WSGATE);
        return ConvJob8{src, WGU8 + (size_t)e * 1024 * D, EFF, D, 5, li, SW1}; } r -= CV_G;
    if (r < CV_G) { const int e = r / CV_G1, li = r - e * CV_G1; const float* src = (e < NE) ? fin(F, I_WUP) + (size_t)e * D * EFF : fin(F, I_WSUP);
        return ConvJob8{src, WGU8 + (size_t)e * 1024 * D, EFF, D, 6, li, SW1}; } r -= CV_G;
    if (r < CV_DN) { const int e = r / CV_D1, li = r - e * CV_D1; const float* src = (e < NE) ? fin(F, I_WDOWN) + (size_t)e * EFF * D : fin(F, I_WSDOWN);
        return ConvJob8{src, WDN8 + (size_t)e * D * EFF, D, EFF, 4, li, SW2}; } r -= CV_DN;
    return ConvJob8{fin(F, I_WPLEGATE), F.ws + WS_WPG, D, D, 4, r, SW3};
}
__device__ __forceinline__ void conv_fp8_items(Frame& F, int lo, int hi, int rank, int nranks) {
    const int LANE_ = pg8::lane_id();
    int it0 = lo + rank; if (it0 >= hi) return;
    f32x4 va[16], vb[16];
    ConvJob8 j0 = conv8_decode(F, it0), j1 = j0; conv8_load(j0, LANE_, va);
    for (;;) {
        const int it1 = it0 + nranks; const bool has1 = it1 < hi;
        if (has1) { j1 = conv8_decode(F, it1); conv8_load(j1, LANE_, vb); }
        conv8_store(j0, LANE_, va);
        if (!has1) break;
        it0 = it1 + nranks; const bool has0 = it0 < hi;
        if (has0) { j0 = conv8_decode(F, it0); conv8_load(j0, LANE_, va); }
        conv8_store(j1, LANE_, vb);
        if (!has0) break;
    }
}
__device__ __forceinline__ void p0_prologue(Frame& F) {
    const int LANE_ = pg8::lane_id(), TID_ = F.wave * 64 + LANE_; (void)TID_;
    const int gw = F.bx * NWAVES + F.wave, NGW = F.G * NWAVES;
    bf16* WIN = (bf16*)(F.ws + WS_WIN); bf16* WPOOL = (bf16*)(F.ws + WS_WPOOL); bf16* WOUT = (bf16*)(F.ws + WS_WOUT); bf16* WPP = (bf16*)(F.ws + WS_WPP);
    constexpr int I_IN = (D / 64) * (INW / 32), I_PL = 4 * (256 / 64) * (256 / 32), I_OUT = (D / 64) * (D / 32), I_PP = (PLE / 64) * (D / 32), I_PG = (D / 64) * (D / 32);
    constexpr int I_SMALL = I_IN + I_PL + I_OUT + I_PP; (void)I_PG;
    auto decode = [&](int it) -> ConvJob {
        int r = it;
        if (r < I_IN) return ConvJob{fin(F, I_WIN), WIN, INW, D, 0, r}; r -= I_IN;
        if (r < I_PL) { const int gq = r >> 5; return ConvJob{fin(F, I_WPOOL) + (size_t)gq * 65536, WPOOL + (size_t)gq * 65536, 256, 256, 0, r & 31}; } r -= I_PL;
        if (r < I_OUT) return ConvJob{fin(F, I_WOUT), WOUT, D, D, 0, r}; r -= I_OUT;
        return ConvJob{fin(F, I_WPLEPROJ), WPP, D, PLE, 0, r};
    };
    for (int it = gw; it < I_SMALL; it += 2 * NGW) {
        const ConvJob j0 = decode(it); const bool two = (it + NGW) < I_SMALL; const ConvJob j1 = decode(two ? it + NGW : it);
        f32x4 v0[8], v1[8];
        conv_load(j0, LANE_, v0); conv_load(j1, LANE_, v1);
        conv_store(j0, LANE_, v0); if (two) conv_store(j1, LANE_, v1);
    }
    conv_fp8_items(F, 0, CONV_A, gw, NGW);
    { const float* P = fin(F, I_P); bf16* PB = (bf16*)(F.ws + WS_PBF);
      for (int i = gw * 64 + LANE_; i < T * PLE / 8; i += NGW * 64) { const f32x4 a = *(const f32x4*)(P + (size_t)i * 8), b = *(const f32x4*)(P + (size_t)i * 8 + 4);
          v4u o; o.x = pk2(a[0], a[1]); o.y = pk2(a[2], a[3]); o.z = pk2(b[0], b[1]); o.w = pk2(b[2], b[3]); *(v4u*)(PB + (size_t)i * 8) = o; } }
    bf16* ABF = (bf16*)(F.ws + WS_ABF);
    for (int m = gw; m < T; m += NGW) rms_row_to_bf16(fin(F, I_X) + (size_t)m * D, fin(F, I_GMIX), ABF + (size_t)m * D, LANE_);
}

__device__ __forceinline__ int t5_bucket(int n) {
    if (n < 16) return n;
    const int large = 16 + (int)(logf((float)n * (1.0f / 16.0f)) / logf(8.0f) * 16.0f);
    return large < 31 ? large : 31;
}
constexpr int VT_LD = 216, VT_KEYS = 208, KT_LD = 72;
constexpr int ATT_KT_OFF = 0, ATT_VT_OFF = VT_KEYS * KT_LD * 2;
__device__ __forceinline__ void attn_task(Frame& F, const LAS float* btab, const LAS bf16* ktl, const LAS bf16* vtl, int b, int kvh, int hg, int qt, const bf16x8 (&qf)[2]) {
    const int LANE_ = pg8::lane_id();
    bf16* MIX = (bf16*)(F.ws + WS_MIX);
    const int lane = LANE_, qi = lane & 15, g = lane >> 4, h = kvh * 8 + hg;
    const int q0 = qt * 16, tok0 = b * SEQ, kl0 = 16 * (qt & 3);
    f32x4 s[5][2];
#pragma unroll
    for (int kb = 0; kb < 5; ++kb)
#pragma unroll
        for (int t = 0; t < 2; ++t) {
            const LAS bf16* kp = ktl + (kl0 + 32 * kb + 16 * t + qi) * KT_LD + 8 * g;
            const bf16x8 k0f = *(const LAS bf16x8*)(kp), k1f = *(const LAS bf16x8*)(kp + 32);
            f32x4 a = (f32x4){0.f, 0.f, 0.f, 0.f};
            a = __builtin_amdgcn_mfma_f32_16x16x32_bf16(k0f, qf[0], a, 0, 0, 0);
            a = __builtin_amdgcn_mfma_f32_16x16x32_bf16(k1f, qf[1], a, 0, 0, 0);
            s[kb][t] = a;
        }
    const float sink = fin(F, I_SINKS)[h];
    const LAS float* bt = btab + hg * 128;
    float mx = sink;
#pragma unroll
    for (int kb = 0; kb < 5; ++kb)
#pragma unroll
        for (int t = 0; t < 2; ++t)
#pragma unroll
            for (int r = 0; r < 4; ++r) {
                const int key = q0 - 128 + 32 * kb + 16 * t + 4 * g + r, dist = q0 + qi - key;
                const bool valid = (dist >= 0) && (dist < 128) && (key >= 0);
                const float lg = valid ? s[kb][t][r] * 0.125f + bt[dist & 127] : -3.0e38f;
                s[kb][t][r] = lg; mx = fmaxf(mx, lg);
            }
    mx = fmaxf(mx, __shfl_xor(mx, 16)); mx = fmaxf(mx, __shfl_xor(mx, 32));
    float sum = 0.f;
#pragma unroll
    for (int kb = 0; kb < 5; ++kb)
#pragma unroll
        for (int t = 0; t < 2; ++t)
#pragma unroll
            for (int r = 0; r < 4; ++r) { const float lg = s[kb][t][r]; const float p = (lg > -1.0e38f) ? __expf(lg - mx) : 0.f; s[kb][t][r] = p; sum += p; }
    sum += __shfl_xor(sum, 16); sum += __shfl_xor(sum, 32);
    const float inv = 1.0f / (sum + __expf(sink - mx));
    f32x4 o[4];
#pragma unroll
    for (int dt = 0; dt < 4; ++dt) o[dt] = (f32x4){0.f, 0.f, 0.f, 0.f};
#pragma unroll
    for (int kb = 0; kb < 5; ++kb) {
        v4u pw; pw.x = pk2(s[kb][0][0], s[kb][0][1]); pw.y = pk2(s[kb][0][2], s[kb][0][3]); pw.z = pk2(s[kb][1][0], s[kb][1][1]); pw.w = pk2(s[kb][1][2], s[kb][1][3]);
        const bf16x8 pf = __builtin_bit_cast(bf16x8, pw);
        const int kkl = kl0 + 32 * kb + 4 * g;
#pragma unroll
        for (int dt = 0; dt < 4; ++dt) {
            const LAS bf16* vp = vtl + (16 * dt + qi) * VT_LD + kkl;
            const v2u lo = *(const LAS v2u*)(vp), hi = *(const LAS v2u*)(vp + 16);
            const v4u vw = (v4u){lo.x, lo.y, hi.x, hi.y};
            o[dt] = __builtin_amdgcn_mfma_f32_16x16x32_bf16(__builtin_bit_cast(bf16x8, vw), pf, o[dt], 0, 0, 0);
        }
    }
    bf16* op = MIX + (size_t)(tok0 + q0 + qi) * D + POOLW + h * 64 + 4 * g;
#pragma unroll
    for (int dt = 0; dt < 4; ++dt) { v2u w; w.x = pk2(o[dt][0] * inv, o[dt][1] * inv); w.y = pk2(o[dt][2] * inv, o[dt][3] * inv); *(v2u*)(op + 16 * dt) = w; }
}
__device__ __forceinline__ void attn_block(Frame& F, int blk) {
    const int TID_ = F.wave * 64 + pg8::lane_id();
    LAS float* btab = (LAS float*)(F.lds + TAB_OFF + 2048);
    LAS bf16* ktl = (LAS bf16*)(F.lds + RING_OFF + ATT_KT_OFF); LAS bf16* vtl = (LAS bf16*)(F.lds + RING_OFF + ATT_VT_OFF);
    const int b = blk >> 6, kvh = (blk >> 5) & 1, qg = blk & 31;
    const bf16* Q = (const bf16*)(F.ws + WS_QBF); const bf16* KVp = (const bf16*)(F.ws + WS_KV);
    bf16x8 qf[4][2];
    { const int lane = TID_ & 63, qi = lane & 15, g = lane >> 4, h = kvh * 8 + F.wave;
#pragma unroll
      for (int i = 0; i < 4; ++i)
#pragma unroll
          for (int ks = 0; ks < 2; ++ks) qf[i][ks] = *(const bf16x8*)(Q + (size_t)(b * SEQ + 64 * qg + 16 * i + qi) * 1024 + h * 64 + 32 * ks + 8 * g); }
    __syncthreads();
    for (int i = TID_; i < 1024; i += NWAVES * 64) { const int hg = i >> 7, dist = i & 127; btab[i] = fin(F, I_RPE)[t5_bucket(dist) * NH + kvh * 8 + hg]; }
    for (int idx = TID_; idx < VT_KEYS * 8; idx += NWAVES * 64) { const int kl = idx >> 3, c = idx & 7, key = 64 * qg - 128 + kl;
        v4u kv = (v4u){0u, 0u, 0u, 0u}, v = (v4u){0u, 0u, 0u, 0u};
        if (key >= 0 && key < SEQ) { const bf16* rp = KVp + (size_t)(b * SEQ + key) * (2 * KVW) + kvh * 64 + 8 * c; kv = *(const v4u*)(rp); v = *(const v4u*)(rp + KVW); }
        *(LAS v4u*)(ktl + kl * KT_LD + 8 * c) = kv;
        LAS bf16* d0 = vtl + (8 * c) * VT_LD + kl;
        d0[0 * VT_LD] = (bf16)(v.x & 0xffffu); d0[1 * VT_LD] = (bf16)(v.x >> 16); d0[2 * VT_LD] = (bf16)(v.y & 0xffffu); d0[3 * VT_LD] = (bf16)(v.y >> 16);
        d0[4 * VT_LD] = (bf16)(v.z & 0xffffu); d0[5 * VT_LD] = (bf16)(v.z >> 16); d0[6 * VT_LD] = (bf16)(v.w & 0xffffu); d0[7 * VT_LD] = (bf16)(v.w >> 16); }
    __syncthreads();
#pragma unroll
    for (int i = 0; i < 4; ++i) attn_task(F, btab, ktl, vtl, b, kvh, F.wave, 4 * qg + i, qf[i]);
}
__device__ __forceinline__ void pool_task(Frame& F, int mt, int gq) {
    const int LANE_ = pg8::lane_id(), TID_ = F.wave * 64 + LANE_;
    const bf16* U = (const bf16*)(F.ws + WS_UBF); bf16* PO = (bf16*)(F.ws + WS_POOLED);
    LAS v4u* UL = (LAS v4u*)(F.lds + RING_OFF);
    const int w = 2 << gq;
    for (int hh = 0; hh < 2; ++hh) {
        const int tbase = mt * 256 + 128 * hh, pos0 = tbase & (SEQ - 1);
        __syncthreads();
        for (int idx = TID_; idx < 143 * 32; idx += NWAVES * 64) { const int r = idx >> 5, c = idx & 31;
            v4u x = (v4u){0u, 0u, 0u, 0u}; if (pos0 - 15 + r >= 0) x = *(const v4u*)(U + (size_t)(tbase - 15 + r) * POOLW + gq * 256 + 8 * c);
            UL[idx] = x; }
        __syncthreads();
        const int c = TID_ & 31, i0 = (TID_ >> 5) * 8;
        float run[8];
#pragma unroll
        for (int q = 0; q < 8; ++q) run[q] = 0.f;
        for (int j = 1; j < w; ++j) { const v4u x = UL[(15 + i0 - j) * 32 + c];
            run[0] += bf_lo(x.x); run[1] += bf_hi(x.x); run[2] += bf_lo(x.y); run[3] += bf_hi(x.y); run[4] += bf_lo(x.z); run[5] += bf_hi(x.z); run[6] += bf_lo(x.w); run[7] += bf_hi(x.w); }
#pragma unroll
        for (int i = 0; i < 8; ++i) {
            const int pos = pos0 + i0 + i; const v4u x = UL[(15 + i0 + i) * 32 + c], y = UL[(15 + i0 + i - w + 1) * 32 + c];
            const float uv[8] = {bf_lo(x.x), bf_hi(x.x), bf_lo(x.y), bf_hi(x.y), bf_lo(x.z), bf_hi(x.z), bf_lo(x.w), bf_hi(x.w)};
            const float ic = 1.0f / (float)((pos + 1) < w ? (pos + 1) : w);
            float o[8];
#pragma unroll
            for (int q = 0; q < 8; ++q) { run[q] += uv[q]; o[q] = run[q] * ic - uv[q]; }
            v4u ow; ow.x = pk2(o[0], o[1]); ow.y = pk2(o[2], o[3]); ow.z = pk2(o[4], o[5]); ow.w = pk2(o[6], o[7]);
            *(v4u*)(PO + (size_t)(tbase + i0 + i) * POOLW + gq * 256 + 8 * c) = ow;
            run[0] -= bf_lo(y.x); run[1] -= bf_hi(y.x); run[2] -= bf_lo(y.y); run[3] -= bf_hi(y.y); run[4] -= bf_lo(y.z); run[5] -= bf_hi(y.z); run[6] -= bf_lo(y.w); run[7] -= bf_hi(y.w);
        }
    }
    VM_WAIT(); __syncthreads();
    pg8::Gemm g{(const bf16*)PO + gq * 256, (const bf16*)(F.ws + WS_WPOOL) + (size_t)gq * 65536, POOLW, 256, 256};
    pg8::SingleOrder S{mt, 0};
    EpiBf16Plain E{(bf16*)(F.ws + WS_MIX), D, gq * 256, fin(F, I_PSCALE)};
    pg8::gemm_phase<EpiBf16Plain, pg8::SingleOrder, false>(F.lds + RING_OFF, g, S, E, F.wave);
}

constexpr int XS_STRIDE = 2052;
constexpr int P4_XS = 0, P4_PART = 16 * XS_STRIDE * 4, P4_SELE = P4_PART + 4 * 16 * 64 * 4, P4_SELW = P4_SELE + 32 * 8 * 4, P4_SELL = P4_SELW + 32 * 8 * 4, P4_HIST = P4_SELL + 32 * 8 * 4, P4_BASE = P4_HIST + 256, P4_END = P4_BASE + 256;
static_assert(P4_END <= MISC_OFF, "P4 LDS map");
__device__ __forceinline__ void p4_route(Frame& F) {
    const int LANE_ = pg8::lane_id(), TID_ = F.wave * 64 + LANE_; (void)TID_;
    LAS float* XS = (LAS float*)(F.lds + P4_XS); LAS float* PART = (LAS float*)(F.lds + P4_PART);
    LAS int* SELE = (LAS int*)(F.lds + P4_SELE); LAS float* SELW = (LAS float*)(F.lds + P4_SELW); LAS int* SELL = (LAS int*)(F.lds + P4_SELL);
    LAS int* HIST = (LAS int*)(F.lds + P4_HIST); LAS int* BASE = (LAS int*)(F.lds + P4_BASE);
    const float* H1 = F.out; unsigned char* XN = F.ws + WS_XN; const float* gf = fin(F, I_GFFN); const float* wr_ = fin(F, I_WROUTER); const float* rb = fin(F, I_RBIAS);
    const int lane = LANE_, wave = F.wave;
    if (TID_ < 64) HIST[TID_] = 0;
    for (int tile = F.bx; tile < T / 32; tile += F.G) {
    for (int pass = 0; pass < 2; ++pass) {
        const int tokp = tile * 32 + pass * 16;
#pragma unroll 1
        for (int q = 0; q < 2; ++q) {
            const int tl = 2 * wave + q; const float* xrow = H1 + (size_t)(tokp + tl) * D;
            f32x4 v[8]; float s = 0.f;
#pragma unroll
            for (int j = 0; j < 4; ++j) { v[2 * j] = *(const f32x4*)(xrow + 512 * j + 8 * lane); v[2 * j + 1] = *(const f32x4*)(xrow + 512 * j + 8 * lane + 4); }
#pragma unroll
            for (int j = 0; j < 8; ++j) s += (v[j][0] * v[j][0] + v[j][1] * v[j][1]) + (v[j][2] * v[j][2] + v[j][3] * v[j][3]);
            const float rstd = 1.0f / sqrtf(wave_sum(s) * (1.0f / D) + EPS);
#pragma unroll
            for (int j = 0; j < 4; ++j) { const f32x4 g0 = *(const f32x4*)(gf + 512 * j + 8 * lane), g1 = *(const f32x4*)(gf + 512 * j + 8 * lane + 4);
                const f32x4 a = v[2 * j] * rstd * g0, b = v[2 * j + 1] * rstd * g1;
                *(LAS f32x4*)(XS + tl * XS_STRIDE + 512 * j + 8 * lane) = a; *(LAS f32x4*)(XS + tl * XS_STRIDE + 512 * j + 8 * lane + 4) = b;
                v2u o; o.x = pk4_fp8(a[0], a[1], a[2], a[3]); o.y = pk4_fp8(b[0], b[1], b[2], b[3]);
                *(v2u*)(XN + (size_t)(tokp + tl) * D + 512 * j + 8 * lane) = o; }
        }
        __syncthreads();
        {
            const int ti = lane & 15, kk = lane >> 4;
            f32x4 acc[4];
#pragma unroll
            for (int et = 0; et < 4; ++et) acc[et] = (f32x4){0.f, 0.f, 0.f, 0.f};
            const LAS float* xa = XS + ti * XS_STRIDE + 256 * wave + kk;
            const float* wb = wr_ + (size_t)(256 * wave + kk) * NE + 4 * ti;
#pragma unroll 16
            for (int ks = 0; ks < 64; ++ks) { const float a = xa[4 * ks]; const f32x4 bw = *(const f32x4*)(wb + (size_t)4 * ks * NE);
#pragma unroll
                for (int et = 0; et < 4; ++et) acc[et] = __builtin_amdgcn_mfma_f32_16x16x4f32(a, bw[et], acc[et], 0, 0, 0); }
            if (wave >= 4) {
#pragma unroll
                for (int r = 0; r < 4; ++r) *(LAS f32x4*)(PART + (wave - 4) * 1024 + (4 * kk + r) * 64 + 4 * ti) = (f32x4){acc[0][r], acc[1][r], acc[2][r], acc[3][r]};
            }
            __syncthreads();
            if (wave < 4) {
#pragma unroll
                for (int r = 0; r < 4; ++r) { LAS f32x4* pp = (LAS f32x4*)(PART + wave * 1024 + (4 * kk + r) * 64 + 4 * ti); const f32x4 o = *pp;
                    *pp = (f32x4){o[0] + acc[0][r], o[1] + acc[1][r], o[2] + acc[2][r], o[3] + acc[3][r]}; }
            }
        }
        __syncthreads();
#pragma unroll 1
        for (int q = 0; q < 2; ++q) {
            const int tl = 2 * wave + q, tw = pass * 16 + tl;
            const float lg = (PART[tl * 64 + lane] + PART[1024 + tl * 64 + lane]) + (PART[2048 + tl * 64 + lane] + PART[3072 + tl * 64 + lane]);
            const float score = 1.0f / (1.0f + expf(-lg)), biased = score + rb[lane];
            const int grp = lane >> 3;
            float m1 = biased; m1 = fmaxf(m1, __shfl_xor(m1, 1)); m1 = fmaxf(m1, __shfl_xor(m1, 2)); m1 = fmaxf(m1, __shfl_xor(m1, 4));
            const unsigned long long bm = __ballot(biased == m1); const unsigned gb = (unsigned)(bm >> (8 * grp)) & 0xffu; const int first = __builtin_ctz(gb);
            float v2 = ((lane & 7) == first) ? -3.0e38f : biased; float m2 = v2; m2 = fmaxf(m2, __shfl_xor(m2, 1)); m2 = fmaxf(m2, __shfl_xor(m2, 2)); m2 = fmaxf(m2, __shfl_xor(m2, 4));
            const float gs = m1 + m2;
            int grank = 0;
#pragma unroll
            for (int j = 0; j < 8; ++j) { const float gj = __shfl(gs, 8 * j); grank += ((gj > gs) || (gj == gs && j < grp)) ? 1 : 0; }
            const bool gsel = grank < 4;
            const float masked = gsel ? biased : -3.0e38f;
            int rank = 0;
#pragma unroll
            for (int j = 0; j < 64; ++j) { const float vj = __shfl(masked, j); rank += ((vj > masked) || (vj == masked && j < lane)) ? 1 : 0; }
            const bool sel = gsel && (rank < 8);
            const float wsum = wave_sum(sel ? score : 0.f);
            const unsigned long long sm = __ballot(sel);
            if (sel) { const int k = __popcll(sm & ((1ull << lane) - 1ull)); const int li = atomicAdd((int*)&HIST[lane], 1);
                SELE[tw * 8 + k] = lane; SELW[tw * 8 + k] = score / wsum * 2.5f; SELL[tw * 8 + k] = li; }
        }
        __syncthreads();
    }
    if (TID_ < 64) BASE[TID_] = (int)__hip_atomic_fetch_add(F.ctl + CW_CNT + 32 * TID_, (unsigned)HIST[TID_], RLX_AGENT);
    __syncthreads();
    if (TID_ < 256) { const int e = SELE[TID_], pos = BASE[e] + SELL[TID_], tok = tile * 32 + (TID_ >> 3);
        ((int*)(F.ws + WS_TOKLIST))[(size_t)e * T + pos] = tok; ((float*)(F.ws + WS_WREC))[tok * 8 + (TID_ & 7)] = SELW[TID_]; ((int*)(F.ws + WS_REC))[tok * 8 + (TID_ & 7)] = e * T + pos; }
    __syncthreads();
    if (TID_ < 64) HIST[TID_] = 0;
    __syncthreads();
    }
}

__device__ __forceinline__ void p7_combine(Frame& F, bool dry) {
    const int LANE_ = pg8::lane_id();
    const LAS int* tab = (const LAS int*)(F.lds + TAB_OFF);
    const unsigned char* Y = F.ws + WS_Y; const int* rec = (const int*)(F.ws + WS_REC); const float* wrec = (const float*)(F.ws + WS_WREC);
    const float* H = F.out; float* HO = dry ? (float*)(F.ws + WS_WGU) : F.out; unsigned char* H2 = dry ? (F.ws + WS_WGU + 64 * MiB) : (F.ws + WS_H2F8);
    const int gw = F.bx * NWAVES + F.wave, NGW = F.G * NWAVES, lane = LANE_;
    for (int t = gw; t < T; t += NGW) {
        int rows[9]; float rwt[9];
#pragma unroll
        for (int k = 0; k < 8; ++k) { const int rc = rec[t * 8 + k]; const int e = rc >> 13, pos = rc & (T - 1); rows[k] = tab[TB_PAD + e] + pos; rwt[k] = wrec[t * 8 + k] * (1.0f / SY); }
        rows[8] = SH_ROW0 + t; rwt[8] = 1.0f / SY;
        v4u y[2][9]; f32x4 h[2][4];
#pragma unroll
        for (int j = 0; j < 2; ++j) { const int c0 = 1024 * j + 16 * lane;
#pragma unroll
            for (int q = 0; q < 4; ++q) h[j][q] = *(const f32x4*)(H + (size_t)t * D + c0 + 4 * q);
#pragma unroll
            for (int k = 0; k < 9; ++k) y[j][k] = *(const v4u*)(Y + (size_t)rows[k] * D + c0); }
#pragma unroll
        for (int j = 0; j < 2; ++j) { const int c0 = 1024 * j + 16 * lane;
#pragma unroll
            for (int k = 0; k < 9; ++k) { const float w = rwt[k]; float f[4];
                fp8x4_to_f32(y[j][k].x, f); h[j][0][0] += w * f[0]; h[j][0][1] += w * f[1]; h[j][0][2] += w * f[2]; h[j][0][3] += w * f[3];
                fp8x4_to_f32(y[j][k].y, f); h[j][1][0] += w * f[0]; h[j][1][1] += w * f[1]; h[j][1][2] += w * f[2]; h[j][1][3] += w * f[3];
                fp8x4_to_f32(y[j][k].z, f); h[j][2][0] += w * f[0]; h[j][2][1] += w * f[1]; h[j][2][2] += w * f[2]; h[j][2][3] += w * f[3];
                fp8x4_to_f32(y[j][k].w, f); h[j][3][0] += w * f[0]; h[j][3][1] += w * f[1]; h[j][3][2] += w * f[2]; h[j][3][3] += w * f[3]; }
#pragma unroll
            for (int q = 0; q < 4; ++q) *(f32x4*)(HO + (size_t)t * D + c0 + 4 * q) = h[j][q];
            v4u o; o.x = pk4_fp8(h[j][0][0], h[j][0][1], h[j][0][2], h[j][0][3]); o.y = pk4_fp8(h[j][1][0], h[j][1][1], h[j][1][2], h[j][1][3]);
            o.z = pk4_fp8(h[j][2][0], h[j][2][1], h[j][2][2], h[j][2][3]); o.w = pk4_fp8(h[j][3][0], h[j][3][1], h[j][3][2], h[j][3][3]);
            *(v4u*)(H2 + (size_t)t * D + c0) = o; }
    }
}
__device__ __forceinline__ void p9_final(Frame& F, bool dry) {
    const int LANE_ = pg8::lane_id();
    const int gw = F.bx * NWAVES + F.wave, NGW = F.G * NWAVES, lane = LANE_; const float* g = fin(F, I_GFINAL); const float* gp = fin(F, I_GPLE);
    const bf16* G = (const bf16*)(F.ws + WS_GBUF); const bf16* PP = (const bf16*)(F.ws + WS_PPROJ);
    for (int t = gw; t < T; t += NGW) {
        const float* row = F.out + (size_t)t * D; float* orow = (dry ? (float*)(F.ws + WS_WGU) : F.out) + (size_t)t * D; f32x4 v[8]; v4u gg[4], pw[4];
#pragma unroll
        for (int j = 0; j < 4; ++j) { v[2 * j] = *(const f32x4*)(row + 512 * j + 8 * lane); v[2 * j + 1] = *(const f32x4*)(row + 512 * j + 8 * lane + 4);
            gg[j] = *(const v4u*)(G + (size_t)t * D + 512 * j + 8 * lane); pw[j] = *(const v4u*)(PP + (size_t)t * D + 512 * j + 8 * lane); }
        float pf[4][8]; float ps = 0.f;
#pragma unroll
        for (int j = 0; j < 4; ++j) { pf[j][0] = bf_lo(pw[j].x); pf[j][1] = bf_hi(pw[j].x); pf[j][2] = bf_lo(pw[j].y); pf[j][3] = bf_hi(pw[j].y); pf[j][4] = bf_lo(pw[j].z); pf[j][5] = bf_hi(pw[j].z); pf[j][6] = bf_lo(pw[j].w); pf[j][7] = bf_hi(pw[j].w);
#pragma unroll
            for (int q = 0; q < 8; ++q) ps += pf[j][q] * pf[j][q]; }
        const float rsp = 1.0f / sqrtf(wave_sum(ps) * (1.0f / D) + EPS);
        float s = 0.f;
#pragma unroll
        for (int j = 0; j < 4; ++j) { const f32x4 g0 = *(const f32x4*)(gp + 512 * j + 8 * lane), g1 = *(const f32x4*)(gp + 512 * j + 8 * lane + 4);
            const float gl[8] = {bf_lo(gg[j].x), bf_hi(gg[j].x), bf_lo(gg[j].y), bf_hi(gg[j].y), bf_lo(gg[j].z), bf_hi(gg[j].z), bf_lo(gg[j].w), bf_hi(gg[j].w)};
#pragma unroll
            for (int q = 0; q < 4; ++q) { v[2 * j][q] += sigmoid_f(gl[q]) * pf[j][q] * rsp * g0[q]; v[2 * j + 1][q] += sigmoid_f(gl[4 + q]) * pf[j][4 + q] * rsp * g1[q]; }
            s += (v[2 * j][0] * v[2 * j][0] + v[2 * j][1] * v[2 * j][1]) + (v[2 * j][2] * v[2 * j][2] + v[2 * j][3] * v[2 * j][3]);
            s += (v[2 * j + 1][0] * v[2 * j + 1][0] + v[2 * j + 1][1] * v[2 * j + 1][1]) + (v[2 * j + 1][2] * v[2 * j + 1][2] + v[2 * j + 1][3] * v[2 * j + 1][3]); }
        const float rstd = 1.0f / sqrtf(wave_sum(s) * (1.0f / D) + EPS);
#pragma unroll
        for (int j = 0; j < 4; ++j) { const f32x4 g0 = *(const f32x4*)(g + 512 * j + 8 * lane), g1 = *(const f32x4*)(g + 512 * j + 8 * lane + 4);
            *(f32x4*)(orow + 512 * j + 8 * lane) = v[2 * j] * rstd * g0; *(f32x4*)(orow + 512 * j + 8 * lane + 4) = v[2 * j + 1] * rstd * g1; }
    }
}
__global__ void __launch_bounds__(NWAVES * 64, 2) fwd_kernel(Args args) {
    extern __shared__ __attribute__((aligned(16))) unsigned char lds[];
    Frame F;
    F.lds = (LAS unsigned char*)lds;
    F.MISC = (volatile LAS unsigned*)(F.lds + MISC_OFF);
    F.wave = __builtin_amdgcn_readfirstlane(threadIdx.x >> 6);
    F.G = gridDim.x; F.bx = blockIdx.x;
    F.ws = args.ws; F.ctl = (gu32*)(args.ws + WS_CTL); F.out = args.out;
    { const int TID_ = threadIdx.x;
    if (TID_ < 64) F.MISC[TID_] = 0u;
    if (TID_ >= 64 && TID_ < 64 + 22) ((LAS unsigned long long*)(F.lds + MISC_OFF + 256))[TID_ - 64] = ((const unsigned long long*)&args)[TID_ - 64]; }
    __syncthreads();
    XcdBarrier bar; bar.bar = (unsigned*)(F.ctl + CW_BAR); bar.x = 0; bar.st = nullptr;
    if (N_LAUNCHES == 1) bar = xcd_barrier_post((unsigned*)(F.ctl + CW_BAR), F.MISC + 8);
#define GRID_BAR() do { if (N_LAUNCHES == 1) xcd_barrier(bar); } while (0)
    const int lo = args.ph_lo, hi = args.ph_hi;
#ifndef PH_MASK
#define PH_MASK 0x3ff
#endif
#ifndef DUP_PHASE
#define DUP_PHASE -1
#endif
#define REPS(k) ((DUP_PHASE == (k)) ? 2 : 1)
#define IN(k) ((((PH_MASK) >> (k)) & 1) && lo <= (k) && (k) < hi)
#define BOTH(k) (IN(k) && IN((k) + 1))

    if (IN(0)) { _Pragma("unroll") for (int rep = 0; rep < REPS(0); ++rep) { p0_prologue(F); if (BOTH(0)) GRID_BAR(); } }

    if (IN(1)) { _Pragma("unroll") for (int rep = 0; rep < REPS(1); ++rep) {
        constexpr int G1 = 144;
        if (F.G == 256 && F.bx >= G1) {
            { pg8::Gemm g{(const bf16*)(F.ws + WS_PBF), (const bf16*)(F.ws + WS_WPP), PLE, PLE, PLE}; pg8::StaticOrder S; S.init(T, D, F.G - G1, F.bx - G1);
              EpiBf16Plain E{(bf16*)(F.ws + WS_PPROJ), D, 0, nullptr};
              pg8::gemm_phase<EpiBf16Plain, pg8::StaticOrder, false>(F.lds + RING_OFF, g, S, E, F.wave); }
            conv_fp8_items(F, CONV_A, CONV_A + CONV_B, (F.bx - G1) * NWAVES + F.wave, (F.G - G1) * NWAVES);
        } else {
            const int gg = (F.G == 256) ? G1 : F.G;
            { pg8::Gemm g{(const bf16*)(F.ws + WS_ABF), (const bf16*)(F.ws + WS_WIN), D, D, D}; pg8::StaticOrder S; S.init(T, INW, gg, F.bx);
              EpiInProj E{F.ws};
              pg8::gemm_phase<EpiInProj, pg8::StaticOrder, false>(F.lds + RING_OFF, g, S, E, F.wave); }
            if (F.G != 256) {
                { pg8::Gemm g{(const bf16*)(F.ws + WS_PBF), (const bf16*)(F.ws + WS_WPP), PLE, PLE, PLE}; pg8::StaticOrder S; S.init(T, D, F.G, F.bx);
                  EpiBf16Plain E{(bf16*)(F.ws + WS_PPROJ), D, 0, nullptr};
                  pg8::gemm_phase<EpiBf16Plain, pg8::StaticOrder, false>(F.lds + RING_OFF, g, S, E, F.wave); }
                conv_fp8_items(F, CONV_A, CONV_A + CONV_B, F.bx * NWAVES + F.wave, F.G * NWAVES);
            }
        }
        if (BOTH(1)) GRID_BAR();
    } }

    if (IN(2)) { _Pragma("unroll") for (int rep = 0; rep < REPS(2); ++rep) {
        if (F.G == 256) {
            if (F.bx < 128) pool_task(F, F.bx >> 2, F.bx & 3);
            else { attn_block(F, 2 * (F.bx - 128)); attn_block(F, 2 * (F.bx - 128) + 1); }
        } else {
            for (int blk = F.bx; blk < 256; blk += F.G) attn_block(F, blk);
            for (int p = F.bx; p < 128; p += F.G) { __syncthreads(); pool_task(F, p >> 2, p & 3); }
        }
        if (BOTH(2)) GRID_BAR();
    } }

    if (IN(3)) { _Pragma("unroll") for (int rep = 0; rep < REPS(3); ++rep) {
        constexpr int G3 = 128;
        if (F.G == 256 && F.bx >= G3) conv_fp8_items(F, CONV_A + CONV_B, CV_TOTAL, (F.bx - G3) * NWAVES + F.wave, (F.G - G3) * NWAVES);
        else {
            pg8::Gemm g{(const bf16*)(F.ws + WS_MIX), (const bf16*)(F.ws + WS_WOUT), D, D, D}; pg8::StaticOrder S; S.init(T, D, (F.G == 256) ? G3 : F.G, F.bx);
            EpiResF32 E{fin(F, I_X), F.out};
            pg8::gemm_phase<EpiResF32, pg8::StaticOrder, false>(F.lds + RING_OFF, g, S, E, F.wave);
            if (F.G != 256) conv_fp8_items(F, CONV_A + CONV_B, CV_TOTAL, F.bx * NWAVES + F.wave, F.G * NWAVES);
        }
        if (BOTH(3)) GRID_BAR();
    } }

    if (IN(4)) { p4_route(F); if (BOTH(4)) GRID_BAR(); }

    if (IN(5)) { _Pragma("unroll") for (int rep = 0; rep < REPS(5); ++rep) {
        moe_tables(F);
        pg8::Gemm g{F.ws + WS_XN, F.ws + WS_WGU, D, D, D};
        MoeOrder S{(const LAS int*)(F.lds + TAB_OFF), (const int*)(F.ws + WS_TOKLIST), F.bx & 7, F.bx >> 3, 4, F.G >> 3};
        EpiGateUp E{F.ws + WS_ACT};
        pg8::gemm_phase<EpiGateUp, MoeOrder, true, 1>(F.lds + RING_OFF, g, S, E, F.wave);
        if (BOTH(5)) GRID_BAR();
    } }

    if (IN(6)) { _Pragma("unroll") for (int rep = 0; rep < REPS(6); ++rep) {
        if (!IN(5)) moe_tables(F);
        pg8::Gemm g{F.ws + WS_ACT, F.ws + WS_WD, EFF, EFF, EFF};
        MoeOrder S{(const LAS int*)(F.lds + TAB_OFF), (const int*)(F.ws + WS_TOKLIST), F.bx & 7, F.bx >> 3, 8, F.G >> 3};
        EpiDown E{F.ws + WS_Y};
        pg8::gemm_phase<EpiDown, MoeOrder, false, 1>(F.lds + RING_OFF, g, S, E, F.wave);
        if (BOTH(6)) GRID_BAR();
    } }

    if (IN(7)) { if (!IN(6)) moe_tables(F); if (DUP_PHASE == 7) { p7_combine(F, true); GRID_BAR(); } p7_combine(F, false); if (BOTH(7)) GRID_BAR(); }

    if (IN(8)) {
        pg8::Gemm g{F.ws + WS_H2F8, F.ws + WS_WPG, D, D, D}; pg8::StaticOrder S; S.init(T, D, F.G, F.bx);
        EpiBf16Mul E{(bf16*)(F.ws + WS_GBUF), 1.0f / SW3};
        pg8::gemm_phase<EpiBf16Mul, pg8::StaticOrder, false, 1>(F.lds + RING_OFF, g, S, E, F.wave);
        if (BOTH(8)) GRID_BAR();
    }

    if (IN(9)) { if (DUP_PHASE == 9) { p9_final(F, true); GRID_BAR(); } p9_final(F, false); }
#undef IN
#undef BOTH
}

extern "C" void kernel_launch(void* const* d_in, const int* in_sizes, int n_in, void* d_out, int out_size, void* d_ws, size_t ws_size, hipStream_t stream) {
    static int grid = 0;
    if (grid == 0) {
        if (n_in != 22 || out_size != T * D || ws_size < WS_END) { fprintf(stderr, "kernel_launch: unexpected sizes n_in %d out %d ws %zu (need %zu)\n", n_in, out_size, ws_size, (size_t)WS_END); grid = -1; return; }
        int dev = 0, cus = 0, per_cu = 0;
        if (hipGetDevice(&dev) != hipSuccess || hipDeviceGetAttribute(&cus, hipDeviceAttributeMultiprocessorCount, dev) != hipSuccess) { grid = -1; return; }
        if (hipFuncSetAttribute((const void*)fwd_kernel, hipFuncAttributeMaxDynamicSharedMemorySize, LDS_BYTES) != hipSuccess) { fprintf(stderr, "kernel_launch: hipFuncSetAttribute failed\n"); grid = -1; return; }
        if (hipOccupancyMaxActiveBlocksPerMultiprocessor(&per_cu, (const void*)fwd_kernel, NWAVES * 64, LDS_BYTES) != hipSuccess || per_cu < 1) fprintf(stderr, "kernel_launch: occupancy query reports %d\n", per_cu);
        (void)hipGetLastError();
        grid = cus > 256 ? 256 : cus;
    }
    if (grid < 0) return;
    if (hipMemsetAsync((char*)d_ws + WS_CTL, 0, CTL_ZERO_BYTES, stream) != hipSuccess) return;
    Args a{};
    for (int i = 0; i < 22; ++i) a.in[i] = (const float*)d_in[i];
    a.out = (float*)d_out; a.ws = (unsigned char*)d_ws;
    for (int li = 0; li < N_LAUNCHES; ++li) {
        a.ph_lo = (N_LAUNCHES == 1) ? 0 : li; a.ph_hi = (N_LAUNCHES == 1) ? N_PHASES : li + 1; a.li = li;
        hipLaunchKernelGGL(fwd_kernel, dim3(grid), dim3(NWAVES * 64), LDS_BYTES, stream, a);
    }
}
```

```cpp
#include <hip/hip_runtime.h>
#include <cstdio>
#include <cstdint>

#ifndef MK_N_LAUNCHES
#define MK_N_LAUNCHES 1
#endif

namespace pg8 {
#define PG8_LAS __attribute__((address_space(3)))
typedef unsigned short bf16_t;
typedef short bf16x8 __attribute__((ext_vector_type(8)));
typedef float f32x4 __attribute__((ext_vector_type(4)));
typedef unsigned u32x4 __attribute__((ext_vector_type(4)));
typedef unsigned u32x2 __attribute__((ext_vector_type(2)));
constexpr int BM = 256, BK = 64, HALF = 128, HTB = HALF * BK * 2  , STAGE_BYTES = 8 * HTB, NXCD = 8, WGM = 8;

__host__ __device__ __forceinline__ int lds_byte(int r, int c) { const int st = (r >> 4) * 2 + (c >> 5), rr = r & 15, cc = c & 31, ob = rr * 64 + cc * 2; return st * 1024 + (ob ^ (((ob >> 9) & 1) << 5)); }
__host__ __device__ __forceinline__ void stage_rc(int b, int& R, int& C) { const int st = b / 1024, sb = b % 1024, swz = sb ^ (((sb >> 9) & 1) << 5); R = (st >> 1) * 16 + swz / 64; C = (st & 1) * 32 + (swz % 64) / 2; }
__host__ __device__ __forceinline__ int perm32(int rho) { const int n = rho >> 4, i = rho & 15; return 8 * (i >> 2) + 4 * n + (i & 3); }

struct Unit { int pm, pn, e, lt; };
struct Gemm { const void* A; const void* Bt; int lda, ldb, K; };
typedef int i32x8 __attribute__((ext_vector_type(8)));
typedef int i32x4 __attribute__((ext_vector_type(4)));
__device__ __forceinline__ i32x8 cat8(bf16x8 lo, bf16x8 hi) { const i32x4 a = __builtin_bit_cast(i32x4, lo), b = __builtin_bit_cast(i32x4, hi); return __builtin_shufflevector(a, b, 0, 1, 2, 3, 4, 5, 6, 7); }

struct StaticOrder {
    int nM, nN, nwg, G, c;
    __host__ __device__ void init(int M, int N, int G_, int c_) { nM = M / BM; nN = N / BM; nwg = nM * nN; G = G_; c = c_; }
    __host__ __device__ bool next(int i, Unit& u) const {
        const long L = (long)i * G + c; if (L >= nwg) return false;
        int wgid = (int)L; { const int q = nwg / NXCD, r = nwg % NXCD, xcd = wgid % NXCD, off = wgid / NXCD; wgid = (xcd < r ? xcd * (q + 1) : r * (q + 1) + (xcd - r) * q) + off; }
        const int nig = WGM * nN, gid = wgid / nig, fm = gid * WGM, gsz = (nM - fm) < WGM ? (nM - fm) : WGM;
        u.pm = fm + ((wgid % nig) % gsz); u.pn = (wgid % nig) / gsz; u.e = 0; u.lt = 0; return true;
    }
    __device__ __forceinline__ int arow(const Unit&, int r) const { return r; }
};
struct SingleOrder {
    int pm, pn;
    __device__ bool next(int i, Unit& u) const { if (i > 0) return false; u.pm = pm; u.pn = pn; u.e = 0; u.lt = 0; return true; }
    __device__ __forceinline__ int arow(const Unit&, int r) const { return r; }
};

__device__ __forceinline__ int lane_id() { int l; asm volatile("v_mbcnt_lo_u32_b32 %0, -1, 0\n\tv_mbcnt_hi_u32_b32 %0, -1, %0" : "=v"(l)); return l; }
__device__ __forceinline__ unsigned cvt_pk_bf16(float lo, float hi) { unsigned r; asm volatile("v_cvt_pk_bf16_f32 %0, %1, %2" : "=v"(r) : "v"(lo), "v"(hi)); return r; }

__host__ __device__ __forceinline__ int perm16(int R) { return 64 * (R >> 5) + 16 * ((R >> 2) & 3) + 4 * ((R >> 4) & 1) + (R & 3); }
template <class Epi, class Sched, bool GATHER, int ESZ = 2, bool ALIGN_EPI = true>
__device__ __forceinline__ void gemm_phase(PG8_LAS unsigned char* lds, const Gemm g, const Sched& S, const Epi& E, int wid) {
    const int lane = lane_id(), tid = wid * 64 + lane, wr = wid >> 2, wc = wid & 3, fr = lane & 15, fq = lane >> 4;
    const int nt = (g.K * ESZ) / 128;
    int Ra[2], Ca[2]; unsigned voffB[2];
#pragma unroll
    for (int i = 0; i < 2; ++i) { int R, C; stage_rc(tid * 16 + i * 8192, R, C); const int Rb = (Epi::PERM == 2) ? perm16(R) : (Epi::PERM ? ((R & ~31) + perm32(R & 31)) : R);
        Ra[i] = R; Ca[i] = C; voffB[i] = (unsigned)(Rb * g.ldb * ESZ + C * 2); }
    const size_t kstep = (size_t)(BK * 2);
    const size_t hstepB = (size_t)((Epi::PERM == 2) ? 8 : HALF) * g.ldb * ESZ, tstepB = (size_t)BM * g.ldb * ESZ;
    const size_t tstepA = (size_t)BM * g.lda * ESZ;
    const unsigned ldsw = (unsigned)wid * 1024u;
    const int aoff = lds_byte(wr * 64 + fr, fq * 8), boff = lds_byte(wc * 32 + fr, fq * 8);
#define PG8_SA(b, h) (((b) * 2 + (h)) * HTB)
#define PG8_SB(b, h) ((4 + (b) * 2 + (h)) * HTB)
#define PG8_STAGE(bufoff, gbase, v0, v1) do { \
        __builtin_amdgcn_global_load_lds((const unsigned*)((const char*)(gbase) + (v0)), (PG8_LAS unsigned*)(lds + (bufoff) + ldsw), 16, 0, 0); \
        __builtin_amdgcn_global_load_lds((const unsigned*)((const char*)(gbase) + (v1)), (PG8_LAS unsigned*)(lds + (bufoff) + ldsw + 8192), 16, 0, 0); } while (0)
#define PG8_STAGE_A0(bufoff, gbase, p0, p1) PG8_STAGE(bufoff, gbase, p0, p1)
#define PG8_STAGE_A1(bufoff, gbase, p0, p1, q0, q1) do { if constexpr (GATHER) { PG8_STAGE(bufoff, gbase, q0, q1); } else { PG8_STAGE(bufoff, (gbase) + hstepA, p0, p1); } } while (0)
#define PG8_LD16(off) (*(const PG8_LAS i32x4*)(lds + (off)))
#define PG8_LDA(dst, b, h) do { if constexpr (ESZ == 2) { _Pragma("unroll") for (int m = 0; m < 4; ++m) _Pragma("unroll") for (int k = 0; k < 2; ++k) dst[m][k] = *(const PG8_LAS bf16x8*)(lds + PG8_SA(b, h) + aoff + m * 2048 + k * 1024); } \
        else { _Pragma("unroll") for (int m = 0; m < 4; ++m) dst##8[m] = __builtin_shufflevector(PG8_LD16(PG8_SA(b, h) + aoff + m * 2048), PG8_LD16(PG8_SA(b, h) + aoff + m * 2048 + 1024), 0, 1, 2, 3, 4, 5, 6, 7); } } while (0)
#define PG8_LDB(dst, b, h) do { if constexpr (ESZ == 2) { _Pragma("unroll") for (int n = 0; n < 2; ++n) _Pragma("unroll") for (int k = 0; k < 2; ++k) dst[n][k] = *(const PG8_LAS bf16x8*)(lds + PG8_SB(b, h) + boff + n * 2048 + k * 1024); } \
        else { _Pragma("unroll") for (int n = 0; n < 2; ++n) dst##8[n] = __builtin_shufflevector(PG8_LD16(PG8_SB(b, h) + boff + n * 2048), PG8_LD16(PG8_SB(b, h) + boff + n * 2048 + 1024), 0, 1, 2, 3, 4, 5, 6, 7); } } while (0)
#define PG8_MMA(ai, bj, At, Bt) do { __builtin_amdgcn_s_setprio(1); \
        if constexpr (ESZ == 2) { _Pragma("unroll") for (int m = 0; m < 4; ++m) _Pragma("unroll") for (int n = 0; n < 2; ++n) _Pragma("unroll") for (int k = 0; k < 2; ++k) \
            acc[ai][bj][m][n] = __builtin_amdgcn_mfma_f32_16x16x32_bf16(Bt[n][k], At[m][k], acc[ai][bj][m][n], 0, 0, 0); } \
        else { _Pragma("unroll") for (int m = 0; m < 4; ++m) _Pragma("unroll") for (int n = 0; n < 2; ++n) \
            asm volatile("v_mfma_scale_f32_16x16x128_f8f6f4 %0, %1, %2, %0, %3, %3 op_sel_hi:[0,0,0]" : "+v"(acc[ai][bj][m][n]) : "v"(Bt##8[n]), "v"(At##8[m]), "v"(sc1)); } \
        __builtin_amdgcn_s_setprio(0); } while (0)
#define PG8_WAIT_V(n) asm volatile("s_waitcnt vmcnt(" #n ")" ::: "memory")
#define PG8_WAIT_L(n) asm volatile("s_waitcnt lgkmcnt(" #n ")" ::: "memory")
#define PG8_BAR __builtin_amdgcn_s_barrier()
#define PG8_SCHED __builtin_amdgcn_sched_barrier(0)
    Unit cur, nxt; int ui = 0;
    if (!S.next(0, cur)) return;
    f32x4 acc[2][2][4][2];
#pragma unroll
    for (int a = 0; a < 2; ++a)
#pragma unroll
        for (int b = 0; b < 2; ++b)
#pragma unroll
            for (int m = 0; m < 4; ++m)
#pragma unroll
                for (int n = 0; n < 2; ++n) acc[a][b][m][n] = (f32x4){0.f, 0.f, 0.f, 0.f};
    const int sc1 = 0x7F7F7F7F;
    bf16x8 At[4][2], B0[2][2], B1[2][2]; i32x8 At8[4], B08[2], B18[2];
    unsigned vA00, vA01, vA10, vA11, nA00, nA01, nA10, nA11;
    const size_t hstepA = GATHER ? (size_t)0 : (size_t)HALF * g.lda * ESZ;
    if constexpr (GATHER) {
        vA00 = (unsigned)(S.arow(cur, Ra[0]) * g.lda * ESZ + Ca[0] * 2); vA01 = (unsigned)(S.arow(cur, Ra[1]) * g.lda * ESZ + Ca[1] * 2);
        vA10 = (unsigned)(S.arow(cur, HALF + Ra[0]) * g.lda * ESZ + Ca[0] * 2); vA11 = (unsigned)(S.arow(cur, HALF + Ra[1]) * g.lda * ESZ + Ca[1] * 2);
    } else {
        vA00 = (unsigned)(Ra[0] * g.lda * ESZ + Ca[0] * 2); vA01 = (unsigned)(Ra[1] * g.lda * ESZ + Ca[1] * 2); vA10 = 0; vA11 = 0;
    }
    nA00 = vA00; nA01 = vA01; nA10 = vA10; nA11 = vA11;
    const char* cA = (const char*)g.A + (GATHER ? (size_t)0 : (size_t)cur.pm * tstepA); const char* cB = (const char*)g.Bt + (size_t)cur.pn * tstepB;
    PG8_STAGE(PG8_SB(0, 0), cB, voffB[0], voffB[1]); PG8_STAGE(PG8_SB(0, 1), cB + hstepB, voffB[0], voffB[1]); PG8_STAGE_A0(PG8_SA(0, 0), cA, vA00, vA01); PG8_STAGE_A1(PG8_SA(0, 1), cA, vA00, vA01, vA10, vA11);
    if (wr == 1) PG8_BAR;
    PG8_WAIT_V(2); PG8_BAR;
    PG8_STAGE(PG8_SB(1, 0), cB + kstep, voffB[0], voffB[1]); PG8_STAGE_A0(PG8_SA(1, 0), cA + kstep, vA00, vA01); PG8_STAGE(PG8_SB(1, 1), cB + hstepB + kstep, voffB[0], voffB[1]);
    PG8_WAIT_V(6); PG8_BAR;
    for (;;) {
        const bool has_next = S.next(ui + 1, nxt);
        const char* nA = has_next ? (const char*)g.A + (GATHER ? (size_t)0 : (size_t)nxt.pm * tstepA) : cA; const char* nB = has_next ? (const char*)g.Bt + (size_t)nxt.pn * tstepB : cB;
        if constexpr (GATHER) {
            if (has_next) {
                nA00 = (unsigned)(S.arow(nxt, Ra[0]) * g.lda * ESZ + Ca[0] * 2); nA01 = (unsigned)(S.arow(nxt, Ra[1]) * g.lda * ESZ + Ca[1] * 2);
                nA10 = (unsigned)(S.arow(nxt, HALF + Ra[0]) * g.lda * ESZ + Ca[0] * 2); nA11 = (unsigned)(S.arow(nxt, HALF + Ra[1]) * g.lda * ESZ + Ca[1] * 2);
            } else { nA00 = vA00; nA01 = vA01; nA10 = vA10; nA11 = vA11; }
        }
#pragma nounroll
        for (int t = 0; t < nt; t += 2) {
            const bool last = (t == nt - 2);
            const char* a1 = cA + (size_t)(t + 1) * kstep;
            const char* a2 = last ? nA : cA + (size_t)(t + 2) * kstep; const char* b2 = last ? nB : cB + (size_t)(t + 2) * kstep;
            const char* a3 = a2 + kstep; const char* b3 = b2 + kstep;
            asm volatile("" : "+v"(voffB[0]), "+v"(voffB[1]), "+v"(vA00), "+v"(vA01));
            if constexpr (GATHER) asm volatile("" : "+v"(vA10), "+v"(vA11));
            unsigned x00 = vA00, x01 = vA01, x10 = vA10, x11 = vA11;
            if constexpr (GATHER) { if (last) { x00 = nA00; x01 = nA01; x10 = nA10; x11 = nA11; } }
            PG8_LDB(B0, 0, 0); PG8_LDB(B1, 0, 1); PG8_SCHED; PG8_LDA(At, 0, 0); PG8_STAGE_A1(PG8_SA(1, 1), a1, vA00, vA01, vA10, vA11);
            PG8_WAIT_V(8); PG8_WAIT_L(0); PG8_BAR; PG8_MMA(0, 0, At, B0); PG8_MMA(0, 1, At, B1); PG8_BAR; PG8_SCHED;
            PG8_LDA(At, 0, 1); PG8_STAGE(PG8_SB(0, 0), b2, voffB[0], voffB[1]); PG8_STAGE(PG8_SB(0, 1), b2 + hstepB, voffB[0], voffB[1]); PG8_STAGE_A0(PG8_SA(0, 0), a2, x00, x01);
            PG8_WAIT_V(8); PG8_WAIT_L(0); PG8_BAR; PG8_MMA(1, 0, At, B0); PG8_MMA(1, 1, At, B1); PG8_BAR; PG8_SCHED;
            PG8_LDB(B0, 1, 0); PG8_LDB(B1, 1, 1); PG8_SCHED; PG8_LDA(At, 1, 0); PG8_STAGE_A1(PG8_SA(0, 1), a2, x00, x01, x10, x11);
            PG8_WAIT_V(8); PG8_WAIT_L(0); PG8_BAR; PG8_MMA(0, 0, At, B0); PG8_MMA(0, 1, At, B1); PG8_BAR; PG8_SCHED;
            PG8_LDA(At, 1, 1); PG8_STAGE(PG8_SB(1, 0), b3, voffB[0], voffB[1]); PG8_STAGE(PG8_SB(1, 1), b3 + hstepB, voffB[0], voffB[1]); PG8_STAGE_A0(PG8_SA(1, 0), a3, x00, x01);
            PG8_WAIT_V(8); PG8_WAIT_L(0); PG8_BAR; PG8_MMA(1, 0, At, B0); PG8_MMA(1, 1, At, B1); PG8_BAR; PG8_SCHED;
        }
        if constexpr (ALIGN_EPI) { if (wr == 0) PG8_BAR; }
        if constexpr (ESZ == 1) asm volatile("s_nop 15\n\ts_nop 15" ::: "memory");
        E(acc, cur, wr, wc, fr, fq);
        if (!has_next) break;
#pragma unroll
        for (int a = 0; a < 2; ++a)
#pragma unroll
            for (int b = 0; b < 2; ++b)
#pragma unroll
                for (int m = 0; m < 4; ++m)
#pragma unroll
                    for (int n = 0; n < 2; ++n) acc[a][b][m][n] = (f32x4){0.f, 0.f, 0.f, 0.f};
        cur = nxt; cA = nA; cB = nB; ++ui;
        if constexpr (GATHER) { vA00 = nA00; vA01 = nA01; vA10 = nA10; vA11 = nA11; }
        if constexpr (ALIGN_EPI) { if (wr == 1) PG8_BAR; }
    }
    PG8_WAIT_V(0);
    if constexpr (!ALIGN_EPI) { if (wr == 0) PG8_BAR; }
    PG8_BAR;
#undef PG8_SA
#undef PG8_SB
#undef PG8_STAGE
#undef PG8_LDA
#undef PG8_LD16
#undef PG8_STAGE_A0
#undef PG8_STAGE_A1
#undef PG8_LDB
#undef PG8_MMA
#undef PG8_WAIT_V
#undef PG8_WAIT_L
#undef PG8_BAR
#undef PG8_SCHED
}
}

constexpr int NWAVES = 8;
constexpr int T = 8192, SEQ = 2048, NB = 4, D = 2048, INW = 2304, POOLW = 1024, NH = 16, NKV = 2, HD = 64, KVW = 128;
constexpr int NE = 64, TOPK = 8, EFF = 512, PLE = 256;
constexpr int SH_ROW0 = T * TOPK + NE * 256;
constexpr int NROWS = SH_ROW0 + T;
constexpr float EPS = 1e-6f;
constexpr float SW1 = 32.0f, SW2 = 16.0f, SA = 4.0f, SY = 16.0f, SW3 = 32.0f;
constexpr int N_PHASES = 10;
constexpr int N_LAUNCHES = MK_N_LAUNCHES;

constexpr size_t MiB = 1u << 20;
constexpr size_t WS_CTL = 0, CTL_ZERO_BYTES = 64 * 1024;
constexpr size_t WS_MISC = 1 * MiB;
constexpr size_t WS_TOKLIST = WS_MISC;
constexpr size_t WS_REC = WS_TOKLIST + (size_t)NE * T * 4;
constexpr size_t WS_WREC = WS_REC + (size_t)T * TOPK * 4;
constexpr size_t WS_RSTDP = WS_WREC + (size_t)T * TOPK * 4;
constexpr size_t WS_PBF = 6 * MiB;
constexpr size_t WS_WRT = 10 * MiB;
constexpr size_t WS_WIN = 12 * MiB;
constexpr size_t WS_WPOOL = WS_WIN + (size_t)INW * D * 2;
constexpr size_t WS_WOUT = WS_WPOOL + (size_t)4 * 256 * 256 * 2;
constexpr size_t WS_WPP = WS_WOUT + (size_t)D * D * 2;
constexpr size_t WS_WPG = WS_WPP + (size_t)D * PLE * 2;
constexpr size_t WS_WGU = WS_WPG + (size_t)D * D * 2;
constexpr size_t WS_WD = WS_WGU + (size_t)65 * 1024 * D;
constexpr size_t WS_XN = WS_WD + (size_t)65 * D * EFF;
constexpr size_t WS_PPROJ = WS_XN + (size_t)T * D * 2;
constexpr size_t WS_ACT = WS_PPROJ + (size_t)T * D * 2;
constexpr size_t WS_H2F8 = WS_ACT;
constexpr size_t WS_H2B = WS_ACT + 16 * MiB;
constexpr size_t WS_GBUF = WS_XN;
constexpr size_t WS_Y = WS_ACT + (size_t)NROWS * EFF * 2;
constexpr size_t WS_ABF = WS_Y;
constexpr size_t WS_UBF = WS_ABF + (size_t)T * D * 2;
constexpr size_t WS_QBF = WS_UBF + (size_t)T * POOLW * 2;
constexpr size_t WS_KV = WS_QBF + (size_t)T * 1024 * 2;
constexpr size_t WS_POOLED = WS_KV + (size_t)T * 2 * KVW * 2;
constexpr size_t WS_MIX = WS_POOLED + (size_t)T * POOLW * 2;
constexpr size_t WS_END = WS_Y + (size_t)NROWS * D * 2;
static_assert(WS_MIX + (size_t)T * D * 2 <= WS_END, "early activations fit under Y");
static_assert(WS_RSTDP + (size_t)T * 4 <= WS_PBF && WS_PBF + (size_t)T * PLE * 2 <= WS_WIN, "misc fits");
static_assert(WS_END <= (size_t)1024 * MiB, "workspace must fit 1 GiB");
constexpr int CW_BAR = 1024;
constexpr int CW_CNT = 8192;
static_assert((CW_CNT + 32 * NE) * 4 <= (int)CTL_ZERO_BYTES, "CTL words inside the memset region");

constexpr int RING_OFF = 0, RING_BYTES = 131072;
constexpr int LDS_BYTES = 163840;
constexpr int MISC_OFF = LDS_BYTES - 512;
constexpr int TAB_OFF = RING_BYTES;
constexpr int TB_CNT = 0, TB_PAD = 80, TB_XCUM = 160;

#define GAS __attribute__((address_space(1)))
#define LAS __attribute__((address_space(3)))
typedef unsigned short bf16;
typedef unsigned v4u __attribute__((ext_vector_type(4)));
typedef unsigned v2u __attribute__((ext_vector_type(2)));
typedef float f32x4 __attribute__((ext_vector_type(4)));
typedef short bf16x8 __attribute__((ext_vector_type(8)));
typedef GAS unsigned gu32;
#define RLX_AGENT __ATOMIC_RELAXED, __HIP_MEMORY_SCOPE_AGENT
#define LDS_WAIT() asm volatile("s_waitcnt lgkmcnt(0)" ::: "memory")
#define VM_WAIT() asm volatile("s_waitcnt vmcnt(0)" ::: "memory")
__device__ __forceinline__ unsigned pk2(float lo, float hi) { return pg8::cvt_pk_bf16(lo, hi); }
__device__ __forceinline__ float bf_lo(unsigned w) { return __builtin_bit_cast(float, w << 16); }
__device__ __forceinline__ float bf_hi(unsigned w) { return __builtin_bit_cast(float, w & 0xffff0000u); }

#define XB_TMO      128
#define XB_XCNT(j)  (256  + 64 * (j))
#define XB_XSUB(j)  (1280 + 64 * (j))
#define XB_XGEN(j)  (2304 + 64 * (j))
#define XB_TOP      3328
#define XB_TOPGEN   3392
#define XCD_BAR_WORDS 3456
#define XB_SPIN_CAP (1u << 18)
__device__ __forceinline__ unsigned xb_ld(unsigned* p)              { return __hip_atomic_load(p, __ATOMIC_RELAXED, __HIP_MEMORY_SCOPE_AGENT); }
__device__ __forceinline__ unsigned xb_add(unsigned* p, unsigned v) { return __hip_atomic_fetch_add(p, v, __ATOMIC_RELAXED, __HIP_MEMORY_SCOPE_AGENT); }
__device__ __forceinline__ unsigned xb_xcc_id() { return (unsigned)__builtin_amdgcn_s_getreg((3 << 11) | 20) & 0xFu; }
#define XB_SPIN(cond, bar) do { unsigned _sp = 0; while (cond) { __builtin_amdgcn_s_sleep(1); \
    if ((++_sp & 255u) == 0u) { if (xb_ld(&(bar)[XB_TMO])) break; if (_sp > XB_SPIN_CAP) { atomicAdd(&(bar)[XB_TMO], 1u); break; } } } } while (0)
struct XcdBarrier { unsigned* bar; unsigned x; volatile LAS unsigned* st; };
__device__ __forceinline__ XcdBarrier xcd_barrier_post(unsigned* bar, volatile LAS unsigned* st) {
    XcdBarrier b; b.bar = bar; b.x = xb_xcc_id(); b.st = st;
    if (threadIdx.x == 0) (void)xb_add(&bar[XB_XCNT(b.x)], 1u);
    return b;
}
__device__ __forceinline__ void xcd_barrier_complete(unsigned* bar, unsigned x, unsigned& nloc, unsigned& nx) {
    const unsigned G = gridDim.x * gridDim.y * gridDim.z;
    unsigned sum, cnt, mine, sp = 0u;
    for (;;) {
        sum = 0u; cnt = 0u; mine = 0u;
#pragma unroll
        for (unsigned j = 0; j < 16; ++j) { const unsigned c = xb_ld(&bar[XB_XCNT(j)]); sum += c; cnt += (c > 0u) ? 1u : 0u; mine = (j == x) ? c : mine; }
        if (sum == G) break;
        __builtin_amdgcn_s_sleep(1);
        if ((++sp & 255u) == 0u) { if (xb_ld(&bar[XB_TMO])) break; if (sp > XB_SPIN_CAP) { atomicAdd(&bar[XB_TMO], 1u); break; } }
    }
    nloc = mine > 0u ? mine : 1u; nx = cnt > 0u ? cnt : 1u;
}
__device__ __forceinline__ void xcd_barrier(const XcdBarrier& b) {
    asm volatile("s_waitcnt vmcnt(0)" ::: "memory");
    __syncthreads();
    if (threadIdx.x == 0) {
        unsigned* bar = b.bar;
        __builtin_amdgcn_s_waitcnt(0);
        unsigned nloc = b.st[0], nx = b.st[1];
        if (nloc == 0u) { xcd_barrier_complete(bar, b.x, nloc, nx); b.st[0] = nloc; b.st[1] = nx; }
        const unsigned old = xb_add(&bar[XB_XSUB(b.x)], 1u);
        const unsigned gen = old / nloc;
        if (old + 1u == (gen + 1u) * nloc) {
            __builtin_amdgcn_fence(__ATOMIC_RELEASE, "agent");
            asm volatile("s_waitcnt vmcnt(0)" ::: "memory");
            const unsigned og = xb_add(&bar[XB_TOP], 1u);
            const unsigned tg = og / nx;
            if (og + 1u == (tg + 1u) * nx) xb_add(&bar[XB_TOPGEN], 1u);
            else XB_SPIN(xb_ld(&bar[XB_TOPGEN]) == tg, bar);
            __builtin_amdgcn_fence(__ATOMIC_ACQUIRE, "agent");
            xb_add(&bar[XB_XGEN(b.x)], 1u);
            asm volatile("s_waitcnt vmcnt(0)" ::: "memory");
        } else {
            XB_SPIN(xb_ld(&bar[XB_XGEN(b.x)]) == gen, bar);
            __builtin_amdgcn_fence(__ATOMIC_ACQUIRE, "agent");
            asm volatile("s_waitcnt vmcnt(0)" ::: "memory");
        }
    }
    __syncthreads();
}

struct Args { const float* in[22]; float* out; unsigned char* ws; int ph_lo, ph_hi, li, pad; };
struct Frame {
    LAS unsigned char* lds;
    volatile LAS unsigned* MISC;
    gu32* ctl;
    unsigned char* ws;
    int wave, G, bx;
    float* out;
};
__device__ __forceinline__ const float* fin(const Frame& F, int i) {
    const unsigned long long v = ((const LAS unsigned long long*)(F.lds + MISC_OFF + 256))[i];
    const unsigned lo = __builtin_amdgcn_readfirstlane((unsigned)v), hi = __builtin_amdgcn_readfirstlane((unsigned)(v >> 32));
    return (const float*)(const GAS float*)(((unsigned long long)hi << 32) | lo);
}
enum { I_X = 0, I_P, I_GMIX, I_WIN, I_WPOOL, I_PSCALE, I_SINKS, I_RPE, I_WOUT, I_GFFN, I_WROUTER, I_RBIAS, I_WGATE, I_WUP, I_WDOWN, I_WSGATE, I_WSUP, I_WSDOWN, I_WPLEPROJ, I_GPLE, I_WPLEGATE, I_GFINAL };

__device__ __forceinline__ float wave_sum(float v) {
#pragma unroll
    for (int o = 1; o < 64; o <<= 1) v += __shfl_xor(v, o);
    return v;
}

using pg8::Unit;
struct EpiInProj {
    static constexpr int PERM = 1;
    unsigned char* ws;
    __device__ __forceinline__ void operator()(const f32x4 (&acc)[2][2][4][2], const Unit& u, int wr, int wc, int fr, int fq) const {
        const int row0 = u.pm * 256 + wr * 64 + fr;
        const size_t boff = WS_UBF + (size_t)(u.pn >= 4 ? 1 : 0) * (WS_QBF - WS_UBF) + (size_t)(u.pn >= 8 ? 1 : 0) * (WS_KV - WS_QBF);
        bf16* base = (bf16*)(ws + boff); const int ldc = (u.pn < 8) ? 1024 : 256; const int col0 = (u.pn & 3) * 256 + wc * 32 + 8 * fq;
#pragma unroll
        for (int ai = 0; ai < 2; ++ai)
#pragma unroll
            for (int m = 0; m < 4; ++m) { bf16* rowp = base + (size_t)(row0 + ai * 128 + m * 16) * ldc + col0;
#pragma unroll
                for (int bj = 0; bj < 2; ++bj) { const f32x4 v0 = acc[ai][bj][m][0], v1 = acc[ai][bj][m][1];
                    v4u w; w.x = pk2(v0[0], v0[1]); w.y = pk2(v0[2], v0[3]); w.z = pk2(v1[0], v1[1]); w.w = pk2(v1[2], v1[3]);
                    *(v4u*)(rowp + bj * 128) = w; } }
    }
};
struct EpiBf16Plain {
    static constexpr int PERM = 1;
    bf16* O; int ldc; int col_off; const float* scale;
    __device__ __forceinline__ void operator()(const f32x4 (&acc)[2][2][4][2], const Unit& u, int wr, int wc, int fr, int fq) const {
        const int row0 = u.pm * 256 + wr * 64 + fr, colt = u.pn * 256 + wc * 32 + 8 * fq;
        f32x4 sv[2][2];
#pragma unroll
        for (int bj = 0; bj < 2; ++bj)
#pragma unroll
            for (int n = 0; n < 2; ++n) sv[bj][n] = scale ? *(const f32x4*)(scale + col_off + colt + bj * 128 + 4 * n) : (f32x4){1.f, 1.f, 1.f, 1.f};
#pragma unroll
        for (int ai = 0; ai < 2; ++ai)
#pragma unroll
            for (int m = 0; m < 4; ++m) { bf16* rowp = O + (size_t)(row0 + ai * 128 + m * 16) * ldc + col_off + colt;
#pragma unroll
                for (int bj = 0; bj < 2; ++bj) { const f32x4 v0 = acc[ai][bj][m][0] * sv[bj][0], v1 = acc[ai][bj][m][1] * sv[bj][1];
                    v4u w; w.x = pk2(v0[0], v0[1]); w.y = pk2(v0[2], v0[3]); w.z = pk2(v1[0], v1[1]); w.w = pk2(v1[2], v1[3]);
                    *(v4u*)(rowp + bj * 128) = w; } }
    }
};
struct EpiResF32 {
    static constexpr int PERM = 0;
    const float* base; float* C;
    __device__ __forceinline__ void operator()(const f32x4 (&acc)[2][2][4][2], const Unit& u, int wr, int wc, int fr, int fq) const {
        const int row0 = u.pm * 256 + wr * 64 + fr, col0 = u.pn * 256 + wc * 32 + 4 * fq;
#pragma unroll
        for (int ai = 0; ai < 2; ++ai)
#pragma unroll
            for (int mp = 0; mp < 2; ++mp) { f32x4 xb[2][2][2];
#pragma unroll
                for (int mm = 0; mm < 2; ++mm) { const size_t ro = (size_t)(row0 + ai * 128 + (2 * mp + mm) * 16) * D + col0;
#pragma unroll
                    for (int bj = 0; bj < 2; ++bj)
#pragma unroll
                        for (int n = 0; n < 2; ++n) xb[mm][bj][n] = *(const f32x4*)(base + ro + bj * 128 + n * 16); }
#pragma unroll
                for (int mm = 0; mm < 2; ++mm) { const size_t ro = (size_t)(row0 + ai * 128 + (2 * mp + mm) * 16) * D + col0;
#pragma unroll
                    for (int bj = 0; bj < 2; ++bj)
#pragma unroll
                        for (int n = 0; n < 2; ++n) *(f32x4*)(C + ro + bj * 128 + n * 16) = xb[mm][bj][n] + acc[ai][bj][2 * mp + mm][n]; } }
    }
};
__device__ __forceinline__ float sigmoid_f(float v) { return __builtin_amdgcn_rcpf(1.0f + __expf(-v)); }
__device__ __forceinline__ unsigned pk4_fp8(float a, float b, float c, float d) { int w = 0; w = __builtin_amdgcn_cvt_pk_fp8_f32(a, b, w, false); w = __builtin_amdgcn_cvt_pk_fp8_f32(c, d, w, true); return (unsigned)w; }
typedef float f32x2_ __attribute__((ext_vector_type(2)));
__device__ __forceinline__ void fp8x4_to_f32(unsigned w, float (&o)[4]) { const f32x2_ lo = __builtin_amdgcn_cvt_pk_f32_fp8((int)w, false), hi = __builtin_amdgcn_cvt_pk_f32_fp8((int)w, true); o[0] = lo[0]; o[1] = lo[1]; o[2] = hi[0]; o[3] = hi[1]; }
struct EpiGateUp {
    static constexpr int PERM = 1;
    unsigned char* ACT;
    __device__ __forceinline__ void operator()(const f32x4 (&acc)[2][2][4][2], const Unit& u, int wr, int wc, int fr, int fq) const {
        const int row0 = u.pm * 256 + wr * 64 + fr, col0 = (u.pn & 3) * 128 + wc * 32 + 8 * fq;
        constexpr float IS = 1.0f / SW1;
#pragma unroll
        for (int ai = 0; ai < 2; ++ai)
#pragma unroll
            for (int m = 0; m < 4; ++m) { float o[8];
#pragma unroll
                for (int n = 0; n < 2; ++n)
#pragma unroll
                    for (int j = 0; j < 4; ++j) { const float gte = acc[ai][0][m][n][j] * IS, up = acc[ai][1][m][n][j] * (IS * SA); o[4 * n + j] = gte * sigmoid_f(gte) * up; }
                v2u w; w.x = pk4_fp8(o[0], o[1], o[2], o[3]); w.y = pk4_fp8(o[4], o[5], o[6], o[7]);
                *(v2u*)(ACT + (size_t)(row0 + ai * 128 + m * 16) * EFF + col0) = w; }
    }
};
struct EpiDown {
    static constexpr int PERM = 2;
    unsigned char* Y;
    __device__ __forceinline__ void operator()(const f32x4 (&acc)[2][2][4][2], const Unit& u, int wr, int wc, int fr, int fq) const {
        const int row0 = u.pm * 256 + wr * 64 + fr, col0 = (u.pn & 7) * 256 + wc * 64 + 16 * fq;
        constexpr float IS = SY / (SA * SW2);
#pragma unroll
        for (int ai = 0; ai < 2; ++ai)
#pragma unroll
            for (int m = 0; m < 4; ++m) { const f32x4 v0 = acc[ai][0][m][0] * IS, v1 = acc[ai][0][m][1] * IS, v2 = acc[ai][1][m][0] * IS, v3 = acc[ai][1][m][1] * IS;
                v4u w; w.x = pk4_fp8(v0[0], v0[1], v0[2], v0[3]); w.y = pk4_fp8(v1[0], v1[1], v1[2], v1[3]); w.z = pk4_fp8(v2[0], v2[1], v2[2], v2[3]); w.w = pk4_fp8(v3[0], v3[1], v3[2], v3[3]);
                *(v4u*)(Y + (size_t)(row0 + ai * 128 + m * 16) * D + col0) = w; }
    }
};
struct EpiBf16Mul {
    static constexpr int PERM = 1;
    bf16* O; float mul;
    __device__ __forceinline__ void operator()(const f32x4 (&acc)[2][2][4][2], const Unit& u, int wr, int wc, int fr, int fq) const {
        const int row0 = u.pm * 256 + wr * 64 + fr, colt = u.pn * 256 + wc * 32 + 8 * fq;
#pragma unroll
        for (int ai = 0; ai < 2; ++ai)
#pragma unroll
            for (int m = 0; m < 4; ++m) { bf16* rowp = O + (size_t)(row0 + ai * 128 + m * 16) * D + colt;
#pragma unroll
                for (int bj = 0; bj < 2; ++bj) { const f32x4 v0 = acc[ai][bj][m][0] * mul, v1 = acc[ai][bj][m][1] * mul;
                    v4u w; w.x = pk2(v0[0], v0[1]); w.y = pk2(v0[2], v0[3]); w.z = pk2(v1[0], v1[1]); w.w = pk2(v1[2], v1[3]);
                    *(v4u*)(rowp + bj * 128) = w; } }
    }
};
struct MoeOrder {
    const LAS int* tab; const int* toklist; int x, r, npn, stride;
    __device__ __forceinline__ bool next(int i, Unit& u) const {
        const int L = i * stride + r; const int tl = L / npn, pn = L - tl * npn;
        if (tl >= tab[TB_XCUM + 9]) return false;
        int s = 0;
#pragma unroll
        for (int q = 1; q <= 8; ++q) s += (tl >= tab[TB_XCUM + q]) ? 1 : 0;
        int lt = tl - tab[TB_XCUM + s], e, row0;
        if (s < 8) { e = x + 8 * s; row0 = tab[TB_PAD + e] + 256 * lt; } else { e = NE; lt = x + 8 * lt; row0 = SH_ROW0 + 256 * lt; }
        u.pm = __builtin_amdgcn_readfirstlane(row0 >> 8); u.pn = __builtin_amdgcn_readfirstlane(e * npn + pn); u.e = __builtin_amdgcn_readfirstlane(e); u.lt = __builtin_amdgcn_readfirstlane(lt); return true;
    }
    __device__ __forceinline__ int arow(const Unit& u, int r_) const {
        const int lr = u.lt * 256 + r_;
        const int ee = (u.e < NE) ? u.e : 0;
        const int tk = toklist[(size_t)ee * T + (lr < T - 1 ? lr : T - 1)];
        return (u.e == NE) ? lr : ((lr < tab[TB_CNT + ee]) ? tk : 0);
    }
};
__device__ __forceinline__ void moe_tables(Frame& F) {
    const int LANE_ = pg8::lane_id(), TID_ = F.wave * 64 + LANE_; (void)TID_;
    LAS int* tab = (LAS int*)(F.lds + TAB_OFF);
    if (TID_ < NE) tab[TB_CNT + TID_] = (int)__hip_atomic_load(F.ctl + CW_CNT + 32 * TID_, RLX_AGENT);
    if (TID_ == NE) tab[TB_CNT + NE] = T;
    __syncthreads();
    if (TID_ == 0) {
        int off = 0;
        for (int e = 0; e < NE; ++e) { tab[TB_PAD + e] = off; off += ((tab[TB_CNT + e] + 255) >> 8) << 8; }
        tab[TB_PAD + NE] = off;
        const int x = F.bx & 7; int c = 0; tab[TB_XCUM] = 0;
        for (int s = 0; s < 8; ++s) { c += (tab[TB_CNT + x + 8 * s] + 255) >> 8; tab[TB_XCUM + s + 1] = c; }
        tab[TB_XCUM + 9] = c + 4;
    }
    __syncthreads();
}

struct ConvJob { const float* src; bf16* dst; int N, ldk, mode, item; };
struct ConvJob8 { const float* src; unsigned char* dst; int N, ldk, mode, item; float scale; };
__device__ __forceinline__ void conv8_load(const ConvJob8& j, int lane, f32x4 (&v)[16]) {
    const int nblk = j.N >> 5, kb = j.item / nblk, nb = j.item - kb * nblk, k0 = 128 * kb, n0 = 32 * nb;
    const float* src = j.src + (size_t)(k0 + 16 * (lane >> 3)) * j.N + n0 + 4 * (lane & 7);
#pragma unroll
    for (int i = 0; i < 16; ++i) v[i] = __builtin_nontemporal_load((const f32x4*)(src + (size_t)i * j.N));
}
__device__ __forceinline__ void conv8_store(const ConvJob8& j, int lane, const f32x4 (&v)[16]) {
    const int nblk = j.N >> 5, kb = j.item / nblk, nb = j.item - kb * nblk, k0 = 128 * kb, n0 = 32 * nb; const float scale = j.scale;
#pragma unroll
    for (int q = 0; q < 4; ++q) { const int n = n0 + 4 * (lane & 7) + q; int dr = n;
        if (j.mode == 5) dr = ((n >> 7) << 8) + (n & 127); else if (j.mode == 6) dr = ((n >> 7) << 8) + 128 + (n & 127);
        v4u o; o.x = pk4_fp8(v[0][q] * scale, v[1][q] * scale, v[2][q] * scale, v[3][q] * scale); o.y = pk4_fp8(v[4][q] * scale, v[5][q] * scale, v[6][q] * scale, v[7][q] * scale);
        o.z = pk4_fp8(v[8][q] * scale, v[9][q] * scale, v[10][q] * scale, v[11][q] * scale); o.w = pk4_fp8(v[12][q] * scale, v[13][q] * scale, v[14][q] * scale, v[15][q] * scale);
        __builtin_nontemporal_store(o, (v4u*)(j.dst + (size_t)dr * j.ldk + k0 + 16 * (lane >> 3))); }
}
__device__ __forceinline__ void conv_load(const ConvJob& j, int lane, f32x4 (&v)[8]) {
    const int nblk = j.N >> 5, kb = j.item / nblk, nb = j.item - kb * nblk, k0 = 64 * kb, n0 = 32 * nb;
    const float* src = j.src + (size_t)(k0 + 8 * (lane >> 3)) * j.N + n0 + 4 * (lane & 7);
#pragma unroll
    for (int i = 0; i < 8; ++i) v[i] = __builtin_nontemporal_load((const f32x4*)(src + (size_t)i * j.N));
}
__device__ __forceinline__ void conv_store(const ConvJob& j, int lane, const f32x4 (&v)[8]) {
    const int nblk = j.N >> 5, kb = j.item / nblk, nb = j.item - kb * nblk, k0 = 64 * kb, n0 = 32 * nb;
#pragma unroll
    for (int q = 0; q < 4; ++q) { const int n = n0 + 4 * (lane & 7) + q; int dr = n;
        if (j.mode == 1) dr = ((n >> 7) << 8) + (n & 127); else if (j.mode == 2) dr = ((n >> 7) << 8) + 128 + (n & 127);
        v4u o; o.x = pk2(v[0][q], v[1][q]); o.y = pk2(v[2][q], v[3][q]); o.z = pk2(v[4][q], v[5][q]); o.w = pk2(v[6][q], v[7][q]);
        *(v4u*)(j.dst + (size_t)dr * j.ldk + k0 + 8 * (lane >> 3)) = o; }
}
__device__ __forceinline__ void rms_row_to_bf16(const float* xrow, const float* g, bf16* orow, int lane) {
    f32x4 v[8]; float s = 0.f;
#pragma unroll
    for (int j = 0; j < 4; ++j) { v[2 * j] = *(const f32x4*)(xrow + 512 * j + 8 * lane); v[2 * j + 1] = *(const f32x4*)(xrow + 512 * j + 8 * lane + 4); }
#pragma unroll
    for (int j = 0; j < 8; ++j) s += (v[j][0] * v[j][0] + v[j][1] * v[j][1]) + (v[j][2] * v[j][2] + v[j][3] * v[j][3]);
    const float rstd = 1.0f / sqrtf(wave_sum(s) * (1.0f / D) + EPS);
#pragma unroll
    for (int j = 0; j < 4; ++j) { const f32x4 g0 = *(const f32x4*)(g + 512 * j + 8 * lane), g1 = *(const f32x4*)(g + 512 * j + 8 * lane + 4);
        const f32x4 a = v[2 * j] * rstd * g0, b = v[2 * j + 1] * rstd * g1;
        v4u o; o.x = pk2(a[0], a[1]); o.y = pk2(a[2], a[3]); o.z = pk2(b[0], b[1]); o.w = pk2(b[2], b[3]);
        *(v4u*)(orow + 512 * j + 8 * lane) = o; }
}
constexpr int CV_G1 = (D / 128) * (EFF / 32), CV_D1 = (EFF / 128) * (D / 32), CV_G = 65 * CV_G1, CV_DN = 65 * CV_D1, CV_PG = (D / 128) * (D / 32), CV_TOTAL = 2 * CV_G + CV_DN + CV_PG;
constexpr int CONV_B = 896 * 16, CONV_C = 1024 * 20, CONV_A = CV_TOTAL - CONV_B - CONV_C;
__device__ __forceinline__ ConvJob8 conv8_decode(Frame& F, int it) {
    unsigned char* WGU8 = F.ws + WS_WGU; unsigned char* WDN8 = F.ws + WS_WD;
    int r = it;
    if (r < CV_G) { const int e = r / CV_G1, li = r - e * CV_G1; const float* src = (e < NE) ? fin(F, I_WGATE) + (size_t)e * D * EFF : fin(F, I_WSGATE);
        return ConvJob8{src, WGU8 + (size_t)e * 1024 * D, EFF, D, 5, li, SW1}; } r -= CV_G;
    if (r < CV_G) { const int e = r / CV_G1, li = r - e * CV_G1; const float* src = (e < NE) ? fin(F, I_WUP) + (size_t)e * D * EFF : fin(F, I_WSUP);
        return ConvJob8{src, WGU8 + (size_t)e * 1024 * D, EFF, D, 6, li, SW1}; } r -= CV_G;
    if (r < CV_DN) { const int e = r / CV_D1, li = r - e * CV_D1; const float* src = (e < NE) ? fin(F, I_WDOWN) + (size_t)e * EFF * D : fin(F, I_WSDOWN);
        return ConvJob8{src, WDN8 + (size_t)e * D * EFF, D, EFF, 4, li, SW2}; } r -= CV_DN;
    return ConvJob8{fin(F, I_WPLEGATE), F.ws + WS_WPG, D, D, 4, r, SW3};
}
__device__ __forceinline__ void conv_fp8_items(Frame& F, int lo, int hi, int rank, int nranks) {
    const int LANE_ = pg8::lane_id();
    int it0 = lo + rank; if (it0 >= hi) return;
    f32x4 va[16], vb[16];
    ConvJob8 j0 = conv8_decode(F, it0), j1 = j0; conv8_load(j0, LANE_, va);
    for (;;) {
        const int it1 = it0 + nranks; const bool has1 = it1 < hi;
        if (has1) { j1 = conv8_decode(F, it1); conv8_load(j1, LANE_, vb); }
        conv8_store(j0, LANE_, va);
        if (!has1) break;
        it0 = it1 + nranks; const bool has0 = it0 < hi;
        if (has0) { j0 = conv8_decode(F, it0); conv8_load(j0, LANE_, va); }
        conv8_store(j1, LANE_, vb);
        if (!has0) break;
    }
}
__device__ __forceinline__ void p0_prologue(Frame& F) {
    const int LANE_ = pg8::lane_id(), TID_ = F.wave * 64 + LANE_; (void)TID_;
    const int gw = F.bx * NWAVES + F.wave, NGW = F.G * NWAVES;
    bf16* WIN = (bf16*)(F.ws + WS_WIN); bf16* WPOOL = (bf16*)(F.ws + WS_WPOOL); bf16* WOUT = (bf16*)(F.ws + WS_WOUT); bf16* WPP = (bf16*)(F.ws + WS_WPP);
    constexpr int I_IN = (D / 64) * (INW / 32), I_PL = 4 * (256 / 64) * (256 / 32), I_OUT = (D / 64) * (D / 32), I_PP = (PLE / 64) * (D / 32), I_PG = (D / 64) * (D / 32);
    constexpr int I_SMALL = I_IN + I_PL + I_OUT + I_PP; (void)I_PG;
    auto decode = [&](int it) -> ConvJob {
        int r = it;
        if (r < I_IN) return ConvJob{fin(F, I_WIN), WIN, INW, D, 0, r}; r -= I_IN;
        if (r < I_PL) { const int gq = r >> 5; return ConvJob{fin(F, I_WPOOL) + (size_t)gq * 65536, WPOOL + (size_t)gq * 65536, 256, 256, 0, r & 31}; } r -= I_PL;
        if (r < I_OUT) return ConvJob{fin(F, I_WOUT), WOUT, D, D, 0, r}; r -= I_OUT;
        return ConvJob{fin(F, I_WPLEPROJ), WPP, D, PLE, 0, r};
    };
    for (int it = gw; it < I_SMALL; it += 2 * NGW) {
        const ConvJob j0 = decode(it); const bool two = (it + NGW) < I_SMALL; const ConvJob j1 = decode(two ? it + NGW : it);
        f32x4 v0[8], v1[8];
        conv_load(j0, LANE_, v0); conv_load(j1, LANE_, v1);
        conv_store(j0, LANE_, v0); if (two) conv_store(j1, LANE_, v1);
    }
    conv_fp8_items(F, 0, CONV_A, gw, NGW);
    { const float* WR = fin(F, I_WROUTER); bf16* WH = (bf16*)(F.ws + WS_WRT); bf16* WL = WH + (size_t)NE * D;
      for (int i = gw * 64 + LANE_; i < NE * (D / 8); i += NGW * 64) { const int e = i & 63, k0 = (i >> 6) * 8; float x[8]; unsigned hh[8], ll[8];
#pragma unroll
          for (int j = 0; j < 8; ++j) x[j] = WR[(size_t)(k0 + j) * NE + e];
#pragma unroll
          for (int j = 0; j < 8; ++j) { hh[j] = pk2(x[j], 0.f) & 0xffffu; ll[j] = pk2(x[j] - bf_lo(hh[j]), 0.f) & 0xffffu; }
          v4u oh, ol; oh.x = hh[0] | (hh[1] << 16); oh.y = hh[2] | (hh[3] << 16); oh.z = hh[4] | (hh[5] << 16); oh.w = hh[6] | (hh[7] << 16);
          ol.x = ll[0] | (ll[1] << 16); ol.y = ll[2] | (ll[3] << 16); ol.z = ll[4] | (ll[5] << 16); ol.w = ll[6] | (ll[7] << 16);
          *(v4u*)(WH + (size_t)e * D + k0) = oh; *(v4u*)(WL + (size_t)e * D + k0) = ol; } }
    { const float* P = fin(F, I_P); bf16* PB = (bf16*)(F.ws + WS_PBF);
      for (int i = gw * 64 + LANE_; i < T * PLE / 8; i += NGW * 64) { const f32x4 a = *(const f32x4*)(P + (size_t)i * 8), b = *(const f32x4*)(P + (size_t)i * 8 + 4);
          v4u o; o.x = pk2(a[0], a[1]); o.y = pk2(a[2], a[3]); o.z = pk2(b[0], b[1]); o.w = pk2(b[2], b[3]); *(v4u*)(PB + (size_t)i * 8) = o; } }
    bf16* ABF = (bf16*)(F.ws + WS_ABF);
    for (int m = gw; m < T; m += NGW) rms_row_to_bf16(fin(F, I_X) + (size_t)m * D, fin(F, I_GMIX), ABF + (size_t)m * D, LANE_);
}

__device__ __forceinline__ int t5_bucket(int n) {
    if (n < 16) return n;
    const int large = 16 + (int)(logf((float)n * (1.0f / 16.0f)) / logf(8.0f) * 16.0f);
    return large < 31 ? large : 31;
}
constexpr int VT_LD = 216, VT_KEYS = 208, KT_LD = 72;
constexpr int ATT_KT_OFF = 0, ATT_VT_OFF = VT_KEYS * KT_LD * 2;
__device__ __forceinline__ void attn_task(Frame& F, const LAS float* btab, const LAS bf16* ktl, const LAS bf16* vtl, int b, int kvh, int hg, int qt, const bf16x8 (&qf)[2]) {
    const int LANE_ = pg8::lane_id();
    bf16* MIX = (bf16*)(F.ws + WS_MIX);
    const int lane = LANE_, qi = lane & 15, g = lane >> 4, h = kvh * 8 + hg;
    const int q0 = qt * 16, tok0 = b * SEQ, kl0 = 16 * (qt & 3);
    f32x4 s[5][2];
#pragma unroll
    for (int kb = 0; kb < 5; ++kb)
#pragma unroll
        for (int t = 0; t < 2; ++t) {
            const LAS bf16* kp = ktl + (kl0 + 32 * kb + 16 * t + qi) * KT_LD + 8 * g;
            const bf16x8 k0f = *(const LAS bf16x8*)(kp), k1f = *(const LAS bf16x8*)(kp + 32);
            f32x4 a = (f32x4){0.f, 0.f, 0.f, 0.f};
            a = __builtin_amdgcn_mfma_f32_16x16x32_bf16(k0f, qf[0], a, 0, 0, 0);
            a = __builtin_amdgcn_mfma_f32_16x16x32_bf16(k1f, qf[1], a, 0, 0, 0);
            s[kb][t] = a;
        }
    const float sink = fin(F, I_SINKS)[h];
    const LAS float* bt = btab + hg * 128;
    float mx = sink;
#pragma unroll
    for (int kb = 0; kb < 5; ++kb)
#pragma unroll
        for (int t = 0; t < 2; ++t)
#pragma unroll
            for (int r = 0; r < 4; ++r) {
                const int key = q0 - 128 + 32 * kb + 16 * t + 4 * g + r, dist = q0 + qi - key;
                const bool valid = (dist >= 0) && (dist < 128) && (key >= 0);
                const float lg = valid ? s[kb][t][r] * 0.125f + bt[dist & 127] : -3.0e38f;
                s[kb][t][r] = lg; mx = fmaxf(mx, lg);
            }
    mx = fmaxf(mx, __shfl_xor(mx, 16)); mx = fmaxf(mx, __shfl_xor(mx, 32));
    float sum = 0.f;
#pragma unroll
    for (int kb = 0; kb < 5; ++kb)
#pragma unroll
        for (int t = 0; t < 2; ++t)
#pragma unroll
            for (int r = 0; r < 4; ++r) { const float lg = s[kb][t][r]; const float p = (lg > -1.0e38f) ? __expf(lg - mx) : 0.f; s[kb][t][r] = p; sum += p; }
    sum += __shfl_xor(sum, 16); sum += __shfl_xor(sum, 32);
    const float inv = 1.0f / (sum + __expf(sink - mx));
    f32x4 o[4];
#pragma unroll
    for (int dt = 0; dt < 4; ++dt) o[dt] = (f32x4){0.f, 0.f, 0.f, 0.f};
#pragma unroll
    for (int kb = 0; kb < 5; ++kb) {
        v4u pw; pw.x = pk2(s[kb][0][0], s[kb][0][1]); pw.y = pk2(s[kb][0][2], s[kb][0][3]); pw.z = pk2(s[kb][1][0], s[kb][1][1]); pw.w = pk2(s[kb][1][2], s[kb][1][3]);
        const bf16x8 pf = __builtin_bit_cast(bf16x8, pw);
        const int kkl = kl0 + 32 * kb + 4 * g;
#pragma unroll
        for (int dt = 0; dt < 4; ++dt) {
            const LAS bf16* vp = vtl + (16 * dt + qi) * VT_LD + kkl;
            const v2u lo = *(const LAS v2u*)(vp), hi = *(const LAS v2u*)(vp + 16);
            const v4u vw = (v4u){lo.x, lo.y, hi.x, hi.y};
            o[dt] = __builtin_amdgcn_mfma_f32_16x16x32_bf16(__builtin_bit_cast(bf16x8, vw), pf, o[dt], 0, 0, 0);
        }
    }
    bf16* op = MIX + (size_t)(tok0 + q0 + qi) * D + POOLW + h * 64 + 4 * g;
#pragma unroll
    for (int dt = 0; dt < 4; ++dt) { v2u w; w.x = pk2(o[dt][0] * inv, o[dt][1] * inv); w.y = pk2(o[dt][2] * inv, o[dt][3] * inv); *(v2u*)(op + 16 * dt) = w; }
}
__device__ __forceinline__ void attn_block(Frame& F, int blk) {
    const int TID_ = F.wave * 64 + pg8::lane_id();
    LAS float* btab = (LAS float*)(F.lds + TAB_OFF + 2048);
    LAS bf16* ktl = (LAS bf16*)(F.lds + RING_OFF + ATT_KT_OFF); LAS bf16* vtl = (LAS bf16*)(F.lds + RING_OFF + ATT_VT_OFF);
    const int b = blk >> 6, kvh = (blk >> 5) & 1, qg = blk & 31;
    const bf16* Q = (const bf16*)(F.ws + WS_QBF); const bf16* KVp = (const bf16*)(F.ws + WS_KV);
    bf16x8 qf[4][2];
    { const int lane = TID_ & 63, qi = lane & 15, g = lane >> 4, h = kvh * 8 + F.wave;
#pragma unroll
      for (int i = 0; i < 4; ++i)
#pragma unroll
          for (int ks = 0; ks < 2; ++ks) qf[i][ks] = *(const bf16x8*)(Q + (size_t)(b * SEQ + 64 * qg + 16 * i + qi) * 1024 + h * 64 + 32 * ks + 8 * g); }
    __syncthreads();
    for (int i = TID_; i < 1024; i += NWAVES * 64) { const int hg = i >> 7, dist = i & 127; btab[i] = fin(F, I_RPE)[t5_bucket(dist) * NH + kvh * 8 + hg]; }
    for (int idx = TID_; idx < VT_KEYS * 8; idx += NWAVES * 64) { const int kl = idx >> 3, c = idx & 7, key = 64 * qg - 128 + kl;
        v4u kv = (v4u){0u, 0u, 0u, 0u}, v = (v4u){0u, 0u, 0u, 0u};
        if (key >= 0 && key < SEQ) { const bf16* rp = KVp + (size_t)(b * SEQ + key) * (2 * KVW) + kvh * 64 + 8 * c; kv = *(const v4u*)(rp); v = *(const v4u*)(rp + KVW); }
        *(LAS v4u*)(ktl + kl * KT_LD + 8 * c) = kv;
        LAS bf16* d0 = vtl + (8 * c) * VT_LD + kl;
        d0[0 * VT_LD] = (bf16)(v.x & 0xffffu); d0[1 * VT_LD] = (bf16)(v.x >> 16); d0[2 * VT_LD] = (bf16)(v.y & 0xffffu); d0[3 * VT_LD] = (bf16)(v.y >> 16);
        d0[4 * VT_LD] = (bf16)(v.z & 0xffffu); d0[5 * VT_LD] = (bf16)(v.z >> 16); d0[6 * VT_LD] = (bf16)(v.w & 0xffffu); d0[7 * VT_LD] = (bf16)(v.w >> 16); }
    __syncthreads();
#pragma unroll
    for (int i = 0; i < 4; ++i) attn_task(F, btab, ktl, vtl, b, kvh, F.wave, 4 * qg + i, qf[i]);
}
__device__ __forceinline__ void pool_task(Frame& F, int mt, int gq) {
    const int LANE_ = pg8::lane_id(), TID_ = F.wave * 64 + LANE_;
    const bf16* U = (const bf16*)(F.ws + WS_UBF); bf16* PO = (bf16*)(F.ws + WS_POOLED);
    LAS v4u* UL = (LAS v4u*)(F.lds + RING_OFF);
    const int w = 2 << gq;
    for (int hh = 0; hh < 2; ++hh) {
        const int tbase = mt * 256 + 128 * hh, pos0 = tbase & (SEQ - 1);
        __syncthreads();
        for (int idx = TID_; idx < 143 * 32; idx += NWAVES * 64) { const int r = idx >> 5, c = idx & 31;
            v4u x = (v4u){0u, 0u, 0u, 0u}; if (pos0 - 15 + r >= 0) x = *(const v4u*)(U + (size_t)(tbase - 15 + r) * POOLW + gq * 256 + 8 * c);
            UL[idx] = x; }
        __syncthreads();
        const int c = TID_ & 31, i0 = (TID_ >> 5) * 8;
        float run[8];
#pragma unroll
        for (int q = 0; q < 8; ++q) run[q] = 0.f;
        for (int j = 1; j < w; ++j) { const v4u x = UL[(15 + i0 - j) * 32 + c];
            run[0] += bf_lo(x.x); run[1] += bf_hi(x.x); run[2] += bf_lo(x.y); run[3] += bf_hi(x.y); run[4] += bf_lo(x.z); run[5] += bf_hi(x.z); run[6] += bf_lo(x.w); run[7] += bf_hi(x.w); }
#pragma unroll
        for (int i = 0; i < 8; ++i) {
            const int pos = pos0 + i0 + i; const v4u x = UL[(15 + i0 + i) * 32 + c], y = UL[(15 + i0 + i - w + 1) * 32 + c];
            const float uv[8] = {bf_lo(x.x), bf_hi(x.x), bf_lo(x.y), bf_hi(x.y), bf_lo(x.z), bf_hi(x.z), bf_lo(x.w), bf_hi(x.w)};
            const float ic = 1.0f / (float)((pos + 1) < w ? (pos + 1) : w);
            float o[8];
#pragma unroll
            for (int q = 0; q < 8; ++q) { run[q] += uv[q]; o[q] = run[q] * ic - uv[q]; }
            v4u ow; ow.x = pk2(o[0], o[1]); ow.y = pk2(o[2], o[3]); ow.z = pk2(o[4], o[5]); ow.w = pk2(o[6], o[7]);
            *(v4u*)(PO + (size_t)(tbase + i0 + i) * POOLW + gq * 256 + 8 * c) = ow;
            run[0] -= bf_lo(y.x); run[1] -= bf_hi(y.x); run[2] -= bf_lo(y.y); run[3] -= bf_hi(y.y); run[4] -= bf_lo(y.z); run[5] -= bf_hi(y.z); run[6] -= bf_lo(y.w); run[7] -= bf_hi(y.w);
        }
    }
    VM_WAIT(); __syncthreads();
    pg8::Gemm g{(const bf16*)PO + gq * 256, (const bf16*)(F.ws + WS_WPOOL) + (size_t)gq * 65536, POOLW, 256, 256};
    pg8::SingleOrder S{mt, 0};
    EpiBf16Plain E{(bf16*)(F.ws + WS_MIX), D, gq * 256, fin(F, I_PSCALE)};
    pg8::gemm_phase<EpiBf16Plain, pg8::SingleOrder, false>(F.lds + RING_OFF, g, S, E, F.wave);
}

constexpr int XS_STRIDE = 2052;
constexpr int P4_XS = 0, P4_PART = 16 * XS_STRIDE * 4, P4_SELE = P4_PART + 4 * 16 * 64 * 4, P4_SELW = P4_SELE + 32 * 8 * 4, P4_SELL = P4_SELW + 32 * 8 * 4, P4_HIST = P4_SELL + 32 * 8 * 4, P4_BASE = P4_HIST + 256, P4_END = P4_BASE + 256;
static_assert(P4_END <= MISC_OFF, "P4 LDS map");
__device__ __forceinline__ void p4_route(Frame& F) {
    const int LANE_ = pg8::lane_id(), TID_ = F.wave * 64 + LANE_; (void)TID_;
    LAS float* XS = (LAS float*)(F.lds + P4_XS); LAS float* PART = (LAS float*)(F.lds + P4_PART);
    LAS int* SELE = (LAS int*)(F.lds + P4_SELE); LAS float* SELW = (LAS float*)(F.lds + P4_SELW); LAS int* SELL = (LAS int*)(F.lds + P4_SELL);
    LAS int* HIST = (LAS int*)(F.lds + P4_HIST); LAS int* BASE = (LAS int*)(F.lds + P4_BASE);
    const float* H1 = F.out; unsigned char* XN = F.ws + WS_XN; const float* gf = fin(F, I_GFFN); const float* rb = fin(F, I_RBIAS);
    const bf16* WH = (const bf16*)(F.ws + WS_WRT); const bf16* WL = WH + (size_t)NE * D;
    const int lane = LANE_, wave = F.wave;
    if (TID_ < 64) HIST[TID_] = 0;
    for (int tile = F.bx; tile < T / 32; tile += F.G) {
    f32x4 gv[8];
#pragma unroll
    for (int j = 0; j < 4; ++j) { gv[2 * j] = *(const f32x4*)(gf + 512 * j + 8 * lane); gv[2 * j + 1] = *(const f32x4*)(gf + 512 * j + 8 * lane + 4); }
#pragma unroll 1
    for (int pass = 0; pass < 2; ++pass) {
        { f32x4 xr[2][8];
#pragma unroll
          for (int q = 0; q < 2; ++q) { const float* xrow = H1 + (size_t)(tile * 32 + 16 * pass + 2 * wave + q) * D;
#pragma unroll
              for (int j = 0; j < 4; ++j) { xr[q][2 * j] = *(const f32x4*)(xrow + 512 * j + 8 * lane); xr[q][2 * j + 1] = *(const f32x4*)(xrow + 512 * j + 8 * lane + 4); } }
#pragma unroll
          for (int q = 0; q < 2; ++q) { const int tl = 2 * wave + q; float s = 0.f;
#pragma unroll
              for (int j = 0; j < 8; ++j) { const f32x4 v = xr[q][j]; s += (v[0] * v[0] + v[1] * v[1]) + (v[2] * v[2] + v[3] * v[3]); }
              const float rstd = 1.0f / sqrtf(wave_sum(s) * (1.0f / D) + EPS);
#pragma unroll
              for (int j = 0; j < 4; ++j) { const f32x4 a = xr[q][2 * j] * rstd * gv[2 * j], b = xr[q][2 * j + 1] * rstd * gv[2 * j + 1];
                  *(LAS f32x4*)(XS + tl * XS_STRIDE + 512 * j + 8 * lane) = a; *(LAS f32x4*)(XS + tl * XS_STRIDE + 512 * j + 8 * lane + 4) = b;
                  v2u o; o.x = pk4_fp8(a[0], a[1], a[2], a[3]); o.y = pk4_fp8(b[0], b[1], b[2], b[3]);
                  *(v2u*)(XN + (size_t)(tile * 32 + 16 * pass + tl) * D + 512 * j + 8 * lane) = o; } } }
        __syncthreads();
        {
            const int ti = lane & 15, kk = lane >> 4;
            f32x4 acc[4];
#pragma unroll
            for (int et = 0; et < 4; ++et) acc[et] = (f32x4){0.f, 0.f, 0.f, 0.f};
#pragma unroll 2
            for (int st = 0; st < 8; ++st) {
                const int k0 = 256 * wave + 32 * st + 8 * kk;
                const f32x4 xa = *(const LAS f32x4*)(XS + ti * XS_STRIDE + k0), xb = *(const LAS f32x4*)(XS + ti * XS_STRIDE + k0 + 4);
                v4u hw, lw;
                hw.x = pk2(xa[0], xa[1]); hw.y = pk2(xa[2], xa[3]); hw.z = pk2(xb[0], xb[1]); hw.w = pk2(xb[2], xb[3]);
                lw.x = pk2(xa[0] - bf_lo(hw.x), xa[1] - bf_hi(hw.x)); lw.y = pk2(xa[2] - bf_lo(hw.y), xa[3] - bf_hi(hw.y)); lw.z = pk2(xb[0] - bf_lo(hw.z), xb[1] - bf_hi(hw.z)); lw.w = pk2(xb[2] - bf_lo(hw.w), xb[3] - bf_hi(hw.w));
                const bf16x8 xh = __builtin_bit_cast(bf16x8, hw), xl = __builtin_bit_cast(bf16x8, lw);
#pragma unroll
                for (int et = 0; et < 4; ++et) { const bf16x8 wh = *(const bf16x8*)(WH + (size_t)(16 * et + ti) * D + k0), wl = *(const bf16x8*)(WL + (size_t)(16 * et + ti) * D + k0);
                    acc[et] = __builtin_amdgcn_mfma_f32_16x16x32_bf16(xh, wh, acc[et], 0, 0, 0);
                    acc[et] = __builtin_amdgcn_mfma_f32_16x16x32_bf16(xl, wh, acc[et], 0, 0, 0);
                    acc[et] = __builtin_amdgcn_mfma_f32_16x16x32_bf16(xh, wl, acc[et], 0, 0, 0); }
            }
            if (wave >= 4) {
#pragma unroll
                for (int et = 0; et < 4; ++et)
#pragma unroll
                    for (int r = 0; r < 4; ++r) PART[(wave - 4) * 1024 + (4 * kk + r) * 64 + 16 * et + ti] = acc[et][r];
            }
            __syncthreads();
            if (wave < 4) {
#pragma unroll
                for (int et = 0; et < 4; ++et)
#pragma unroll
                    for (int r = 0; r < 4; ++r) { LAS float* pp = PART + wave * 1024 + (4 * kk + r) * 64 + 16 * et + ti; *pp = *pp + acc[et][r]; }
            }
        }
        __syncthreads();
#pragma unroll 1
        for (int q = 0; q < 2; ++q) {
            const int tl = 2 * wave + q, tw = pass * 16 + tl;
            const float lg = (PART[tl * 64 + lane] + PART[1024 + tl * 64 + lane]) + (PART[2048 + tl * 64 + lane] + PART[3072 + tl * 64 + lane]);
            const float score = 1.0f / (1.0f + expf(-lg)), biased = score + rb[lane];
            const int grp = lane >> 3;
            float m1 = biased; m1 = fmaxf(m1, __shfl_xor(m1, 1)); m1 = fmaxf(m1, __shfl_xor(m1, 2)); m1 = fmaxf(m1, __shfl_xor(m1, 4));
            const unsigned long long bm = __ballot(biased == m1); const unsigned gb = (unsigned)(bm >> (8 * grp)) & 0xffu; const int first = __builtin_ctz(gb);
            float v2 = ((lane & 7) == first) ? -3.0e38f : biased; float m2 = v2; m2 = fmaxf(m2, __shfl_xor(m2, 1)); m2 = fmaxf(m2, __shfl_xor(m2, 2)); m2 = fmaxf(m2, __shfl_xor(m2, 4));
            const float gs = m1 + m2;
            int grank = 0;
#pragma unroll
            for (int j = 0; j < 8; ++j) { const float gj = __shfl(gs, 8 * j); grank += ((gj > gs) || (gj == gs && j < grp)) ? 1 : 0; }
            const bool gsel = grank < 4;
            const float masked = gsel ? biased : -3.0e38f;
            int rank = 0;
#pragma unroll
            for (int j = 0; j < 64; ++j) { const float vj = __shfl(masked, j); rank += ((vj > masked) || (vj == masked && j < lane)) ? 1 : 0; }
            const bool sel = gsel && (rank < 8);
            const float wsum = wave_sum(sel ? score : 0.f);
            const unsigned long long sm = __ballot(sel);
            if (sel) { const int k = __popcll(sm & ((1ull << lane) - 1ull)); const int li = atomicAdd((int*)&HIST[lane], 1);
                SELE[tw * 8 + k] = lane; SELW[tw * 8 + k] = score / wsum * 2.5f; SELL[tw * 8 + k] = li; }
        }
        __syncthreads();
    }
    if (TID_ < 64) BASE[TID_] = (int)__hip_atomic_fetch_add(F.ctl + CW_CNT + 32 * TID_, (unsigned)HIST[TID_], RLX_AGENT);
    __syncthreads();
    if (TID_ < 256) { const int e = SELE[TID_], pos = BASE[e] + SELL[TID_], tok = tile * 32 + (TID_ >> 3);
        ((int*)(F.ws + WS_TOKLIST))[(size_t)e * T + pos] = tok; ((float*)(F.ws + WS_WREC))[tok * 8 + (TID_ & 7)] = SELW[TID_]; ((int*)(F.ws + WS_REC))[tok * 8 + (TID_ & 7)] = e * T + pos; }
    __syncthreads();
    if (TID_ < 64) HIST[TID_] = 0;
    __syncthreads();
    }
}

__device__ __forceinline__ void p7_combine(Frame& F, bool dry) {
    const int LANE_ = pg8::lane_id();
    const LAS int* tab = (const LAS int*)(F.lds + TAB_OFF);
    const unsigned char* Y = F.ws + WS_Y; const int* rec = (const int*)(F.ws + WS_REC); const float* wrec = (const float*)(F.ws + WS_WREC);
    const float* H = F.out; bf16* HO = dry ? (bf16*)(F.ws + WS_WGU) : (bf16*)(F.ws + WS_H2B); unsigned char* H2 = dry ? (F.ws + WS_WGU + 64 * MiB) : (F.ws + WS_H2F8);
    const int gw = F.bx * NWAVES + F.wave, NGW = F.G * NWAVES, lane = LANE_;
    for (int t = gw; t < T; t += NGW) {
        int rows[9]; float rwt[9];
#pragma unroll
        for (int k = 0; k < 8; ++k) { const int rc = rec[t * 8 + k]; const int e = rc >> 13, pos = rc & (T - 1); rows[k] = tab[TB_PAD + e] + pos; rwt[k] = wrec[t * 8 + k] * (1.0f / SY); }
        rows[8] = SH_ROW0 + t; rwt[8] = 1.0f / SY;
        v4u y[2][9]; f32x4 h[2][4];
#pragma unroll
        for (int j = 0; j < 2; ++j) { const int c0 = 1024 * j + 16 * lane;
#pragma unroll
            for (int q = 0; q < 4; ++q) h[j][q] = *(const f32x4*)(H + (size_t)t * D + c0 + 4 * q);
#pragma unroll
            for (int k = 0; k < 9; ++k) y[j][k] = *(const v4u*)(Y + (size_t)rows[k] * D + c0); }
#pragma unroll
        for (int j = 0; j < 2; ++j) { const int c0 = 1024 * j + 16 * lane;
#pragma unroll
            for (int k = 0; k < 9; ++k) { const float w = rwt[k]; float f[4];
                fp8x4_to_f32(y[j][k].x, f); h[j][0][0] += w * f[0]; h[j][0][1] += w * f[1]; h[j][0][2] += w * f[2]; h[j][0][3] += w * f[3];
                fp8x4_to_f32(y[j][k].y, f); h[j][1][0] += w * f[0]; h[j][1][1] += w * f[1]; h[j][1][2] += w * f[2]; h[j][1][3] += w * f[3];
                fp8x4_to_f32(y[j][k].z, f); h[j][2][0] += w * f[0]; h[j][2][1] += w * f[1]; h[j][2][2] += w * f[2]; h[j][2][3] += w * f[3];
                fp8x4_to_f32(y[j][k].w, f); h[j][3][0] += w * f[0]; h[j][3][1] += w * f[1]; h[j][3][2] += w * f[2]; h[j][3][3] += w * f[3]; }
            { v4u b0, b1; b0.x = pk2(h[j][0][0], h[j][0][1]); b0.y = pk2(h[j][0][2], h[j][0][3]); b0.z = pk2(h[j][1][0], h[j][1][1]); b0.w = pk2(h[j][1][2], h[j][1][3]);
              b1.x = pk2(h[j][2][0], h[j][2][1]); b1.y = pk2(h[j][2][2], h[j][2][3]); b1.z = pk2(h[j][3][0], h[j][3][1]); b1.w = pk2(h[j][3][2], h[j][3][3]);
              *(v4u*)(HO + (size_t)t * D + c0) = b0; *(v4u*)(HO + (size_t)t * D + c0 + 8) = b1; }
            v4u o; o.x = pk4_fp8(h[j][0][0], h[j][0][1], h[j][0][2], h[j][0][3]); o.y = pk4_fp8(h[j][1][0], h[j][1][1], h[j][1][2], h[j][1][3]);
            o.z = pk4_fp8(h[j][2][0], h[j][2][1], h[j][2][2], h[j][2][3]); o.w = pk4_fp8(h[j][3][0], h[j][3][1], h[j][3][2], h[j][3][3]);
            *(v4u*)(H2 + (size_t)t * D + c0) = o; }
    }
}
__device__ __forceinline__ void p9_final(Frame& F, bool dry) {
    const int LANE_ = pg8::lane_id();
    const int gw = F.bx * NWAVES + F.wave, NGW = F.G * NWAVES, lane = LANE_; const float* g = fin(F, I_GFINAL); const float* gp = fin(F, I_GPLE);
    const bf16* G = (const bf16*)(F.ws + WS_GBUF); const bf16* PP = (const bf16*)(F.ws + WS_PPROJ);
    for (int t = gw; t < T; t += NGW) {
        const bf16* row = (const bf16*)(F.ws + WS_H2B) + (size_t)t * D; float* orow = (dry ? (float*)(F.ws + WS_WGU) : F.out) + (size_t)t * D; f32x4 v[8]; v4u gg[4], pw[4];
#pragma unroll
        for (int j = 0; j < 4; ++j) { const v4u hw = *(const v4u*)(row + 512 * j + 8 * lane);
            v[2 * j] = (f32x4){bf_lo(hw.x), bf_hi(hw.x), bf_lo(hw.y), bf_hi(hw.y)}; v[2 * j + 1] = (f32x4){bf_lo(hw.z), bf_hi(hw.z), bf_lo(hw.w), bf_hi(hw.w)};
            gg[j] = *(const v4u*)(G + (size_t)t * D + 512 * j + 8 * lane); pw[j] = *(const v4u*)(PP + (size_t)t * D + 512 * j + 8 * lane); }
        float pf[4][8]; float ps = 0.f;
#pragma unroll
        for (int j = 0; j < 4; ++j) { pf[j][0] = bf_lo(pw[j].x); pf[j][1] = bf_hi(pw[j].x); pf[j][2] = bf_lo(pw[j].y); pf[j][3] = bf_hi(pw[j].y); pf[j][4] = bf_lo(pw[j].z); pf[j][5] = bf_hi(pw[j].z); pf[j][6] = bf_lo(pw[j].w); pf[j][7] = bf_hi(pw[j].w);
#pragma unroll
            for (int q = 0; q < 8; ++q) ps += pf[j][q] * pf[j][q]; }
        const float rsp = 1.0f / sqrtf(wave_sum(ps) * (1.0f / D) + EPS);
        float s = 0.f;
#pragma unroll
        for (int j = 0; j < 4; ++j) { const f32x4 g0 = *(const f32x4*)(gp + 512 * j + 8 * lane), g1 = *(const f32x4*)(gp + 512 * j + 8 * lane + 4);
            const float gl[8] = {bf_lo(gg[j].x), bf_hi(gg[j].x), bf_lo(gg[j].y), bf_hi(gg[j].y), bf_lo(gg[j].z), bf_hi(gg[j].z), bf_lo(gg[j].w), bf_hi(gg[j].w)};
#pragma unroll
            for (int q = 0; q < 4; ++q) { v[2 * j][q] += sigmoid_f(gl[q]) * pf[j][q] * rsp * g0[q]; v[2 * j + 1][q] += sigmoid_f(gl[4 + q]) * pf[j][4 + q] * rsp * g1[q]; }
            s += (v[2 * j][0] * v[2 * j][0] + v[2 * j][1] * v[2 * j][1]) + (v[2 * j][2] * v[2 * j][2] + v[2 * j][3] * v[2 * j][3]);
            s += (v[2 * j + 1][0] * v[2 * j + 1][0] + v[2 * j + 1][1] * v[2 * j + 1][1]) + (v[2 * j + 1][2] * v[2 * j + 1][2] + v[2 * j + 1][3] * v[2 * j + 1][3]); }
        const float rstd = 1.0f / sqrtf(wave_sum(s) * (1.0f / D) + EPS);
#pragma unroll
        for (int j = 0; j < 4; ++j) { const f32x4 g0 = *(const f32x4*)(g + 512 * j + 8 * lane), g1 = *(const f32x4*)(g + 512 * j + 8 * lane + 4);
            *(f32x4*)(orow + 512 * j + 8 * lane) = v[2 * j] * rstd * g0; *(f32x4*)(orow + 512 * j + 8 * lane + 4) = v[2 * j + 1] * rstd * g1; }
    }
}
__global__ void __launch_bounds__(NWAVES * 64, 2) fwd_kernel(Args args) {
    extern __shared__ __attribute__((aligned(16))) unsigned char lds[];
    Frame F;
    F.lds = (LAS unsigned char*)lds;
    F.MISC = (volatile LAS unsigned*)(F.lds + MISC_OFF);
    F.wave = __builtin_amdgcn_readfirstlane(threadIdx.x >> 6);
    F.G = gridDim.x; F.bx = blockIdx.x;
    F.ws = args.ws; F.ctl = (gu32*)(args.ws + WS_CTL); F.out = args.out;
    { const int TID_ = threadIdx.x;
    if (TID_ < 64) F.MISC[TID_] = 0u;
    if (TID_ >= 64 && TID_ < 64 + 22) ((LAS unsigned long long*)(F.lds + MISC_OFF + 256))[TID_ - 64] = ((const unsigned long long*)&args)[TID_ - 64]; }
    __syncthreads();
    XcdBarrier bar; bar.bar = (unsigned*)(F.ctl + CW_BAR); bar.x = 0; bar.st = nullptr;
    if (N_LAUNCHES == 1) bar = xcd_barrier_post((unsigned*)(F.ctl + CW_BAR), F.MISC + 8);
#define GRID_BAR() do { if (N_LAUNCHES == 1) xcd_barrier(bar); } while (0)
    const int lo = args.ph_lo, hi = args.ph_hi;
#ifndef PH_MASK
#define PH_MASK 0x3ff
#endif
#ifndef DUP_PHASE
#define DUP_PHASE -1
#endif
#define REPS(k) ((DUP_PHASE == (k)) ? 2 : 1)
#define IN(k) ((((PH_MASK) >> (k)) & 1) && lo <= (k) && (k) < hi)
#define BOTH(k) (IN(k) && IN((k) + 1))

    if (IN(0)) { _Pragma("unroll") for (int rep = 0; rep < REPS(0); ++rep) { p0_prologue(F); if (BOTH(0)) GRID_BAR(); } }

    if (IN(1)) { _Pragma("unroll") for (int rep = 0; rep < REPS(1); ++rep) {
        constexpr int G1 = 144;
        if (F.G == 256 && F.bx >= G1) {
            { pg8::Gemm g{(const bf16*)(F.ws + WS_PBF), (const bf16*)(F.ws + WS_WPP), PLE, PLE, PLE}; pg8::StaticOrder S; S.init(T, D, F.G - G1, F.bx - G1);
              EpiBf16Plain E{(bf16*)(F.ws + WS_PPROJ), D, 0, nullptr};
              pg8::gemm_phase<EpiBf16Plain, pg8::StaticOrder, false>(F.lds + RING_OFF, g, S, E, F.wave); }
            conv_fp8_items(F, CONV_A, CONV_A + CONV_B, (F.bx - G1) * NWAVES + F.wave, (F.G - G1) * NWAVES);
        } else {
            const int gg = (F.G == 256) ? G1 : F.G;
            { pg8::Gemm g{(const bf16*)(F.ws + WS_ABF), (const bf16*)(F.ws + WS_WIN), D, D, D}; pg8::StaticOrder S; S.init(T, INW, gg, F.bx);
              EpiInProj E{F.ws};
              pg8::gemm_phase<EpiInProj, pg8::StaticOrder, false>(F.lds + RING_OFF, g, S, E, F.wave); }
            if (F.G != 256) {
                { pg8::Gemm g{(const bf16*)(F.ws + WS_PBF), (const bf16*)(F.ws + WS_WPP), PLE, PLE, PLE}; pg8::StaticOrder S; S.init(T, D, F.G, F.bx);
                  EpiBf16Plain E{(bf16*)(F.ws + WS_PPROJ), D, 0, nullptr};
                  pg8::gemm_phase<EpiBf16Plain, pg8::StaticOrder, false>(F.lds + RING_OFF, g, S, E, F.wave); }
                conv_fp8_items(F, CONV_A, CONV_A + CONV_B, F.bx * NWAVES + F.wave, F.G * NWAVES);
            }
        }
        if (BOTH(1)) GRID_BAR();
    } }

    if (IN(2)) { _Pragma("unroll") for (int rep = 0; rep < REPS(2); ++rep) {
        if (F.G == 256) {
            if (F.bx < 128) pool_task(F, F.bx >> 2, F.bx & 3);
            else { attn_block(F, 2 * (F.bx - 128)); attn_block(F, 2 * (F.bx - 128) + 1); }
        } else {
            for (int blk = F.bx; blk < 256; blk += F.G) attn_block(F, blk);
            for (int p = F.bx; p < 128; p += F.G) { __syncthreads(); pool_task(F, p >> 2, p & 3); }
        }
        if (BOTH(2)) GRID_BAR();
    } }

    if (IN(3)) { _Pragma("unroll") for (int rep = 0; rep < REPS(3); ++rep) {
        constexpr int G3 = 128;
        if (F.G == 256 && F.bx >= G3) conv_fp8_items(F, CONV_A + CONV_B, CV_TOTAL, (F.bx - G3) * NWAVES + F.wave, (F.G - G3) * NWAVES);
        else {
            pg8::Gemm g{(const bf16*)(F.ws + WS_MIX), (const bf16*)(F.ws + WS_WOUT), D, D, D}; pg8::StaticOrder S; S.init(T, D, (F.G == 256) ? G3 : F.G, F.bx);
            EpiResF32 E{fin(F, I_X), F.out};
            pg8::gemm_phase<EpiResF32, pg8::StaticOrder, false>(F.lds + RING_OFF, g, S, E, F.wave);
            if (F.G != 256) conv_fp8_items(F, CONV_A + CONV_B, CV_TOTAL, F.bx * NWAVES + F.wave, F.G * NWAVES);
        }
        if (BOTH(3)) GRID_BAR();
    } }

    if (IN(4)) { p4_route(F); if (BOTH(4)) GRID_BAR(); }

    if (IN(5)) { _Pragma("unroll") for (int rep = 0; rep < REPS(5); ++rep) {
        moe_tables(F);
        pg8::Gemm g{F.ws + WS_XN, F.ws + WS_WGU, D, D, D};
        MoeOrder S{(const LAS int*)(F.lds + TAB_OFF), (const int*)(F.ws + WS_TOKLIST), F.bx & 7, F.bx >> 3, 4, F.G >> 3};
        EpiGateUp E{F.ws + WS_ACT};
        pg8::gemm_phase<EpiGateUp, MoeOrder, true, 1>(F.lds + RING_OFF, g, S, E, F.wave);
        if (BOTH(5)) GRID_BAR();
    } }

    if (IN(6)) { _Pragma("unroll") for (int rep = 0; rep < REPS(6); ++rep) {
        if (!IN(5)) moe_tables(F);
        pg8::Gemm g{F.ws + WS_ACT, F.ws + WS_WD, EFF, EFF, EFF};
        MoeOrder S{(const LAS int*)(F.lds + TAB_OFF), (const int*)(F.ws + WS_TOKLIST), F.bx & 7, F.bx >> 3, 8, F.G >> 3};
        EpiDown E{F.ws + WS_Y};
        pg8::gemm_phase<EpiDown, MoeOrder, false, 1>(F.lds + RING_OFF, g, S, E, F.wave);
        if (BOTH(6)) GRID_BAR();
    } }

    if (IN(7)) { if (!IN(6)) moe_tables(F); if (DUP_PHASE == 7) { p7_combine(F, true); GRID_BAR(); } p7_combine(F, false); if (BOTH(7)) GRID_BAR(); }

    if (IN(8)) {
        pg8::Gemm g{F.ws + WS_H2F8, F.ws + WS_WPG, D, D, D}; pg8::StaticOrder S; S.init(T, D, F.G, F.bx);
        EpiBf16Mul E{(bf16*)(F.ws + WS_GBUF), 1.0f / SW3};
        pg8::gemm_phase<EpiBf16Mul, pg8::StaticOrder, false, 1>(F.lds + RING_OFF, g, S, E, F.wave);
        if (BOTH(8)) GRID_BAR();
    }

    if (IN(9)) { if (DUP_PHASE == 9) { p9_final(F, true); GRID_BAR(); } p9_final(F, false); }
#undef IN
#undef BOTH
}

extern "C" void kernel_launch(void* const* d_in, const int* in_sizes, int n_in, void* d_out, int out_size, void* d_ws, size_t ws_size, hipStream_t stream) {
    static int grid = 0;
    if (grid == 0) {
        if (n_in != 22 || out_size != T * D || ws_size < WS_END) { fprintf(stderr, "kernel_launch: unexpected sizes n_in %d out %d ws %zu (need %zu)\n", n_in, out_size, ws_size, (size_t)WS_END); grid = -1; return; }
        int dev = 0, cus = 0, per_cu = 0;
        if (hipGetDevice(&dev) != hipSuccess || hipDeviceGetAttribute(&cus, hipDeviceAttributeMultiprocessorCount, dev) != hipSuccess) { grid = -1; return; }
        if (hipFuncSetAttribute((const void*)fwd_kernel, hipFuncAttributeMaxDynamicSharedMemorySize, LDS_BYTES) != hipSuccess) { fprintf(stderr, "kernel_launch: hipFuncSetAttribute failed\n"); grid = -1; return; }
        if (hipOccupancyMaxActiveBlocksPerMultiprocessor(&per_cu, (const void*)fwd_kernel, NWAVES * 64, LDS_BYTES) != hipSuccess || per_cu < 1) fprintf(stderr, "kernel_launch: occupancy query reports %d\n", per_cu);
        (void)hipGetLastError();
        grid = cus > 256 ? 256 : cus;
    }
    if (grid < 0) return;
    if (hipMemsetAsync((char*)d_ws + WS_CTL, 0, CTL_ZERO_BYTES, stream) != hipSuccess) return;
    Args a{};
    for (int i = 0; i < 22; ++i) a.in[i] = (const float*)d_in[i];
    a.out = (float*)d_out; a.ws = (unsigned char*)d_ws;
    for (int li = 0; li < N_LAUNCHES; ++li) {
        a.ph_lo = (N_LAUNCHES == 1) ? 0 : li; a.ph_hi = (N_LAUNCHES == 1) ? N_PHASES : li + 1; a.li = li;
        hipLaunchKernelGGL(fwd_kernel, dim3(grid), dim3(NWAVES * 64), LDS_BYTES, stream, a);
    }
}
```

```cpp
#include <hip/hip_runtime.h>
#include <cstdio>
#include <cstdint>

#ifndef MK_N_LAUNCHES
#define MK_N_LAUNCHES 1
#endif

namespace pg8 {
#define PG8_LAS __attribute__((address_space(3)))
typedef unsigned short bf16_t;
typedef short bf16x8 __attribute__((ext_vector_type(8)));
typedef float f32x4 __attribute__((ext_vector_type(4)));
typedef unsigned u32x4 __attribute__((ext_vector_type(4)));
typedef unsigned u32x2 __attribute__((ext_vector_type(2)));
constexpr int BM = 256, BK = 64, HALF = 128, HTB = HALF * BK * 2  , STAGE_BYTES = 8 * HTB, NXCD = 8, WGM = 8;

__host__ __device__ __forceinline__ int lds_byte(int r, int c) { const int st = (r >> 4) * 2 + (c >> 5), rr = r & 15, cc = c & 31, ob = rr * 64 + cc * 2; return st * 1024 + (ob ^ (((ob >> 9) & 1) << 5)); }
__host__ __device__ __forceinline__ void stage_rc(int b, int& R, int& C) { const int st = b / 1024, sb = b % 1024, swz = sb ^ (((sb >> 9) & 1) << 5); R = (st >> 1) * 16 + swz / 64; C = (st & 1) * 32 + (swz % 64) / 2; }
__host__ __device__ __forceinline__ int perm32(int rho) { const int n = rho >> 4, i = rho & 15; return 8 * (i >> 2) + 4 * n + (i & 3); }

struct Unit { int pm, pn, e, lt, half; };
struct Gemm { const void* A; const void* Bt; int lda, ldb, K; };
typedef int i32x8 __attribute__((ext_vector_type(8)));
typedef int i32x4 __attribute__((ext_vector_type(4)));
__device__ __forceinline__ i32x8 cat8(bf16x8 lo, bf16x8 hi) { const i32x4 a = __builtin_bit_cast(i32x4, lo), b = __builtin_bit_cast(i32x4, hi); return __builtin_shufflevector(a, b, 0, 1, 2, 3, 4, 5, 6, 7); }

struct StaticOrder {
    static constexpr bool HALVES = false;
    int nM, nN, nwg, G, c;
    __host__ __device__ void init(int M, int N, int G_, int c_) { nM = M / BM; nN = N / BM; nwg = nM * nN; G = G_; c = c_; }
    __host__ __device__ bool next(int i, Unit& u) const {
        const long L = (long)i * G + c; if (L >= nwg) return false;
        int wgid = (int)L; { const int q = nwg / NXCD, r = nwg % NXCD, xcd = wgid % NXCD, off = wgid / NXCD; wgid = (xcd < r ? xcd * (q + 1) : r * (q + 1) + (xcd - r) * q) + off; }
        const int nig = WGM * nN, gid = wgid / nig, fm = gid * WGM, gsz = (nM - fm) < WGM ? (nM - fm) : WGM;
        u.pm = fm + ((wgid % nig) % gsz); u.pn = (wgid % nig) / gsz; u.e = 0; u.lt = 0; u.half = 0; return true;
    }
    __device__ __forceinline__ int arow(const Unit&, int r) const { return r; }
};
struct SingleOrder {
    static constexpr bool HALVES = false;
    int pm, pn;
    __device__ bool next(int i, Unit& u) const { if (i > 0) return false; u.pm = pm; u.pn = pn; u.e = 0; u.lt = 0; u.half = 0; return true; }
    __device__ __forceinline__ int arow(const Unit&, int r) const { return r; }
};

__device__ __forceinline__ int lane_id() { int l; asm volatile("v_mbcnt_lo_u32_b32 %0, -1, 0\n\tv_mbcnt_hi_u32_b32 %0, -1, %0" : "=v"(l)); return l; }
__device__ __forceinline__ unsigned cvt_pk_bf16(float lo, float hi) { unsigned r; asm volatile("v_cvt_pk_bf16_f32 %0, %1, %2" : "=v"(r) : "v"(lo), "v"(hi)); return r; }

__host__ __device__ __forceinline__ int perm16(int R) { return 64 * (R >> 5) + 16 * ((R >> 2) & 3) + 4 * ((R >> 4) & 1) + (R & 3); }
template <class Epi, class Sched, bool GATHER, int ESZ = 2, bool ALIGN_EPI = true>
__device__ __forceinline__ void gemm_phase(PG8_LAS unsigned char* lds, const Gemm g, const Sched& S, const Epi& E, int wid) {
    const int lane = lane_id(), tid = wid * 64 + lane, wr = wid >> 2, wc = wid & 3, fr = lane & 15, fq = lane >> 4;
    const int nt = (g.K * ESZ) / 128;
    int Ra[2], Ca[2]; unsigned voffB[2];
#pragma unroll
    for (int i = 0; i < 2; ++i) { int R, C; stage_rc(tid * 16 + i * 8192, R, C); const int Rb = (Epi::PERM == 2) ? perm16(R) : (Epi::PERM ? ((R & ~31) + perm32(R & 31)) : R);
        Ra[i] = R; Ca[i] = C; voffB[i] = (unsigned)(Rb * g.ldb * ESZ + C * 2); }
    const size_t kstep = (size_t)(BK * 2);
    const size_t hstepB = (size_t)((Epi::PERM == 2) ? 8 : HALF) * g.ldb * ESZ, tstepB = (size_t)BM * g.ldb * ESZ;
    const size_t tstepA = (size_t)BM * g.lda * ESZ;
    const unsigned ldsw = (unsigned)wid * 1024u;
    const int aoff = lds_byte(wr * 64 + fr, fq * 8), boff = lds_byte(wc * 32 + fr, fq * 8);
#define PG8_SA(b, h) (((b) * 2 + (h)) * HTB)
#define PG8_SB(b, h) ((4 + (b) * 2 + (h)) * HTB)
#define PG8_STAGE(bufoff, gbase, v0, v1) do { \
        __builtin_amdgcn_global_load_lds((const unsigned*)((const char*)(gbase) + (v0)), (PG8_LAS unsigned*)(lds + (bufoff) + ldsw), 16, 0, 0); \
        __builtin_amdgcn_global_load_lds((const unsigned*)((const char*)(gbase) + (v1)), (PG8_LAS unsigned*)(lds + (bufoff) + ldsw + 8192), 16, 0, 0); } while (0)
#define PG8_STAGE_A0(bufoff, gbase, p0, p1) PG8_STAGE(bufoff, gbase, p0, p1)
#define PG8_STAGE_A1(bufoff, gbase, p0, p1, q0, q1) do { if constexpr (GATHER) { PG8_STAGE(bufoff, gbase, q0, q1); } else { PG8_STAGE(bufoff, (gbase) + hstepA, p0, p1); } } while (0)
#define PG8_LD16(off) (*(const PG8_LAS i32x4*)(lds + (off)))
#define PG8_LDA(dst, b, h) do { if constexpr (ESZ == 2) { _Pragma("unroll") for (int m = 0; m < 4; ++m) _Pragma("unroll") for (int k = 0; k < 2; ++k) dst[m][k] = *(const PG8_LAS bf16x8*)(lds + PG8_SA(b, h) + aoff + m * 2048 + k * 1024); } \
        else { _Pragma("unroll") for (int m = 0; m < 4; ++m) dst##8[m] = __builtin_shufflevector(PG8_LD16(PG8_SA(b, h) + aoff + m * 2048), PG8_LD16(PG8_SA(b, h) + aoff + m * 2048 + 1024), 0, 1, 2, 3, 4, 5, 6, 7); } } while (0)
#define PG8_LDB(dst, b, h) do { if constexpr (ESZ == 2) { _Pragma("unroll") for (int n = 0; n < 2; ++n) _Pragma("unroll") for (int k = 0; k < 2; ++k) dst[n][k] = *(const PG8_LAS bf16x8*)(lds + PG8_SB(b, h) + boff + n * 2048 + k * 1024); } \
        else { _Pragma("unroll") for (int n = 0; n < 2; ++n) dst##8[n] = __builtin_shufflevector(PG8_LD16(PG8_SB(b, h) + boff + n * 2048), PG8_LD16(PG8_SB(b, h) + boff + n * 2048 + 1024), 0, 1, 2, 3, 4, 5, 6, 7); } } while (0)
#define PG8_MMA(ai, bj, At, Bt) do { __builtin_amdgcn_s_setprio(1); \
        if constexpr (ESZ == 2) { _Pragma("unroll") for (int m = 0; m < 4; ++m) _Pragma("unroll") for (int n = 0; n < 2; ++n) _Pragma("unroll") for (int k = 0; k < 2; ++k) \
            acc[ai][bj][m][n] = __builtin_amdgcn_mfma_f32_16x16x32_bf16(Bt[n][k], At[m][k], acc[ai][bj][m][n], 0, 0, 0); } \
        else { _Pragma("unroll") for (int m = 0; m < 4; ++m) _Pragma("unroll") for (int n = 0; n < 2; ++n) \
            asm volatile("v_mfma_scale_f32_16x16x128_f8f6f4 %0, %1, %2, %0, %3, %3 op_sel_hi:[0,0,0]" : "+v"(acc[ai][bj][m][n]) : "v"(Bt##8[n]), "v"(At##8[m]), "v"(sc1)); } \
        __builtin_amdgcn_s_setprio(0); } while (0)
#define PG8_WAIT_V(n) asm volatile("s_waitcnt vmcnt(" #n ")" ::: "memory")
#define PG8_WAIT_L(n) asm volatile("s_waitcnt lgkmcnt(" #n ")" ::: "memory")
#define PG8_BAR __builtin_amdgcn_s_barrier()
#define PG8_SCHED __builtin_amdgcn_sched_barrier(0)
    Unit cur, nxt; int ui = 0;
    if (!S.next(0, cur)) return;
    f32x4 acc[2][2][4][2];
#pragma unroll
    for (int a = 0; a < 2; ++a)
#pragma unroll
        for (int b = 0; b < 2; ++b)
#pragma unroll
            for (int m = 0; m < 4; ++m)
#pragma unroll
                for (int n = 0; n < 2; ++n) acc[a][b][m][n] = (f32x4){0.f, 0.f, 0.f, 0.f};
    const int sc1 = 0x7F7F7F7F;
    bf16x8 At[4][2], B0[2][2], B1[2][2]; i32x8 At8[4], B08[2], B18[2];
    unsigned vA00, vA01, vA10, vA11, nA00, nA01, nA10, nA11;
    const size_t hstepA = GATHER ? (size_t)0 : (size_t)HALF * g.lda * ESZ;
    if constexpr (GATHER) {
        vA00 = (unsigned)(S.arow(cur, Ra[0]) * g.lda * ESZ + Ca[0] * 2); vA01 = (unsigned)(S.arow(cur, Ra[1]) * g.lda * ESZ + Ca[1] * 2);
        vA10 = (unsigned)(S.arow(cur, HALF + Ra[0]) * g.lda * ESZ + Ca[0] * 2); vA11 = (unsigned)(S.arow(cur, HALF + Ra[1]) * g.lda * ESZ + Ca[1] * 2);
    } else {
        vA00 = (unsigned)(Ra[0] * g.lda * ESZ + Ca[0] * 2); vA01 = (unsigned)(Ra[1] * g.lda * ESZ + Ca[1] * 2); vA10 = 0; vA11 = 0;
    }
    nA00 = vA00; nA01 = vA01; nA10 = vA10; nA11 = vA11;
    const char* cA = (const char*)g.A + (GATHER ? (size_t)0 : (size_t)cur.pm * tstepA); const char* cB = (const char*)g.Bt + (size_t)cur.pn * tstepB;
    PG8_STAGE(PG8_SB(0, 0), cB, voffB[0], voffB[1]); PG8_STAGE(PG8_SB(0, 1), cB + hstepB, voffB[0], voffB[1]); PG8_STAGE_A0(PG8_SA(0, 0), cA, vA00, vA01); PG8_STAGE_A1(PG8_SA(0, 1), cA, vA00, vA01, vA10, vA11);
    if (wr == 1) PG8_BAR;
    PG8_WAIT_V(2); PG8_BAR;
    PG8_STAGE(PG8_SB(1, 0), cB + kstep, voffB[0], voffB[1]); PG8_STAGE_A0(PG8_SA(1, 0), cA + kstep, vA00, vA01); PG8_STAGE(PG8_SB(1, 1), cB + hstepB + kstep, voffB[0], voffB[1]);
    PG8_WAIT_V(6); PG8_BAR;
    for (;;) {
        const bool has_next = S.next(ui + 1, nxt);
        const char* nA = has_next ? (const char*)g.A + (GATHER ? (size_t)0 : (size_t)nxt.pm * tstepA) : cA; const char* nB = has_next ? (const char*)g.Bt + (size_t)nxt.pn * tstepB : cB;
        if constexpr (GATHER) {
            if (has_next) {
                nA00 = (unsigned)(S.arow(nxt, Ra[0]) * g.lda * ESZ + Ca[0] * 2); nA01 = (unsigned)(S.arow(nxt, Ra[1]) * g.lda * ESZ + Ca[1] * 2);
                nA10 = (unsigned)(S.arow(nxt, HALF + Ra[0]) * g.lda * ESZ + Ca[0] * 2); nA11 = (unsigned)(S.arow(nxt, HALF + Ra[1]) * g.lda * ESZ + Ca[1] * 2);
            } else { nA00 = vA00; nA01 = vA01; nA10 = vA10; nA11 = vA11; }
        }
#pragma nounroll
        for (int t = 0; t < nt; t += 2) {
            const bool last = (t == nt - 2);
            const char* a1 = cA + (size_t)(t + 1) * kstep;
            const char* a2 = last ? nA : cA + (size_t)(t + 2) * kstep; const char* b2 = last ? nB : cB + (size_t)(t + 2) * kstep;
            const char* a3 = a2 + kstep; const char* b3 = b2 + kstep;
            asm volatile("" : "+v"(voffB[0]), "+v"(voffB[1]), "+v"(vA00), "+v"(vA01));
            if constexpr (GATHER) asm volatile("" : "+v"(vA10), "+v"(vA11));
            unsigned x00 = vA00, x01 = vA01, x10 = vA10, x11 = vA11;
            if constexpr (GATHER) { if (last) { x00 = nA00; x01 = nA01; x10 = nA10; x11 = nA11; } }
            const bool hf = Sched::HALVES && (cur.half != 0);
            PG8_LDB(B0, 0, 0); PG8_LDB(B1, 0, 1); PG8_SCHED; PG8_LDA(At, 0, 0); PG8_STAGE_A1(PG8_SA(1, 1), a1, vA00, vA01, vA10, vA11);
            PG8_WAIT_V(8); PG8_WAIT_L(0); PG8_BAR; PG8_MMA(0, 0, At, B0); PG8_MMA(0, 1, At, B1); PG8_BAR; PG8_SCHED;
            if (!hf) PG8_LDA(At, 0, 1); PG8_STAGE(PG8_SB(0, 0), b2, voffB[0], voffB[1]); PG8_STAGE(PG8_SB(0, 1), b2 + hstepB, voffB[0], voffB[1]); PG8_STAGE_A0(PG8_SA(0, 0), a2, x00, x01);
            PG8_WAIT_V(8); PG8_WAIT_L(0); PG8_BAR; if (!hf) { PG8_MMA(1, 0, At, B0); PG8_MMA(1, 1, At, B1); } PG8_BAR; PG8_SCHED;
            PG8_LDB(B0, 1, 0); PG8_LDB(B1, 1, 1); PG8_SCHED; PG8_LDA(At, 1, 0); PG8_STAGE_A1(PG8_SA(0, 1), a2, x00, x01, x10, x11);
            PG8_WAIT_V(8); PG8_WAIT_L(0); PG8_BAR; PG8_MMA(0, 0, At, B0); PG8_MMA(0, 1, At, B1); PG8_BAR; PG8_SCHED;
            if (!hf) PG8_LDA(At, 1, 1); PG8_STAGE(PG8_SB(1, 0), b3, voffB[0], voffB[1]); PG8_STAGE(PG8_SB(1, 1), b3 + hstepB, voffB[0], voffB[1]); PG8_STAGE_A0(PG8_SA(1, 0), a3, x00, x01);
            PG8_WAIT_V(8); PG8_WAIT_L(0); PG8_BAR; if (!hf) { PG8_MMA(1, 0, At, B0); PG8_MMA(1, 1, At, B1); } PG8_BAR; PG8_SCHED;
        }
        if constexpr (ALIGN_EPI) { if (wr == 0) PG8_BAR; }
        if constexpr (ESZ == 1) asm volatile("s_nop 15\n\ts_nop 15" ::: "memory");
        E(acc, cur, wr, wc, fr, fq);
        if (!has_next) break;
#pragma unroll
        for (int a = 0; a < 2; ++a)
#pragma unroll
            for (int b = 0; b < 2; ++b)
#pragma unroll
                for (int m = 0; m < 4; ++m)
#pragma unroll
                    for (int n = 0; n < 2; ++n) acc[a][b][m][n] = (f32x4){0.f, 0.f, 0.f, 0.f};
        cur = nxt; cA = nA; cB = nB; ++ui;
        if constexpr (GATHER) { vA00 = nA00; vA01 = nA01; vA10 = nA10; vA11 = nA11; }
        if constexpr (ALIGN_EPI) { if (wr == 1) PG8_BAR; }
    }
    PG8_WAIT_V(0);
    if constexpr (!ALIGN_EPI) { if (wr == 0) PG8_BAR; }
    PG8_BAR;
#undef PG8_SA
#undef PG8_SB
#undef PG8_STAGE
#undef PG8_LDA
#undef PG8_LD16
#undef PG8_STAGE_A0
#undef PG8_STAGE_A1
#undef PG8_LDB
#undef PG8_MMA
#undef PG8_WAIT_V
#undef PG8_WAIT_L
#undef PG8_BAR
#undef PG8_SCHED
}
}

constexpr int NWAVES = 8;
constexpr int T = 8192, SEQ = 2048, NB = 4, D = 2048, INW = 2304, POOLW = 1024, NH = 16, NKV = 2, HD = 64, KVW = 128;
constexpr int NE = 64, TOPK = 8, EFF = 512, PLE = 256;
constexpr int SH_ROW0 = T * TOPK + NE * 256;
constexpr int NROWS = SH_ROW0 + T;
constexpr float EPS = 1e-6f;
constexpr float SW1 = 32.0f, SW2 = 16.0f, SA = 4.0f, SY = 16.0f, SW3 = 32.0f;
constexpr int N_PHASES = 10;
constexpr int N_LAUNCHES = MK_N_LAUNCHES;

constexpr size_t MiB = 1u << 20;
constexpr size_t WS_CTL = 0, CTL_ZERO_BYTES = 64 * 1024;
constexpr size_t WS_MISC = 1 * MiB;
constexpr size_t WS_TOKLIST = WS_MISC;
constexpr size_t WS_REC = WS_TOKLIST + (size_t)NE * T * 4;
constexpr size_t WS_WREC = WS_REC + (size_t)T * TOPK * 4;
constexpr size_t WS_RSTDP = WS_WREC + (size_t)T * TOPK * 4;
constexpr size_t WS_PBF = 6 * MiB;
constexpr size_t WS_WRT = 10 * MiB;
constexpr size_t WS_WIN = 12 * MiB;
constexpr size_t WS_WPOOL = WS_WIN + (size_t)INW * D * 2;
constexpr size_t WS_WOUT = WS_WPOOL + (size_t)4 * 256 * 256 * 2;
constexpr size_t WS_WPP = WS_WOUT + (size_t)D * D * 2;
constexpr size_t WS_WPG = WS_WPP + (size_t)D * PLE * 2;
constexpr size_t WS_WGU = WS_WPG + (size_t)D * D * 2;
constexpr size_t WS_WD = WS_WGU + (size_t)65 * 1024 * D;
constexpr size_t WS_XN = WS_WD + (size_t)65 * D * EFF;
constexpr size_t WS_PPROJ = WS_XN + (size_t)T * D * 2;
constexpr size_t WS_ACT = WS_PPROJ + (size_t)T * D * 2;
constexpr size_t WS_H2F8 = WS_ACT;
constexpr size_t WS_H2B = WS_ACT + 16 * MiB;
constexpr size_t WS_GBUF = WS_XN;
constexpr size_t WS_Y = WS_ACT + (size_t)NROWS * EFF * 2;
constexpr size_t WS_ABF = WS_Y;
constexpr size_t WS_UBF = WS_ABF + (size_t)T * D * 2;
constexpr size_t WS_QBF = WS_UBF + (size_t)T * POOLW * 2;
constexpr size_t WS_KV = WS_QBF + (size_t)T * 1024 * 2;
constexpr size_t WS_POOLED = WS_KV + (size_t)T * 2 * KVW * 2;
constexpr size_t WS_MIX = WS_POOLED + (size_t)T * POOLW * 2;
constexpr size_t WS_END = WS_Y + (size_t)NROWS * D * 2;
static_assert(WS_MIX + (size_t)T * D * 2 <= WS_END, "early activations fit under Y");
static_assert(WS_RSTDP + (size_t)T * 4 <= WS_PBF && WS_PBF + (size_t)T * PLE * 2 <= WS_WIN, "misc fits");
static_assert(WS_END <= (size_t)1024 * MiB, "workspace must fit 1 GiB");
constexpr int CW_BAR = 1024;
constexpr int CW_CNT = 8192;
static_assert((CW_CNT + 32 * NE) * 4 <= (int)CTL_ZERO_BYTES, "CTL words inside the memset region");

constexpr int RING_OFF = 0, RING_BYTES = 131072;
constexpr int LDS_BYTES = 163840;
constexpr int MISC_OFF = LDS_BYTES - 512;
constexpr int TAB_OFF = RING_BYTES;
constexpr int TB_CNT = 0, TB_PAD = 80, TB_XF = 160, TB_XH = 176, TB_SH0 = 192, TB_SHN = 193;

#define GAS __attribute__((address_space(1)))
#define LAS __attribute__((address_space(3)))
typedef unsigned short bf16;
typedef unsigned v4u __attribute__((ext_vector_type(4)));
typedef unsigned v2u __attribute__((ext_vector_type(2)));
typedef float f32x4 __attribute__((ext_vector_type(4)));
typedef short bf16x8 __attribute__((ext_vector_type(8)));
typedef GAS unsigned gu32;
#define RLX_AGENT __ATOMIC_RELAXED, __HIP_MEMORY_SCOPE_AGENT
#define LDS_WAIT() asm volatile("s_waitcnt lgkmcnt(0)" ::: "memory")
#define VM_WAIT() asm volatile("s_waitcnt vmcnt(0)" ::: "memory")
__device__ __forceinline__ unsigned pk2(float lo, float hi) { return pg8::cvt_pk_bf16(lo, hi); }
__device__ __forceinline__ float bf_lo(unsigned w) { return __builtin_bit_cast(float, w << 16); }
__device__ __forceinline__ float bf_hi(unsigned w) { return __builtin_bit_cast(float, w & 0xffff0000u); }

#define XB_TMO      128
#define XB_XCNT(j)  (256  + 64 * (j))
#define XB_XSUB(j)  (1280 + 64 * (j))
#define XB_XGEN(j)  (2304 + 64 * (j))
#define XB_TOP      3328
#define XB_TOPGEN   3392
#define XCD_BAR_WORDS 3456
#define XB_SPIN_CAP (1u << 18)
__device__ __forceinline__ unsigned xb_ld(unsigned* p)              { return __hip_atomic_load(p, __ATOMIC_RELAXED, __HIP_MEMORY_SCOPE_AGENT); }
__device__ __forceinline__ unsigned xb_add(unsigned* p, unsigned v) { return __hip_atomic_fetch_add(p, v, __ATOMIC_RELAXED, __HIP_MEMORY_SCOPE_AGENT); }
__device__ __forceinline__ unsigned xb_xcc_id() { return (unsigned)__builtin_amdgcn_s_getreg((3 << 11) | 20) & 0xFu; }
#define XB_SPIN(cond, bar) do { unsigned _sp = 0; while (cond) { __builtin_amdgcn_s_sleep(1); \
    if ((++_sp & 255u) == 0u) { if (xb_ld(&(bar)[XB_TMO])) break; if (_sp > XB_SPIN_CAP) { atomicAdd(&(bar)[XB_TMO], 1u); break; } } } } while (0)
struct XcdBarrier { unsigned* bar; unsigned x; volatile LAS unsigned* st; };
__device__ __forceinline__ XcdBarrier xcd_barrier_post(unsigned* bar, volatile LAS unsigned* st) {
    XcdBarrier b; b.bar = bar; b.x = xb_xcc_id(); b.st = st;
    if (threadIdx.x == 0) (void)xb_add(&bar[XB_XCNT(b.x)], 1u);
    return b;
}
__device__ __forceinline__ void xcd_barrier_complete(unsigned* bar, unsigned x, unsigned& nloc, unsigned& nx) {
    const unsigned G = gridDim.x * gridDim.y * gridDim.z;
    unsigned sum, cnt, mine, sp = 0u;
    for (;;) {
        sum = 0u; cnt = 0u; mine = 0u;
#pragma unroll
        for (unsigned j = 0; j < 16; ++j) { const unsigned c = xb_ld(&bar[XB_XCNT(j)]); sum += c; cnt += (c > 0u) ? 1u : 0u; mine = (j == x) ? c : mine; }
        if (sum == G) break;
        __builtin_amdgcn_s_sleep(1);
        if ((++sp & 255u) == 0u) { if (xb_ld(&bar[XB_TMO])) break; if (sp > XB_SPIN_CAP) { atomicAdd(&bar[XB_TMO], 1u); break; } }
    }
    nloc = mine > 0u ? mine : 1u; nx = cnt > 0u ? cnt : 1u;
}
__device__ __forceinline__ void xcd_barrier(const XcdBarrier& b) {
    asm volatile("s_waitcnt vmcnt(0)" ::: "memory");
    __syncthreads();
    if (threadIdx.x == 0) {
        unsigned* bar = b.bar;
        __builtin_amdgcn_s_waitcnt(0);
        unsigned nloc = b.st[0], nx = b.st[1];
        if (nloc == 0u) { xcd_barrier_complete(bar, b.x, nloc, nx); b.st[0] = nloc; b.st[1] = nx; }
        const unsigned old = xb_add(&bar[XB_XSUB(b.x)], 1u);
        const unsigned gen = old / nloc;
        if (old + 1u == (gen + 1u) * nloc) {
            __builtin_amdgcn_fence(__ATOMIC_RELEASE, "agent");
            asm volatile("s_waitcnt vmcnt(0)" ::: "memory");
            const unsigned og = xb_add(&bar[XB_TOP], 1u);
            const unsigned tg = og / nx;
            if (og + 1u == (tg + 1u) * nx) xb_add(&bar[XB_TOPGEN], 1u);
            else XB_SPIN(xb_ld(&bar[XB_TOPGEN]) == tg, bar);
            __builtin_amdgcn_fence(__ATOMIC_ACQUIRE, "agent");
            xb_add(&bar[XB_XGEN(b.x)], 1u);
            asm volatile("s_waitcnt vmcnt(0)" ::: "memory");
        } else {
            XB_SPIN(xb_ld(&bar[XB_XGEN(b.x)]) == gen, bar);
            __builtin_amdgcn_fence(__ATOMIC_ACQUIRE, "agent");
            asm volatile("s_waitcnt vmcnt(0)" ::: "memory");
        }
    }
    __syncthreads();
}

struct Args { const float* in[22]; float* out; unsigned char* ws; int ph_lo, ph_hi, li, pad; };
struct Frame {
    LAS unsigned char* lds;
    volatile LAS unsigned* MISC;
    gu32* ctl;
    unsigned char* ws;
    int wave, G, bx;
    float* out;
};
__device__ __forceinline__ const float* fin(const Frame& F, int i) {
    const unsigned long long v = ((const LAS unsigned long long*)(F.lds + MISC_OFF + 256))[i];
    const unsigned lo = __builtin_amdgcn_readfirstlane((unsigned)v), hi = __builtin_amdgcn_readfirstlane((unsigned)(v >> 32));
    return (const float*)(const GAS float*)(((unsigned long long)hi << 32) | lo);
}
enum { I_X = 0, I_P, I_GMIX, I_WIN, I_WPOOL, I_PSCALE, I_SINKS, I_RPE, I_WOUT, I_GFFN, I_WROUTER, I_RBIAS, I_WGATE, I_WUP, I_WDOWN, I_WSGATE, I_WSUP, I_WSDOWN, I_WPLEPROJ, I_GPLE, I_WPLEGATE, I_GFINAL };

__device__ __forceinline__ float wave_sum(float v) {
#pragma unroll
    for (int o = 1; o < 64; o <<= 1) v += __shfl_xor(v, o);
    return v;
}

using pg8::Unit;
struct EpiInProj {
    static constexpr int PERM = 1;
    unsigned char* ws;
    __device__ __forceinline__ void operator()(const f32x4 (&acc)[2][2][4][2], const Unit& u, int wr, int wc, int fr, int fq) const {
        const int row0 = u.pm * 256 + wr * 64 + fr;
        const size_t boff = WS_UBF + (size_t)(u.pn >= 4 ? 1 : 0) * (WS_QBF - WS_UBF) + (size_t)(u.pn >= 8 ? 1 : 0) * (WS_KV - WS_QBF);
        bf16* base = (bf16*)(ws + boff); const int ldc = (u.pn < 8) ? 1024 : 256; const int col0 = (u.pn & 3) * 256 + wc * 32 + 8 * fq;
#pragma unroll
        for (int ai = 0; ai < 2; ++ai)
#pragma unroll
            for (int m = 0; m < 4; ++m) { bf16* rowp = base + (size_t)(row0 + ai * 128 + m * 16) * ldc + col0;
#pragma unroll
                for (int bj = 0; bj < 2; ++bj) { const f32x4 v0 = acc[ai][bj][m][0], v1 = acc[ai][bj][m][1];
                    v4u w; w.x = pk2(v0[0], v0[1]); w.y = pk2(v0[2], v0[3]); w.z = pk2(v1[0], v1[1]); w.w = pk2(v1[2], v1[3]);
                    *(v4u*)(rowp + bj * 128) = w; } }
    }
};
struct EpiBf16Plain {
    static constexpr int PERM = 1;
    bf16* O; int ldc; int col_off; const float* scale;
    __device__ __forceinline__ void operator()(const f32x4 (&acc)[2][2][4][2], const Unit& u, int wr, int wc, int fr, int fq) const {
        const int row0 = u.pm * 256 + wr * 64 + fr, colt = u.pn * 256 + wc * 32 + 8 * fq;
        f32x4 sv[2][2];
#pragma unroll
        for (int bj = 0; bj < 2; ++bj)
#pragma unroll
            for (int n = 0; n < 2; ++n) sv[bj][n] = scale ? *(const f32x4*)(scale + col_off + colt + bj * 128 + 4 * n) : (f32x4){1.f, 1.f, 1.f, 1.f};
#pragma unroll
        for (int ai = 0; ai < 2; ++ai)
#pragma unroll
            for (int m = 0; m < 4; ++m) { bf16* rowp = O + (size_t)(row0 + ai * 128 + m * 16) * ldc + col_off + colt;
#pragma unroll
                for (int bj = 0; bj < 2; ++bj) { const f32x4 v0 = acc[ai][bj][m][0] * sv[bj][0], v1 = acc[ai][bj][m][1] * sv[bj][1];
                    v4u w; w.x = pk2(v0[0], v0[1]); w.y = pk2(v0[2], v0[3]); w.z = pk2(v1[0], v1[1]); w.w = pk2(v1[2], v1[3]);
                    *(v4u*)(rowp + bj * 128) = w; } }
    }
};
struct EpiResF32 {
    static constexpr int PERM = 0;
    const float* base; float* C;
    __device__ __forceinline__ void operator()(const f32x4 (&acc)[2][2][4][2], const Unit& u, int wr, int wc, int fr, int fq) const {
        const int row0 = u.pm * 256 + wr * 64 + fr, col0 = u.pn * 256 + wc * 32 + 4 * fq;
#pragma unroll
        for (int ai = 0; ai < 2; ++ai)
#pragma unroll
            for (int mp = 0; mp < 2; ++mp) { f32x4 xb[2][2][2];
#pragma unroll
                for (int mm = 0; mm < 2; ++mm) { const size_t ro = (size_t)(row0 + ai * 128 + (2 * mp + mm) * 16) * D + col0;
#pragma unroll
                    for (int bj = 0; bj < 2; ++bj)
#pragma unroll
                        for (int n = 0; n < 2; ++n) xb[mm][bj][n] = *(const f32x4*)(base + ro + bj * 128 + n * 16); }
#pragma unroll
                for (int mm = 0; mm < 2; ++mm) { const size_t ro = (size_t)(row0 + ai * 128 + (2 * mp + mm) * 16) * D + col0;
#pragma unroll
                    for (int bj = 0; bj < 2; ++bj)
#pragma unroll
                        for (int n = 0; n < 2; ++n) *(f32x4*)(C + ro + bj * 128 + n * 16) = xb[mm][bj][n] + acc[ai][bj][2 * mp + mm][n]; } }
    }
};
__device__ __forceinline__ float sigmoid_f(float v) { return __builtin_amdgcn_rcpf(1.0f + __expf(-v)); }
__device__ __forceinline__ unsigned pk4_fp8(float a, float b, float c, float d) { int w = 0; w = __builtin_amdgcn_cvt_pk_fp8_f32(a, b, w, false); w = __builtin_amdgcn_cvt_pk_fp8_f32(c, d, w, true); return (unsigned)w; }
typedef float f32x2_ __attribute__((ext_vector_type(2)));
__device__ __forceinline__ void fp8x4_to_f32(unsigned w, float (&o)[4]) { const f32x2_ lo = __builtin_amdgcn_cvt_pk_f32_fp8((int)w, false), hi = __builtin_amdgcn_cvt_pk_f32_fp8((int)w, true); o[0] = lo[0]; o[1] = lo[1]; o[2] = hi[0]; o[3] = hi[1]; }
struct EpiGateUp {
    static constexpr int PERM = 1;
    unsigned char* ACT;
    __device__ __forceinline__ void operator()(const f32x4 (&acc)[2][2][4][2], const Unit& u, int wr, int wc, int fr, int fq) const {
        const int row0 = u.pm * 256 + wr * 64 + fr, col0 = (u.pn & 3) * 128 + wc * 32 + 8 * fq;
        constexpr float IS = 1.0f / SW1;
#pragma unroll
        for (int ai = 0; ai < 2; ++ai) { if (ai == 1 && u.half) break;
#pragma unroll
            for (int m = 0; m < 4; ++m) { float o[8];
#pragma unroll
                for (int n = 0; n < 2; ++n)
#pragma unroll
                    for (int j = 0; j < 4; ++j) { const float gte = acc[ai][0][m][n][j] * IS, up = acc[ai][1][m][n][j] * (IS * SA); o[4 * n + j] = gte * sigmoid_f(gte) * up; }
                v2u w; w.x = pk4_fp8(o[0], o[1], o[2], o[3]); w.y = pk4_fp8(o[4], o[5], o[6], o[7]);
                *(v2u*)(ACT + (size_t)(row0 + ai * 128 + m * 16) * EFF + col0) = w; } }
    }
};
struct EpiDown {
    static constexpr int PERM = 2;
    unsigned char* Y;
    __device__ __forceinline__ void operator()(const f32x4 (&acc)[2][2][4][2], const Unit& u, int wr, int wc, int fr, int fq) const {
        const int row0 = u.pm * 256 + wr * 64 + fr, col0 = (u.pn & 7) * 256 + wc * 64 + 16 * fq;
        constexpr float IS = SY / (SA * SW2);
#pragma unroll
        for (int ai = 0; ai < 2; ++ai) { if (ai == 1 && u.half) break;
#pragma unroll
            for (int m = 0; m < 4; ++m) { const f32x4 v0 = acc[ai][0][m][0] * IS, v1 = acc[ai][0][m][1] * IS, v2 = acc[ai][1][m][0] * IS, v3 = acc[ai][1][m][1] * IS;
                v4u w; w.x = pk4_fp8(v0[0], v0[1], v0[2], v0[3]); w.y = pk4_fp8(v1[0], v1[1], v1[2], v1[3]); w.z = pk4_fp8(v2[0], v2[1], v2[2], v2[3]); w.w = pk4_fp8(v3[0], v3[1], v3[2], v3[3]);
                *(v4u*)(Y + (size_t)(row0 + ai * 128 + m * 16) * D + col0) = w; } }
    }
};
struct EpiBf16Mul {
    static constexpr int PERM = 1;
    bf16* O; float mul;
    __device__ __forceinline__ void operator()(const f32x4 (&acc)[2][2][4][2], const Unit& u, int wr, int wc, int fr, int fq) const {
        const int row0 = u.pm * 256 + wr * 64 + fr, colt = u.pn * 256 + wc * 32 + 8 * fq;
#pragma unroll
        for (int ai = 0; ai < 2; ++ai)
#pragma unroll
            for (int m = 0; m < 4; ++m) { bf16* rowp = O + (size_t)(row0 + ai * 128 + m * 16) * D + colt;
#pragma unroll
                for (int bj = 0; bj < 2; ++bj) { const f32x4 v0 = acc[ai][bj][m][0] * mul, v1 = acc[ai][bj][m][1] * mul;
                    v4u w; w.x = pk2(v0[0], v0[1]); w.y = pk2(v0[2], v0[3]); w.z = pk2(v1[0], v1[1]); w.w = pk2(v1[2], v1[3]);
                    *(v4u*)(rowp + bj * 128) = w; } }
    }
};
struct MoeOrder {
    static constexpr bool HALVES = true;
    const LAS int* tab; const int* toklist; int x, r, npn, stride;
    __device__ __forceinline__ bool next(int i, Unit& u) const {
        const int L = i * stride + r; const int tl = L / npn, pn = L - tl * npn;
        const int nf = tab[TB_XF + 8], ns = tab[TB_SHN], nh = tab[TB_XH + 8];
        if (tl >= nf + ns + nh) return false;
        int e, lt, row0, half = 0;
        if (tl < nf) { int s = 0;
#pragma unroll
            for (int q = 1; q <= 7; ++q) s += (tl >= tab[TB_XF + q]) ? 1 : 0;
            lt = tl - tab[TB_XF + s]; e = x + 8 * s; row0 = tab[TB_PAD + e] + 256 * lt; }
        else if (tl < nf + ns) { lt = tab[TB_SH0] + (tl - nf); e = NE; row0 = SH_ROW0 + 256 * lt; }
        else { const int hi = tl - nf - ns; int s = 0;
#pragma unroll
            for (int q = 1; q <= 7; ++q) s += (hi >= tab[TB_XH + q]) ? 1 : 0;
            e = x + 8 * s; lt = tab[TB_XF + s + 1] - tab[TB_XF + s]; row0 = tab[TB_PAD + e] + 256 * lt; half = 1; }
        u.pm = __builtin_amdgcn_readfirstlane(row0 >> 8); u.pn = __builtin_amdgcn_readfirstlane(e * npn + pn); u.e = __builtin_amdgcn_readfirstlane(e); u.lt = __builtin_amdgcn_readfirstlane(lt);
        u.half = __builtin_amdgcn_readfirstlane(half); return true;
    }
    __device__ __forceinline__ int arow(const Unit& u, int r_) const {
        const int lr = u.lt * 256 + r_;
        const int ee = (u.e < NE) ? u.e : 0;
        const int tk = toklist[(size_t)ee * T + (lr < T - 1 ? lr : T - 1)];
        return (u.e == NE) ? lr : ((lr < tab[TB_CNT + ee]) ? tk : 0);
    }
};
__device__ __forceinline__ void moe_tables(Frame& F) {
    const int LANE_ = pg8::lane_id(), TID_ = F.wave * 64 + LANE_; (void)TID_;
    LAS int* tab = (LAS int*)(F.lds + TAB_OFF);
    const int x = F.bx & 7;
    if (F.wave == 0) {
        const int e = LANE_, c = (int)__hip_atomic_load(F.ctl + CW_CNT + 32 * e, RLX_AGENT), nt = (c + 255) >> 8;
        const int hf = (nt > 0 && (c - ((nt - 1) << 8)) <= 128) ? 1 : 0, fl = nt - hf;
        tab[TB_CNT + e] = c; if (e == 0) tab[TB_CNT + NE] = T;
        int inc = nt << 8;
#pragma unroll
        for (int o = 1; o < 64; o <<= 1) { const int v = __shfl_up(inc, o); inc += (e >= o) ? v : 0; }
        tab[TB_PAD + e] = inc - (nt << 8); if (e == 63) tab[TB_PAD + NE] = inc;
        int ld = 2 * fl + hf;
        ld += __shfl_xor(ld, 8); ld += __shfl_xor(ld, 16); ld += __shfl_xor(ld, 32);
        int cf = fl, ch = hf;
#pragma unroll
        for (int o = 8; o < 64; o <<= 1) { const int vf = __shfl_up(cf, o), vh = __shfl_up(ch, o); cf += (e >= o) ? vf : 0; ch += (e >= o) ? vh : 0; }
        if ((e & 7) == x) { tab[TB_XF + (e >> 3) + 1] = cf; tab[TB_XH + (e >> 3) + 1] = ch; }
        if (e == 0) { tab[TB_XF] = 0; tab[TB_XH] = 0; }
        int load[8], nsh[8];
#pragma unroll
        for (int l = 0; l < 8; ++l) { load[l] = __shfl(ld, l); nsh[l] = 0; }
        for (int j = 0; j < 32; ++j) { int best = 0, bl = load[0];
#pragma unroll
            for (int l = 1; l < 8; ++l) { const bool lt_ = load[l] < bl; best = lt_ ? l : best; bl = lt_ ? load[l] : bl; }
#pragma unroll
            for (int l = 0; l < 8; ++l) { nsh[l] += (l == best) ? 1 : 0; load[l] += (l == best) ? 2 : 0; } }
        int s0 = 0, sn = 0;
#pragma unroll
        for (int l = 0; l < 8; ++l) { s0 += (l < x) ? nsh[l] : 0; sn = (l == x) ? nsh[l] : sn; }
        if (e == 0) { tab[TB_SH0] = s0; tab[TB_SHN] = sn; }
    }
    __syncthreads();
}
struct ConvJob { const float* src; bf16* dst; int N, ldk, mode, item; };
struct ConvJob8 { const float* src; unsigned char* dst; int N, ldk, mode, item; float scale; };
__device__ __forceinline__ void conv8_load(const ConvJob8& j, int lane, f32x4 (&v)[16]) {
    const int nblk = j.N >> 5, kb = j.item / nblk, nb = j.item - kb * nblk, k0 = 128 * kb, n0 = 32 * nb;
    const float* src = j.src + (size_t)(k0 + 16 * (lane >> 3)) * j.N + n0 + 4 * (lane & 7);
#pragma unroll
    for (int i = 0; i < 16; ++i) v[i] = __builtin_nontemporal_load((const f32x4*)(src + (size_t)i * j.N));
}
__device__ __forceinline__ void conv8_store(const ConvJob8& j, int lane, const f32x4 (&v)[16]) {
    const int nblk = j.N >> 5, kb = j.item / nblk, nb = j.item - kb * nblk, k0 = 128 * kb, n0 = 32 * nb; const float scale = j.scale;
#pragma unroll
    for (int q = 0; q < 4; ++q) { const int n = n0 + 4 * (lane & 7) + q; int dr = n;
        if (j.mode == 5) dr = ((n >> 7) << 8) + (n & 127); else if (j.mode == 6) dr = ((n >> 7) << 8) + 128 + (n & 127);
        v4u o; o.x = pk4_fp8(v[0][q] * scale, v[1][q] * scale, v[2][q] * scale, v[3][q] * scale); o.y = pk4_fp8(v[4][q] * scale, v[5][q] * scale, v[6][q] * scale, v[7][q] * scale);
        o.z = pk4_fp8(v[8][q] * scale, v[9][q] * scale, v[10][q] * scale, v[11][q] * scale); o.w = pk4_fp8(v[12][q] * scale, v[13][q] * scale, v[14][q] * scale, v[15][q] * scale);
        __builtin_nontemporal_store(o, (v4u*)(j.dst + (size_t)dr * j.ldk + k0 + 16 * (lane >> 3))); }
}
__device__ __forceinline__ void conv_load(const ConvJob& j, int lane, f32x4 (&v)[8]) {
    const int nblk = j.N >> 5, kb = j.item / nblk, nb = j.item - kb * nblk, k0 = 64 * kb, n0 = 32 * nb;
    const float* src = j.src + (size_t)(k0 + 8 * (lane >> 3)) * j.N + n0 + 4 * (lane & 7);
#pragma unroll
    for (int i = 0; i < 8; ++i) v[i] = __builtin_nontemporal_load((const f32x4*)(src + (size_t)i * j.N));
}
__device__ __forceinline__ void conv_store(const ConvJob& j, int lane, const f32x4 (&v)[8]) {
    const int nblk = j.N >> 5, kb = j.item / nblk, nb = j.item - kb * nblk, k0 = 64 * kb, n0 = 32 * nb;
#pragma unroll
    for (int q = 0; q < 4; ++q) { const int n = n0 + 4 * (lane & 7) + q; int dr = n;
        if (j.mode == 1) dr = ((n >> 7) << 8) + (n & 127); else if (j.mode == 2) dr = ((n >> 7) << 8) + 128 + (n & 127);
        v4u o; o.x = pk2(v[0][q], v[1][q]); o.y = pk2(v[2][q], v[3][q]); o.z = pk2(v[4][q], v[5][q]); o.w = pk2(v[6][q], v[7][q]);
        *(v4u*)(j.dst + (size_t)dr * j.ldk + k0 + 8 * (lane >> 3)) = o; }
}
__device__ __forceinline__ void rms_row_to_bf16(const float* xrow, const float* g, bf16* orow, int lane) {
    f32x4 v[8]; float s = 0.f;
#pragma unroll
    for (int j = 0; j < 4; ++j) { v[2 * j] = *(const f32x4*)(xrow + 512 * j + 8 * lane); v[2 * j + 1] = *(const f32x4*)(xrow + 512 * j + 8 * lane + 4); }
#pragma unroll
    for (int j = 0; j < 8; ++j) s += (v[j][0] * v[j][0] + v[j][1] * v[j][1]) + (v[j][2] * v[j][2] + v[j][3] * v[j][3]);
    const float rstd = 1.0f / sqrtf(wave_sum(s) * (1.0f / D) + EPS);
#pragma unroll
    for (int j = 0; j < 4; ++j) { const f32x4 g0 = *(const f32x4*)(g + 512 * j + 8 * lane), g1 = *(const f32x4*)(g + 512 * j + 8 * lane + 4);
        const f32x4 a = v[2 * j] * rstd * g0, b = v[2 * j + 1] * rstd * g1;
        v4u o; o.x = pk2(a[0], a[1]); o.y = pk2(a[2], a[3]); o.z = pk2(b[0], b[1]); o.w = pk2(b[2], b[3]);
        *(v4u*)(orow + 512 * j + 8 * lane) = o; }
}
constexpr int CV_G1 = (D / 128) * (EFF / 32), CV_D1 = (EFF / 128) * (D / 32), CV_G = 65 * CV_G1, CV_DN = 65 * CV_D1, CV_PG = (D / 128) * (D / 32), CV_TOTAL = 2 * CV_G + CV_DN + CV_PG;
constexpr int CONV_B = 896 * 16, CONV_C = 1024 * 20, CONV_A = CV_TOTAL - CONV_B - CONV_C;
__device__ __forceinline__ ConvJob8 conv8_decode(Frame& F, int it) {
    unsigned char* WGU8 = F.ws + WS_WGU; unsigned char* WDN8 = F.ws + WS_WD;
    int r = it;
    if (r < CV_G) { const int e = r / CV_G1, li = r - e * CV_G1; const float* src = (e < NE) ? fin(F, I_WGATE) + (size_t)e * D * EFF : fin(F, I_WSGATE);
        return ConvJob8{src, WGU8 + (size_t)e * 1024 * D, EFF, D, 5, li, SW1}; } r -= CV_G;
    if (r < CV_G) { const int e = r / CV_G1, li = r - e * CV_G1; const float* src = (e < NE) ? fin(F, I_WUP) + (size_t)e * D * EFF : fin(F, I_WSUP);
        return ConvJob8{src, WGU8 + (size_t)e * 1024 * D, EFF, D, 6, li, SW1}; } r -= CV_G;
    if (r < CV_DN) { const int e = r / CV_D1, li = r - e * CV_D1; const float* src = (e < NE) ? fin(F, I_WDOWN) + (size_t)e * EFF * D : fin(F, I_WSDOWN);
        return ConvJob8{src, WDN8 + (size_t)e * D * EFF, D, EFF, 4, li, SW2}; } r -= CV_DN;
    return ConvJob8{fin(F, I_WPLEGATE), F.ws + WS_WPG, D, D, 4, r, SW3};
}
__device__ __forceinline__ void conv_fp8_items(Frame& F, int lo, int hi, int rank, int nranks) {
    const int LANE_ = pg8::lane_id();
    int it0 = lo + rank; if (it0 >= hi) return;
    f32x4 va[16], vb[16];
    ConvJob8 j0 = conv8_decode(F, it0), j1 = j0; conv8_load(j0, LANE_, va);
    for (;;) {
        const int it1 = it0 + nranks; const bool has1 = it1 < hi;
        if (has1) { j1 = conv8_decode(F, it1); conv8_load(j1, LANE_, vb); }
        conv8_store(j0, LANE_, va);
        if (!has1) break;
        it0 = it1 + nranks; const bool has0 = it0 < hi;
        if (has0) { j0 = conv8_decode(F, it0); conv8_load(j0, LANE_, va); }
        conv8_store(j1, LANE_, vb);
        if (!has0) break;
    }
}
__device__ __forceinline__ void p0_prologue(Frame& F) {
    const int LANE_ = pg8::lane_id(), TID_ = F.wave * 64 + LANE_; (void)TID_;
    const int gw = F.bx * NWAVES + F.wave, NGW = F.G * NWAVES;
    bf16* WIN = (bf16*)(F.ws + WS_WIN); bf16* WPOOL = (bf16*)(F.ws + WS_WPOOL); bf16* WOUT = (bf16*)(F.ws + WS_WOUT); bf16* WPP = (bf16*)(F.ws + WS_WPP);
    constexpr int I_IN = (D / 64) * (INW / 32), I_PL = 4 * (256 / 64) * (256 / 32), I_OUT = (D / 64) * (D / 32), I_PP = (PLE / 64) * (D / 32), I_PG = (D / 64) * (D / 32);
    constexpr int I_SMALL = I_IN + I_PL + I_OUT + I_PP; (void)I_PG;
    auto decode = [&](int it) -> ConvJob {
        int r = it;
        if (r < I_IN) return ConvJob{fin(F, I_WIN), WIN, INW, D, 0, r}; r -= I_IN;
        if (r < I_PL) { const int gq = r >> 5; return ConvJob{fin(F, I_WPOOL) + (size_t)gq * 65536, WPOOL + (size_t)gq * 65536, 256, 256, 0, r & 31}; } r -= I_PL;
        if (r < I_OUT) return ConvJob{fin(F, I_WOUT), WOUT, D, D, 0, r}; r -= I_OUT;
        return ConvJob{fin(F, I_WPLEPROJ), WPP, D, PLE, 0, r};
    };
    for (int it = gw; it < I_SMALL; it += 2 * NGW) {
        const ConvJob j0 = decode(it); const bool two = (it + NGW) < I_SMALL; const ConvJob j1 = decode(two ? it + NGW : it);
        f32x4 v0[8], v1[8];
        conv_load(j0, LANE_, v0); conv_load(j1, LANE_, v1);
        conv_store(j0, LANE_, v0); if (two) conv_store(j1, LANE_, v1);
    }
    conv_fp8_items(F, 0, CONV_A, gw, NGW);
    { const float* WR = fin(F, I_WROUTER); bf16* WH = (bf16*)(F.ws + WS_WRT); bf16* WL = WH + (size_t)NE * D;
      for (int i = gw * 64 + LANE_; i < NE * (D / 8); i += NGW * 64) { const int e = i & 63, k0 = (i >> 6) * 8; float x[8]; unsigned hh[8], ll[8];
#pragma unroll
          for (int j = 0; j < 8; ++j) x[j] = WR[(size_t)(k0 + j) * NE + e];
#pragma unroll
          for (int j = 0; j < 8; ++j) { hh[j] = pk2(x[j], 0.f) & 0xffffu; ll[j] = pk2(x[j] - bf_lo(hh[j]), 0.f) & 0xffffu; }
          v4u oh, ol; oh.x = hh[0] | (hh[1] << 16); oh.y = hh[2] | (hh[3] << 16); oh.z = hh[4] | (hh[5] << 16); oh.w = hh[6] | (hh[7] << 16);
          ol.x = ll[0] | (ll[1] << 16); ol.y = ll[2] | (ll[3] << 16); ol.z = ll[4] | (ll[5] << 16); ol.w = ll[6] | (ll[7] << 16);
          *(v4u*)(WH + (size_t)e * D + k0) = oh; *(v4u*)(WL + (size_t)e * D + k0) = ol; } }
    { const float* P = fin(F, I_P); bf16* PB = (bf16*)(F.ws + WS_PBF);
      for (int i = gw * 64 + LANE_; i < T * PLE / 8; i += NGW * 64) { const f32x4 a = *(const f32x4*)(P + (size_t)i * 8), b = *(const f32x4*)(P + (size_t)i * 8 + 4);
          v4u o; o.x = pk2(a[0], a[1]); o.y = pk2(a[2], a[3]); o.z = pk2(b[0], b[1]); o.w = pk2(b[2], b[3]); *(v4u*)(PB + (size_t)i * 8) = o; } }
    bf16* ABF = (bf16*)(F.ws + WS_ABF);
    for (int m = gw; m < T; m += NGW) rms_row_to_bf16(fin(F, I_X) + (size_t)m * D, fin(F, I_GMIX), ABF + (size_t)m * D, LANE_);
}

__device__ __forceinline__ int t5_bucket(int n) {
    if (n < 16) return n;
    const int large = 16 + (int)(logf((float)n * (1.0f / 16.0f)) / logf(8.0f) * 16.0f);
    return large < 31 ? large : 31;
}
constexpr int VT_LD = 216, VT_KEYS = 208, KT_LD = 72;
constexpr int ATT_KT_OFF = 0, ATT_VT_OFF = VT_KEYS * KT_LD * 2;
__device__ __forceinline__ void attn_task(Frame& F, const LAS float* btab, const LAS bf16* ktl, const LAS bf16* vtl, int b, int kvh, int hg, int qt, const bf16x8 (&qf)[2]) {
    const int LANE_ = pg8::lane_id();
    bf16* MIX = (bf16*)(F.ws + WS_MIX);
    const int lane = LANE_, qi = lane & 15, g = lane >> 4, h = kvh * 8 + hg;
    const int q0 = qt * 16, tok0 = b * SEQ, kl0 = 16 * (qt & 3);
    f32x4 s[5][2];
#pragma unroll
    for (int kb = 0; kb < 5; ++kb)
#pragma unroll
        for (int t = 0; t < 2; ++t) {
            const LAS bf16* kp = ktl + (kl0 + 32 * kb + 16 * t + qi) * KT_LD + 8 * g;
            const bf16x8 k0f = *(const LAS bf16x8*)(kp), k1f = *(const LAS bf16x8*)(kp + 32);
            f32x4 a = (f32x4){0.f, 0.f, 0.f, 0.f};
            a = __builtin_amdgcn_mfma_f32_16x16x32_bf16(k0f, qf[0], a, 0, 0, 0);
            a = __builtin_amdgcn_mfma_f32_16x16x32_bf16(k1f, qf[1], a, 0, 0, 0);
            s[kb][t] = a;
        }
    const float sink = fin(F, I_SINKS)[h];
    const LAS float* bt = btab + hg * 128;
    float mx = sink;
#pragma unroll
    for (int kb = 0; kb < 5; ++kb)
#pragma unroll
        for (int t = 0; t < 2; ++t)
#pragma unroll
            for (int r = 0; r < 4; ++r) {
                const int key = q0 - 128 + 32 * kb + 16 * t + 4 * g + r, dist = q0 + qi - key;
                const bool valid = (dist >= 0) && (dist < 128) && (key >= 0);
                const float lg = valid ? s[kb][t][r] * 0.125f + bt[dist & 127] : -3.0e38f;
                s[kb][t][r] = lg; mx = fmaxf(mx, lg);
            }
    mx = fmaxf(mx, __shfl_xor(mx, 16)); mx = fmaxf(mx, __shfl_xor(mx, 32));
    float sum = 0.f;
#pragma unroll
    for (int kb = 0; kb < 5; ++kb)
#pragma unroll
        for (int t = 0; t < 2; ++t)
#pragma unroll
            for (int r = 0; r < 4; ++r) { const float lg = s[kb][t][r]; const float p = (lg > -1.0e38f) ? __expf(lg - mx) : 0.f; s[kb][t][r] = p; sum += p; }
    sum += __shfl_xor(sum, 16); sum += __shfl_xor(sum, 32);
    const float inv = 1.0f / (sum + __expf(sink - mx));
    f32x4 o[4];
#pragma unroll
    for (int dt = 0; dt < 4; ++dt) o[dt] = (f32x4){0.f, 0.f, 0.f, 0.f};
#pragma unroll
    for (int kb = 0; kb < 5; ++kb) {
        v4u pw; pw.x = pk2(s[kb][0][0], s[kb][0][1]); pw.y = pk2(s[kb][0][2], s[kb][0][3]); pw.z = pk2(s[kb][1][0], s[kb][1][1]); pw.w = pk2(s[kb][1][2], s[kb][1][3]);
        const bf16x8 pf = __builtin_bit_cast(bf16x8, pw);
        const int kkl = kl0 + 32 * kb + 4 * g;
#pragma unroll
        for (int dt = 0; dt < 4; ++dt) {
            const LAS bf16* vp = vtl + (16 * dt + qi) * VT_LD + kkl;
            const v2u lo = *(const LAS v2u*)(vp), hi = *(const LAS v2u*)(vp + 16);
            const v4u vw = (v4u){lo.x, lo.y, hi.x, hi.y};
            o[dt] = __builtin_amdgcn_mfma_f32_16x16x32_bf16(__builtin_bit_cast(bf16x8, vw), pf, o[dt], 0, 0, 0);
        }
    }
    bf16* op = MIX + (size_t)(tok0 + q0 + qi) * D + POOLW + h * 64 + 4 * g;
#pragma unroll
    for (int dt = 0; dt < 4; ++dt) { v2u w; w.x = pk2(o[dt][0] * inv, o[dt][1] * inv); w.y = pk2(o[dt][2] * inv, o[dt][3] * inv); *(v2u*)(op + 16 * dt) = w; }
}
__device__ __forceinline__ void attn_block(Frame& F, int blk) {
    const int TID_ = F.wave * 64 + pg8::lane_id();
    LAS float* btab = (LAS float*)(F.lds + TAB_OFF + 2048);
    LAS bf16* ktl = (LAS bf16*)(F.lds + RING_OFF + ATT_KT_OFF); LAS bf16* vtl = (LAS bf16*)(F.lds + RING_OFF + ATT_VT_OFF);
    const int b = blk >> 6, kvh = (blk >> 5) & 1, qg = blk & 31;
    const bf16* Q = (const bf16*)(F.ws + WS_QBF); const bf16* KVp = (const bf16*)(F.ws + WS_KV);
    bf16x8 qf[4][2];
    { const int lane = TID_ & 63, qi = lane & 15, g = lane >> 4, h = kvh * 8 + F.wave;
#pragma unroll
      for (int i = 0; i < 4; ++i)
#pragma unroll
          for (int ks = 0; ks < 2; ++ks) qf[i][ks] = *(const bf16x8*)(Q + (size_t)(b * SEQ + 64 * qg + 16 * i + qi) * 1024 + h * 64 + 32 * ks + 8 * g); }
    __syncthreads();
    for (int i = TID_; i < 1024; i += NWAVES * 64) { const int hg = i >> 7, dist = i & 127; btab[i] = fin(F, I_RPE)[t5_bucket(dist) * NH + kvh * 8 + hg]; }
    for (int idx = TID_; idx < VT_KEYS * 8; idx += NWAVES * 64) { const int kl = idx >> 3, c = idx & 7, key = 64 * qg - 128 + kl;
        v4u kv = (v4u){0u, 0u, 0u, 0u}, v = (v4u){0u, 0u, 0u, 0u};
        if (key >= 0 && key < SEQ) { const bf16* rp = KVp + (size_t)(b * SEQ + key) * (2 * KVW) + kvh * 64 + 8 * c; kv = *(const v4u*)(rp); v = *(const v4u*)(rp + KVW); }
        *(LAS v4u*)(ktl + kl * KT_LD + 8 * c) = kv;
        LAS bf16* d0 = vtl + (8 * c) * VT_LD + kl;
        d0[0 * VT_LD] = (bf16)(v.x & 0xffffu); d0[1 * VT_LD] = (bf16)(v.x >> 16); d0[2 * VT_LD] = (bf16)(v.y & 0xffffu); d0[3 * VT_LD] = (bf16)(v.y >> 16);
        d0[4 * VT_LD] = (bf16)(v.z & 0xffffu); d0[5 * VT_LD] = (bf16)(v.z >> 16); d0[6 * VT_LD] = (bf16)(v.w & 0xffffu); d0[7 * VT_LD] = (bf16)(v.w >> 16); }
    __syncthreads();
#pragma unroll
    for (int i = 0; i < 4; ++i) attn_task(F, btab, ktl, vtl, b, kvh, F.wave, 4 * qg + i, qf[i]);
}
__device__ __forceinline__ void pool_task(Frame& F, int mt, int gq) {
    const int LANE_ = pg8::lane_id(), TID_ = F.wave * 64 + LANE_;
    const bf16* U = (const bf16*)(F.ws + WS_UBF); bf16* PO = (bf16*)(F.ws + WS_POOLED);
    LAS v4u* UL = (LAS v4u*)(F.lds + RING_OFF);
    const int w = 2 << gq;
    for (int hh = 0; hh < 2; ++hh) {
        const int tbase = mt * 256 + 128 * hh, pos0 = tbase & (SEQ - 1);
        __syncthreads();
        for (int idx = TID_; idx < 143 * 32; idx += NWAVES * 64) { const int r = idx >> 5, c = idx & 31;
            v4u x = (v4u){0u, 0u, 0u, 0u}; if (pos0 - 15 + r >= 0) x = *(const v4u*)(U + (size_t)(tbase - 15 + r) * POOLW + gq * 256 + 8 * c);
            UL[idx] = x; }
        __syncthreads();
        const int c = TID_ & 31, i0 = (TID_ >> 5) * 8;
        float run[8];
#pragma unroll
        for (int q = 0; q < 8; ++q) run[q] = 0.f;
        for (int j = 1; j < w; ++j) { const v4u x = UL[(15 + i0 - j) * 32 + c];
            run[0] += bf_lo(x.x); run[1] += bf_hi(x.x); run[2] += bf_lo(x.y); run[3] += bf_hi(x.y); run[4] += bf_lo(x.z); run[5] += bf_hi(x.z); run[6] += bf_lo(x.w); run[7] += bf_hi(x.w); }
#pragma unroll
        for (int i = 0; i < 8; ++i) {
            const int pos = pos0 + i0 + i; const v4u x = UL[(15 + i0 + i) * 32 + c], y = UL[(15 + i0 + i - w + 1) * 32 + c];
            const float uv[8] = {bf_lo(x.x), bf_hi(x.x), bf_lo(x.y), bf_hi(x.y), bf_lo(x.z), bf_hi(x.z), bf_lo(x.w), bf_hi(x.w)};
            const float ic = 1.0f / (float)((pos + 1) < w ? (pos + 1) : w);
            float o[8];
#pragma unroll
            for (int q = 0; q < 8; ++q) { run[q] += uv[q]; o[q] = run[q] * ic - uv[q]; }
            v4u ow; ow.x = pk2(o[0], o[1]); ow.y = pk2(o[2], o[3]); ow.z = pk2(o[4], o[5]); ow.w = pk2(o[6], o[7]);
            *(v4u*)(PO + (size_t)(tbase + i0 + i) * POOLW + gq * 256 + 8 * c) = ow;
            run[0] -= bf_lo(y.x); run[1] -= bf_hi(y.x); run[2] -= bf_lo(y.y); run[3] -= bf_hi(y.y); run[4] -= bf_lo(y.z); run[5] -= bf_hi(y.z); run[6] -= bf_lo(y.w); run[7] -= bf_hi(y.w);
        }
    }
    VM_WAIT(); __syncthreads();
    pg8::Gemm g{(const bf16*)PO + gq * 256, (const bf16*)(F.ws + WS_WPOOL) + (size_t)gq * 65536, POOLW, 256, 256};
    pg8::SingleOrder S{mt, 0};
    EpiBf16Plain E{(bf16*)(F.ws + WS_MIX), D, gq * 256, fin(F, I_PSCALE)};
    pg8::gemm_phase<EpiBf16Plain, pg8::SingleOrder, false>(F.lds + RING_OFF, g, S, E, F.wave);
}

constexpr int XS_STRIDE = 2052;
constexpr int P4_XS = 0, P4_PART = 16 * XS_STRIDE * 4, P4_SELE = P4_PART + 4 * 16 * 64 * 4, P4_SELW = P4_SELE + 32 * 8 * 4, P4_SELL = P4_SELW + 32 * 8 * 4, P4_HIST = P4_SELL + 32 * 8 * 4, P4_BASE = P4_HIST + 256, P4_END = P4_BASE + 256;
static_assert(P4_END <= MISC_OFF, "P4 LDS map");
__device__ __forceinline__ void p4_route(Frame& F) {
    const int LANE_ = pg8::lane_id(), TID_ = F.wave * 64 + LANE_; (void)TID_;
    LAS float* XS = (LAS float*)(F.lds + P4_XS); LAS float* PART = (LAS float*)(F.lds + P4_PART);
    LAS int* SELE = (LAS int*)(F.lds + P4_SELE); LAS float* SELW = (LAS float*)(F.lds + P4_SELW); LAS int* SELL = (LAS int*)(F.lds + P4_SELL);
    LAS int* HIST = (LAS int*)(F.lds + P4_HIST); LAS int* BASE = (LAS int*)(F.lds + P4_BASE);
    const float* H1 = F.out; unsigned char* XN = F.ws + WS_XN; const float* gf = fin(F, I_GFFN); const float* rb = fin(F, I_RBIAS);
    const bf16* WH = (const bf16*)(F.ws + WS_WRT); const bf16* WL = WH + (size_t)NE * D;
    const int lane = LANE_, wave = F.wave;
    if (TID_ < 64) HIST[TID_] = 0;
    for (int tile = F.bx; tile < T / 32; tile += F.G) {
    f32x4 gv[8];
#pragma unroll
    for (int j = 0; j < 4; ++j) { gv[2 * j] = *(const f32x4*)(gf + 512 * j + 8 * lane); gv[2 * j + 1] = *(const f32x4*)(gf + 512 * j + 8 * lane + 4); }
#pragma unroll 1
    for (int pass = 0; pass < 2; ++pass) {
        { f32x4 xr[2][8];
#pragma unroll
          for (int q = 0; q < 2; ++q) { const float* xrow = H1 + (size_t)(tile * 32 + 16 * pass + 2 * wave + q) * D;
#pragma unroll
              for (int j = 0; j < 4; ++j) { xr[q][2 * j] = *(const f32x4*)(xrow + 512 * j + 8 * lane); xr[q][2 * j + 1] = *(const f32x4*)(xrow + 512 * j + 8 * lane + 4); } }
#pragma unroll
          for (int q = 0; q < 2; ++q) { const int tl = 2 * wave + q; float s = 0.f;
#pragma unroll
              for (int j = 0; j < 8; ++j) { const f32x4 v = xr[q][j]; s += (v[0] * v[0] + v[1] * v[1]) + (v[2] * v[2] + v[3] * v[3]); }
              const float rstd = 1.0f / sqrtf(wave_sum(s) * (1.0f / D) + EPS);
#pragma unroll
              for (int j = 0; j < 4; ++j) { const f32x4 a = xr[q][2 * j] * rstd * gv[2 * j], b = xr[q][2 * j + 1] * rstd * gv[2 * j + 1];
                  *(LAS f32x4*)(XS + tl * XS_STRIDE + 512 * j + 8 * lane) = a; *(LAS f32x4*)(XS + tl * XS_STRIDE + 512 * j + 8 * lane + 4) = b;
                  v2u o; o.x = pk4_fp8(a[0], a[1], a[2], a[3]); o.y = pk4_fp8(b[0], b[1], b[2], b[3]);
                  *(v2u*)(XN + (size_t)(tile * 32 + 16 * pass + tl) * D + 512 * j + 8 * lane) = o; } } }
        __syncthreads();
        {
            const int ti = lane & 15, kk = lane >> 4;
            f32x4 acc[4];
#pragma unroll
            for (int et = 0; et < 4; ++et) acc[et] = (f32x4){0.f, 0.f, 0.f, 0.f};
#pragma unroll 2
            for (int st = 0; st < 8; ++st) {
                const int k0 = 256 * wave + 32 * st + 8 * kk;
                const f32x4 xa = *(const LAS f32x4*)(XS + ti * XS_STRIDE + k0), xb = *(const LAS f32x4*)(XS + ti * XS_STRIDE + k0 + 4);
                v4u hw, lw;
                hw.x = pk2(xa[0], xa[1]); hw.y = pk2(xa[2], xa[3]); hw.z = pk2(xb[0], xb[1]); hw.w = pk2(xb[2], xb[3]);
                lw.x = pk2(xa[0] - bf_lo(hw.x), xa[1] - bf_hi(hw.x)); lw.y = pk2(xa[2] - bf_lo(hw.y), xa[3] - bf_hi(hw.y)); lw.z = pk2(xb[0] - bf_lo(hw.z), xb[1] - bf_hi(hw.z)); lw.w = pk2(xb[2] - bf_lo(hw.w), xb[3] - bf_hi(hw.w));
                const bf16x8 xh = __builtin_bit_cast(bf16x8, hw), xl = __builtin_bit_cast(bf16x8, lw);
#pragma unroll
                for (int et = 0; et < 4; ++et) { const bf16x8 wh = *(const bf16x8*)(WH + (size_t)(16 * et + ti) * D + k0), wl = *(const bf16x8*)(WL + (size_t)(16 * et + ti) * D + k0);
                    acc[et] = __builtin_amdgcn_mfma_f32_16x16x32_bf16(xh, wh, acc[et], 0, 0, 0);
                    acc[et] = __builtin_amdgcn_mfma_f32_16x16x32_bf16(xl, wh, acc[et], 0, 0, 0);
                    acc[et] = __builtin_amdgcn_mfma_f32_16x16x32_bf16(xh, wl, acc[et], 0, 0, 0); }
            }
            if (wave >= 4) {
#pragma unroll
                for (int et = 0; et < 4; ++et)
#pragma unroll
                    for (int r = 0; r < 4; ++r) PART[(wave - 4) * 1024 + (4 * kk + r) * 64 + 16 * et + ti] = acc[et][r];
            }
            __syncthreads();
            if (wave < 4) {
#pragma unroll
                for (int et = 0; et < 4; ++et)
#pragma unroll
                    for (int r = 0; r < 4; ++r) { LAS float* pp = PART + wave * 1024 + (4 * kk + r) * 64 + 16 * et + ti; *pp = *pp + acc[et][r]; }
            }
        }
        __syncthreads();
#pragma unroll 1
        for (int q = 0; q < 2; ++q) {
            const int tl = 2 * wave + q, tw = pass * 16 + tl;
            const float lg = (PART[tl * 64 + lane] + PART[1024 + tl * 64 + lane]) + (PART[2048 + tl * 64 + lane] + PART[3072 + tl * 64 + lane]);
            const float score = 1.0f / (1.0f + expf(-lg)), biased = score + rb[lane];
            const int grp = lane >> 3;
            float m1 = biased; m1 = fmaxf(m1, __shfl_xor(m1, 1)); m1 = fmaxf(m1, __shfl_xor(m1, 2)); m1 = fmaxf(m1, __shfl_xor(m1, 4));
            const unsigned long long bm = __ballot(biased == m1); const unsigned gb = (unsigned)(bm >> (8 * grp)) & 0xffu; const int first = __builtin_ctz(gb);
            float v2 = ((lane & 7) == first) ? -3.0e38f : biased; float m2 = v2; m2 = fmaxf(m2, __shfl_xor(m2, 1)); m2 = fmaxf(m2, __shfl_xor(m2, 2)); m2 = fmaxf(m2, __shfl_xor(m2, 4));
            const float gs = m1 + m2;
            int grank = 0;
#pragma unroll
            for (int j = 0; j < 8; ++j) { const float gj = __shfl(gs, 8 * j); grank += ((gj > gs) || (gj == gs && j < grp)) ? 1 : 0; }
            const bool gsel = grank < 4;
            const float masked = gsel ? biased : -3.0e38f;
            int rank = 0;
#pragma unroll
            for (int j = 0; j < 64; ++j) { const float vj = __shfl(masked, j); rank += ((vj > masked) || (vj == masked && j < lane)) ? 1 : 0; }
            const bool sel = gsel && (rank < 8);
            const float wsum = wave_sum(sel ? score : 0.f);
            const unsigned long long sm = __ballot(sel);
            if (sel) { const int k = __popcll(sm & ((1ull << lane) - 1ull)); const int li = atomicAdd((int*)&HIST[lane], 1);
                SELE[tw * 8 + k] = lane; SELW[tw * 8 + k] = score / wsum * 2.5f; SELL[tw * 8 + k] = li; }
        }
        __syncthreads();
    }
    if (TID_ < 64) BASE[TID_] = (int)__hip_atomic_fetch_add(F.ctl + CW_CNT + 32 * TID_, (unsigned)HIST[TID_], RLX_AGENT);
    __syncthreads();
    if (TID_ < 256) { const int e = SELE[TID_], pos = BASE[e] + SELL[TID_], tok = tile * 32 + (TID_ >> 3);
        ((int*)(F.ws + WS_TOKLIST))[(size_t)e * T + pos] = tok; ((float*)(F.ws + WS_WREC))[tok * 8 + (TID_ & 7)] = SELW[TID_]; ((int*)(F.ws + WS_REC))[tok * 8 + (TID_ & 7)] = e * T + pos; }
    __syncthreads();
    if (TID_ < 64) HIST[TID_] = 0;
    __syncthreads();
    }
}

__device__ __forceinline__ void p7_combine(Frame& F, bool dry) {
    const int LANE_ = pg8::lane_id();
    const LAS int* tab = (const LAS int*)(F.lds + TAB_OFF);
    const unsigned char* Y = F.ws + WS_Y; const int* rec = (const int*)(F.ws + WS_REC); const float* wrec = (const float*)(F.ws + WS_WREC);
    const float* H = F.out; bf16* HO = dry ? (bf16*)(F.ws + WS_WGU) : (bf16*)(F.ws + WS_H2B); unsigned char* H2 = dry ? (F.ws + WS_WGU + 64 * MiB) : (F.ws + WS_H2F8);
    const int gw = F.bx * NWAVES + F.wave, NGW = F.G * NWAVES, lane = LANE_;
    for (int t = gw; t < T; t += NGW) {
        int rows[9]; float rwt[9];
#pragma unroll
        for (int k = 0; k < 8; ++k) { const int rc = rec[t * 8 + k]; const int e = rc >> 13, pos = rc & (T - 1); rows[k] = tab[TB_PAD + e] + pos; rwt[k] = wrec[t * 8 + k] * (1.0f / SY); }
        rows[8] = SH_ROW0 + t; rwt[8] = 1.0f / SY;
        v4u y[2][9]; f32x4 h[2][4];
#pragma unroll
        for (int j = 0; j < 2; ++j) { const int c0 = 1024 * j + 16 * lane;
#pragma unroll
            for (int q = 0; q < 4; ++q) h[j][q] = *(const f32x4*)(H + (size_t)t * D + c0 + 4 * q);
#pragma unroll
            for (int k = 0; k < 9; ++k) y[j][k] = *(const v4u*)(Y + (size_t)rows[k] * D + c0); }
#pragma unroll
        for (int j = 0; j < 2; ++j) { const int c0 = 1024 * j + 16 * lane;
#pragma unroll
            for (int k = 0; k < 9; ++k) { const float w = rwt[k]; float f[4];
                fp8x4_to_f32(y[j][k].x, f); h[j][0][0] += w * f[0]; h[j][0][1] += w * f[1]; h[j][0][2] += w * f[2]; h[j][0][3] += w * f[3];
                fp8x4_to_f32(y[j][k].y, f); h[j][1][0] += w * f[0]; h[j][1][1] += w * f[1]; h[j][1][2] += w * f[2]; h[j][1][3] += w * f[3];
                fp8x4_to_f32(y[j][k].z, f); h[j][2][0] += w * f[0]; h[j][2][1] += w * f[1]; h[j][2][2] += w * f[2]; h[j][2][3] += w * f[3];
                fp8x4_to_f32(y[j][k].w, f); h[j][3][0] += w * f[0]; h[j][3][1] += w * f[1]; h[j][3][2] += w * f[2]; h[j][3][3] += w * f[3]; }
            { v4u b0, b1; b0.x = pk2(h[j][0][0], h[j][0][1]); b0.y = pk2(h[j][0][2], h[j][0][3]); b0.z = pk2(h[j][1][0], h[j][1][1]); b0.w = pk2(h[j][1][2], h[j][1][3]);
              b1.x = pk2(h[j][2][0], h[j][2][1]); b1.y = pk2(h[j][2][2], h[j][2][3]); b1.z = pk2(h[j][3][0], h[j][3][1]); b1.w = pk2(h[j][3][2], h[j][3][3]);
              *(v4u*)(HO + (size_t)t * D + c0) = b0; *(v4u*)(HO + (size_t)t * D + c0 + 8) = b1; }
            v4u o; o.x = pk4_fp8(h[j][0][0], h[j][0][1], h[j][0][2], h[j][0][3]); o.y = pk4_fp8(h[j][1][0], h[j][1][1], h[j][1][2], h[j][1][3]);
            o.z = pk4_fp8(h[j][2][0], h[j][2][1], h[j][2][2], h[j][2][3]); o.w = pk4_fp8(h[j][3][0], h[j][3][1], h[j][3][2], h[j][3][3]);
            *(v4u*)(H2 + (size_t)t * D + c0) = o; }
    }
}
__device__ __forceinline__ void p9_final(Frame& F, bool dry) {
    const int LANE_ = pg8::lane_id();
    const int gw = F.bx * NWAVES + F.wave, NGW = F.G * NWAVES, lane = LANE_; const float* g = fin(F, I_GFINAL); const float* gp = fin(F, I_GPLE);
    const bf16* G = (const bf16*)(F.ws + WS_GBUF); const bf16* PP = (const bf16*)(F.ws + WS_PPROJ);
    for (int t = gw; t < T; t += NGW) {
        const bf16* row = (const bf16*)(F.ws + WS_H2B) + (size_t)t * D; float* orow = (dry ? (float*)(F.ws + WS_WGU) : F.out) + (size_t)t * D; f32x4 v[8]; v4u gg[4], pw[4];
#pragma unroll
        for (int j = 0; j < 4; ++j) { const v4u hw = *(const v4u*)(row + 512 * j + 8 * lane);
            v[2 * j] = (f32x4){bf_lo(hw.x), bf_hi(hw.x), bf_lo(hw.y), bf_hi(hw.y)}; v[2 * j + 1] = (f32x4){bf_lo(hw.z), bf_hi(hw.z), bf_lo(hw.w), bf_hi(hw.w)};
            gg[j] = *(const v4u*)(G + (size_t)t * D + 512 * j + 8 * lane); pw[j] = *(const v4u*)(PP + (size_t)t * D + 512 * j + 8 * lane); }
        float pf[4][8]; float ps = 0.f;
#pragma unroll
        for (int j = 0; j < 4; ++j) { pf[j][0] = bf_lo(pw[j].x); pf[j][1] = bf_hi(pw[j].x); pf[j][2] = bf_lo(pw[j].y); pf[j][3] = bf_hi(pw[j].y); pf[j][4] = bf_lo(pw[j].z); pf[j][5] = bf_hi(pw[j].z); pf[j][6] = bf_lo(pw[j].w); pf[j][7] = bf_hi(pw[j].w);
#pragma unroll
            for (int q = 0; q < 8; ++q) ps += pf[j][q] * pf[j][q]; }
        const float rsp = 1.0f / sqrtf(wave_sum(ps) * (1.0f / D) + EPS);
        float s = 0.f;
#pragma unroll
        for (int j = 0; j < 4; ++j) { const f32x4 g0 = *(const f32x4*)(gp + 512 * j + 8 * lane), g1 = *(const f32x4*)(gp + 512 * j + 8 * lane + 4);
            const float gl[8] = {bf_lo(gg[j].x), bf_hi(gg[j].x), bf_lo(gg[j].y), bf_hi(gg[j].y), bf_lo(gg[j].z), bf_hi(gg[j].z), bf_lo(gg[j].w), bf_hi(gg[j].w)};
#pragma unroll
            for (int q = 0; q < 4; ++q) { v[2 * j][q] += sigmoid_f(gl[q]) * pf[j][q] * rsp * g0[q]; v[2 * j + 1][q] += sigmoid_f(gl[4 + q]) * pf[j][4 + q] * rsp * g1[q]; }
            s += (v[2 * j][0] * v[2 * j][0] + v[2 * j][1] * v[2 * j][1]) + (v[2 * j][2] * v[2 * j][2] + v[2 * j][3] * v[2 * j][3]);
            s += (v[2 * j + 1][0] * v[2 * j + 1][0] + v[2 * j + 1][1] * v[2 * j + 1][1]) + (v[2 * j + 1][2] * v[2 * j + 1][2] + v[2 * j + 1][3] * v[2 * j + 1][3]); }
        const float rstd = 1.0f / sqrtf(wave_sum(s) * (1.0f / D) + EPS);
#pragma unroll
        for (int j = 0; j < 4; ++j) { const f32x4 g0 = *(const f32x4*)(g + 512 * j + 8 * lane), g1 = *(const f32x4*)(g + 512 * j + 8 * lane + 4);
            *(f32x4*)(orow + 512 * j + 8 * lane) = v[2 * j] * rstd * g0; *(f32x4*)(orow + 512 * j + 8 * lane + 4) = v[2 * j + 1] * rstd * g1; }
    }
}
__global__ void __launch_bounds__(NWAVES * 64, 2) fwd_kernel(Args args) {
    extern __shared__ __attribute__((aligned(16))) unsigned char lds[];
    Frame F;
    F.lds = (LAS unsigned char*)lds;
    F.MISC = (volatile LAS unsigned*)(F.lds + MISC_OFF);
    F.wave = __builtin_amdgcn_readfirstlane(threadIdx.x >> 6);
    F.G = gridDim.x; F.bx = blockIdx.x;
    F.ws = args.ws; F.ctl = (gu32*)(args.ws + WS_CTL); F.out = args.out;
    { const int TID_ = threadIdx.x;
    if (TID_ < 64) F.MISC[TID_] = 0u;
    if (TID_ >= 64 && TID_ < 64 + 22) ((LAS unsigned long long*)(F.lds + MISC_OFF + 256))[TID_ - 64] = ((const unsigned long long*)&args)[TID_ - 64]; }
    __syncthreads();
    XcdBarrier bar; bar.bar = (unsigned*)(F.ctl + CW_BAR); bar.x = 0; bar.st = nullptr;
    if (N_LAUNCHES == 1) bar = xcd_barrier_post((unsigned*)(F.ctl + CW_BAR), F.MISC + 8);
#define GRID_BAR() do { if (N_LAUNCHES == 1) xcd_barrier(bar); } while (0)
    const int lo = args.ph_lo, hi = args.ph_hi;
#ifndef PH_MASK
#define PH_MASK 0x3ff
#endif
#ifndef DUP_PHASE
#define DUP_PHASE -1
#endif
#define REPS(k) ((DUP_PHASE == (k)) ? 2 : 1)
#define IN(k) ((((PH_MASK) >> (k)) & 1) && lo <= (k) && (k) < hi)
#define BOTH(k) (IN(k) && IN((k) + 1))

    if (IN(0)) { _Pragma("unroll") for (int rep = 0; rep < REPS(0); ++rep) { p0_prologue(F); if (BOTH(0)) GRID_BAR(); } }

    if (IN(1)) { _Pragma("unroll") for (int rep = 0; rep < REPS(1); ++rep) {
        constexpr int G1 = 144;
        if (F.G == 256 && F.bx >= G1) {
            { pg8::Gemm g{(const bf16*)(F.ws + WS_PBF), (const bf16*)(F.ws + WS_WPP), PLE, PLE, PLE}; pg8::StaticOrder S; S.init(T, D, F.G - G1, F.bx - G1);
              EpiBf16Plain E{(bf16*)(F.ws + WS_PPROJ), D, 0, nullptr};
              pg8::gemm_phase<EpiBf16Plain, pg8::StaticOrder, false>(F.lds + RING_OFF, g, S, E, F.wave); }
            conv_fp8_items(F, CONV_A, CONV_A + CONV_B, (F.bx - G1) * NWAVES + F.wave, (F.G - G1) * NWAVES);
        } else {
            const int gg = (F.G == 256) ? G1 : F.G;
            { pg8::Gemm g{(const bf16*)(F.ws + WS_ABF), (const bf16*)(F.ws + WS_WIN), D, D, D}; pg8::StaticOrder S; S.init(T, INW, gg, F.bx);
              EpiInProj E{F.ws};
              pg8::gemm_phase<EpiInProj, pg8::StaticOrder, false>(F.lds + RING_OFF, g, S, E, F.wave); }
            if (F.G != 256) {
                { pg8::Gemm g{(const bf16*)(F.ws + WS_PBF), (const bf16*)(F.ws + WS_WPP), PLE, PLE, PLE}; pg8::StaticOrder S; S.init(T, D, F.G, F.bx);
                  EpiBf16Plain E{(bf16*)(F.ws + WS_PPROJ), D, 0, nullptr};
                  pg8::gemm_phase<EpiBf16Plain, pg8::StaticOrder, false>(F.lds + RING_OFF, g, S, E, F.wave); }
                conv_fp8_items(F, CONV_A, CONV_A + CONV_B, F.bx * NWAVES + F.wave, F.G * NWAVES);
            }
        }
        if (BOTH(1)) GRID_BAR();
    } }

    if (IN(2)) { _Pragma("unroll") for (int rep = 0; rep < REPS(2); ++rep) {
        if (F.G == 256) {
            if (F.bx < 128) pool_task(F, F.bx >> 2, F.bx & 3);
            else { attn_block(F, 2 * (F.bx - 128)); attn_block(F, 2 * (F.bx - 128) + 1); }
        } else {
            for (int blk = F.bx; blk < 256; blk += F.G) attn_block(F, blk);
            for (int p = F.bx; p < 128; p += F.G) { __syncthreads(); pool_task(F, p >> 2, p & 3); }
        }
        if (BOTH(2)) GRID_BAR();
    } }

    if (IN(3)) { _Pragma("unroll") for (int rep = 0; rep < REPS(3); ++rep) {
        constexpr int G3 = 128;
        if (F.G == 256 && F.bx >= G3) conv_fp8_items(F, CONV_A + CONV_B, CV_TOTAL, (F.bx - G3) * NWAVES + F.wave, (F.G - G3) * NWAVES);
        else {
            pg8::Gemm g{(const bf16*)(F.ws + WS_MIX), (const bf16*)(F.ws + WS_WOUT), D, D, D}; pg8::StaticOrder S; S.init(T, D, (F.G == 256) ? G3 : F.G, F.bx);
            EpiResF32 E{fin(F, I_X), F.out};
            pg8::gemm_phase<EpiResF32, pg8::StaticOrder, false>(F.lds + RING_OFF, g, S, E, F.wave);
            if (F.G != 256) conv_fp8_items(F, CONV_A + CONV_B, CV_TOTAL, F.bx * NWAVES + F.wave, F.G * NWAVES);
        }
        if (BOTH(3)) GRID_BAR();
    } }

    if (IN(4)) { p4_route(F); if (BOTH(4)) GRID_BAR(); }

    if (IN(5)) { _Pragma("unroll") for (int rep = 0; rep < REPS(5); ++rep) {
        moe_tables(F);
        pg8::Gemm g{F.ws + WS_XN, F.ws + WS_WGU, D, D, D};
        MoeOrder S{(const LAS int*)(F.lds + TAB_OFF), (const int*)(F.ws + WS_TOKLIST), F.bx & 7, F.bx >> 3, 4, F.G >> 3};
        EpiGateUp E{F.ws + WS_ACT};
        pg8::gemm_phase<EpiGateUp, MoeOrder, true, 1>(F.lds + RING_OFF, g, S, E, F.wave);
        if (BOTH(5)) GRID_BAR();
    } }

    if (IN(6)) { _Pragma("unroll") for (int rep = 0; rep < REPS(6); ++rep) {
        if (!IN(5)) moe_tables(F);
        pg8::Gemm g{F.ws + WS_ACT, F.ws + WS_WD, EFF, EFF, EFF};
        MoeOrder S{(const LAS int*)(F.lds + TAB_OFF), (const int*)(F.ws + WS_TOKLIST), F.bx & 7, F.bx >> 3, 8, F.G >> 3};
        EpiDown E{F.ws + WS_Y};
        pg8::gemm_phase<EpiDown, MoeOrder, false, 1>(F.lds + RING_OFF, g, S, E, F.wave);
        if (BOTH(6)) GRID_BAR();
    } }

    if (IN(7)) { if (!IN(6)) moe_tables(F); if (DUP_PHASE == 7) { p7_combine(F, true); GRID_BAR(); } p7_combine(F, false); if (BOTH(7)) GRID_BAR(); }

    if (IN(8)) {
        pg8::Gemm g{F.ws + WS_H2F8, F.ws + WS_WPG, D, D, D}; pg8::StaticOrder S; S.init(T, D, F.G, F.bx);
        EpiBf16Mul E{(bf16*)(F.ws + WS_GBUF), 1.0f / SW3};
        pg8::gemm_phase<EpiBf16Mul, pg8::StaticOrder, false, 1>(F.lds + RING_OFF, g, S, E, F.wave);
        if (BOTH(8)) GRID_BAR();
    }

    if (IN(9)) { if (DUP_PHASE == 9) { p9_final(F, true); GRID_BAR(); } p9_final(F, false); }
#undef IN
#undef BOTH
}

extern "C" void kernel_launch(void* const* d_in, const int* in_sizes, int n_in, void* d_out, int out_size, void* d_ws, size_t ws_size, hipStream_t stream) {
    static int grid = 0;
    if (grid == 0) {
        if (n_in != 22 || out_size != T * D || ws_size < WS_END) { fprintf(stderr, "kernel_launch: unexpected sizes n_in %d out %d ws %zu (need %zu)\n", n_in, out_size, ws_size, (size_t)WS_END); grid = -1; return; }
        int dev = 0, cus = 0, per_cu = 0;
        if (hipGetDevice(&dev) != hipSuccess || hipDeviceGetAttribute(&cus, hipDeviceAttributeMultiprocessorCount, dev) != hipSuccess) { grid = -1; return; }
        if (hipFuncSetAttribute((const void*)fwd_kernel, hipFuncAttributeMaxDynamicSharedMemorySize, LDS_BYTES) != hipSuccess) { fprintf(stderr, "kernel_launch: hipFuncSetAttribute failed\n"); grid = -1; return; }
        if (hipOccupancyMaxActiveBlocksPerMultiprocessor(&per_cu, (const void*)fwd_kernel, NWAVES * 64, LDS_BYTES) != hipSuccess || per_cu < 1) fprintf(stderr, "kernel_launch: occupancy query reports %d\n", per_cu);
        (void)hipGetLastError();
        grid = cus > 256 ? 256 : cus;
    }
    if (grid < 0) return;
    if (hipMemsetAsync((char*)d_ws + WS_CTL, 0, CTL_ZERO_BYTES, stream) != hipSuccess) return;
    Args a{};
    for (int i = 0; i < 22; ++i) a.in[i] = (const float*)d_in[i];
    a.out = (float*)d_out; a.ws = (unsigned char*)d_ws;
    for (int li = 0; li < N_LAUNCHES; ++li) {
        a.ph_lo = (N_LAUNCHES == 1) ? 0 : li; a.ph_hi = (N_LAUNCHES == 1) ? N_PHASES : li + 1; a.li = li;
        hipLaunchKernelGGL(fwd_kernel, dim3(grid), dim3(NWAVES * 64), LDS_BYTES, stream, a);
    }
}
```

```cpp
#include <hip/hip_runtime.h>
#include <cstdio>
#include <cstdint>

#ifndef MK_N_LAUNCHES
#define MK_N_LAUNCHES 1
#endif

namespace pg8 {
#define PG8_LAS __attribute__((address_space(3)))
typedef unsigned short bf16_t;
typedef short bf16x8 __attribute__((ext_vector_type(8)));
typedef float f32x4 __attribute__((ext_vector_type(4)));
typedef unsigned u32x4 __attribute__((ext_vector_type(4)));
typedef unsigned u32x2 __attribute__((ext_vector_type(2)));
constexpr int BM = 256, BK = 64, HALF = 128, HTB = HALF * BK * 2  , STAGE_BYTES = 8 * HTB, NXCD = 8, WGM = 8;

__host__ __device__ __forceinline__ int lds_byte(int r, int c) { const int st = (r >> 4) * 2 + (c >> 5), rr = r & 15, cc = c & 31, ob = rr * 64 + cc * 2; return st * 1024 + (ob ^ (((ob >> 9) & 1) << 5)); }
__host__ __device__ __forceinline__ void stage_rc(int b, int& R, int& C) { const int st = b / 1024, sb = b % 1024, swz = sb ^ (((sb >> 9) & 1) << 5); R = (st >> 1) * 16 + swz / 64; C = (st & 1) * 32 + (swz % 64) / 2; }
__host__ __device__ __forceinline__ int perm32(int rho) { const int n = rho >> 4, i = rho & 15; return 8 * (i >> 2) + 4 * n + (i & 3); }

struct Unit { int pm, pn, e, lt, half; };
struct Gemm { const void* A; const void* Bt; int lda, ldb, K; };
typedef int i32x8 __attribute__((ext_vector_type(8)));
typedef int i32x4 __attribute__((ext_vector_type(4)));
__device__ __forceinline__ i32x8 cat8(bf16x8 lo, bf16x8 hi) { const i32x4 a = __builtin_bit_cast(i32x4, lo), b = __builtin_bit_cast(i32x4, hi); return __builtin_shufflevector(a, b, 0, 1, 2, 3, 4, 5, 6, 7); }

struct StaticOrder {
    static constexpr bool HALVES = false;
    int nM, nN, nwg, G, c;
    __host__ __device__ void init(int M, int N, int G_, int c_) { nM = M / BM; nN = N / BM; nwg = nM * nN; G = G_; c = c_; }
    __host__ __device__ bool next(int i, Unit& u) const {
        const long L = (long)i * G + c; if (L >= nwg) return false;
        int wgid = (int)L; { const int q = nwg / NXCD, r = nwg % NXCD, xcd = wgid % NXCD, off = wgid / NXCD; wgid = (xcd < r ? xcd * (q + 1) : r * (q + 1) + (xcd - r) * q) + off; }
        const int nig = WGM * nN, gid = wgid / nig, fm = gid * WGM, gsz = (nM - fm) < WGM ? (nM - fm) : WGM;
        u.pm = fm + ((wgid % nig) % gsz); u.pn = (wgid % nig) / gsz; u.e = 0; u.lt = 0; u.half = 0; return true;
    }
    __device__ __forceinline__ int arow(const Unit&, int r) const { return r; }
};
struct SingleOrder {
    static constexpr bool HALVES = false;
    int pm, pn;
    __device__ bool next(int i, Unit& u) const { if (i > 0) return false; u.pm = pm; u.pn = pn; u.e = 0; u.lt = 0; u.half = 0; return true; }
    __device__ __forceinline__ int arow(const Unit&, int r) const { return r; }
};

__device__ __forceinline__ int lane_id() { int l; asm volatile("v_mbcnt_lo_u32_b32 %0, -1, 0\n\tv_mbcnt_hi_u32_b32 %0, -1, %0" : "=v"(l)); return l; }
__device__ __forceinline__ unsigned cvt_pk_bf16(float lo, float hi) { unsigned r; asm volatile("v_cvt_pk_bf16_f32 %0, %1, %2" : "=v"(r) : "v"(lo), "v"(hi)); return r; }

__host__ __device__ __forceinline__ int perm16(int R) { return 64 * (R >> 5) + 16 * ((R >> 2) & 3) + 4 * ((R >> 4) & 1) + (R & 3); }
template <class Epi, class Sched, bool GATHER, int ESZ = 2, bool ALIGN_EPI = true>
__device__ __forceinline__ void gemm_phase(PG8_LAS unsigned char* lds, const Gemm g, const Sched& S, const Epi& E, int wid) {
    const int lane = lane_id(), tid = wid * 64 + lane, wr = wid >> 2, wc = wid & 3, fr = lane & 15, fq = lane >> 4;
    const int nt = (g.K * ESZ) / 128;
    int Ra[2], Ca[2]; unsigned voffB[2];
#pragma unroll
    for (int i = 0; i < 2; ++i) { int R, C; stage_rc(tid * 16 + i * 8192, R, C); const int Rb = (Epi::PERM == 2) ? perm16(R) : (Epi::PERM ? ((R & ~31) + perm32(R & 31)) : R);
        Ra[i] = R; Ca[i] = C; voffB[i] = (unsigned)(Rb * g.ldb * ESZ + C * 2); }
    const size_t kstep = (size_t)(BK * 2);
    const size_t hstepB = (size_t)((Epi::PERM == 2) ? 8 : HALF) * g.ldb * ESZ, tstepB = (size_t)BM * g.ldb * ESZ;
    const size_t tstepA = (size_t)BM * g.lda * ESZ;
    const unsigned ldsw = (unsigned)wid * 1024u;
    const int aoff = lds_byte(wr * 64 + fr, fq * 8), boff = lds_byte(wc * 32 + fr, fq * 8);
#define PG8_SA(b, h) (((b) * 2 + (h)) * HTB)
#define PG8_SB(b, h) ((4 + (b) * 2 + (h)) * HTB)
#define PG8_STAGE(bufoff, gbase, v0, v1) do { \
        __builtin_amdgcn_global_load_lds((const unsigned*)((const char*)(gbase) + (v0)), (PG8_LAS unsigned*)(lds + (bufoff) + ldsw), 16, 0, 0); \
        __builtin_amdgcn_global_load_lds((const unsigned*)((const char*)(gbase) + (v1)), (PG8_LAS unsigned*)(lds + (bufoff) + ldsw + 8192), 16, 0, 0); } while (0)
#define PG8_STAGE_A0(bufoff, gbase, p0, p1) PG8_STAGE(bufoff, gbase, p0, p1)
#define PG8_STAGE_A1(bufoff, gbase, p0, p1, q0, q1) do { if constexpr (GATHER) { PG8_STAGE(bufoff, gbase, q0, q1); } else { PG8_STAGE(bufoff, (gbase) + hstepA, p0, p1); } } while (0)
#define PG8_LD16(off) (*(const PG8_LAS i32x4*)(lds + (off)))
#define PG8_LDA(dst, b, h) do { if constexpr (ESZ == 2) { _Pragma("unroll") for (int m = 0; m < 4; ++m) _Pragma("unroll") for (int k = 0; k < 2; ++k) dst[m][k] = *(const PG8_LAS bf16x8*)(lds + PG8_SA(b, h) + aoff + m * 2048 + k * 1024); } \
        else { _Pragma("unroll") for (int m = 0; m < 4; ++m) dst##8[m] = __builtin_shufflevector(PG8_LD16(PG8_SA(b, h) + aoff + m * 2048), PG8_LD16(PG8_SA(b, h) + aoff + m * 2048 + 1024), 0, 1, 2, 3, 4, 5, 6, 7); } } while (0)
#define PG8_LDB(dst, b, h) do { if constexpr (ESZ == 2) { _Pragma("unroll") for (int n = 0; n < 2; ++n) _Pragma("unroll") for (int k = 0; k < 2; ++k) dst[n][k] = *(const PG8_LAS bf16x8*)(lds + PG8_SB(b, h) + boff + n * 2048 + k * 1024); } \
        else { _Pragma("unroll") for (int n = 0; n < 2; ++n) dst##8[n] = __builtin_shufflevector(PG8_LD16(PG8_SB(b, h) + boff + n * 2048), PG8_LD16(PG8_SB(b, h) + boff + n * 2048 + 1024), 0, 1, 2, 3, 4, 5, 6, 7); } } while (0)
#define PG8_MMA(ai, bj, At, Bt) do { __builtin_amdgcn_s_setprio(1); \
        if constexpr (ESZ == 2) { _Pragma("unroll") for (int m = 0; m < 4; ++m) _Pragma("unroll") for (int n = 0; n < 2; ++n) _Pragma("unroll") for (int k = 0; k < 2; ++k) \
            acc[ai][bj][m][n] = __builtin_amdgcn_mfma_f32_16x16x32_bf16(Bt[n][k], At[m][k], acc[ai][bj][m][n], 0, 0, 0); } \
        else { _Pragma("unroll") for (int m = 0; m < 4; ++m) _Pragma("unroll") for (int n = 0; n < 2; ++n) \
            asm volatile("v_mfma_scale_f32_16x16x128_f8f6f4 %0, %1, %2, %0, %3, %3 op_sel_hi:[0,0,0]" : "+v"(acc[ai][bj][m][n]) : "v"(Bt##8[n]), "v"(At##8[m]), "v"(sc1)); } \
        __builtin_amdgcn_s_setprio(0); } while (0)
#define PG8_WAIT_V(n) asm volatile("s_waitcnt vmcnt(" #n ")" ::: "memory")
#define PG8_WAIT_L(n) asm volatile("s_waitcnt lgkmcnt(" #n ")" ::: "memory")
#define PG8_BAR __builtin_amdgcn_s_barrier()
#define PG8_SCHED __builtin_amdgcn_sched_barrier(0)
    Unit cur, nxt; int ui = 0;
    if (!S.next(0, cur)) return;
    f32x4 acc[2][2][4][2];
#pragma unroll
    for (int a = 0; a < 2; ++a)
#pragma unroll
        for (int b = 0; b < 2; ++b)
#pragma unroll
            for (int m = 0; m < 4; ++m)
#pragma unroll
                for (int n = 0; n < 2; ++n) acc[a][b][m][n] = (f32x4){0.f, 0.f, 0.f, 0.f};
    const int sc1 = 0x7F7F7F7F;
    bf16x8 At[4][2], B0[2][2], B1[2][2]; i32x8 At8[4], B08[2], B18[2];
    unsigned vA00, vA01, vA10, vA11, nA00, nA01, nA10, nA11;
    const size_t hstepA = GATHER ? (size_t)0 : (size_t)HALF * g.lda * ESZ;
    if constexpr (GATHER) {
        vA00 = (unsigned)(S.arow(cur, Ra[0]) * g.lda * ESZ + Ca[0] * 2); vA01 = (unsigned)(S.arow(cur, Ra[1]) * g.lda * ESZ + Ca[1] * 2);
        vA10 = (unsigned)(S.arow(cur, HALF + Ra[0]) * g.lda * ESZ + Ca[0] * 2); vA11 = (unsigned)(S.arow(cur, HALF + Ra[1]) * g.lda * ESZ + Ca[1] * 2);
    } else {
        vA00 = (unsigned)(Ra[0] * g.lda * ESZ + Ca[0] * 2); vA01 = (unsigned)(Ra[1] * g.lda * ESZ + Ca[1] * 2); vA10 = 0; vA11 = 0;
    }
    nA00 = vA00; nA01 = vA01; nA10 = vA10; nA11 = vA11;
    const char* cA = (const char*)g.A + (GATHER ? (size_t)0 : (size_t)cur.pm * tstepA); const char* cB = (const char*)g.Bt + (size_t)cur.pn * tstepB;
    PG8_STAGE(PG8_SB(0, 0), cB, voffB[0], voffB[1]); PG8_STAGE(PG8_SB(0, 1), cB + hstepB, voffB[0], voffB[1]); PG8_STAGE_A0(PG8_SA(0, 0), cA, vA00, vA01); PG8_STAGE_A1(PG8_SA(0, 1), cA, vA00, vA01, vA10, vA11);
    if (wr == 1) PG8_BAR;
    PG8_WAIT_V(2); PG8_BAR;
    PG8_STAGE(PG8_SB(1, 0), cB + kstep, voffB[0], voffB[1]); PG8_STAGE_A0(PG8_SA(1, 0), cA + kstep, vA00, vA01); PG8_STAGE(PG8_SB(1, 1), cB + hstepB + kstep, voffB[0], voffB[1]);
    PG8_WAIT_V(6); PG8_BAR;
    for (;;) {
        const bool has_next = S.next(ui + 1, nxt);
        const char* nA = has_next ? (const char*)g.A + (GATHER ? (size_t)0 : (size_t)nxt.pm * tstepA) : cA; const char* nB = has_next ? (const char*)g.Bt + (size_t)nxt.pn * tstepB : cB;
        if constexpr (GATHER) {
            if (has_next) {
                nA00 = (unsigned)(S.arow(nxt, Ra[0]) * g.lda * ESZ + Ca[0] * 2); nA01 = (unsigned)(S.arow(nxt, Ra[1]) * g.lda * ESZ + Ca[1] * 2);
                nA10 = (unsigned)(S.arow(nxt, HALF + Ra[0]) * g.lda * ESZ + Ca[0] * 2); nA11 = (unsigned)(S.arow(nxt, HALF + Ra[1]) * g.lda * ESZ + Ca[1] * 2);
            } else { nA00 = vA00; nA01 = vA01; nA10 = vA10; nA11 = vA11; }
        }
#pragma nounroll
        for (int t = 0; t < nt; t += 2) {
            const bool last = (t == nt - 2);
            const char* a1 = cA + (size_t)(t + 1) * kstep;
            const char* a2 = last ? nA : cA + (size_t)(t + 2) * kstep; const char* b2 = last ? nB : cB + (size_t)(t + 2) * kstep;
            const char* a3 = a2 + kstep; const char* b3 = b2 + kstep;
            asm volatile("" : "+v"(voffB[0]), "+v"(voffB[1]), "+v"(vA00), "+v"(vA01));
            if constexpr (GATHER) asm volatile("" : "+v"(vA10), "+v"(vA11));
            unsigned x00 = vA00, x01 = vA01, x10 = vA10, x11 = vA11;
            if constexpr (GATHER) { if (last) { x00 = nA00; x01 = nA01; x10 = nA10; x11 = nA11; } }
            const bool hf = Sched::HALVES && (cur.half != 0);
            PG8_LDB(B0, 0, 0); PG8_LDB(B1, 0, 1); PG8_SCHED; PG8_LDA(At, 0, 0); PG8_STAGE_A1(PG8_SA(1, 1), a1, vA00, vA01, vA10, vA11);
            PG8_WAIT_V(8); PG8_WAIT_L(0); PG8_BAR; PG8_MMA(0, 0, At, B0); PG8_MMA(0, 1, At, B1); PG8_BAR; PG8_SCHED;
            if (!hf) PG8_LDA(At, 0, 1); PG8_STAGE(PG8_SB(0, 0), b2, voffB[0], voffB[1]); PG8_STAGE(PG8_SB(0, 1), b2 + hstepB, voffB[0], voffB[1]); PG8_STAGE_A0(PG8_SA(0, 0), a2, x00, x01);
            PG8_WAIT_V(8); PG8_WAIT_L(0); PG8_BAR; if (!hf) { PG8_MMA(1, 0, At, B0); PG8_MMA(1, 1, At, B1); } PG8_BAR; PG8_SCHED;
            PG8_LDB(B0, 1, 0); PG8_LDB(B1, 1, 1); PG8_SCHED; PG8_LDA(At, 1, 0); PG8_STAGE_A1(PG8_SA(0, 1), a2, x00, x01, x10, x11);
            PG8_WAIT_V(8); PG8_WAIT_L(0); PG8_BAR; PG8_MMA(0, 0, At, B0); PG8_MMA(0, 1, At, B1); PG8_BAR; PG8_SCHED;
            if (!hf) PG8_LDA(At, 1, 1); PG8_STAGE(PG8_SB(1, 0), b3, voffB[0], voffB[1]); PG8_STAGE(PG8_SB(1, 1), b3 + hstepB, voffB[0], voffB[1]); PG8_STAGE_A0(PG8_SA(1, 0), a3, x00, x01);
            PG8_WAIT_V(8); PG8_WAIT_L(0); PG8_BAR; if (!hf) { PG8_MMA(1, 0, At, B0); PG8_MMA(1, 1, At, B1); } PG8_BAR; PG8_SCHED;
        }
        if constexpr (ALIGN_EPI) { if (wr == 0) PG8_BAR; }
        if constexpr (ESZ == 1) asm volatile("s_nop 15\n\ts_nop 15" ::: "memory");
        E(acc, cur, wr, wc, fr, fq);
        if (!has_next) break;
#pragma unroll
        for (int a = 0; a < 2; ++a)
#pragma unroll
            for (int b = 0; b < 2; ++b)
#pragma unroll
                for (int m = 0; m < 4; ++m)
#pragma unroll
                    for (int n = 0; n < 2; ++n) acc[a][b][m][n] = (f32x4){0.f, 0.f, 0.f, 0.f};
        cur = nxt; cA = nA; cB = nB; ++ui;
        if constexpr (GATHER) { vA00 = nA00; vA01 = nA01; vA10 = nA10; vA11 = nA11; }
        if constexpr (ALIGN_EPI) { if (wr == 1) PG8_BAR; }
    }
    PG8_WAIT_V(0);
    if constexpr (!ALIGN_EPI) { if (wr == 0) PG8_BAR; }
    PG8_BAR;
#undef PG8_SA
#undef PG8_SB
#undef PG8_STAGE
#undef PG8_LDA
#undef PG8_LD16
#undef PG8_STAGE_A0
#undef PG8_STAGE_A1
#undef PG8_LDB
#undef PG8_MMA
#undef PG8_WAIT_V
#undef PG8_WAIT_L
#undef PG8_BAR
#undef PG8_SCHED
}
}

constexpr int NWAVES = 8;
constexpr int T = 8192, SEQ = 2048, NB = 4, D = 2048, INW = 2304, POOLW = 1024, NH = 16, NKV = 2, HD = 64, KVW = 128;
constexpr int NE = 64, TOPK = 8, EFF = 512, PLE = 256;
constexpr int SH_ROW0 = T * TOPK + NE * 256;
constexpr int NROWS = SH_ROW0 + T;
constexpr float EPS = 1e-6f;
constexpr float SW1 = 32.0f, SW2 = 16.0f, SA = 4.0f, SY = 16.0f, SW3 = 32.0f;
constexpr int N_PHASES = 10;
constexpr int N_LAUNCHES = MK_N_LAUNCHES;

constexpr size_t MiB = 1u << 20;
constexpr size_t WS_CTL = 0, CTL_ZERO_BYTES = 64 * 1024;
constexpr size_t WS_MISC = 1 * MiB;
constexpr size_t WS_TOKLIST = WS_MISC;
constexpr size_t WS_REC = WS_TOKLIST + (size_t)NE * T * 4;
constexpr size_t WS_WREC = WS_REC + (size_t)T * TOPK * 4;
constexpr size_t WS_RSTDP = WS_WREC + (size_t)T * TOPK * 4;
constexpr size_t WS_PBF = 6 * MiB;
constexpr size_t WS_WRT = 10 * MiB;
constexpr size_t WS_WIN = 12 * MiB;
constexpr size_t WS_WPOOL = WS_WIN + (size_t)INW * D * 2;
constexpr size_t WS_WOUT = WS_WPOOL + (size_t)4 * 256 * 256 * 2;
constexpr size_t WS_WPP = WS_WOUT + (size_t)D * D * 2;
constexpr size_t WS_WPG = WS_WPP + (size_t)D * PLE * 2;
constexpr size_t WS_WGU = WS_WPG + (size_t)D * D * 2;
constexpr size_t WS_WD = WS_WGU + (size_t)65 * 1024 * D;
constexpr size_t WS_XN = WS_WD + (size_t)65 * D * EFF;
constexpr size_t WS_PPROJ = WS_XN + (size_t)T * D * 2;
constexpr size_t WS_ACT = WS_PPROJ + (size_t)T * D * 2;
constexpr size_t WS_H2F8 = WS_ACT;
constexpr size_t WS_H2B = WS_ACT + 16 * MiB;
constexpr size_t WS_GBUF = WS_XN;
constexpr size_t WS_Y = WS_ACT + (size_t)NROWS * EFF * 2;
constexpr size_t WS_ABF = WS_Y;
constexpr size_t WS_UBF = WS_ABF + (size_t)T * D * 2;
constexpr size_t WS_QBF = WS_UBF + (size_t)T * POOLW * 2;
constexpr size_t WS_KV = WS_QBF + (size_t)T * 1024 * 2;
constexpr size_t WS_POOLED = WS_KV + (size_t)T * 2 * KVW * 2;
constexpr size_t WS_MIX = WS_POOLED + (size_t)T * POOLW * 2;
constexpr size_t WS_END = WS_Y + (size_t)NROWS * D * 2;
static_assert(WS_MIX + (size_t)T * D * 2 <= WS_END, "early activations fit under Y");
static_assert(WS_RSTDP + (size_t)T * 4 <= WS_PBF && WS_PBF + (size_t)T * PLE * 2 <= WS_WIN, "misc fits");
static_assert(WS_END <= (size_t)1024 * MiB, "workspace must fit 1 GiB");
constexpr int CW_BAR = 1024;
constexpr int CW_CNT = 8192;
constexpr int CW_CONVQ = CW_CNT + 32 * NE;
static_assert((CW_CONVQ + 32 * 24) * 4 <= 48 * 1024, "CTL words inside the memset region (below the dummy line at 48 KiB)");

constexpr int RING_OFF = 0, RING_BYTES = 131072;
constexpr int LDS_BYTES = 163840;
constexpr int MISC_OFF = LDS_BYTES - 512;
constexpr int TAB_OFF = RING_BYTES;
constexpr int TB_CNT = 0, TB_PAD = 80, TB_XF = 160, TB_XH = 176, TB_SH0 = 192, TB_SHN = 193;

#define GAS __attribute__((address_space(1)))
#define LAS __attribute__((address_space(3)))
typedef unsigned short bf16;
typedef unsigned v4u __attribute__((ext_vector_type(4)));
typedef unsigned v2u __attribute__((ext_vector_type(2)));
typedef float f32x4 __attribute__((ext_vector_type(4)));
typedef short bf16x8 __attribute__((ext_vector_type(8)));
typedef GAS unsigned gu32;
#define RLX_AGENT __ATOMIC_RELAXED, __HIP_MEMORY_SCOPE_AGENT
#define LDS_WAIT() asm volatile("s_waitcnt lgkmcnt(0)" ::: "memory")
#define VM_WAIT() asm volatile("s_waitcnt vmcnt(0)" ::: "memory")
__device__ __forceinline__ unsigned pk2(float lo, float hi) { return pg8::cvt_pk_bf16(lo, hi); }
__device__ __forceinline__ float bf_lo(unsigned w) { return __builtin_bit_cast(float, w << 16); }
__device__ __forceinline__ float bf_hi(unsigned w) { return __builtin_bit_cast(float, w & 0xffff0000u); }

#define XB_TMO      128
#define XB_XCNT(j)  (256  + 64 * (j))
#define XB_XSUB(j)  (1280 + 64 * (j))
#define XB_XGEN(j)  (2304 + 64 * (j))
#define XB_TOP      3328
#define XB_TOPGEN   3392
#define XCD_BAR_WORDS 3456
#define XB_SPIN_CAP (1u << 18)
__device__ __forceinline__ unsigned xb_ld(unsigned* p)              { return __hip_atomic_load(p, __ATOMIC_RELAXED, __HIP_MEMORY_SCOPE_AGENT); }
__device__ __forceinline__ unsigned xb_add(unsigned* p, unsigned v) { return __hip_atomic_fetch_add(p, v, __ATOMIC_RELAXED, __HIP_MEMORY_SCOPE_AGENT); }
__device__ __forceinline__ unsigned xb_xcc_id() { return (unsigned)__builtin_amdgcn_s_getreg((3 << 11) | 20) & 0xFu; }
#define XB_SPIN(cond, bar) do { unsigned _sp = 0; while (cond) { __builtin_amdgcn_s_sleep(1); \
    if ((++_sp & 255u) == 0u) { if (xb_ld(&(bar)[XB_TMO])) break; if (_sp > XB_SPIN_CAP) { atomicAdd(&(bar)[XB_TMO], 1u); break; } } } } while (0)
struct XcdBarrier { unsigned* bar; unsigned x; volatile LAS unsigned* st; };
__device__ __forceinline__ XcdBarrier xcd_barrier_post(unsigned* bar, volatile LAS unsigned* st) {
    XcdBarrier b; b.bar = bar; b.x = xb_xcc_id(); b.st = st;
    if (threadIdx.x == 0) (void)xb_add(&bar[XB_XCNT(b.x)], 1u);
    return b;
}
__device__ __forceinline__ void xcd_barrier_complete(unsigned* bar, unsigned x, unsigned& nloc, unsigned& nx) {
    const unsigned G = gridDim.x * gridDim.y * gridDim.z;
    unsigned sum, cnt, mine, sp = 0u;
    for (;;) {
        sum = 0u; cnt = 0u; mine = 0u;
#pragma unroll
        for (unsigned j = 0; j < 16; ++j) { const unsigned c = xb_ld(&bar[XB_XCNT(j)]); sum += c; cnt += (c > 0u) ? 1u : 0u; mine = (j == x) ? c : mine; }
        if (sum == G) break;
        __builtin_amdgcn_s_sleep(1);
        if ((++sp & 255u) == 0u) { if (xb_ld(&bar[XB_TMO])) break; if (sp > XB_SPIN_CAP) { atomicAdd(&bar[XB_TMO], 1u); break; } }
    }
    nloc = mine > 0u ? mine : 1u; nx = cnt > 0u ? cnt : 1u;
}
__device__ __forceinline__ void xcd_barrier(const XcdBarrier& b) {
    asm volatile("s_waitcnt vmcnt(0)" ::: "memory");
    __syncthreads();
    if (threadIdx.x == 0) {
        unsigned* bar = b.bar;
        __builtin_amdgcn_s_waitcnt(0);
        unsigned nloc = b.st[0], nx = b.st[1];
        if (nloc == 0u) { xcd_barrier_complete(bar, b.x, nloc, nx); b.st[0] = nloc; b.st[1] = nx; }
        const unsigned old = xb_add(&bar[XB_XSUB(b.x)], 1u);
        const unsigned gen = old / nloc;
        if (old + 1u == (gen + 1u) * nloc) {
            __builtin_amdgcn_fence(__ATOMIC_RELEASE, "agent");
            asm volatile("s_waitcnt vmcnt(0)" ::: "memory");
            const unsigned og = xb_add(&bar[XB_TOP], 1u);
            const unsigned tg = og / nx;
            if (og + 1u == (tg + 1u) * nx) xb_add(&bar[XB_TOPGEN], 1u);
            else XB_SPIN(xb_ld(&bar[XB_TOPGEN]) == tg, bar);
            __builtin_amdgcn_fence(__ATOMIC_ACQUIRE, "agent");
            xb_add(&bar[XB_XGEN(b.x)], 1u);
            asm volatile("s_waitcnt vmcnt(0)" ::: "memory");
        } else {
            XB_SPIN(xb_ld(&bar[XB_XGEN(b.x)]) == gen, bar);
            __builtin_amdgcn_fence(__ATOMIC_ACQUIRE, "agent");
            asm volatile("s_waitcnt vmcnt(0)" ::: "memory");
        }
    }
    __syncthreads();
}

struct Args { const float* in[22]; float* out; unsigned char* ws; int ph_lo, ph_hi, li, pad; };
struct Frame {
    LAS unsigned char* lds;
    volatile LAS unsigned* MISC;
    gu32* ctl;
    unsigned char* ws;
    int wave, G, bx;
    float* out;
};
__device__ __forceinline__ const float* fin(const Frame& F, int i) {
    const unsigned long long v = ((const LAS unsigned long long*)(F.lds + MISC_OFF + 256))[i];
    const unsigned lo = __builtin_amdgcn_readfirstlane((unsigned)v), hi = __builtin_amdgcn_readfirstlane((unsigned)(v >> 32));
    return (const float*)(const GAS float*)(((unsigned long long)hi << 32) | lo);
}
enum { I_X = 0, I_P, I_GMIX, I_WIN, I_WPOOL, I_PSCALE, I_SINKS, I_RPE, I_WOUT, I_GFFN, I_WROUTER, I_RBIAS, I_WGATE, I_WUP, I_WDOWN, I_WSGATE, I_WSUP, I_WSDOWN, I_WPLEPROJ, I_GPLE, I_WPLEGATE, I_GFINAL };

__device__ __forceinline__ float wave_sum(float v) {
#pragma unroll
    for (int o = 1; o < 64; o <<= 1) v += __shfl_xor(v, o);
    return v;
}

using pg8::Unit;
struct EpiInProj {
    static constexpr int PERM = 1;
    unsigned char* ws;
    __device__ __forceinline__ void operator()(const f32x4 (&acc)[2][2][4][2], const Unit& u, int wr, int wc, int fr, int fq) const {
        const int row0 = u.pm * 256 + wr * 64 + fr;
        const size_t boff = WS_UBF + (size_t)(u.pn >= 4 ? 1 : 0) * (WS_QBF - WS_UBF) + (size_t)(u.pn >= 8 ? 1 : 0) * (WS_KV - WS_QBF);
        bf16* base = (bf16*)(ws + boff); const int ldc = (u.pn < 8) ? 1024 : 256; const int col0 = (u.pn & 3) * 256 + wc * 32 + 8 * fq;
#pragma unroll
        for (int ai = 0; ai < 2; ++ai)
#pragma unroll
            for (int m = 0; m < 4; ++m) { bf16* rowp = base + (size_t)(row0 + ai * 128 + m * 16) * ldc + col0;
#pragma unroll
                for (int bj = 0; bj < 2; ++bj) { const f32x4 v0 = acc[ai][bj][m][0], v1 = acc[ai][bj][m][1];
                    v4u w; w.x = pk2(v0[0], v0[1]); w.y = pk2(v0[2], v0[3]); w.z = pk2(v1[0], v1[1]); w.w = pk2(v1[2], v1[3]);
                    *(v4u*)(rowp + bj * 128) = w; } }
    }
};
struct EpiBf16Plain {
    static constexpr int PERM = 1;
    bf16* O; int ldc; int col_off; const float* scale;
    __device__ __forceinline__ void operator()(const f32x4 (&acc)[2][2][4][2], const Unit& u, int wr, int wc, int fr, int fq) const {
        const int row0 = u.pm * 256 + wr * 64 + fr, colt = u.pn * 256 + wc * 32 + 8 * fq;
        f32x4 sv[2][2];
#pragma unroll
        for (int bj = 0; bj < 2; ++bj)
#pragma unroll
            for (int n = 0; n < 2; ++n) sv[bj][n] = scale ? *(const f32x4*)(scale + col_off + colt + bj * 128 + 4 * n) : (f32x4){1.f, 1.f, 1.f, 1.f};
#pragma unroll
        for (int ai = 0; ai < 2; ++ai)
#pragma unroll
            for (int m = 0; m < 4; ++m) { bf16* rowp = O + (size_t)(row0 + ai * 128 + m * 16) * ldc + col_off + colt;
#pragma unroll
                for (int bj = 0; bj < 2; ++bj) { const f32x4 v0 = acc[ai][bj][m][0] * sv[bj][0], v1 = acc[ai][bj][m][1] * sv[bj][1];
                    v4u w; w.x = pk2(v0[0], v0[1]); w.y = pk2(v0[2], v0[3]); w.z = pk2(v1[0], v1[1]); w.w = pk2(v1[2], v1[3]);
                    *(v4u*)(rowp + bj * 128) = w; } }
    }
};
struct EpiResF32 {
    static constexpr int PERM = 0;
    const float* base; float* C;
    __device__ __forceinline__ void operator()(const f32x4 (&acc)[2][2][4][2], const Unit& u, int wr, int wc, int fr, int fq) const {
        const int row0 = u.pm * 256 + wr * 64 + fr, col0 = u.pn * 256 + wc * 32 + 4 * fq;
#pragma unroll
        for (int ai = 0; ai < 2; ++ai)
#pragma unroll
            for (int mp = 0; mp < 2; ++mp) { f32x4 xb[2][2][2];
#pragma unroll
                for (int mm = 0; mm < 2; ++mm) { const size_t ro = (size_t)(row0 + ai * 128 + (2 * mp + mm) * 16) * D + col0;
#pragma unroll
                    for (int bj = 0; bj < 2; ++bj)
#pragma unroll
                        for (int n = 0; n < 2; ++n) xb[mm][bj][n] = *(const f32x4*)(base + ro + bj * 128 + n * 16); }
#pragma unroll
                for (int mm = 0; mm < 2; ++mm) { const size_t ro = (size_t)(row0 + ai * 128 + (2 * mp + mm) * 16) * D + col0;
#pragma unroll
                    for (int bj = 0; bj < 2; ++bj)
#pragma unroll
                        for (int n = 0; n < 2; ++n) *(f32x4*)(C + ro + bj * 128 + n * 16) = xb[mm][bj][n] + acc[ai][bj][2 * mp + mm][n]; } }
    }
};
__device__ __forceinline__ float sigmoid_f(float v) { return __builtin_amdgcn_rcpf(1.0f + __expf(-v)); }
__device__ __forceinline__ unsigned pk4_fp8(float a, float b, float c, float d) { int w = 0; w = __builtin_amdgcn_cvt_pk_fp8_f32(a, b, w, false); w = __builtin_amdgcn_cvt_pk_fp8_f32(c, d, w, true); return (unsigned)w; }
typedef float f32x2_ __attribute__((ext_vector_type(2)));
__device__ __forceinline__ void fp8x4_to_f32(unsigned w, float (&o)[4]) { const f32x2_ lo = __builtin_amdgcn_cvt_pk_f32_fp8((int)w, false), hi = __builtin_amdgcn_cvt_pk_f32_fp8((int)w, true); o[0] = lo[0]; o[1] = lo[1]; o[2] = hi[0]; o[3] = hi[1]; }
struct EpiGateUp {
    static constexpr int PERM = 1;
    unsigned char* ACT;
    __device__ __forceinline__ void operator()(const f32x4 (&acc)[2][2][4][2], const Unit& u, int wr, int wc, int fr, int fq) const {
        const int row0 = u.pm * 256 + wr * 64 + fr, col0 = (u.pn & 3) * 128 + wc * 32 + 8 * fq;
        constexpr float IS = 1.0f / SW1;
#pragma unroll
        for (int ai = 0; ai < 2; ++ai) { if (ai == 1 && u.half) break;
#pragma unroll
            for (int m = 0; m < 4; ++m) { float o[8];
#pragma unroll
                for (int n = 0; n < 2; ++n)
#pragma unroll
                    for (int j = 0; j < 4; ++j) { const float gte = acc[ai][0][m][n][j] * IS, up = acc[ai][1][m][n][j] * (IS * SA); o[4 * n + j] = gte * sigmoid_f(gte) * up; }
                v2u w; w.x = pk4_fp8(o[0], o[1], o[2], o[3]); w.y = pk4_fp8(o[4], o[5], o[6], o[7]);
                *(v2u*)(ACT + (size_t)(row0 + ai * 128 + m * 16) * EFF + col0) = w; } }
    }
};
struct EpiDown {
    static constexpr int PERM = 2;
    unsigned char* Y;
    __device__ __forceinline__ void operator()(const f32x4 (&acc)[2][2][4][2], const Unit& u, int wr, int wc, int fr, int fq) const {
        const int row0 = u.pm * 256 + wr * 64 + fr, col0 = (u.pn & 7) * 256 + wc * 64 + 16 * fq;
        constexpr float IS = SY / (SA * SW2);
#pragma unroll
        for (int ai = 0; ai < 2; ++ai) { if (ai == 1 && u.half) break;
#pragma unroll
            for (int m = 0; m < 4; ++m) { const f32x4 v0 = acc[ai][0][m][0] * IS, v1 = acc[ai][0][m][1] * IS, v2 = acc[ai][1][m][0] * IS, v3 = acc[ai][1][m][1] * IS;
                v4u w; w.x = pk4_fp8(v0[0], v0[1], v0[2], v0[3]); w.y = pk4_fp8(v1[0], v1[1], v1[2], v1[3]); w.z = pk4_fp8(v2[0], v2[1], v2[2], v2[3]); w.w = pk4_fp8(v3[0], v3[1], v3[2], v3[3]);
                *(v4u*)(Y + (size_t)(row0 + ai * 128 + m * 16) * D + col0) = w; } }
    }
};
struct EpiBf16Mul {
    static constexpr int PERM = 1;
    bf16* O; float mul;
    __device__ __forceinline__ void operator()(const f32x4 (&acc)[2][2][4][2], const Unit& u, int wr, int wc, int fr, int fq) const {
        const int row0 = u.pm * 256 + wr * 64 + fr, colt = u.pn * 256 + wc * 32 + 8 * fq;
#pragma unroll
        for (int ai = 0; ai < 2; ++ai)
#pragma unroll
            for (int m = 0; m < 4; ++m) { bf16* rowp = O + (size_t)(row0 + ai * 128 + m * 16) * D + colt;
#pragma unroll
                for (int bj = 0; bj < 2; ++bj) { const f32x4 v0 = acc[ai][bj][m][0] * mul, v1 = acc[ai][bj][m][1] * mul;
                    v4u w; w.x = pk2(v0[0], v0[1]); w.y = pk2(v0[2], v0[3]); w.z = pk2(v1[0], v1[1]); w.w = pk2(v1[2], v1[3]);
                    *(v4u*)(rowp + bj * 128) = w; } }
    }
};
struct MoeOrder {
    static constexpr bool HALVES = true;
    const LAS int* tab; const int* toklist; int x, r, npn, stride;
    __device__ __forceinline__ bool next(int i, Unit& u) const {
        const int L = i * stride + r; const int tl = L / npn, pn = L - tl * npn;
        const int nf = tab[TB_XF + 8], ns = tab[TB_SHN], nh = tab[TB_XH + 8];
        if (tl >= nf + ns + nh) return false;
        int e, lt, row0, half = 0;
        if (tl < nf) { int s = 0;
#pragma unroll
            for (int q = 1; q <= 7; ++q) s += (tl >= tab[TB_XF + q]) ? 1 : 0;
            lt = tl - tab[TB_XF + s]; e = x + 8 * s; row0 = tab[TB_PAD + e] + 256 * lt; }
        else if (tl < nf + ns) { lt = tab[TB_SH0] + (tl - nf); e = NE; row0 = SH_ROW0 + 256 * lt; }
        else { const int hi = tl - nf - ns; int s = 0;
#pragma unroll
            for (int q = 1; q <= 7; ++q) s += (hi >= tab[TB_XH + q]) ? 1 : 0;
            e = x + 8 * s; lt = tab[TB_XF + s + 1] - tab[TB_XF + s]; row0 = tab[TB_PAD + e] + 256 * lt; half = 1; }
        u.pm = __builtin_amdgcn_readfirstlane(row0 >> 8); u.pn = __builtin_amdgcn_readfirstlane(e * npn + pn); u.e = __builtin_amdgcn_readfirstlane(e); u.lt = __builtin_amdgcn_readfirstlane(lt);
        u.half = __builtin_amdgcn_readfirstlane(half); return true;
    }
    __device__ __forceinline__ int arow(const Unit& u, int r_) const {
        const int lr = u.lt * 256 + r_;
        const int ee = (u.e < NE) ? u.e : 0;
        const int tk = toklist[(size_t)ee * T + (lr < T - 1 ? lr : T - 1)];
        return (u.e == NE) ? lr : ((lr < tab[TB_CNT + ee]) ? tk : 0);
    }
};
__device__ __forceinline__ void moe_tables(Frame& F) {
    const int LANE_ = pg8::lane_id(), TID_ = F.wave * 64 + LANE_; (void)TID_;
    LAS int* tab = (LAS int*)(F.lds + TAB_OFF);
    const int x = F.bx & 7;
    if (F.wave == 0) {
        const int e = LANE_, c = (int)__hip_atomic_load(F.ctl + CW_CNT + 32 * e, RLX_AGENT), nt = (c + 255) >> 8;
        const int hf = (nt > 0 && (c - ((nt - 1) << 8)) <= 128) ? 1 : 0, fl = nt - hf;
        tab[TB_CNT + e] = c; if (e == 0) tab[TB_CNT + NE] = T;
        int inc = nt << 8;
#pragma unroll
        for (int o = 1; o < 64; o <<= 1) { const int v = __shfl_up(inc, o); inc += (e >= o) ? v : 0; }
        tab[TB_PAD + e] = inc - (nt << 8); if (e == 63) tab[TB_PAD + NE] = inc;
        int ld = 2 * fl + hf;
        ld += __shfl_xor(ld, 8); ld += __shfl_xor(ld, 16); ld += __shfl_xor(ld, 32);
        int cf = fl, ch = hf;
#pragma unroll
        for (int o = 8; o < 64; o <<= 1) { const int vf = __shfl_up(cf, o), vh = __shfl_up(ch, o); cf += (e >= o) ? vf : 0; ch += (e >= o) ? vh : 0; }
        if ((e & 7) == x) { tab[TB_XF + (e >> 3) + 1] = cf; tab[TB_XH + (e >> 3) + 1] = ch; }
        if (e == 0) { tab[TB_XF] = 0; tab[TB_XH] = 0; }
        int load[8], nsh[8];
#pragma unroll
        for (int l = 0; l < 8; ++l) { load[l] = __shfl(ld, l); nsh[l] = 0; }
        for (int j = 0; j < 32; ++j) { int best = 0, bl = load[0];
#pragma unroll
            for (int l = 1; l < 8; ++l) { const bool lt_ = load[l] < bl; best = lt_ ? l : best; bl = lt_ ? load[l] : bl; }
#pragma unroll
            for (int l = 0; l < 8; ++l) { nsh[l] += (l == best) ? 1 : 0; load[l] += (l == best) ? 2 : 0; } }
        int s0 = 0, sn = 0;
#pragma unroll
        for (int l = 0; l < 8; ++l) { s0 += (l < x) ? nsh[l] : 0; sn = (l == x) ? nsh[l] : sn; }
        if (e == 0) { tab[TB_SH0] = s0; tab[TB_SHN] = sn; }
    }
    __syncthreads();
}
struct ConvJob { const float* src; bf16* dst; int N, ldk, mode, item; };
struct ConvJob8 { const float* src; unsigned char* dst; int N, ldk, mode, item; float scale; };
__device__ __forceinline__ void conv8_load(const ConvJob8& j, int lane, f32x4 (&v)[16]) {
    const int nblk = j.N >> 5, kb = j.item / nblk, nb = j.item - kb * nblk, k0 = 128 * kb, n0 = 32 * nb;
    const float* src = j.src + (size_t)(k0 + 16 * (lane >> 3)) * j.N + n0 + 4 * (lane & 7);
#pragma unroll
    for (int i = 0; i < 16; ++i) v[i] = __builtin_nontemporal_load((const f32x4*)(src + (size_t)i * j.N));
}
__device__ __forceinline__ void conv8_store(const ConvJob8& j, int lane, const f32x4 (&v)[16]) {
    const int nblk = j.N >> 5, kb = j.item / nblk, nb = j.item - kb * nblk, k0 = 128 * kb, n0 = 32 * nb; const float scale = j.scale;
#pragma unroll
    for (int q = 0; q < 4; ++q) { const int n = n0 + 4 * (lane & 7) + q; int dr = n;
        if (j.mode == 5) dr = ((n >> 7) << 8) + (n & 127); else if (j.mode == 6) dr = ((n >> 7) << 8) + 128 + (n & 127);
        v4u o; o.x = pk4_fp8(v[0][q] * scale, v[1][q] * scale, v[2][q] * scale, v[3][q] * scale); o.y = pk4_fp8(v[4][q] * scale, v[5][q] * scale, v[6][q] * scale, v[7][q] * scale);
        o.z = pk4_fp8(v[8][q] * scale, v[9][q] * scale, v[10][q] * scale, v[11][q] * scale); o.w = pk4_fp8(v[12][q] * scale, v[13][q] * scale, v[14][q] * scale, v[15][q] * scale);
        __builtin_nontemporal_store(o, (v4u*)(j.dst + (size_t)dr * j.ldk + k0 + 16 * (lane >> 3))); }
}
__device__ __forceinline__ void conv_load(const ConvJob& j, int lane, f32x4 (&v)[8]) {
    const int nblk = j.N >> 5, kb = j.item / nblk, nb = j.item - kb * nblk, k0 = 64 * kb, n0 = 32 * nb;
    const float* src = j.src + (size_t)(k0 + 8 * (lane >> 3)) * j.N + n0 + 4 * (lane & 7);
#pragma unroll
    for (int i = 0; i < 8; ++i) v[i] = __builtin_nontemporal_load((const f32x4*)(src + (size_t)i * j.N));
}
__device__ __forceinline__ void conv_store(const ConvJob& j, int lane, const f32x4 (&v)[8]) {
    const int nblk = j.N >> 5, kb = j.item / nblk, nb = j.item - kb * nblk, k0 = 64 * kb, n0 = 32 * nb;
#pragma unroll
    for (int q = 0; q < 4; ++q) { const int n = n0 + 4 * (lane & 7) + q; int dr = n;
        if (j.mode == 1) dr = ((n >> 7) << 8) + (n & 127); else if (j.mode == 2) dr = ((n >> 7) << 8) + 128 + (n & 127);
        v4u o; o.x = pk2(v[0][q], v[1][q]); o.y = pk2(v[2][q], v[3][q]); o.z = pk2(v[4][q], v[5][q]); o.w = pk2(v[6][q], v[7][q]);
        *(v4u*)(j.dst + (size_t)dr * j.ldk + k0 + 8 * (lane >> 3)) = o; }
}
__device__ __forceinline__ void rms_row_to_bf16(const float* xrow, const float* g, bf16* orow, int lane) {
    f32x4 v[8]; float s = 0.f;
#pragma unroll
    for (int j = 0; j < 4; ++j) { v[2 * j] = *(const f32x4*)(xrow + 512 * j + 8 * lane); v[2 * j + 1] = *(const f32x4*)(xrow + 512 * j + 8 * lane + 4); }
#pragma unroll
    for (int j = 0; j < 8; ++j) s += (v[j][0] * v[j][0] + v[j][1] * v[j][1]) + (v[j][2] * v[j][2] + v[j][3] * v[j][3]);
    const float rstd = 1.0f / sqrtf(wave_sum(s) * (1.0f / D) + EPS);
#pragma unroll
    for (int j = 0; j < 4; ++j) { const f32x4 g0 = *(const f32x4*)(g + 512 * j + 8 * lane), g1 = *(const f32x4*)(g + 512 * j + 8 * lane + 4);
        const f32x4 a = v[2 * j] * rstd * g0, b = v[2 * j + 1] * rstd * g1;
        v4u o; o.x = pk2(a[0], a[1]); o.y = pk2(a[2], a[3]); o.z = pk2(b[0], b[1]); o.w = pk2(b[2], b[3]);
        *(v4u*)(orow + 512 * j + 8 * lane) = o; }
}
constexpr int CV_G1 = (D / 128) * (EFF / 32), CV_D1 = (EFF / 128) * (D / 32), CV_G = 65 * CV_G1, CV_DN = 65 * CV_D1, CV_PG = (D / 128) * (D / 32), CV_TOTAL = 2 * CV_G + CV_DN + CV_PG;
constexpr int CONV_B = 896 * 16, CONV_C = 1024 * 20, CONV_A = CV_TOTAL - CONV_B - CONV_C;
__device__ __forceinline__ ConvJob8 conv8_decode(Frame& F, int it) {
    unsigned char* WGU8 = F.ws + WS_WGU; unsigned char* WDN8 = F.ws + WS_WD;
    int r = it;
    if (r < CV_G) { const int e = r / CV_G1, li = r - e * CV_G1; const float* src = (e < NE) ? fin(F, I_WGATE) + (size_t)e * D * EFF : fin(F, I_WSGATE);
        return ConvJob8{src, WGU8 + (size_t)e * 1024 * D, EFF, D, 5, li, SW1}; } r -= CV_G;
    if (r < CV_G) { const int e = r / CV_G1, li = r - e * CV_G1; const float* src = (e < NE) ? fin(F, I_WUP) + (size_t)e * D * EFF : fin(F, I_WSUP);
        return ConvJob8{src, WGU8 + (size_t)e * 1024 * D, EFF, D, 6, li, SW1}; } r -= CV_G;
    if (r < CV_DN) { const int e = r / CV_D1, li = r - e * CV_D1; const float* src = (e < NE) ? fin(F, I_WDOWN) + (size_t)e * EFF * D : fin(F, I_WSDOWN);
        return ConvJob8{src, WDN8 + (size_t)e * D * EFF, D, EFF, 4, li, SW2}; } r -= CV_DN;
    return ConvJob8{fin(F, I_WPLEGATE), F.ws + WS_WPG, D, D, 4, r, SW3};
}
__device__ __forceinline__ void conv_fp8_items(Frame& F, int lo, int hi, int rank, int nranks) {
    const int LANE_ = pg8::lane_id();
    int it0 = lo + rank; if (it0 >= hi) return;
    f32x4 va[16], vb[16];
    ConvJob8 j0 = conv8_decode(F, it0), j1 = j0; conv8_load(j0, LANE_, va);
    for (;;) {
        const int it1 = it0 + nranks; const bool has1 = it1 < hi;
        if (has1) { j1 = conv8_decode(F, it1); conv8_load(j1, LANE_, vb); }
        conv8_store(j0, LANE_, va);
        if (!has1) break;
        it0 = it1 + nranks; const bool has0 = it0 < hi;
        if (has0) { j0 = conv8_decode(F, it0); conv8_load(j0, LANE_, va); }
        conv8_store(j1, LANE_, vb);
        if (!has0) break;
    }
}
constexpr int SEG_N0 = 14000, SEG_N1 = 16000, SEG_N2 = CV_TOTAL - SEG_N0 - SEG_N1;
static_assert(SEG_N0 % 8 == 0 && SEG_N1 % 8 == 0 && SEG_N2 % 8 == 0 && SEG_N2 > 0, "queue segments");
__device__ __forceinline__ void conv_dyn(Frame& F, int seg) {
    const int LANE_ = pg8::lane_id(); const bool t0 = (F.wave == 0 && LANE_ == 0);
    const int x = F.bx & 7;
    const int segn = (seg == 0 ? SEG_N0 : (seg == 1 ? SEG_N1 : SEG_N2)) / 8, lo = (seg == 0 ? 0 : (seg == 1 ? SEG_N0 : SEG_N0 + SEG_N1)) + x * segn;
    gu32* ctr = F.ctl + CW_CONVQ + 32 * (seg * 8 + x);
    volatile LAS unsigned* Q = F.MISC + 16;
    __syncthreads();
    if (t0) { const unsigned a = __hip_atomic_fetch_add(ctr, 8u, RLX_AGENT), b = __hip_atomic_fetch_add(ctr, 8u, RLX_AGENT); Q[0] = a; Q[1] = b; }
    __syncthreads();
    int c0 = __builtin_amdgcn_readfirstlane((int)Q[0]), c1 = __builtin_amdgcn_readfirstlane((int)Q[1]);
    f32x4 va[16], vb[16]; ConvJob8 ja, jb;
    bool ha = (c0 + F.wave) < segn, hb = false;
    ja = conv8_decode(F, lo + (ha ? c0 + F.wave : 0)); jb = ja;
    if (ha) conv8_load(ja, LANE_, va);
    for (;;) {
        unsigned vn = 0u; if (t0) vn = __hip_atomic_fetch_add(ctr, 8u, RLX_AGENT);
        hb = (c1 + F.wave) < segn; if (hb) { jb = conv8_decode(F, lo + c1 + F.wave); conv8_load(jb, LANE_, vb); }
        if (ha) conv8_store(ja, LANE_, va);
        if (c0 >= segn) break;
        __syncthreads(); if (t0) Q[0] = vn; __syncthreads();
        c0 = __builtin_amdgcn_readfirstlane((int)Q[0]);
        vn = 0u; if (t0) vn = __hip_atomic_fetch_add(ctr, 8u, RLX_AGENT);
        ha = (c0 + F.wave) < segn; if (ha) { ja = conv8_decode(F, lo + c0 + F.wave); conv8_load(ja, LANE_, va); }
        if (hb) conv8_store(jb, LANE_, vb);
        if (c1 >= segn) break;
        __syncthreads(); if (t0) Q[1] = vn; __syncthreads();
        c1 = __builtin_amdgcn_readfirstlane((int)Q[1]);
    }
    __syncthreads();
}
__device__ __forceinline__ void p0_prologue(Frame& F) {
    const int LANE_ = pg8::lane_id(), TID_ = F.wave * 64 + LANE_; (void)TID_;
    const int gw = F.bx * NWAVES + F.wave, NGW = F.G * NWAVES;
    bf16* WIN = (bf16*)(F.ws + WS_WIN); bf16* WPOOL = (bf16*)(F.ws + WS_WPOOL); bf16* WOUT = (bf16*)(F.ws + WS_WOUT); bf16* WPP = (bf16*)(F.ws + WS_WPP);
    constexpr int I_IN = (D / 64) * (INW / 32), I_PL = 4 * (256 / 64) * (256 / 32), I_OUT = (D / 64) * (D / 32), I_PP = (PLE / 64) * (D / 32), I_PG = (D / 64) * (D / 32);
    constexpr int I_SMALL = I_IN + I_PL + I_OUT + I_PP; (void)I_PG;
    auto decode = [&](int it) -> ConvJob {
        int r = it;
        if (r < I_IN) return ConvJob{fin(F, I_WIN), WIN, INW, D, 0, r}; r -= I_IN;
        if (r < I_PL) { const int gq = r >> 5; return ConvJob{fin(F, I_WPOOL) + (size_t)gq * 65536, WPOOL + (size_t)gq * 65536, 256, 256, 0, r & 31}; } r -= I_PL;
        if (r < I_OUT) return ConvJob{fin(F, I_WOUT), WOUT, D, D, 0, r}; r -= I_OUT;
        return ConvJob{fin(F, I_WPLEPROJ), WPP, D, PLE, 0, r};
    };
    for (int it = gw; it < I_SMALL; it += 2 * NGW) {
        const ConvJob j0 = decode(it); const bool two = (it + NGW) < I_SMALL; const ConvJob j1 = decode(two ? it + NGW : it);
        f32x4 v0[8], v1[8];
        conv_load(j0, LANE_, v0); conv_load(j1, LANE_, v1);
        conv_store(j0, LANE_, v0); if (two) conv_store(j1, LANE_, v1);
    }
    if (F.G != 256) conv_fp8_items(F, 0, CONV_A, gw, NGW);
    { const float* WR = fin(F, I_WROUTER); bf16* WH = (bf16*)(F.ws + WS_WRT); bf16* WL = WH + (size_t)NE * D;
      for (int i = gw * 64 + LANE_; i < NE * (D / 8); i += NGW * 64) { const int e = i & 63, k0 = (i >> 6) * 8; float x[8]; unsigned hh[8], ll[8];
#pragma unroll
          for (int j = 0; j < 8; ++j) x[j] = WR[(size_t)(k0 + j) * NE + e];
#pragma unroll
          for (int j = 0; j < 8; ++j) { hh[j] = pk2(x[j], 0.f) & 0xffffu; ll[j] = pk2(x[j] - bf_lo(hh[j]), 0.f) & 0xffffu; }
          v4u oh, ol; oh.x = hh[0] | (hh[1] << 16); oh.y = hh[2] | (hh[3] << 16); oh.z = hh[4] | (hh[5] << 16); oh.w = hh[6] | (hh[7] << 16);
          ol.x = ll[0] | (ll[1] << 16); ol.y = ll[2] | (ll[3] << 16); ol.z = ll[4] | (ll[5] << 16); ol.w = ll[6] | (ll[7] << 16);
          *(v4u*)(WH + (size_t)e * D + k0) = oh; *(v4u*)(WL + (size_t)e * D + k0) = ol; } }
    { const float* P = fin(F, I_P); bf16* PB = (bf16*)(F.ws + WS_PBF);
      for (int i = gw * 64 + LANE_; i < T * PLE / 8; i += NGW * 64) { const f32x4 a = *(const f32x4*)(P + (size_t)i * 8), b = *(const f32x4*)(P + (size_t)i * 8 + 4);
          v4u o; o.x = pk2(a[0], a[1]); o.y = pk2(a[2], a[3]); o.z = pk2(b[0], b[1]); o.w = pk2(b[2], b[3]); *(v4u*)(PB + (size_t)i * 8) = o; } }
    bf16* ABF = (bf16*)(F.ws + WS_ABF);
    for (int m = gw; m < T; m += NGW) rms_row_to_bf16(fin(F, I_X) + (size_t)m * D, fin(F, I_GMIX), ABF + (size_t)m * D, LANE_);
    if (F.G == 256) conv_dyn(F, 0);
}

__device__ __forceinline__ int t5_bucket(int n) {
    if (n < 16) return n;
    const int large = 16 + (int)(logf((float)n * (1.0f / 16.0f)) / logf(8.0f) * 16.0f);
    return large < 31 ? large : 31;
}
constexpr int VT_LD = 216, VT_KEYS = 208, KT_LD = 72;
constexpr int ATT_KT_OFF = 0, ATT_VT_OFF = VT_KEYS * KT_LD * 2;
__device__ __forceinline__ void attn_task(Frame& F, const LAS float* btab, const LAS bf16* ktl, const LAS bf16* vtl, int b, int kvh, int hg, int qt, const bf16x8 (&qf)[2]) {
    const int LANE_ = pg8::lane_id();
    bf16* MIX = (bf16*)(F.ws + WS_MIX);
    const int lane = LANE_, qi = lane & 15, g = lane >> 4, h = kvh * 8 + hg;
    const int q0 = qt * 16, tok0 = b * SEQ, kl0 = 16 * (qt & 3);
    f32x4 s[5][2];
#pragma unroll
    for (int kb = 0; kb < 5; ++kb)
#pragma unroll
        for (int t = 0; t < 2; ++t) {
            const LAS bf16* kp = ktl + (kl0 + 32 * kb + 16 * t + qi) * KT_LD + 8 * g;
            const bf16x8 k0f = *(const LAS bf16x8*)(kp), k1f = *(const LAS bf16x8*)(kp + 32);
            f32x4 a = (f32x4){0.f, 0.f, 0.f, 0.f};
            a = __builtin_amdgcn_mfma_f32_16x16x32_bf16(k0f, qf[0], a, 0, 0, 0);
            a = __builtin_amdgcn_mfma_f32_16x16x32_bf16(k1f, qf[1], a, 0, 0, 0);
            s[kb][t] = a;
        }
    const float sink = fin(F, I_SINKS)[h];
    const LAS float* bt = btab + hg * 128;
    float mx = sink;
#pragma unroll
    for (int kb = 0; kb < 5; ++kb)
#pragma unroll
        for (int t = 0; t < 2; ++t)
#pragma unroll
            for (int r = 0; r < 4; ++r) {
                const int key = q0 - 128 + 32 * kb + 16 * t + 4 * g + r, dist = q0 + qi - key;
                const bool valid = (dist >= 0) && (dist < 128) && (key >= 0);
                const float lg = valid ? s[kb][t][r] * 0.125f + bt[dist & 127] : -3.0e38f;
                s[kb][t][r] = lg; mx = fmaxf(mx, lg);
            }
    mx = fmaxf(mx, __shfl_xor(mx, 16)); mx = fmaxf(mx, __shfl_xor(mx, 32));
    float sum = 0.f;
#pragma unroll
    for (int kb = 0; kb < 5; ++kb)
#pragma unroll
        for (int t = 0; t < 2; ++t)
#pragma unroll
            for (int r = 0; r < 4; ++r) { const float lg = s[kb][t][r]; const float p = (lg > -1.0e38f) ? __expf(lg - mx) : 0.f; s[kb][t][r] = p; sum += p; }
    sum += __shfl_xor(sum, 16); sum += __shfl_xor(sum, 32);
    const float inv = 1.0f / (sum + __expf(sink - mx));
    f32x4 o[4];
#pragma unroll
    for (int dt = 0; dt < 4; ++dt) o[dt] = (f32x4){0.f, 0.f, 0.f, 0.f};
#pragma unroll
    for (int kb = 0; kb < 5; ++kb) {
        v4u pw; pw.x = pk2(s[kb][0][0], s[kb][0][1]); pw.y = pk2(s[kb][0][2], s[kb][0][3]); pw.z = pk2(s[kb][1][0], s[kb][1][1]); pw.w = pk2(s[kb][1][2], s[kb][1][3]);
        const bf16x8 pf = __builtin_bit_cast(bf16x8, pw);
        const int kkl = kl0 + 32 * kb + 4 * g;
#pragma unroll
        for (int dt = 0; dt < 4; ++dt) {
            const LAS bf16* vp = vtl + (16 * dt + qi) * VT_LD + kkl;
            const v2u lo = *(const LAS v2u*)(vp), hi = *(const LAS v2u*)(vp + 16);
            const v4u vw = (v4u){lo.x, lo.y, hi.x, hi.y};
            o[dt] = __builtin_amdgcn_mfma_f32_16x16x32_bf16(__builtin_bit_cast(bf16x8, vw), pf, o[dt], 0, 0, 0);
        }
    }
    bf16* op = MIX + (size_t)(tok0 + q0 + qi) * D + POOLW + h * 64 + 4 * g;
#pragma unroll
    for (int dt = 0; dt < 4; ++dt) { v2u w; w.x = pk2(o[dt][0] * inv, o[dt][1] * inv); w.y = pk2(o[dt][2] * inv, o[dt][3] * inv); *(v2u*)(op + 16 * dt) = w; }
}
__device__ __forceinline__ void attn_block(Frame& F, int blk, bool fill_btab) {
    const int TID_ = F.wave * 64 + pg8::lane_id();
    LAS float* btab = (LAS float*)(F.lds + TAB_OFF + 2048);
    LAS bf16* ktl = (LAS bf16*)(F.lds + RING_OFF + ATT_KT_OFF); LAS bf16* vtl = (LAS bf16*)(F.lds + RING_OFF + ATT_VT_OFF);
    const int b = blk >> 6, kvh = (blk >> 5) & 1, qg = blk & 31;
    const bf16* Q = (const bf16*)(F.ws + WS_QBF); const bf16* KVp = (const bf16*)(F.ws + WS_KV);
    bf16x8 qf[4][2];
    { const int lane = TID_ & 63, qi = lane & 15, g = lane >> 4, h = kvh * 8 + F.wave;
#pragma unroll
      for (int i = 0; i < 4; ++i)
#pragma unroll
          for (int ks = 0; ks < 2; ++ks) qf[i][ks] = *(const bf16x8*)(Q + (size_t)(b * SEQ + 64 * qg + 16 * i + qi) * 1024 + h * 64 + 32 * ks + 8 * g); }
    v4u kv[4], vv[4];
#pragma unroll
    for (int it = 0; it < 4; ++it) { const int idx = TID_ + it * NWAVES * 64, kl = idx >> 3, c = idx & 7, key = 64 * qg - 128 + kl;
        kv[it] = (v4u){0u, 0u, 0u, 0u}; vv[it] = (v4u){0u, 0u, 0u, 0u};
        if (idx < VT_KEYS * 8 && key >= 0 && key < SEQ) { const bf16* rp = KVp + (size_t)(b * SEQ + key) * (2 * KVW) + kvh * 64 + 8 * c; kv[it] = *(const v4u*)(rp); vv[it] = *(const v4u*)(rp + KVW); } }
    __syncthreads();
    if (fill_btab) for (int i = TID_; i < 1024; i += NWAVES * 64) { const int hg = i >> 7, dist = i & 127; btab[i] = fin(F, I_RPE)[t5_bucket(dist) * NH + kvh * 8 + hg]; }
#pragma unroll
    for (int it = 0; it < 4; ++it) { const int idx = TID_ + it * NWAVES * 64, kl = idx >> 3, c = idx & 7;
        if (idx < VT_KEYS * 8) { const v4u v = vv[it];
            *(LAS v4u*)(ktl + kl * KT_LD + 8 * c) = kv[it];
            LAS bf16* d0 = vtl + (8 * c) * VT_LD + kl;
            d0[0 * VT_LD] = (bf16)(v.x & 0xffffu); d0[1 * VT_LD] = (bf16)(v.x >> 16); d0[2 * VT_LD] = (bf16)(v.y & 0xffffu); d0[3 * VT_LD] = (bf16)(v.y >> 16);
            d0[4 * VT_LD] = (bf16)(v.z & 0xffffu); d0[5 * VT_LD] = (bf16)(v.z >> 16); d0[6 * VT_LD] = (bf16)(v.w & 0xffffu); d0[7 * VT_LD] = (bf16)(v.w >> 16); } }
    __syncthreads();
#pragma unroll
    for (int i = 0; i < 4; ++i) attn_task(F, btab, ktl, vtl, b, kvh, F.wave, 4 * qg + i, qf[i]);
}
__device__ __forceinline__ void pool_task(Frame& F, int mt, int gq) {
    const int LANE_ = pg8::lane_id(), TID_ = F.wave * 64 + LANE_;
    const bf16* U = (const bf16*)(F.ws + WS_UBF); bf16* PO = (bf16*)(F.ws + WS_POOLED);
    LAS v4u* UL = (LAS v4u*)(F.lds + RING_OFF);
    const int w = 2 << gq;
    for (int hh = 0; hh < 2; ++hh) {
        const int tbase = mt * 256 + 128 * hh, pos0 = tbase & (SEQ - 1);
        __syncthreads();
        for (int idx = TID_; idx < 143 * 32; idx += NWAVES * 64) { const int r = idx >> 5, c = idx & 31;
            v4u x = (v4u){0u, 0u, 0u, 0u}; if (pos0 - 15 + r >= 0) x = *(const v4u*)(U + (size_t)(tbase - 15 + r) * POOLW + gq * 256 + 8 * c);
            UL[idx] = x; }
        __syncthreads();
        const int c = TID_ & 31, i0 = (TID_ >> 5) * 8;
        float run[8];
#pragma unroll
        for (int q = 0; q < 8; ++q) run[q] = 0.f;
        for (int j = 1; j < w; ++j) { const v4u x = UL[(15 + i0 - j) * 32 + c];
            run[0] += bf_lo(x.x); run[1] += bf_hi(x.x); run[2] += bf_lo(x.y); run[3] += bf_hi(x.y); run[4] += bf_lo(x.z); run[5] += bf_hi(x.z); run[6] += bf_lo(x.w); run[7] += bf_hi(x.w); }
#pragma unroll
        for (int i = 0; i < 8; ++i) {
            const int pos = pos0 + i0 + i; const v4u x = UL[(15 + i0 + i) * 32 + c], y = UL[(15 + i0 + i - w + 1) * 32 + c];
            const float uv[8] = {bf_lo(x.x), bf_hi(x.x), bf_lo(x.y), bf_hi(x.y), bf_lo(x.z), bf_hi(x.z), bf_lo(x.w), bf_hi(x.w)};
            const float ic = 1.0f / (float)((pos + 1) < w ? (pos + 1) : w);
            float o[8];
#pragma unroll
            for (int q = 0; q < 8; ++q) { run[q] += uv[q]; o[q] = run[q] * ic - uv[q]; }
            v4u ow; ow.x = pk2(o[0], o[1]); ow.y = pk2(o[2], o[3]); ow.z = pk2(o[4], o[5]); ow.w = pk2(o[6], o[7]);
            *(v4u*)(PO + (size_t)(tbase + i0 + i) * POOLW + gq * 256 + 8 * c) = ow;
            run[0] -= bf_lo(y.x); run[1] -= bf_hi(y.x); run[2] -= bf_lo(y.y); run[3] -= bf_hi(y.y); run[4] -= bf_lo(y.z); run[5] -= bf_hi(y.z); run[6] -= bf_lo(y.w); run[7] -= bf_hi(y.w);
        }
    }
    VM_WAIT(); __syncthreads();
    pg8::Gemm g{(const bf16*)PO + gq * 256, (const bf16*)(F.ws + WS_WPOOL) + (size_t)gq * 65536, POOLW, 256, 256};
    pg8::SingleOrder S{mt, 0};
    EpiBf16Plain E{(bf16*)(F.ws + WS_MIX), D, gq * 256, fin(F, I_PSCALE)};
    pg8::gemm_phase<EpiBf16Plain, pg8::SingleOrder, false>(F.lds + RING_OFF, g, S, E, F.wave);
}

constexpr int XS_STRIDE = 2052;
constexpr int P4_XS = 0, P4_PART = 16 * XS_STRIDE * 4, P4_SELE = P4_PART + 4 * 16 * 64 * 4, P4_SELW = P4_SELE + 32 * 8 * 4, P4_SELL = P4_SELW + 32 * 8 * 4, P4_HIST = P4_SELL + 32 * 8 * 4, P4_BASE = P4_HIST + 256, P4_END = P4_BASE + 256;
static_assert(P4_END <= MISC_OFF, "P4 LDS map");
__device__ __forceinline__ void p4_route(Frame& F) {
    const int LANE_ = pg8::lane_id(), TID_ = F.wave * 64 + LANE_; (void)TID_;
    LAS float* XS = (LAS float*)(F.lds + P4_XS); LAS float* PART = (LAS float*)(F.lds + P4_PART);
    LAS int* SELE = (LAS int*)(F.lds + P4_SELE); LAS float* SELW = (LAS float*)(F.lds + P4_SELW); LAS int* SELL = (LAS int*)(F.lds + P4_SELL);
    LAS int* HIST = (LAS int*)(F.lds + P4_HIST); LAS int* BASE = (LAS int*)(F.lds + P4_BASE);
    const float* H1 = F.out; unsigned char* XN = F.ws + WS_XN; const float* gf = fin(F, I_GFFN); const float* rb = fin(F, I_RBIAS);
    const bf16* WH = (const bf16*)(F.ws + WS_WRT); const bf16* WL = WH + (size_t)NE * D;
    const int lane = LANE_, wave = F.wave;
    if (TID_ < 64) HIST[TID_] = 0;
    for (int tile = F.bx; tile < T / 32; tile += F.G) {
    f32x4 gv[8];
#pragma unroll
    for (int j = 0; j < 4; ++j) { gv[2 * j] = *(const f32x4*)(gf + 512 * j + 8 * lane); gv[2 * j + 1] = *(const f32x4*)(gf + 512 * j + 8 * lane + 4); }
#pragma unroll 1
    for (int pass = 0; pass < 2; ++pass) {
        { f32x4 xr[2][8];
#pragma unroll
          for (int q = 0; q < 2; ++q) { const float* xrow = H1 + (size_t)(tile * 32 + 16 * pass + 2 * wave + q) * D;
#pragma unroll
              for (int j = 0; j < 4; ++j) { xr[q][2 * j] = *(const f32x4*)(xrow + 512 * j + 8 * lane); xr[q][2 * j + 1] = *(const f32x4*)(xrow + 512 * j + 8 * lane + 4); } }
#pragma unroll
          for (int q = 0; q < 2; ++q) { const int tl = 2 * wave + q; float s = 0.f;
#pragma unroll
              for (int j = 0; j < 8; ++j) { const f32x4 v = xr[q][j]; s += (v[0] * v[0] + v[1] * v[1]) + (v[2] * v[2] + v[3] * v[3]); }
              const float rstd = 1.0f / sqrtf(wave_sum(s) * (1.0f / D) + EPS);
#pragma unroll
              for (int j = 0; j < 4; ++j) { const f32x4 a = xr[q][2 * j] * rstd * gv[2 * j], b = xr[q][2 * j + 1] * rstd * gv[2 * j + 1];
                  *(LAS f32x4*)(XS + tl * XS_STRIDE + 512 * j + 8 * lane) = a; *(LAS f32x4*)(XS + tl * XS_STRIDE + 512 * j + 8 * lane + 4) = b;
                  v2u o; o.x = pk4_fp8(a[0], a[1], a[2], a[3]); o.y = pk4_fp8(b[0], b[1], b[2], b[3]);
                  *(v2u*)(XN + (size_t)(tile * 32 + 16 * pass + tl) * D + 512 * j + 8 * lane) = o; } } }
        __syncthreads();
        {
            const int ti = lane & 15, kk = lane >> 4;
            f32x4 acc[4];
#pragma unroll
            for (int et = 0; et < 4; ++et) acc[et] = (f32x4){0.f, 0.f, 0.f, 0.f};
#pragma unroll 2
            for (int st = 0; st < 8; ++st) {
                const int k0 = 256 * wave + 32 * st + 8 * kk;
                const f32x4 xa = *(const LAS f32x4*)(XS + ti * XS_STRIDE + k0), xb = *(const LAS f32x4*)(XS + ti * XS_STRIDE + k0 + 4);
                v4u hw, lw;
                hw.x = pk2(xa[0], xa[1]); hw.y = pk2(xa[2], xa[3]); hw.z = pk2(xb[0], xb[1]); hw.w = pk2(xb[2], xb[3]);
                lw.x = pk2(xa[0] - bf_lo(hw.x), xa[1] - bf_hi(hw.x)); lw.y = pk2(xa[2] - bf_lo(hw.y), xa[3] - bf_hi(hw.y)); lw.z = pk2(xb[0] - bf_lo(hw.z), xb[1] - bf_hi(hw.z)); lw.w = pk2(xb[2] - bf_lo(hw.w), xb[3] - bf_hi(hw.w));
                const bf16x8 xh = __builtin_bit_cast(bf16x8, hw), xl = __builtin_bit_cast(bf16x8, lw);
#pragma unroll
                for (int et = 0; et < 4; ++et) { const bf16x8 wh = *(const bf16x8*)(WH + (size_t)(16 * et + ti) * D + k0), wl = *(const bf16x8*)(WL + (size_t)(16 * et + ti) * D + k0);
                    acc[et] = __builtin_amdgcn_mfma_f32_16x16x32_bf16(xh, wh, acc[et], 0, 0, 0);
                    acc[et] = __builtin_amdgcn_mfma_f32_16x16x32_bf16(xl, wh, acc[et], 0, 0, 0);
                    acc[et] = __builtin_amdgcn_mfma_f32_16x16x32_bf16(xh, wl, acc[et], 0, 0, 0); }
            }
            if (wave >= 4) {
#pragma unroll
                for (int et = 0; et < 4; ++et)
#pragma unroll
                    for (int r = 0; r < 4; ++r) PART[(wave - 4) * 1024 + (4 * kk + r) * 64 + 16 * et + ti] = acc[et][r];
            }
            __syncthreads();
            if (wave < 4) {
#pragma unroll
                for (int et = 0; et < 4; ++et)
#pragma unroll
                    for (int r = 0; r < 4; ++r) { LAS float* pp = PART + wave * 1024 + (4 * kk + r) * 64 + 16 * et + ti; *pp = *pp + acc[et][r]; }
            }
        }
        __syncthreads();
#pragma unroll 1
        for (int q = 0; q < 2; ++q) {
            const int tl = 2 * wave + q, tw = pass * 16 + tl;
            const float lg = (PART[tl * 64 + lane] + PART[1024 + tl * 64 + lane]) + (PART[2048 + tl * 64 + lane] + PART[3072 + tl * 64 + lane]);
            const float score = 1.0f / (1.0f + expf(-lg)), biased = score + rb[lane];
            const int grp = lane >> 3;
            float m1 = biased; m1 = fmaxf(m1, __shfl_xor(m1, 1)); m1 = fmaxf(m1, __shfl_xor(m1, 2)); m1 = fmaxf(m1, __shfl_xor(m1, 4));
            const unsigned long long bm = __ballot(biased == m1); const unsigned gb = (unsigned)(bm >> (8 * grp)) & 0xffu; const int first = __builtin_ctz(gb);
            float v2 = ((lane & 7) == first) ? -3.0e38f : biased; float m2 = v2; m2 = fmaxf(m2, __shfl_xor(m2, 1)); m2 = fmaxf(m2, __shfl_xor(m2, 2)); m2 = fmaxf(m2, __shfl_xor(m2, 4));
            const float gs = m1 + m2;
            int grank = 0;
#pragma unroll
            for (int j = 0; j < 8; ++j) { const float gj = __shfl(gs, 8 * j); grank += ((gj > gs) || (gj == gs && j < grp)) ? 1 : 0; }
            const bool gsel = grank < 4;
            const float masked = gsel ? biased : -3.0e38f;
            int rank = 0;
#pragma unroll
            for (int j = 0; j < 64; ++j) { const float vj = __shfl(masked, j); rank += ((vj > masked) || (vj == masked && j < lane)) ? 1 : 0; }
            const bool sel = gsel && (rank < 8);
            const float wsum = wave_sum(sel ? score : 0.f);
            const unsigned long long sm = __ballot(sel);
            if (sel) { const int k = __popcll(sm & ((1ull << lane) - 1ull)); const int li = atomicAdd((int*)&HIST[lane], 1);
                SELE[tw * 8 + k] = lane; SELW[tw * 8 + k] = score / wsum * 2.5f; SELL[tw * 8 + k] = li; }
        }
        __syncthreads();
    }
    if (TID_ < 64) BASE[TID_] = (int)__hip_atomic_fetch_add(F.ctl + CW_CNT + 32 * TID_, (unsigned)HIST[TID_], RLX_AGENT);
    __syncthreads();
    if (TID_ < 256) { const int e = SELE[TID_], pos = BASE[e] + SELL[TID_], tok = tile * 32 + (TID_ >> 3);
        ((int*)(F.ws + WS_TOKLIST))[(size_t)e * T + pos] = tok; ((float*)(F.ws + WS_WREC))[tok * 8 + (TID_ & 7)] = SELW[TID_]; ((int*)(F.ws + WS_REC))[tok * 8 + (TID_ & 7)] = e * T + pos; }
    __syncthreads();
    if (TID_ < 64) HIST[TID_] = 0;
    __syncthreads();
    }
}

__device__ __forceinline__ void p7_combine(Frame& F, bool dry) {
    const int LANE_ = pg8::lane_id();
    const LAS int* tab = (const LAS int*)(F.lds + TAB_OFF);
    const unsigned char* Y = F.ws + WS_Y; const int* rec = (const int*)(F.ws + WS_REC); const float* wrec = (const float*)(F.ws + WS_WREC);
    const float* H = F.out; bf16* HO = dry ? (bf16*)(F.ws + WS_WGU) : (bf16*)(F.ws + WS_H2B); unsigned char* H2 = dry ? (F.ws + WS_WGU + 64 * MiB) : (F.ws + WS_H2F8);
    const int gw = F.bx * NWAVES + F.wave, NGW = F.G * NWAVES, lane = LANE_;
    for (int t = gw; t < T; t += NGW) {
        int rows[9]; float rwt[9];
#pragma unroll
        for (int k = 0; k < 8; ++k) { const int rc = rec[t * 8 + k]; const int e = rc >> 13, pos = rc & (T - 1); rows[k] = tab[TB_PAD + e] + pos; rwt[k] = wrec[t * 8 + k] * (1.0f / SY); }
        rows[8] = SH_ROW0 + t; rwt[8] = 1.0f / SY;
        v4u y[2][9]; f32x4 h[2][4];
#pragma unroll
        for (int j = 0; j < 2; ++j) { const int c0 = 1024 * j + 16 * lane;
#pragma unroll
            for (int q = 0; q < 4; ++q) h[j][q] = *(const f32x4*)(H + (size_t)t * D + c0 + 4 * q);
#pragma unroll
            for (int k = 0; k < 9; ++k) y[j][k] = *(const v4u*)(Y + (size_t)rows[k] * D + c0); }
#pragma unroll
        for (int j = 0; j < 2; ++j) { const int c0 = 1024 * j + 16 * lane;
#pragma unroll
            for (int k = 0; k < 9; ++k) { const float w = rwt[k]; float f[4];
                fp8x4_to_f32(y[j][k].x, f); h[j][0][0] += w * f[0]; h[j][0][1] += w * f[1]; h[j][0][2] += w * f[2]; h[j][0][3] += w * f[3];
                fp8x4_to_f32(y[j][k].y, f); h[j][1][0] += w * f[0]; h[j][1][1] += w * f[1]; h[j][1][2] += w * f[2]; h[j][1][3] += w * f[3];
                fp8x4_to_f32(y[j][k].z, f); h[j][2][0] += w * f[0]; h[j][2][1] += w * f[1]; h[j][2][2] += w * f[2]; h[j][2][3] += w * f[3];
                fp8x4_to_f32(y[j][k].w, f); h[j][3][0] += w * f[0]; h[j][3][1] += w * f[1]; h[j][3][2] += w * f[2]; h[j][3][3] += w * f[3]; }
            { v4u b0, b1; b0.x = pk2(h[j][0][0], h[j][0][1]); b0.y = pk2(h[j][0][2], h[j][0][3]); b0.z = pk2(h[j][1][0], h[j][1][1]); b0.w = pk2(h[j][1][2], h[j][1][3]);
              b1.x = pk2(h[j][2][0], h[j][2][1]); b1.y = pk2(h[j][2][2], h[j][2][3]); b1.z = pk2(h[j][3][0], h[j][3][1]); b1.w = pk2(h[j][3][2], h[j][3][3]);
              *(v4u*)(HO + (size_t)t * D + c0) = b0; *(v4u*)(HO + (size_t)t * D + c0 + 8) = b1; }
            v4u o; o.x = pk4_fp8(h[j][0][0], h[j][0][1], h[j][0][2], h[j][0][3]); o.y = pk4_fp8(h[j][1][0], h[j][1][1], h[j][1][2], h[j][1][3]);
            o.z = pk4_fp8(h[j][2][0], h[j][2][1], h[j][2][2], h[j][2][3]); o.w = pk4_fp8(h[j][3][0], h[j][3][1], h[j][3][2], h[j][3][3]);
            *(v4u*)(H2 + (size_t)t * D + c0) = o; }
    }
}
__device__ __forceinline__ void p9_final(Frame& F, bool dry) {
    const int LANE_ = pg8::lane_id();
    const int gw = F.bx * NWAVES + F.wave, NGW = F.G * NWAVES, lane = LANE_; const float* g = fin(F, I_GFINAL); const float* gp = fin(F, I_GPLE);
    const bf16* G = (const bf16*)(F.ws + WS_GBUF); const bf16* PP = (const bf16*)(F.ws + WS_PPROJ);
    for (int t = gw; t < T; t += NGW) {
        const bf16* row = (const bf16*)(F.ws + WS_H2B) + (size_t)t * D; float* orow = (dry ? (float*)(F.ws + WS_WGU) : F.out) + (size_t)t * D; f32x4 v[8]; v4u gg[4], pw[4];
#pragma unroll
        for (int j = 0; j < 4; ++j) { const v4u hw = *(const v4u*)(row + 512 * j + 8 * lane);
            v[2 * j] = (f32x4){bf_lo(hw.x), bf_hi(hw.x), bf_lo(hw.y), bf_hi(hw.y)}; v[2 * j + 1] = (f32x4){bf_lo(hw.z), bf_hi(hw.z), bf_lo(hw.w), bf_hi(hw.w)};
            gg[j] = *(const v4u*)(G + (size_t)t * D + 512 * j + 8 * lane); pw[j] = *(const v4u*)(PP + (size_t)t * D + 512 * j + 8 * lane); }
        float pf[4][8]; float ps = 0.f;
#pragma unroll
        for (int j = 0; j < 4; ++j) { pf[j][0] = bf_lo(pw[j].x); pf[j][1] = bf_hi(pw[j].x); pf[j][2] = bf_lo(pw[j].y); pf[j][3] = bf_hi(pw[j].y); pf[j][4] = bf_lo(pw[j].z); pf[j][5] = bf_hi(pw[j].z); pf[j][6] = bf_lo(pw[j].w); pf[j][7] = bf_hi(pw[j].w);
#pragma unroll
            for (int q = 0; q < 8; ++q) ps += pf[j][q] * pf[j][q]; }
        const float rsp = 1.0f / sqrtf(wave_sum(ps) * (1.0f / D) + EPS);
        float s = 0.f;
#pragma unroll
        for (int j = 0; j < 4; ++j) { const f32x4 g0 = *(const f32x4*)(gp + 512 * j + 8 * lane), g1 = *(const f32x4*)(gp + 512 * j + 8 * lane + 4);
            const float gl[8] = {bf_lo(gg[j].x), bf_hi(gg[j].x), bf_lo(gg[j].y), bf_hi(gg[j].y), bf_lo(gg[j].z), bf_hi(gg[j].z), bf_lo(gg[j].w), bf_hi(gg[j].w)};
#pragma unroll
            for (int q = 0; q < 4; ++q) { v[2 * j][q] += sigmoid_f(gl[q]) * pf[j][q] * rsp * g0[q]; v[2 * j + 1][q] += sigmoid_f(gl[4 + q]) * pf[j][4 + q] * rsp * g1[q]; }
            s += (v[2 * j][0] * v[2 * j][0] + v[2 * j][1] * v[2 * j][1]) + (v[2 * j][2] * v[2 * j][2] + v[2 * j][3] * v[2 * j][3]);
            s += (v[2 * j + 1][0] * v[2 * j + 1][0] + v[2 * j + 1][1] * v[2 * j + 1][1]) + (v[2 * j + 1][2] * v[2 * j + 1][2] + v[2 * j + 1][3] * v[2 * j + 1][3]); }
        const float rstd = 1.0f / sqrtf(wave_sum(s) * (1.0f / D) + EPS);
#pragma unroll
        for (int j = 0; j < 4; ++j) { const f32x4 g0 = *(const f32x4*)(g + 512 * j + 8 * lane), g1 = *(const f32x4*)(g + 512 * j + 8 * lane + 4);
            *(f32x4*)(orow + 512 * j + 8 * lane) = v[2 * j] * rstd * g0; *(f32x4*)(orow + 512 * j + 8 * lane + 4) = v[2 * j + 1] * rstd * g1; }
    }
}
__global__ void __launch_bounds__(NWAVES * 64, 2) fwd_kernel(Args args) {
    extern __shared__ __attribute__((aligned(16))) unsigned char lds[];
    Frame F;
    F.lds = (LAS unsigned char*)lds;
    F.MISC = (volatile LAS unsigned*)(F.lds + MISC_OFF);
    F.wave = __builtin_amdgcn_readfirstlane(threadIdx.x >> 6);
    F.G = gridDim.x; F.bx = blockIdx.x;
    F.ws = args.ws; F.ctl = (gu32*)(args.ws + WS_CTL); F.out = args.out;
    { const int TID_ = threadIdx.x;
    if (TID_ < 64) F.MISC[TID_] = 0u;
    if (TID_ >= 64 && TID_ < 64 + 22) ((LAS unsigned long long*)(F.lds + MISC_OFF + 256))[TID_ - 64] = ((const unsigned long long*)&args)[TID_ - 64]; }
    __syncthreads();
    XcdBarrier bar; bar.bar = (unsigned*)(F.ctl + CW_BAR); bar.x = 0; bar.st = nullptr;
    if (N_LAUNCHES == 1) bar = xcd_barrier_post((unsigned*)(F.ctl + CW_BAR), F.MISC + 8);
#define GRID_BAR() do { if (N_LAUNCHES == 1) xcd_barrier(bar); } while (0)
    const int lo = args.ph_lo, hi = args.ph_hi;
#ifndef PH_MASK
#define PH_MASK 0x3ff
#endif
#ifndef DUP_PHASE
#define DUP_PHASE -1
#endif
#define REPS(k) ((DUP_PHASE == (k)) ? 2 : 1)
#define IN(k) ((((PH_MASK) >> (k)) & 1) && lo <= (k) && (k) < hi)
#define BOTH(k) (IN(k) && IN((k) + 1))

    if (IN(0)) { _Pragma("unroll") for (int rep = 0; rep < REPS(0); ++rep) { p0_prologue(F); if (BOTH(0)) GRID_BAR(); } }

    if (IN(1)) { _Pragma("unroll") for (int rep = 0; rep < REPS(1); ++rep) {
        constexpr int G1 = 144;
        if (F.G == 256 && F.bx >= G1) {
            { pg8::Gemm g{(const bf16*)(F.ws + WS_PBF), (const bf16*)(F.ws + WS_WPP), PLE, PLE, PLE}; pg8::StaticOrder S; S.init(T, D, F.G - G1, F.bx - G1);
              EpiBf16Plain E{(bf16*)(F.ws + WS_PPROJ), D, 0, nullptr};
              pg8::gemm_phase<EpiBf16Plain, pg8::StaticOrder, false>(F.lds + RING_OFF, g, S, E, F.wave); }
            conv_dyn(F, 1);
        } else {
            const int gg = (F.G == 256) ? G1 : F.G;
            { pg8::Gemm g{(const bf16*)(F.ws + WS_ABF), (const bf16*)(F.ws + WS_WIN), D, D, D}; pg8::StaticOrder S; S.init(T, INW, gg, F.bx);
              EpiInProj E{F.ws};
              pg8::gemm_phase<EpiInProj, pg8::StaticOrder, false>(F.lds + RING_OFF, g, S, E, F.wave); }
            if (F.G == 256) conv_dyn(F, 1);
            if (F.G != 256) {
                { pg8::Gemm g{(const bf16*)(F.ws + WS_PBF), (const bf16*)(F.ws + WS_WPP), PLE, PLE, PLE}; pg8::StaticOrder S; S.init(T, D, F.G, F.bx);
                  EpiBf16Plain E{(bf16*)(F.ws + WS_PPROJ), D, 0, nullptr};
                  pg8::gemm_phase<EpiBf16Plain, pg8::StaticOrder, false>(F.lds + RING_OFF, g, S, E, F.wave); }
                conv_fp8_items(F, CONV_A, CONV_A + CONV_B, F.bx * NWAVES + F.wave, F.G * NWAVES);
            }
        }
        if (BOTH(1)) GRID_BAR();
    } }

    if (IN(2)) { _Pragma("unroll") for (int rep = 0; rep < REPS(2); ++rep) {
        if (F.G == 256) {
            if (F.bx < 128) pool_task(F, F.bx >> 2, F.bx & 3);
            else { attn_block(F, 2 * (F.bx - 128), true); attn_block(F, 2 * (F.bx - 128) + 1, false); }
        } else {
            for (int blk = F.bx; blk < 256; blk += F.G) attn_block(F, blk, true);
            for (int p = F.bx; p < 128; p += F.G) { __syncthreads(); pool_task(F, p >> 2, p & 3); }
        }
        if (BOTH(2)) GRID_BAR();
    } }

    if (IN(3)) { _Pragma("unroll") for (int rep = 0; rep < REPS(3); ++rep) {
        constexpr int G3 = 128;
        if (F.G == 256 && F.bx >= G3) conv_dyn(F, 2);
        else {
            pg8::Gemm g{(const bf16*)(F.ws + WS_MIX), (const bf16*)(F.ws + WS_WOUT), D, D, D}; pg8::StaticOrder S; S.init(T, D, (F.G == 256) ? G3 : F.G, F.bx);
            EpiResF32 E{fin(F, I_X), F.out};
            pg8::gemm_phase<EpiResF32, pg8::StaticOrder, false>(F.lds + RING_OFF, g, S, E, F.wave);
            if (F.G == 256) conv_dyn(F, 2);
            if (F.G != 256) conv_fp8_items(F, CONV_A + CONV_B, CV_TOTAL, F.bx * NWAVES + F.wave, F.G * NWAVES);
        }
        if (BOTH(3)) GRID_BAR();
    } }

    if (IN(4)) { _Pragma("nounroll") for (int rep = 0; rep < ((DUP_PHASE == 4) ? 2 : 1); ++rep) { if (rep == 1) { GRID_BAR(); if (F.bx == 0 && threadIdx.x < NE) __hip_atomic_store(F.ctl + CW_CNT + 32 * threadIdx.x, 0u, RLX_AGENT); GRID_BAR(); }
        p4_route(F); } if (BOTH(4)) GRID_BAR(); }

    if (IN(5)) { _Pragma("unroll") for (int rep = 0; rep < REPS(5); ++rep) {
        moe_tables(F);
        pg8::Gemm g{F.ws + WS_XN, F.ws + WS_WGU, D, D, D};
        MoeOrder S{(const LAS int*)(F.lds + TAB_OFF), (const int*)(F.ws + WS_TOKLIST), F.bx & 7, F.bx >> 3, 4, F.G >> 3};
        EpiGateUp E{F.ws + WS_ACT};
        pg8::gemm_phase<EpiGateUp, MoeOrder, true, 1>(F.lds + RING_OFF, g, S, E, F.wave);
        if (BOTH(5)) GRID_BAR();
    } }

    if (IN(6)) { _Pragma("unroll") for (int rep = 0; rep < REPS(6); ++rep) {
        if (!IN(5)) moe_tables(F);
        pg8::Gemm g{F.ws + WS_ACT, F.ws + WS_WD, EFF, EFF, EFF};
        MoeOrder S{(const LAS int*)(F.lds + TAB_OFF), (const int*)(F.ws + WS_TOKLIST), F.bx & 7, F.bx >> 3, 8, F.G >> 3};
        EpiDown E{F.ws + WS_Y};
        pg8::gemm_phase<EpiDown, MoeOrder, false, 1>(F.lds + RING_OFF, g, S, E, F.wave);
        if (BOTH(6)) GRID_BAR();
    } }

    if (IN(7)) { if (!IN(6)) moe_tables(F); if (DUP_PHASE == 7) { p7_combine(F, true); GRID_BAR(); } p7_combine(F, false); if (BOTH(7)) GRID_BAR(); }

    if (IN(8)) {
        pg8::Gemm g{F.ws + WS_H2F8, F.ws + WS_WPG, D, D, D}; pg8::StaticOrder S; S.init(T, D, F.G, F.bx);
        EpiBf16Mul E{(bf16*)(F.ws + WS_GBUF), 1.0f / SW3};
        pg8::gemm_phase<EpiBf16Mul, pg8::StaticOrder, false, 1>(F.lds + RING_OFF, g, S, E, F.wave);
        if (BOTH(8)) GRID_BAR();
    }

    if (IN(9)) { if (DUP_PHASE == 9) { p9_final(F, true); GRID_BAR(); } p9_final(F, false); }
#undef IN
#undef BOTH
}

extern "C" void kernel_launch(void* const* d_in, const int* in_sizes, int n_in, void* d_out, int out_size, void* d_ws, size_t ws_size, hipStream_t stream) {
    static int grid = 0;
    if (grid == 0) {
        if (n_in != 22 || out_size != T * D || ws_size < WS_END) { fprintf(stderr, "kernel_launch: unexpected sizes n_in %d out %d ws %zu (need %zu)\n", n_in, out_size, ws_size, (size_t)WS_END); grid = -1; return; }
        int dev = 0, cus = 0, per_cu = 0;
        if (hipGetDevice(&dev) != hipSuccess || hipDeviceGetAttribute(&cus, hipDeviceAttributeMultiprocessorCount, dev) != hipSuccess) { grid = -1; return; }
        if (hipFuncSetAttribute((const void*)fwd_kernel, hipFuncAttributeMaxDynamicSharedMemorySize, LDS_BYTES) != hipSuccess) { fprintf(stderr, "kernel_launch: hipFuncSetAttribute failed\n"); grid = -1; return; }
        if (hipOccupancyMaxActiveBlocksPerMultiprocessor(&per_cu, (const void*)fwd_kernel, NWAVES * 64, LDS_BYTES) != hipSuccess || per_cu < 1) fprintf(stderr, "kernel_launch: occupancy query reports %d\n", per_cu);
        (void)hipGetLastError();
        grid = cus > 256 ? 256 : cus;
    }
    if (grid < 0) return;
    if (hipMemsetAsync((char*)d_ws + WS_CTL, 0, CTL_ZERO_BYTES, stream) != hipSuccess) return;
    Args a{};
    for (int i = 0; i < 22; ++i) a.in[i] = (const float*)d_in[i];
    a.out = (float*)d_out; a.ws = (unsigned char*)d_ws;
    for (int li = 0; li < N_LAUNCHES; ++li) {
        a.ph_lo = (N_LAUNCHES == 1) ? 0 : li; a.ph_hi = (N_LAUNCHES == 1) ? N_PHASES : li + 1; a.li = li;
        hipLaunchKernelGGL(fwd_kernel, dim3(grid), dim3(NWAVES * 64), LDS_BYTES, stream, a);
    }
}
```

```cpp
#include <hip/hip_runtime.h>
#include <cstdio>
#include <cstdint>

#ifndef MK_N_LAUNCHES
#define MK_N_LAUNCHES 1
#endif

namespace pg8 {
#define PG8_LAS __attribute__((address_space(3)))
typedef unsigned short bf16_t;
typedef short bf16x8 __attribute__((ext_vector_type(8)));
typedef float f32x4 __attribute__((ext_vector_type(4)));
typedef unsigned u32x4 __attribute__((ext_vector_type(4)));
typedef unsigned u32x2 __attribute__((ext_vector_type(2)));
constexpr int BM = 256, BK = 64, HALF = 128, HTB = HALF * BK * 2  , STAGE_BYTES = 8 * HTB, NXCD = 8, WGM = 8;

__host__ __device__ __forceinline__ int lds_byte(int r, int c) { const int st = (r >> 4) * 2 + (c >> 5), rr = r & 15, cc = c & 31, ob = rr * 64 + cc * 2; return st * 1024 + (ob ^ (((ob >> 9) & 1) << 5)); }
__host__ __device__ __forceinline__ void stage_rc(int b, int& R, int& C) { const int st = b / 1024, sb = b % 1024, swz = sb ^ (((sb >> 9) & 1) << 5); R = (st >> 1) * 16 + swz / 64; C = (st & 1) * 32 + (swz % 64) / 2; }
__host__ __device__ __forceinline__ int perm32(int rho) { const int n = rho >> 4, i = rho & 15; return 8 * (i >> 2) + 4 * n + (i & 3); }

struct Unit { int pm, pn, e, lt, half; };
struct Gemm { const void* A; const void* Bt; int lda, ldb, K; };
typedef int i32x8 __attribute__((ext_vector_type(8)));
typedef int i32x4 __attribute__((ext_vector_type(4)));
__device__ __forceinline__ i32x8 cat8(bf16x8 lo, bf16x8 hi) { const i32x4 a = __builtin_bit_cast(i32x4, lo), b = __builtin_bit_cast(i32x4, hi); return __builtin_shufflevector(a, b, 0, 1, 2, 3, 4, 5, 6, 7); }

struct StaticOrder {
    static constexpr bool HALVES = false;
    int nM, nN, nwg, G, c;
    __host__ __device__ void init(int M, int N, int G_, int c_) { nM = M / BM; nN = N / BM; nwg = nM * nN; G = G_; c = c_; }
    __host__ __device__ bool next(int i, Unit& u) const {
        const long L = (long)i * G + c; if (L >= nwg) return false;
        int wgid = (int)L; { const int q = nwg / NXCD, r = nwg % NXCD, xcd = wgid % NXCD, off = wgid / NXCD; wgid = (xcd < r ? xcd * (q + 1) : r * (q + 1) + (xcd - r) * q) + off; }
        const int nig = WGM * nN, gid = wgid / nig, fm = gid * WGM, gsz = (nM - fm) < WGM ? (nM - fm) : WGM;
        u.pm = fm + ((wgid % nig) % gsz); u.pn = (wgid % nig) / gsz; u.e = 0; u.lt = 0; u.half = 0; return true;
    }
    __device__ __forceinline__ int arow(const Unit&, int r) const { return r; }
};
struct SingleOrder {
    static constexpr bool HALVES = false;
    int pm, pn;
    __device__ bool next(int i, Unit& u) const { if (i > 0) return false; u.pm = pm; u.pn = pn; u.e = 0; u.lt = 0; u.half = 0; return true; }
    __device__ __forceinline__ int arow(const Unit&, int r) const { return r; }
};

__device__ __forceinline__ int lane_id() { int l; asm volatile("v_mbcnt_lo_u32_b32 %0, -1, 0\n\tv_mbcnt_hi_u32_b32 %0, -1, %0" : "=v"(l)); return l; }
__device__ __forceinline__ unsigned cvt_pk_bf16(float lo, float hi) { unsigned r; asm volatile("v_cvt_pk_bf16_f32 %0, %1, %2" : "=v"(r) : "v"(lo), "v"(hi)); return r; }

__host__ __device__ __forceinline__ int perm16(int R) { return 64 * (R >> 5) + 16 * ((R >> 2) & 3) + 4 * ((R >> 4) & 1) + (R & 3); }
template <class Epi, class Sched, bool GATHER, int ESZ = 2, bool ALIGN_EPI = true>
__device__ __forceinline__ void gemm_phase(PG8_LAS unsigned char* lds, const Gemm g, const Sched& S, const Epi& E, int wid) {
    const int lane = lane_id(), tid = wid * 64 + lane, wr = wid >> 2, wc = wid & 3, fr = lane & 15, fq = lane >> 4;
    const int nt = (g.K * ESZ) / 128;
    int Ra[2], Ca[2]; unsigned voffB[2];
#pragma unroll
    for (int i = 0; i < 2; ++i) { int R, C; stage_rc(tid * 16 + i * 8192, R, C); const int Rb = (Epi::PERM == 2) ? perm16(R) : (Epi::PERM ? ((R & ~31) + perm32(R & 31)) : R);
        Ra[i] = R; Ca[i] = C; voffB[i] = (unsigned)(Rb * g.ldb * ESZ + C * 2); }
    const size_t kstep = (size_t)(BK * 2);
    const size_t hstepB = (size_t)((Epi::PERM == 2) ? 8 : HALF) * g.ldb * ESZ, tstepB = (size_t)BM * g.ldb * ESZ;
    const size_t tstepA = (size_t)BM * g.lda * ESZ;
    const unsigned ldsw = (unsigned)wid * 1024u;
    const int aoff = lds_byte(wr * 64 + fr, fq * 8), boff = lds_byte(wc * 32 + fr, fq * 8);
#define PG8_SA(b, h) (((b) * 2 + (h)) * HTB)
#define PG8_SB(b, h) ((4 + (b) * 2 + (h)) * HTB)
#define PG8_STAGE(bufoff, gbase, v0, v1) do { \
        __builtin_amdgcn_global_load_lds((const unsigned*)((const char*)(gbase) + (v0)), (PG8_LAS unsigned*)(lds + (bufoff) + ldsw), 16, 0, 0); \
        __builtin_amdgcn_global_load_lds((const unsigned*)((const char*)(gbase) + (v1)), (PG8_LAS unsigned*)(lds + (bufoff) + ldsw + 8192), 16, 0, 0); } while (0)
#define PG8_STAGE_A0(bufoff, gbase, p0, p1) PG8_STAGE(bufoff, gbase, p0, p1)
#define PG8_STAGE_A1(bufoff, gbase, p0, p1, q0, q1) do { if constexpr (GATHER) { PG8_STAGE(bufoff, gbase, q0, q1); } else { PG8_STAGE(bufoff, (gbase) + hstepA, p0, p1); } } while (0)
#define PG8_LD16(off) (*(const PG8_LAS i32x4*)(lds + (off)))
#define PG8_LDA(dst, b, h) do { if constexpr (ESZ == 2) { _Pragma("unroll") for (int m = 0; m < 4; ++m) _Pragma("unroll") for (int k = 0; k < 2; ++k) dst[m][k] = *(const PG8_LAS bf16x8*)(lds + PG8_SA(b, h) + aoff + m * 2048 + k * 1024); } \
        else { _Pragma("unroll") for (int m = 0; m < 4; ++m) dst##8[m] = __builtin_shufflevector(PG8_LD16(PG8_SA(b, h) + aoff + m * 2048), PG8_LD16(PG8_SA(b, h) + aoff + m * 2048 + 1024), 0, 1, 2, 3, 4, 5, 6, 7); } } while (0)
#define PG8_LDB(dst, b, h) do { if constexpr (ESZ == 2) { _Pragma("unroll") for (int n = 0; n < 2; ++n) _Pragma("unroll") for (int k = 0; k < 2; ++k) dst[n][k] = *(const PG8_LAS bf16x8*)(lds + PG8_SB(b, h) + boff + n * 2048 + k * 1024); } \
        else { _Pragma("unroll") for (int n = 0; n < 2; ++n) dst##8[n] = __builtin_shufflevector(PG8_LD16(PG8_SB(b, h) + boff + n * 2048), PG8_LD16(PG8_SB(b, h) + boff + n * 2048 + 1024), 0, 1, 2, 3, 4, 5, 6, 7); } } while (0)
#define PG8_MMA(ai, bj, At, Bt) do { __builtin_amdgcn_s_setprio(1); \
        if constexpr (ESZ == 2) { _Pragma("unroll") for (int m = 0; m < 4; ++m) _Pragma("unroll") for (int n = 0; n < 2; ++n) _Pragma("unroll") for (int k = 0; k < 2; ++k) \
            acc[ai][bj][m][n] = __builtin_amdgcn_mfma_f32_16x16x32_bf16(Bt[n][k], At[m][k], acc[ai][bj][m][n], 0, 0, 0); } \
        else { _Pragma("unroll") for (int m = 0; m < 4; ++m) _Pragma("unroll") for (int n = 0; n < 2; ++n) \
            asm volatile("v_mfma_scale_f32_16x16x128_f8f6f4 %0, %1, %2, %0, %3, %3 op_sel_hi:[0,0,0]" : "+v"(acc[ai][bj][m][n]) : "v"(Bt##8[n]), "v"(At##8[m]), "v"(sc1)); } \
        __builtin_amdgcn_s_setprio(0); } while (0)
#define PG8_WAIT_V(n) asm volatile("s_waitcnt vmcnt(" #n ")" ::: "memory")
#define PG8_WAIT_L(n) asm volatile("s_waitcnt lgkmcnt(" #n ")" ::: "memory")
#define PG8_BAR __builtin_amdgcn_s_barrier()
#define PG8_SCHED __builtin_amdgcn_sched_barrier(0)
    Unit cur, nxt; int ui = 0;
    if (!S.next(0, cur)) return;
    f32x4 acc[2][2][4][2];
#pragma unroll
    for (int a = 0; a < 2; ++a)
#pragma unroll
        for (int b = 0; b < 2; ++b)
#pragma unroll
            for (int m = 0; m < 4; ++m)
#pragma unroll
                for (int n = 0; n < 2; ++n) acc[a][b][m][n] = (f32x4){0.f, 0.f, 0.f, 0.f};
    const int sc1 = 0x7F7F7F7F;
    bf16x8 At[4][2], B0[2][2], B1[2][2]; i32x8 At8[4], B08[2], B18[2];
    unsigned vA00, vA01, vA10, vA11, nA00, nA01, nA10, nA11;
    const size_t hstepA = GATHER ? (size_t)0 : (size_t)HALF * g.lda * ESZ;
    if constexpr (GATHER) {
        vA00 = (unsigned)(S.arow(cur, Ra[0]) * g.lda * ESZ + Ca[0] * 2); vA01 = (unsigned)(S.arow(cur, Ra[1]) * g.lda * ESZ + Ca[1] * 2);
        vA10 = (unsigned)(S.arow(cur, HALF + Ra[0]) * g.lda * ESZ + Ca[0] * 2); vA11 = (unsigned)(S.arow(cur, HALF + Ra[1]) * g.lda * ESZ + Ca[1] * 2);
    } else {
        vA00 = (unsigned)(Ra[0] * g.lda * ESZ + Ca[0] * 2); vA01 = (unsigned)(Ra[1] * g.lda * ESZ + Ca[1] * 2); vA10 = 0; vA11 = 0;
    }
    nA00 = vA00; nA01 = vA01; nA10 = vA10; nA11 = vA11;
    const char* cA = (const char*)g.A + (GATHER ? (size_t)0 : (size_t)cur.pm * tstepA); const char* cB = (const char*)g.Bt + (size_t)cur.pn * tstepB;
    PG8_STAGE(PG8_SB(0, 0), cB, voffB[0], voffB[1]); PG8_STAGE(PG8_SB(0, 1), cB + hstepB, voffB[0], voffB[1]); PG8_STAGE_A0(PG8_SA(0, 0), cA, vA00, vA01); PG8_STAGE_A1(PG8_SA(0, 1), cA, vA00, vA01, vA10, vA11);
    if (wr == 1) PG8_BAR;
    PG8_WAIT_V(2); PG8_BAR;
    PG8_STAGE(PG8_SB(1, 0), cB + kstep, voffB[0], voffB[1]); PG8_STAGE_A0(PG8_SA(1, 0), cA + kstep, vA00, vA01); PG8_STAGE(PG8_SB(1, 1), cB + hstepB + kstep, voffB[0], voffB[1]);
    PG8_WAIT_V(6); PG8_BAR;
    for (;;) {
        const bool has_next = S.next(ui + 1, nxt);
        const char* nA = has_next ? (const char*)g.A + (GATHER ? (size_t)0 : (size_t)nxt.pm * tstepA) : cA; const char* nB = has_next ? (const char*)g.Bt + (size_t)nxt.pn * tstepB : cB;
        if constexpr (GATHER) {
            if (has_next) {
                nA00 = (unsigned)(S.arow(nxt, Ra[0]) * g.lda * ESZ + Ca[0] * 2); nA01 = (unsigned)(S.arow(nxt, Ra[1]) * g.lda * ESZ + Ca[1] * 2);
                nA10 = (unsigned)(S.arow(nxt, HALF + Ra[0]) * g.lda * ESZ + Ca[0] * 2); nA11 = (unsigned)(S.arow(nxt, HALF + Ra[1]) * g.lda * ESZ + Ca[1] * 2);
            } else { nA00 = vA00; nA01 = vA01; nA10 = vA10; nA11 = vA11; }
        }
#pragma nounroll
        for (int t = 0; t < nt; t += 2) {
            const bool last = (t == nt - 2);
            const char* a1 = cA + (size_t)(t + 1) * kstep;
            const char* a2 = last ? nA : cA + (size_t)(t + 2) * kstep; const char* b2 = last ? nB : cB + (size_t)(t + 2) * kstep;
            const char* a3 = a2 + kstep; const char* b3 = b2 + kstep;
            asm volatile("" : "+v"(voffB[0]), "+v"(voffB[1]), "+v"(vA00), "+v"(vA01));
            if constexpr (GATHER) asm volatile("" : "+v"(vA10), "+v"(vA11));
            unsigned x00 = vA00, x01 = vA01, x10 = vA10, x11 = vA11;
            if constexpr (GATHER) { if (last) { x00 = nA00; x01 = nA01; x10 = nA10; x11 = nA11; } }
            const bool hf = Sched::HALVES && (cur.half != 0);
            PG8_LDB(B0, 0, 0); PG8_LDB(B1, 0, 1); PG8_SCHED; PG8_LDA(At, 0, 0); PG8_STAGE_A1(PG8_SA(1, 1), a1, vA00, vA01, vA10, vA11);
            PG8_WAIT_V(8); PG8_WAIT_L(0); PG8_BAR; PG8_MMA(0, 0, At, B0); PG8_MMA(0, 1, At, B1); PG8_BAR; PG8_SCHED;
            if (!hf) PG8_LDA(At, 0, 1); PG8_STAGE(PG8_SB(0, 0), b2, voffB[0], voffB[1]); PG8_STAGE(PG8_SB(0, 1), b2 + hstepB, voffB[0], voffB[1]); PG8_STAGE_A0(PG8_SA(0, 0), a2, x00, x01);
            PG8_WAIT_V(8); PG8_WAIT_L(0); PG8_BAR; if (!hf) { PG8_MMA(1, 0, At, B0); PG8_MMA(1, 1, At, B1); } PG8_BAR; PG8_SCHED;
            PG8_LDB(B0, 1, 0); PG8_LDB(B1, 1, 1); PG8_SCHED; PG8_LDA(At, 1, 0); PG8_STAGE_A1(PG8_SA(0, 1), a2, x00, x01, x10, x11);
            PG8_WAIT_V(8); PG8_WAIT_L(0); PG8_BAR; PG8_MMA(0, 0, At, B0); PG8_MMA(0, 1, At, B1); PG8_BAR; PG8_SCHED;
            if (!hf) PG8_LDA(At, 1, 1); PG8_STAGE(PG8_SB(1, 0), b3, voffB[0], voffB[1]); PG8_STAGE(PG8_SB(1, 1), b3 + hstepB, voffB[0], voffB[1]); PG8_STAGE_A0(PG8_SA(1, 0), a3, x00, x01);
            PG8_WAIT_V(8); PG8_WAIT_L(0); PG8_BAR; if (!hf) { PG8_MMA(1, 0, At, B0); PG8_MMA(1, 1, At, B1); } PG8_BAR; PG8_SCHED;
        }
        if constexpr (ALIGN_EPI) { if (wr == 0) PG8_BAR; }
        if constexpr (ESZ == 1) asm volatile("s_nop 15\n\ts_nop 15" ::: "memory");
        E(acc, cur, wr, wc, fr, fq);
        if (!has_next) break;
#pragma unroll
        for (int a = 0; a < 2; ++a)
#pragma unroll
            for (int b = 0; b < 2; ++b)
#pragma unroll
                for (int m = 0; m < 4; ++m)
#pragma unroll
                    for (int n = 0; n < 2; ++n) acc[a][b][m][n] = (f32x4){0.f, 0.f, 0.f, 0.f};
        cur = nxt; cA = nA; cB = nB; ++ui;
        if constexpr (GATHER) { vA00 = nA00; vA01 = nA01; vA10 = nA10; vA11 = nA11; }
        if constexpr (ALIGN_EPI) { if (wr == 1) PG8_BAR; }
    }
    PG8_WAIT_V(0);
    if constexpr (!ALIGN_EPI) { if (wr == 0) PG8_BAR; }
    PG8_BAR;
#undef PG8_SA
#undef PG8_SB
#undef PG8_STAGE
#undef PG8_LDA
#undef PG8_LD16
#undef PG8_STAGE_A0
#undef PG8_STAGE_A1
#undef PG8_LDB
#undef PG8_MMA
#undef PG8_WAIT_V
#undef PG8_WAIT_L
#undef PG8_BAR
#undef PG8_SCHED
}
}

constexpr int NWAVES = 8;
constexpr int T = 8192, SEQ = 2048, NB = 4, D = 2048, INW = 2304, POOLW = 1024, NH = 16, NKV = 2, HD = 64, KVW = 128;
constexpr int NE = 64, TOPK = 8, EFF = 512, PLE = 256;
constexpr int SH_ROW0 = T * TOPK + NE * 256;
constexpr int NROWS = SH_ROW0 + T;
constexpr float EPS = 1e-6f;
constexpr float SW1 = 32.0f, SW2 = 16.0f, SA = 4.0f, SY = 16.0f, SW3 = 32.0f;
constexpr int N_PHASES = 10;
constexpr int N_LAUNCHES = MK_N_LAUNCHES;

constexpr size_t MiB = 1u << 20;
constexpr size_t WS_CTL = 0, CTL_ZERO_BYTES = 64 * 1024;
constexpr size_t WS_MISC = 1 * MiB;
constexpr size_t WS_TOKLIST = WS_MISC;
constexpr size_t WS_REC = WS_TOKLIST + (size_t)NE * T * 4;
constexpr size_t WS_WREC = WS_REC + (size_t)T * TOPK * 4;
constexpr size_t WS_RSTDP = WS_WREC + (size_t)T * TOPK * 4;
constexpr size_t WS_PBF = 6 * MiB;
constexpr size_t WS_WRT = 10 * MiB;
constexpr size_t WS_WIN = 12 * MiB;
constexpr size_t WS_WPOOL = WS_WIN + (size_t)INW * D * 2;
constexpr size_t WS_WOUT = WS_WPOOL + (size_t)4 * 256 * 256 * 2;
constexpr size_t WS_WPP = WS_WOUT + (size_t)D * D * 2;
constexpr size_t WS_WPG = WS_WPP + (size_t)D * PLE * 2;
constexpr size_t WS_WGU = WS_WPG + (size_t)D * D * 2;
constexpr size_t WS_WD = WS_WGU + (size_t)65 * 1024 * D;
constexpr size_t WS_XN = WS_WD + (size_t)65 * D * EFF;
constexpr size_t WS_PPROJ = WS_XN + (size_t)T * D * 2;
constexpr size_t WS_ACT = WS_PPROJ + (size_t)T * D * 2;
constexpr size_t WS_H2F8 = WS_ACT;
constexpr size_t WS_H2B = WS_ACT + 16 * MiB;
constexpr size_t WS_GBUF = WS_XN;
constexpr size_t WS_Y = WS_ACT + (size_t)NROWS * EFF * 2;
constexpr size_t WS_ABF = WS_Y;
constexpr size_t WS_UBF = WS_ABF + (size_t)T * D * 2;
constexpr size_t WS_QBF = WS_UBF + (size_t)T * POOLW * 2;
constexpr size_t WS_KV = WS_QBF + (size_t)T * 1024 * 2;
constexpr size_t WS_POOLED = WS_KV + (size_t)T * 2 * KVW * 2;
constexpr size_t WS_MIX = WS_POOLED + (size_t)T * POOLW * 2;
constexpr size_t WS_H1 = WS_Y + (size_t)NROWS * D * 2;
constexpr size_t WS_END = WS_H1 + (size_t)T * D * 4;
static_assert(WS_MIX + (size_t)T * D * 2 <= WS_END, "early activations fit under Y");
static_assert(WS_RSTDP + (size_t)T * 4 <= WS_PBF && WS_PBF + (size_t)T * PLE * 2 <= WS_WIN, "misc fits");
static_assert(WS_END <= (size_t)1024 * MiB, "workspace must fit 1 GiB");
constexpr int CW_BAR = 1024;
constexpr int CW_CNT = 8192;
constexpr int CW_CONVQ = CW_CNT + 32 * NE;
static_assert((CW_CONVQ + 32 * 24) * 4 <= 48 * 1024, "CTL words inside the memset region (below the dummy line at 48 KiB)");

constexpr int RING_OFF = 0, RING_BYTES = 131072;
constexpr int LDS_BYTES = 163840;
constexpr int MISC_OFF = LDS_BYTES - 512;
constexpr int TAB_OFF = RING_BYTES;
constexpr int TB_CNT = 0, TB_PAD = 80, TB_XF = 160, TB_XH = 176, TB_SH0 = 192, TB_SHN = 193;

#define GAS __attribute__((address_space(1)))
#define LAS __attribute__((address_space(3)))
typedef unsigned short bf16;
typedef unsigned v4u __attribute__((ext_vector_type(4)));
typedef unsigned v2u __attribute__((ext_vector_type(2)));
typedef float f32x4 __attribute__((ext_vector_type(4)));
typedef short bf16x8 __attribute__((ext_vector_type(8)));
typedef GAS unsigned gu32;
#define RLX_AGENT __ATOMIC_RELAXED, __HIP_MEMORY_SCOPE_AGENT
#define LDS_WAIT() asm volatile("s_waitcnt lgkmcnt(0)" ::: "memory")
#define VM_WAIT() asm volatile("s_waitcnt vmcnt(0)" ::: "memory")
__device__ __forceinline__ unsigned pk2(float lo, float hi) { return pg8::cvt_pk_bf16(lo, hi); }
__device__ __forceinline__ float bf_lo(unsigned w) { return __builtin_bit_cast(float, w << 16); }
__device__ __forceinline__ float bf_hi(unsigned w) { return __builtin_bit_cast(float, w & 0xffff0000u); }

#define XB_TMO      128
#define XB_XCNT(j)  (256  + 64 * (j))
#define XB_XSUB(j)  (1280 + 64 * (j))
#define XB_XGEN(j)  (2304 + 64 * (j))
#define XB_TOP      3328
#define XB_TOPGEN   3392
#define XCD_BAR_WORDS 3456
#define XB_SPIN_CAP (1u << 18)
__device__ __forceinline__ unsigned xb_ld(unsigned* p)              { return __hip_atomic_load(p, __ATOMIC_RELAXED, __HIP_MEMORY_SCOPE_AGENT); }
__device__ __forceinline__ unsigned xb_add(unsigned* p, unsigned v) { return __hip_atomic_fetch_add(p, v, __ATOMIC_RELAXED, __HIP_MEMORY_SCOPE_AGENT); }
__device__ __forceinline__ unsigned xb_xcc_id() { return (unsigned)__builtin_amdgcn_s_getreg((3 << 11) | 20) & 0xFu; }
#define XB_SPIN(cond, bar) do { unsigned _sp = 0; while (cond) { __builtin_amdgcn_s_sleep(1); \
    if ((++_sp & 255u) == 0u) { if (xb_ld(&(bar)[XB_TMO])) break; if (_sp > XB_SPIN_CAP) { atomicAdd(&(bar)[XB_TMO], 1u); break; } } } } while (0)
struct XcdBarrier { unsigned* bar; unsigned x; volatile LAS unsigned* st; };
__device__ __forceinline__ XcdBarrier xcd_barrier_post(unsigned* bar, volatile LAS unsigned* st) {
    XcdBarrier b; b.bar = bar; b.x = xb_xcc_id(); b.st = st;
    if (threadIdx.x == 0) (void)xb_add(&bar[XB_XCNT(b.x)], 1u);
    return b;
}
__device__ __forceinline__ void xcd_barrier_complete(unsigned* bar, unsigned x, unsigned& nloc, unsigned& nx) {
    const unsigned G = gridDim.x * gridDim.y * gridDim.z;
    unsigned sum, cnt, mine, sp = 0u;
    for (;;) {
        sum = 0u; cnt = 0u; mine = 0u;
#pragma unroll
        for (unsigned j = 0; j < 16; ++j) { const unsigned c = xb_ld(&bar[XB_XCNT(j)]); sum += c; cnt += (c > 0u) ? 1u : 0u; mine = (j == x) ? c : mine; }
        if (sum == G) break;
        __builtin_amdgcn_s_sleep(1);
        if ((++sp & 255u) == 0u) { if (xb_ld(&bar[XB_TMO])) break; if (sp > XB_SPIN_CAP) { atomicAdd(&bar[XB_TMO], 1u); break; } }
    }
    nloc = mine > 0u ? mine : 1u; nx = cnt > 0u ? cnt : 1u;
}
__device__ __forceinline__ void xcd_barrier(const XcdBarrier& b) {
    asm volatile("s_waitcnt vmcnt(0)" ::: "memory");
    __syncthreads();
    if (threadIdx.x == 0) {
        unsigned* bar = b.bar;
        __builtin_amdgcn_s_waitcnt(0);
        unsigned nloc = b.st[0], nx = b.st[1];
        if (nloc == 0u) { xcd_barrier_complete(bar, b.x, nloc, nx); b.st[0] = nloc; b.st[1] = nx; }
        const unsigned old = xb_add(&bar[XB_XSUB(b.x)], 1u);
        const unsigned gen = old / nloc;
        if (old + 1u == (gen + 1u) * nloc) {
            __builtin_amdgcn_fence(__ATOMIC_RELEASE, "agent");
            asm volatile("s_waitcnt vmcnt(0)" ::: "memory");
            const unsigned og = xb_add(&bar[XB_TOP], 1u);
            const unsigned tg = og / nx;
            if (og + 1u == (tg + 1u) * nx) xb_add(&bar[XB_TOPGEN], 1u);
            else XB_SPIN(xb_ld(&bar[XB_TOPGEN]) == tg, bar);
            __builtin_amdgcn_fence(__ATOMIC_ACQUIRE, "agent");
            xb_add(&bar[XB_XGEN(b.x)], 1u);
            asm volatile("s_waitcnt vmcnt(0)" ::: "memory");
        } else {
            XB_SPIN(xb_ld(&bar[XB_XGEN(b.x)]) == gen, bar);
            __builtin_amdgcn_fence(__ATOMIC_ACQUIRE, "agent");
            asm volatile("s_waitcnt vmcnt(0)" ::: "memory");
        }
    }
    __syncthreads();
}

struct Args { const float* in[22]; float* out; unsigned char* ws; int ph_lo, ph_hi, li, pad; };
struct Frame {
    LAS unsigned char* lds;
    volatile LAS unsigned* MISC;
    gu32* ctl;
    unsigned char* ws;
    int wave, G, bx;
    float* out;
};
__device__ __forceinline__ const float* fin(const Frame& F, int i) {
    const unsigned long long v = ((const LAS unsigned long long*)(F.lds + MISC_OFF + 256))[i];
    const unsigned lo = __builtin_amdgcn_readfirstlane((unsigned)v), hi = __builtin_amdgcn_readfirstlane((unsigned)(v >> 32));
    return (const float*)(const GAS float*)(((unsigned long long)hi << 32) | lo);
}
enum { I_X = 0, I_P, I_GMIX, I_WIN, I_WPOOL, I_PSCALE, I_SINKS, I_RPE, I_WOUT, I_GFFN, I_WROUTER, I_RBIAS, I_WGATE, I_WUP, I_WDOWN, I_WSGATE, I_WSUP, I_WSDOWN, I_WPLEPROJ, I_GPLE, I_WPLEGATE, I_GFINAL };

__device__ __forceinline__ float wave_sum(float v) {
#pragma unroll
    for (int o = 1; o < 64; o <<= 1) v += __shfl_xor(v, o);
    return v;
}

using pg8::Unit;
struct EpiInProj {
    static constexpr int PERM = 1;
    unsigned char* ws;
    __device__ __forceinline__ void operator()(const f32x4 (&acc)[2][2][4][2], const Unit& u, int wr, int wc, int fr, int fq) const {
        const int row0 = u.pm * 256 + wr * 64 + fr;
        const size_t boff = WS_UBF + (size_t)(u.pn >= 4 ? 1 : 0) * (WS_QBF - WS_UBF) + (size_t)(u.pn >= 8 ? 1 : 0) * (WS_KV - WS_QBF);
        bf16* base = (bf16*)(ws + boff); const int ldc = (u.pn < 8) ? 1024 : 256; const int col0 = (u.pn & 3) * 256 + wc * 32 + 8 * fq;
#pragma unroll
        for (int ai = 0; ai < 2; ++ai)
#pragma unroll
            for (int m = 0; m < 4; ++m) { bf16* rowp = base + (size_t)(row0 + ai * 128 + m * 16) * ldc + col0;
#pragma unroll
                for (int bj = 0; bj < 2; ++bj) { const f32x4 v0 = acc[ai][bj][m][0], v1 = acc[ai][bj][m][1];
                    v4u w; w.x = pk2(v0[0], v0[1]); w.y = pk2(v0[2], v0[3]); w.z = pk2(v1[0], v1[1]); w.w = pk2(v1[2], v1[3]);
                    *(v4u*)(rowp + bj * 128) = w; } }
    }
};
struct EpiBf16Plain {
    static constexpr int PERM = 1;
    bf16* O; int ldc; int col_off; const float* scale;
    __device__ __forceinline__ void operator()(const f32x4 (&acc)[2][2][4][2], const Unit& u, int wr, int wc, int fr, int fq) const {
        const int row0 = u.pm * 256 + wr * 64 + fr, colt = u.pn * 256 + wc * 32 + 8 * fq;
        f32x4 sv[2][2];
#pragma unroll
        for (int bj = 0; bj < 2; ++bj)
#pragma unroll
            for (int n = 0; n < 2; ++n) sv[bj][n] = scale ? *(const f32x4*)(scale + col_off + colt + bj * 128 + 4 * n) : (f32x4){1.f, 1.f, 1.f, 1.f};
#pragma unroll
        for (int ai = 0; ai < 2; ++ai)
#pragma unroll
            for (int m = 0; m < 4; ++m) { bf16* rowp = O + (size_t)(row0 + ai * 128 + m * 16) * ldc + col_off + colt;
#pragma unroll
                for (int bj = 0; bj < 2; ++bj) { const f32x4 v0 = acc[ai][bj][m][0] * sv[bj][0], v1 = acc[ai][bj][m][1] * sv[bj][1];
                    v4u w; w.x = pk2(v0[0], v0[1]); w.y = pk2(v0[2], v0[3]); w.z = pk2(v1[0], v1[1]); w.w = pk2(v1[2], v1[3]);
                    *(v4u*)(rowp + bj * 128) = w; } }
    }
};
struct EpiResF32 {
    static constexpr int PERM = 0;
    const float* base; float* C;
    __device__ __forceinline__ void operator()(const f32x4 (&acc)[2][2][4][2], const Unit& u, int wr, int wc, int fr, int fq) const {
        const int row0 = u.pm * 256 + wr * 64 + fr, col0 = u.pn * 256 + wc * 32 + 4 * fq;
#pragma unroll
        for (int ai = 0; ai < 2; ++ai)
#pragma unroll
            for (int mp = 0; mp < 2; ++mp) { f32x4 xb[2][2][2];
#pragma unroll
                for (int mm = 0; mm < 2; ++mm) { const size_t ro = (size_t)(row0 + ai * 128 + (2 * mp + mm) * 16) * D + col0;
#pragma unroll
                    for (int bj = 0; bj < 2; ++bj)
#pragma unroll
                        for (int n = 0; n < 2; ++n) xb[mm][bj][n] = *(const f32x4*)(base + ro + bj * 128 + n * 16); }
#pragma unroll
                for (int mm = 0; mm < 2; ++mm) { const size_t ro = (size_t)(row0 + ai * 128 + (2 * mp + mm) * 16) * D + col0;
#pragma unroll
                    for (int bj = 0; bj < 2; ++bj)
#pragma unroll
                        for (int n = 0; n < 2; ++n) *(f32x4*)(C + ro + bj * 128 + n * 16) = xb[mm][bj][n] + acc[ai][bj][2 * mp + mm][n]; } }
    }
};
__device__ __forceinline__ float sigmoid_f(float v) { return __builtin_amdgcn_rcpf(1.0f + __expf(-v)); }
__device__ __forceinline__ unsigned pk4_fp8(float a, float b, float c, float d) { int w = 0; w = __builtin_amdgcn_cvt_pk_fp8_f32(a, b, w, false); w = __builtin_amdgcn_cvt_pk_fp8_f32(c, d, w, true); return (unsigned)w; }
typedef float f32x2_ __attribute__((ext_vector_type(2)));
__device__ __forceinline__ void fp8x4_to_f32(unsigned w, float (&o)[4]) { const f32x2_ lo = __builtin_amdgcn_cvt_pk_f32_fp8((int)w, false), hi = __builtin_amdgcn_cvt_pk_f32_fp8((int)w, true); o[0] = lo[0]; o[1] = lo[1]; o[2] = hi[0]; o[3] = hi[1]; }
struct EpiGateUp {
    static constexpr int PERM = 1;
    unsigned char* ACT;
    __device__ __forceinline__ void operator()(const f32x4 (&acc)[2][2][4][2], const Unit& u, int wr, int wc, int fr, int fq) const {
        const int row0 = u.pm * 256 + wr * 64 + fr, col0 = (u.pn & 3) * 128 + wc * 32 + 8 * fq;
        constexpr float IS = 1.0f / SW1;
#pragma unroll
        for (int ai = 0; ai < 2; ++ai) { if (ai == 1 && u.half) break;
#pragma unroll
            for (int m = 0; m < 4; ++m) { float o[8];
#pragma unroll
                for (int n = 0; n < 2; ++n)
#pragma unroll
                    for (int j = 0; j < 4; ++j) { const float gte = acc[ai][0][m][n][j] * IS, up = acc[ai][1][m][n][j] * (IS * SA); o[4 * n + j] = gte * sigmoid_f(gte) * up; }
                v2u w; w.x = pk4_fp8(o[0], o[1], o[2], o[3]); w.y = pk4_fp8(o[4], o[5], o[6], o[7]);
                *(v2u*)(ACT + (size_t)(row0 + ai * 128 + m * 16) * EFF + col0) = w; } }
    }
};
struct EpiDown {
    static constexpr int PERM = 2;
    unsigned char* Y;
    __device__ __forceinline__ void operator()(const f32x4 (&acc)[2][2][4][2], const Unit& u, int wr, int wc, int fr, int fq) const {
        const int row0 = u.pm * 256 + wr * 64 + fr, col0 = (u.pn & 7) * 256 + wc * 64 + 16 * fq;
        constexpr float IS = SY / (SA * SW2);
#pragma unroll
        for (int ai = 0; ai < 2; ++ai) { if (ai == 1 && u.half) break;
#pragma unroll
            for (int m = 0; m < 4; ++m) { const f32x4 v0 = acc[ai][0][m][0] * IS, v1 = acc[ai][0][m][1] * IS, v2 = acc[ai][1][m][0] * IS, v3 = acc[ai][1][m][1] * IS;
                v4u w; w.x = pk4_fp8(v0[0], v0[1], v0[2], v0[3]); w.y = pk4_fp8(v1[0], v1[1], v1[2], v1[3]); w.z = pk4_fp8(v2[0], v2[1], v2[2], v2[3]); w.w = pk4_fp8(v3[0], v3[1], v3[2], v3[3]);
                *(v4u*)(Y + (size_t)(row0 + ai * 128 + m * 16) * D + col0) = w; } }
    }
};
struct EpiBf16Mul {
    static constexpr int PERM = 1;
    bf16* O; float mul;
    __device__ __forceinline__ void operator()(const f32x4 (&acc)[2][2][4][2], const Unit& u, int wr, int wc, int fr, int fq) const {
        const int row0 = u.pm * 256 + wr * 64 + fr, colt = u.pn * 256 + wc * 32 + 8 * fq;
#pragma unroll
        for (int ai = 0; ai < 2; ++ai)
#pragma unroll
            for (int m = 0; m < 4; ++m) { bf16* rowp = O + (size_t)(row0 + ai * 128 + m * 16) * D + colt;
#pragma unroll
                for (int bj = 0; bj < 2; ++bj) { const f32x4 v0 = acc[ai][bj][m][0] * mul, v1 = acc[ai][bj][m][1] * mul;
                    v4u w; w.x = pk2(v0[0], v0[1]); w.y = pk2(v0[2], v0[3]); w.z = pk2(v1[0], v1[1]); w.w = pk2(v1[2], v1[3]);
                    *(v4u*)(rowp + bj * 128) = w; } }
    }
};
struct MoeOrder {
    static constexpr bool HALVES = true;
    const LAS int* tab; const int* toklist; int x, r, npn, stride;
    __device__ __forceinline__ bool next(int i, Unit& u) const {
        const int L = i * stride + r; const int tl = L / npn, pn = L - tl * npn;
        const int nf = tab[TB_XF + 8], ns = tab[TB_SHN], nh = tab[TB_XH + 8];
        if (tl >= nf + ns + nh) return false;
        int e, lt, row0, half = 0;
        if (tl < nf) { int s = 0;
#pragma unroll
            for (int q = 1; q <= 7; ++q) s += (tl >= tab[TB_XF + q]) ? 1 : 0;
            lt = tl - tab[TB_XF + s]; e = x + 8 * s; row0 = tab[TB_PAD + e] + 256 * lt; }
        else if (tl < nf + ns) { lt = tab[TB_SH0] + (tl - nf); e = NE; row0 = SH_ROW0 + 256 * lt; }
        else { const int hi = tl - nf - ns; int s = 0;
#pragma unroll
            for (int q = 1; q <= 7; ++q) s += (hi >= tab[TB_XH + q]) ? 1 : 0;
            e = x + 8 * s; lt = tab[TB_XF + s + 1] - tab[TB_XF + s]; row0 = tab[TB_PAD + e] + 256 * lt; half = 1; }
        u.pm = __builtin_amdgcn_readfirstlane(row0 >> 8); u.pn = __builtin_amdgcn_readfirstlane(e * npn + pn); u.e = __builtin_amdgcn_readfirstlane(e); u.lt = __builtin_amdgcn_readfirstlane(lt);
        u.half = __builtin_amdgcn_readfirstlane(half); return true;
    }
    __device__ __forceinline__ int arow(const Unit& u, int r_) const {
        const int lr = u.lt * 256 + r_;
        const int ee = (u.e < NE) ? u.e : 0;
        const int tk = toklist[(size_t)ee * T + (lr < T - 1 ? lr : T - 1)];
        return (u.e == NE) ? lr : ((lr < tab[TB_CNT + ee]) ? tk : 0);
    }
};
__device__ __forceinline__ void moe_tables(Frame& F) {
    const int LANE_ = pg8::lane_id(), TID_ = F.wave * 64 + LANE_; (void)TID_;
    LAS int* tab = (LAS int*)(F.lds + TAB_OFF);
    const int x = F.bx & 7;
    if (F.wave == 0) {
        const int e = LANE_, c = (int)__hip_atomic_load(F.ctl + CW_CNT + 32 * e, RLX_AGENT), nt = (c + 255) >> 8;
        const int hf = (nt > 0 && (c - ((nt - 1) << 8)) <= 128) ? 1 : 0, fl = nt - hf;
        tab[TB_CNT + e] = c; if (e == 0) tab[TB_CNT + NE] = T;
        int inc = nt << 8;
#pragma unroll
        for (int o = 1; o < 64; o <<= 1) { const int v = __shfl_up(inc, o); inc += (e >= o) ? v : 0; }
        tab[TB_PAD + e] = inc - (nt << 8); if (e == 63) tab[TB_PAD + NE] = inc;
        int ld = 2 * fl + hf;
        ld += __shfl_xor(ld, 8); ld += __shfl_xor(ld, 16); ld += __shfl_xor(ld, 32);
        int cf = fl, ch = hf;
#pragma unroll
        for (int o = 8; o < 64; o <<= 1) { const int vf = __shfl_up(cf, o), vh = __shfl_up(ch, o); cf += (e >= o) ? vf : 0; ch += (e >= o) ? vh : 0; }
        if ((e & 7) == x) { tab[TB_XF + (e >> 3) + 1] = cf; tab[TB_XH + (e >> 3) + 1] = ch; }
        if (e == 0) { tab[TB_XF] = 0; tab[TB_XH] = 0; }
        int load[8], nsh[8];
#pragma unroll
        for (int l = 0; l < 8; ++l) { load[l] = __shfl(ld, l); nsh[l] = 0; }
        for (int j = 0; j < 32; ++j) { int best = 0, bl = load[0];
#pragma unroll
            for (int l = 1; l < 8; ++l) { const bool lt_ = load[l] < bl; best = lt_ ? l : best; bl = lt_ ? load[l] : bl; }
#pragma unroll
            for (int l = 0; l < 8; ++l) { nsh[l] += (l == best) ? 1 : 0; load[l] += (l == best) ? 2 : 0; } }
        int s0 = 0, sn = 0;
#pragma unroll
        for (int l = 0; l < 8; ++l) { s0 += (l < x) ? nsh[l] : 0; sn = (l == x) ? nsh[l] : sn; }
        if (e == 0) { tab[TB_SH0] = s0; tab[TB_SHN] = sn; }
    }
    __syncthreads();
}
struct ConvJob { const float* src; bf16* dst; int N, ldk, mode, item; };
struct ConvJob8 { const float* src; unsigned char* dst; int N, ldk, mode, item; float scale; };
__device__ __forceinline__ void conv8_load(const ConvJob8& j, int lane, f32x4 (&v)[16]) {
    const int nblk = j.N >> 5, kb = j.item / nblk, nb = j.item - kb * nblk, k0 = 128 * kb, n0 = 32 * nb;
    const float* src = j.src + (size_t)(k0 + 16 * (lane >> 3)) * j.N + n0 + 4 * (lane & 7);
#pragma unroll
    for (int i = 0; i < 16; ++i) v[i] = __builtin_nontemporal_load((const f32x4*)(src + (size_t)i * j.N));
}
__device__ __forceinline__ void conv8_store(const ConvJob8& j, int lane, const f32x4 (&v)[16]) {
    const int nblk = j.N >> 5, kb = j.item / nblk, nb = j.item - kb * nblk, k0 = 128 * kb, n0 = 32 * nb; const float scale = j.scale;
#pragma unroll
    for (int q = 0; q < 4; ++q) { const int n = n0 + 4 * (lane & 7) + q; int dr = n;
        if (j.mode == 5) dr = ((n >> 7) << 8) + (n & 127); else if (j.mode == 6) dr = ((n >> 7) << 8) + 128 + (n & 127);
        v4u o; o.x = pk4_fp8(v[0][q] * scale, v[1][q] * scale, v[2][q] * scale, v[3][q] * scale); o.y = pk4_fp8(v[4][q] * scale, v[5][q] * scale, v[6][q] * scale, v[7][q] * scale);
        o.z = pk4_fp8(v[8][q] * scale, v[9][q] * scale, v[10][q] * scale, v[11][q] * scale); o.w = pk4_fp8(v[12][q] * scale, v[13][q] * scale, v[14][q] * scale, v[15][q] * scale);
        __builtin_nontemporal_store(o, (v4u*)(j.dst + (size_t)dr * j.ldk + k0 + 16 * (lane >> 3))); }
}
__device__ __forceinline__ void conv_load(const ConvJob& j, int lane, f32x4 (&v)[8]) {
    const int nblk = j.N >> 5, kb = j.item / nblk, nb = j.item - kb * nblk, k0 = 64 * kb, n0 = 32 * nb;
    const float* src = j.src + (size_t)(k0 + 8 * (lane >> 3)) * j.N + n0 + 4 * (lane & 7);
#pragma unroll
    for (int i = 0; i < 8; ++i) v[i] = __builtin_nontemporal_load((const f32x4*)(src + (size_t)i * j.N));
}
__device__ __forceinline__ void conv_store(const ConvJob& j, int lane, const f32x4 (&v)[8]) {
    const int nblk = j.N >> 5, kb = j.item / nblk, nb = j.item - kb * nblk, k0 = 64 * kb, n0 = 32 * nb;
#pragma unroll
    for (int q = 0; q < 4; ++q) { const int n = n0 + 4 * (lane & 7) + q; int dr = n;
        if (j.mode == 1) dr = ((n >> 7) << 8) + (n & 127); else if (j.mode == 2) dr = ((n >> 7) << 8) + 128 + (n & 127);
        v4u o; o.x = pk2(v[0][q], v[1][q]); o.y = pk2(v[2][q], v[3][q]); o.z = pk2(v[4][q], v[5][q]); o.w = pk2(v[6][q], v[7][q]);
        *(v4u*)(j.dst + (size_t)dr * j.ldk + k0 + 8 * (lane >> 3)) = o; }
}
__device__ __forceinline__ void rms_row_to_bf16(const float* xrow, const float* g, bf16* orow, int lane) {
    f32x4 v[8]; float s = 0.f;
#pragma unroll
    for (int j = 0; j < 4; ++j) { v[2 * j] = *(const f32x4*)(xrow + 512 * j + 8 * lane); v[2 * j + 1] = *(const f32x4*)(xrow + 512 * j + 8 * lane + 4); }
#pragma unroll
    for (int j = 0; j < 8; ++j) s += (v[j][0] * v[j][0] + v[j][1] * v[j][1]) + (v[j][2] * v[j][2] + v[j][3] * v[j][3]);
    const float rstd = 1.0f / sqrtf(wave_sum(s) * (1.0f / D) + EPS);
#pragma unroll
    for (int j = 0; j < 4; ++j) { const f32x4 g0 = *(const f32x4*)(g + 512 * j + 8 * lane), g1 = *(const f32x4*)(g + 512 * j + 8 * lane + 4);
        const f32x4 a = v[2 * j] * rstd * g0, b = v[2 * j + 1] * rstd * g1;
        v4u o; o.x = pk2(a[0], a[1]); o.y = pk2(a[2], a[3]); o.z = pk2(b[0], b[1]); o.w = pk2(b[2], b[3]);
        *(v4u*)(orow + 512 * j + 8 * lane) = o; }
}
constexpr int CV_G1 = (D / 128) * (EFF / 32), CV_D1 = (EFF / 128) * (D / 32), CV_G = 65 * CV_G1, CV_DN = 65 * CV_D1, CV_PG = (D / 128) * (D / 32), CV_TOTAL = 2 * CV_G + CV_DN + CV_PG;
constexpr int CONV_B = 896 * 16, CONV_C = 1024 * 20, CONV_A = CV_TOTAL - CONV_B - CONV_C;
__device__ __forceinline__ ConvJob8 conv8_decode(Frame& F, int it) {
    unsigned char* WGU8 = F.ws + WS_WGU; unsigned char* WDN8 = F.ws + WS_WD;
    int r = it;
    if (r < CV_G) { const int e = r / CV_G1, li = r - e * CV_G1; const float* src = (e < NE) ? fin(F, I_WGATE) + (size_t)e * D * EFF : fin(F, I_WSGATE);
        return ConvJob8{src, WGU8 + (size_t)e * 1024 * D, EFF, D, 5, li, SW1}; } r -= CV_G;
    if (r < CV_G) { const int e = r / CV_G1, li = r - e * CV_G1; const float* src = (e < NE) ? fin(F, I_WUP) + (size_t)e * D * EFF : fin(F, I_WSUP);
        return ConvJob8{src, WGU8 + (size_t)e * 1024 * D, EFF, D, 6, li, SW1}; } r -= CV_G;
    if (r < CV_DN) { const int e = r / CV_D1, li = r - e * CV_D1; const float* src = (e < NE) ? fin(F, I_WDOWN) + (size_t)e * EFF * D : fin(F, I_WSDOWN);
        return ConvJob8{src, WDN8 + (size_t)e * D * EFF, D, EFF, 4, li, SW2}; } r -= CV_DN;
    return ConvJob8{fin(F, I_WPLEGATE), F.ws + WS_WPG, D, D, 4, r, SW3};
}
__device__ __forceinline__ void conv_fp8_items(Frame& F, int lo, int hi, int rank, int nranks) {
    const int LANE_ = pg8::lane_id();
    int it0 = lo + rank; if (it0 >= hi) return;
    f32x4 va[16], vb[16];
    ConvJob8 j0 = conv8_decode(F, it0), j1 = j0; conv8_load(j0, LANE_, va);
    for (;;) {
        const int it1 = it0 + nranks; const bool has1 = it1 < hi;
        if (has1) { j1 = conv8_decode(F, it1); conv8_load(j1, LANE_, vb); }
        conv8_store(j0, LANE_, va);
        if (!has1) break;
        it0 = it1 + nranks; const bool has0 = it0 < hi;
        if (has0) { j0 = conv8_decode(F, it0); conv8_load(j0, LANE_, va); }
        conv8_store(j1, LANE_, vb);
        if (!has0) break;
    }
}
constexpr int SEG_N0 = 14000, SEG_N1 = 16000, SEG_N2 = CV_TOTAL - SEG_N0 - SEG_N1;
static_assert(SEG_N0 % 8 == 0 && SEG_N1 % 8 == 0 && SEG_N2 % 8 == 0 && SEG_N2 > 0, "queue segments");
__device__ __forceinline__ void conv_dyn(Frame& F, int seg) {
    const int LANE_ = pg8::lane_id(); const bool t0 = (F.wave == 0 && LANE_ == 0);
    const int x = F.bx & 7;
    const int segn = (seg == 0 ? SEG_N0 : (seg == 1 ? SEG_N1 : SEG_N2)) / 8, lo = (seg == 0 ? 0 : (seg == 1 ? SEG_N0 : SEG_N0 + SEG_N1)) + x * segn;
    gu32* ctr = F.ctl + CW_CONVQ + 32 * (seg * 8 + x);
    volatile LAS unsigned* Q = F.MISC + 16;
    __syncthreads();
    if (t0) { const unsigned a = __hip_atomic_fetch_add(ctr, 8u, RLX_AGENT), b = __hip_atomic_fetch_add(ctr, 8u, RLX_AGENT); Q[0] = a; Q[1] = b; }
    __syncthreads();
    int c0 = __builtin_amdgcn_readfirstlane((int)Q[0]), c1 = __builtin_amdgcn_readfirstlane((int)Q[1]);
    f32x4 va[16], vb[16]; ConvJob8 ja, jb;
    bool ha = (c0 + F.wave) < segn, hb = false;
    ja = conv8_decode(F, lo + (ha ? c0 + F.wave : 0)); jb = ja;
    if (ha) conv8_load(ja, LANE_, va);
    for (;;) {
        unsigned vn = 0u; if (t0) vn = __hip_atomic_fetch_add(ctr, 8u, RLX_AGENT);
        hb = (c1 + F.wave) < segn; if (hb) { jb = conv8_decode(F, lo + c1 + F.wave); conv8_load(jb, LANE_, vb); }
        if (ha) conv8_store(ja, LANE_, va);
        if (c0 >= segn) break;
        __syncthreads(); if (t0) Q[0] = vn; __syncthreads();
        c0 = __builtin_amdgcn_readfirstlane((int)Q[0]);
        vn = 0u; if (t0) vn = __hip_atomic_fetch_add(ctr, 8u, RLX_AGENT);
        ha = (c0 + F.wave) < segn; if (ha) { ja = conv8_decode(F, lo + c0 + F.wave); conv8_load(ja, LANE_, va); }
        if (hb) conv8_store(jb, LANE_, vb);
        if (c1 >= segn) break;
        __syncthreads(); if (t0) Q[1] = vn; __syncthreads();
        c1 = __builtin_amdgcn_readfirstlane((int)Q[1]);
    }
    __syncthreads();
}
__device__ __forceinline__ void p0_prologue(Frame& F) {
    const int LANE_ = pg8::lane_id(), TID_ = F.wave * 64 + LANE_; (void)TID_;
    const int gw = F.bx * NWAVES + F.wave, NGW = F.G * NWAVES;
    bf16* WIN = (bf16*)(F.ws + WS_WIN); bf16* WPOOL = (bf16*)(F.ws + WS_WPOOL); bf16* WOUT = (bf16*)(F.ws + WS_WOUT); bf16* WPP = (bf16*)(F.ws + WS_WPP);
    constexpr int I_IN = (D / 64) * (INW / 32), I_PL = 4 * (256 / 64) * (256 / 32), I_OUT = (D / 64) * (D / 32), I_PP = (PLE / 64) * (D / 32), I_PG = (D / 64) * (D / 32);
    constexpr int I_SMALL = I_IN + I_PL + I_OUT + I_PP; (void)I_PG;
    auto decode = [&](int it) -> ConvJob {
        int r = it;
        if (r < I_IN) return ConvJob{fin(F, I_WIN), WIN, INW, D, 0, r}; r -= I_IN;
        if (r < I_PL) { const int gq = r >> 5; return ConvJob{fin(F, I_WPOOL) + (size_t)gq * 65536, WPOOL + (size_t)gq * 65536, 256, 256, 0, r & 31}; } r -= I_PL;
        if (r < I_OUT) return ConvJob{fin(F, I_WOUT), WOUT, D, D, 0, r}; r -= I_OUT;
        return ConvJob{fin(F, I_WPLEPROJ), WPP, D, PLE, 0, r};
    };
    for (int it = gw; it < I_SMALL; it += 2 * NGW) {
        const ConvJob j0 = decode(it); const bool two = (it + NGW) < I_SMALL; const ConvJob j1 = decode(two ? it + NGW : it);
        f32x4 v0[8], v1[8];
        conv_load(j0, LANE_, v0); conv_load(j1, LANE_, v1);
        conv_store(j0, LANE_, v0); if (two) conv_store(j1, LANE_, v1);
    }
    if (F.G != 256) conv_fp8_items(F, 0, CONV_A, gw, NGW);
    { const float* WR = fin(F, I_WROUTER); bf16* WH = (bf16*)(F.ws + WS_WRT); bf16* WL = WH + (size_t)NE * D;
      for (int i = gw * 64 + LANE_; i < NE * (D / 8); i += NGW * 64) { const int e = i & 63, k0 = (i >> 6) * 8; float x[8]; unsigned hh[8], ll[8];
#pragma unroll
          for (int j = 0; j < 8; ++j) x[j] = WR[(size_t)(k0 + j) * NE + e];
#pragma unroll
          for (int j = 0; j < 8; ++j) { hh[j] = pk2(x[j], 0.f) & 0xffffu; ll[j] = pk2(x[j] - bf_lo(hh[j]), 0.f) & 0xffffu; }
          v4u oh, ol; oh.x = hh[0] | (hh[1] << 16); oh.y = hh[2] | (hh[3] << 16); oh.z = hh[4] | (hh[5] << 16); oh.w = hh[6] | (hh[7] << 16);
          ol.x = ll[0] | (ll[1] << 16); ol.y = ll[2] | (ll[3] << 16); ol.z = ll[4] | (ll[5] << 16); ol.w = ll[6] | (ll[7] << 16);
          const size_t fo = ((size_t)((k0 >> 5) * 4 + (e >> 4)) * 16 + (e & 15)) * 32 + (k0 & 31);
          *(v4u*)(WH + fo) = oh; *(v4u*)(WL + fo) = ol; } }
    { const float* P = fin(F, I_P); bf16* PB = (bf16*)(F.ws + WS_PBF);
      for (int i = gw * 64 + LANE_; i < T * PLE / 8; i += NGW * 64) { const f32x4 a = *(const f32x4*)(P + (size_t)i * 8), b = *(const f32x4*)(P + (size_t)i * 8 + 4);
          v4u o; o.x = pk2(a[0], a[1]); o.y = pk2(a[2], a[3]); o.z = pk2(b[0], b[1]); o.w = pk2(b[2], b[3]); *(v4u*)(PB + (size_t)i * 8) = o; } }
    bf16* ABF = (bf16*)(F.ws + WS_ABF);
    for (int m = gw; m < T; m += NGW) rms_row_to_bf16(fin(F, I_X) + (size_t)m * D, fin(F, I_GMIX), ABF + (size_t)m * D, LANE_);
    if (F.G == 256) conv_dyn(F, 0);
}

__device__ __forceinline__ int t5_bucket(int n) {
    if (n < 16) return n;
    const int large = 16 + (int)(logf((float)n * (1.0f / 16.0f)) / logf(8.0f) * 16.0f);
    return large < 31 ? large : 31;
}
constexpr int VT_LD = 216, VT_KEYS = 208, KT_LD = 72;
constexpr int ATT_KT_OFF = 0, ATT_VT_OFF = VT_KEYS * KT_LD * 2;
__device__ __forceinline__ void attn_task(Frame& F, const LAS float* btab, const LAS bf16* ktl, const LAS bf16* vtl, int b, int kvh, int hg, int qt, const bf16x8 (&qf)[2]) {
    const int LANE_ = pg8::lane_id();
    bf16* MIX = (bf16*)(F.ws + WS_MIX);
    const int lane = LANE_, qi = lane & 15, g = lane >> 4, h = kvh * 8 + hg;
    const int q0 = qt * 16, tok0 = b * SEQ, kl0 = 16 * (qt & 3);
    f32x4 s[5][2];
#pragma unroll
    for (int kb = 0; kb < 5; ++kb)
#pragma unroll
        for (int t = 0; t < 2; ++t) {
            const LAS bf16* kp = ktl + (kl0 + 32 * kb + 16 * t + qi) * KT_LD + 8 * g;
            const bf16x8 k0f = *(const LAS bf16x8*)(kp), k1f = *(const LAS bf16x8*)(kp + 32);
            f32x4 a = (f32x4){0.f, 0.f, 0.f, 0.f};
            a = __builtin_amdgcn_mfma_f32_16x16x32_bf16(k0f, qf[0], a, 0, 0, 0);
            a = __builtin_amdgcn_mfma_f32_16x16x32_bf16(k1f, qf[1], a, 0, 0, 0);
            s[kb][t] = a;
        }
    const float sink = fin(F, I_SINKS)[h];
    const LAS float* bt = btab + hg * 128;
    float mx = sink;
#pragma unroll
    for (int kb = 0; kb < 5; ++kb)
#pragma unroll
        for (int t = 0; t < 2; ++t)
#pragma unroll
            for (int r = 0; r < 4; ++r) {
                const int key = q0 - 128 + 32 * kb + 16 * t + 4 * g + r, dist = q0 + qi - key;
                const bool valid = (dist >= 0) && (dist < 128) && (key >= 0);
                const float lg = valid ? s[kb][t][r] * 0.125f + bt[dist & 127] : -3.0e38f;
                s[kb][t][r] = lg; mx = fmaxf(mx, lg);
            }
    mx = fmaxf(mx, __shfl_xor(mx, 16)); mx = fmaxf(mx, __shfl_xor(mx, 32));
    float sum = 0.f;
#pragma unroll
    for (int kb = 0; kb < 5; ++kb)
#pragma unroll
        for (int t = 0; t < 2; ++t)
#pragma unroll
            for (int r = 0; r < 4; ++r) { const float lg = s[kb][t][r]; const float p = (lg > -1.0e38f) ? __expf(lg - mx) : 0.f; s[kb][t][r] = p; sum += p; }
    sum += __shfl_xor(sum, 16); sum += __shfl_xor(sum, 32);
    const float inv = 1.0f / (sum + __expf(sink - mx));
    f32x4 o[4];
#pragma unroll
    for (int dt = 0; dt < 4; ++dt) o[dt] = (f32x4){0.f, 0.f, 0.f, 0.f};
#pragma unroll
    for (int kb = 0; kb < 5; ++kb) {
        v4u pw; pw.x = pk2(s[kb][0][0], s[kb][0][1]); pw.y = pk2(s[kb][0][2], s[kb][0][3]); pw.z = pk2(s[kb][1][0], s[kb][1][1]); pw.w = pk2(s[kb][1][2], s[kb][1][3]);
        const bf16x8 pf = __builtin_bit_cast(bf16x8, pw);
        const int kkl = kl0 + 32 * kb + 4 * g;
#pragma unroll
        for (int dt = 0; dt < 4; ++dt) {
            const LAS bf16* vp = vtl + (16 * dt + qi) * VT_LD + kkl;
            const v2u lo = *(const LAS v2u*)(vp), hi = *(const LAS v2u*)(vp + 16);
            const v4u vw = (v4u){lo.x, lo.y, hi.x, hi.y};
            o[dt] = __builtin_amdgcn_mfma_f32_16x16x32_bf16(__builtin_bit_cast(bf16x8, vw), pf, o[dt], 0, 0, 0);
        }
    }
    bf16* op = MIX + (size_t)(tok0 + q0 + qi) * D + POOLW + h * 64 + 4 * g;
#pragma unroll
    for (int dt = 0; dt < 4; ++dt) { v2u w; w.x = pk2(o[dt][0] * inv, o[dt][1] * inv); w.y = pk2(o[dt][2] * inv, o[dt][3] * inv); *(v2u*)(op + 16 * dt) = w; }
}
__device__ __forceinline__ void attn_block(Frame& F, int blk, bool fill_btab) {
    const int TID_ = F.wave * 64 + pg8::lane_id();
    LAS float* btab = (LAS float*)(F.lds + TAB_OFF + 2048);
    LAS bf16* ktl = (LAS bf16*)(F.lds + RING_OFF + ATT_KT_OFF); LAS bf16* vtl = (LAS bf16*)(F.lds + RING_OFF + ATT_VT_OFF);
    const int b = blk >> 6, kvh = (blk >> 5) & 1, qg = blk & 31;
    const bf16* Q = (const bf16*)(F.ws + WS_QBF); const bf16* KVp = (const bf16*)(F.ws + WS_KV);
    bf16x8 qf[4][2];
    { const int lane = TID_ & 63, qi = lane & 15, g = lane >> 4, h = kvh * 8 + F.wave;
#pragma unroll
      for (int i = 0; i < 4; ++i)
#pragma unroll
          for (int ks = 0; ks < 2; ++ks) qf[i][ks] = *(const bf16x8*)(Q + (size_t)(b * SEQ + 64 * qg + 16 * i + qi) * 1024 + h * 64 + 32 * ks + 8 * g); }
    v4u kv[4], vv[4];
#pragma unroll
    for (int it = 0; it < 4; ++it) { const int idx = TID_ + it * NWAVES * 64, kl = idx >> 3, c = idx & 7, key = 64 * qg - 128 + kl;
        kv[it] = (v4u){0u, 0u, 0u, 0u}; vv[it] = (v4u){0u, 0u, 0u, 0u};
        if (idx < VT_KEYS * 8 && key >= 0 && key < SEQ) { const bf16* rp = KVp + (size_t)(b * SEQ + key) * (2 * KVW) + kvh * 64 + 8 * c; kv[it] = *(const v4u*)(rp); vv[it] = *(const v4u*)(rp + KVW); } }
    __syncthreads();
    if (fill_btab) for (int i = TID_; i < 1024; i += NWAVES * 64) { const int hg = i >> 7, dist = i & 127; btab[i] = fin(F, I_RPE)[t5_bucket(dist) * NH + kvh * 8 + hg]; }
#pragma unroll
    for (int it = 0; it < 4; ++it) { const int idx = TID_ + it * NWAVES * 64, kl = idx >> 3, c = idx & 7;
        if (idx < VT_KEYS * 8) { const v4u v = vv[it];
            *(LAS v4u*)(ktl + kl * KT_LD + 8 * c) = kv[it];
            LAS bf16* d0 = vtl + (8 * c) * VT_LD + kl;
            d0[0 * VT_LD] = (bf16)(v.x & 0xffffu); d0[1 * VT_LD] = (bf16)(v.x >> 16); d0[2 * VT_LD] = (bf16)(v.y & 0xffffu); d0[3 * VT_LD] = (bf16)(v.y >> 16);
            d0[4 * VT_LD] = (bf16)(v.z & 0xffffu); d0[5 * VT_LD] = (bf16)(v.z >> 16); d0[6 * VT_LD] = (bf16)(v.w & 0xffffu); d0[7 * VT_LD] = (bf16)(v.w >> 16); } }
    __syncthreads();
#pragma unroll
    for (int i = 0; i < 4; ++i) attn_task(F, btab, ktl, vtl, b, kvh, F.wave, 4 * qg + i, qf[i]);
}
__device__ __forceinline__ void pool_task(Frame& F, int mt, int gq) {
    const int LANE_ = pg8::lane_id(), TID_ = F.wave * 64 + LANE_;
    const bf16* U = (const bf16*)(F.ws + WS_UBF); bf16* PO = (bf16*)(F.ws + WS_POOLED);
    LAS v4u* UL = (LAS v4u*)(F.lds + RING_OFF);
    const int w = 2 << gq;
    for (int hh = 0; hh < 2; ++hh) {
        const int tbase = mt * 256 + 128 * hh, pos0 = tbase & (SEQ - 1);
        __syncthreads();
        for (int idx = TID_; idx < 143 * 32; idx += NWAVES * 64) { const int r = idx >> 5, c = idx & 31;
            v4u x = (v4u){0u, 0u, 0u, 0u}; if (pos0 - 15 + r >= 0) x = *(const v4u*)(U + (size_t)(tbase - 15 + r) * POOLW + gq * 256 + 8 * c);
            UL[idx] = x; }
        __syncthreads();
        const int c = TID_ & 31, i0 = (TID_ >> 5) * 8;
        float run[8];
#pragma unroll
        for (int q = 0; q < 8; ++q) run[q] = 0.f;
        for (int j = 1; j < w; ++j) { const v4u x = UL[(15 + i0 - j) * 32 + c];
            run[0] += bf_lo(x.x); run[1] += bf_hi(x.x); run[2] += bf_lo(x.y); run[3] += bf_hi(x.y); run[4] += bf_lo(x.z); run[5] += bf_hi(x.z); run[6] += bf_lo(x.w); run[7] += bf_hi(x.w); }
#pragma unroll
        for (int i = 0; i < 8; ++i) {
            const int pos = pos0 + i0 + i; const v4u x = UL[(15 + i0 + i) * 32 + c], y = UL[(15 + i0 + i - w + 1) * 32 + c];
            const float uv[8] = {bf_lo(x.x), bf_hi(x.x), bf_lo(x.y), bf_hi(x.y), bf_lo(x.z), bf_hi(x.z), bf_lo(x.w), bf_hi(x.w)};
            const float ic = 1.0f / (float)((pos + 1) < w ? (pos + 1) : w);
            float o[8];
#pragma unroll
            for (int q = 0; q < 8; ++q) { run[q] += uv[q]; o[q] = run[q] * ic - uv[q]; }
            v4u ow; ow.x = pk2(o[0], o[1]); ow.y = pk2(o[2], o[3]); ow.z = pk2(o[4], o[5]); ow.w = pk2(o[6], o[7]);
            *(v4u*)(PO + (size_t)(tbase + i0 + i) * POOLW + gq * 256 + 8 * c) = ow;
            run[0] -= bf_lo(y.x); run[1] -= bf_hi(y.x); run[2] -= bf_lo(y.y); run[3] -= bf_hi(y.y); run[4] -= bf_lo(y.z); run[5] -= bf_hi(y.z); run[6] -= bf_lo(y.w); run[7] -= bf_hi(y.w);
        }
    }
    VM_WAIT(); __syncthreads();
    pg8::Gemm g{(const bf16*)PO + gq * 256, (const bf16*)(F.ws + WS_WPOOL) + (size_t)gq * 65536, POOLW, 256, 256};
    pg8::SingleOrder S{mt, 0};
    EpiBf16Plain E{(bf16*)(F.ws + WS_MIX), D, gq * 256, fin(F, I_PSCALE)};
    pg8::gemm_phase<EpiBf16Plain, pg8::SingleOrder, false>(F.lds + RING_OFF, g, S, E, F.wave);
}

constexpr int XS_STRIDE = 2052;
constexpr int P4_XS = 0, P4_PART = 16 * XS_STRIDE * 4, P4_SELE = P4_PART + 4 * 16 * 64 * 4, P4_SELW = P4_SELE + 32 * 8 * 4, P4_SELL = P4_SELW + 32 * 8 * 4, P4_HIST = P4_SELL + 32 * 8 * 4, P4_BASE = P4_HIST + 256, P4_END = P4_BASE + 256;
static_assert(P4_END <= MISC_OFF, "P4 LDS map");
__device__ __forceinline__ unsigned fkey(float f) { const unsigned u = __builtin_bit_cast(unsigned, f); return (u & 0x80000000u) ? ~u : (u | 0x80000000u); }
__device__ __forceinline__ void p4_route(Frame& F) {
    const int LANE_ = pg8::lane_id(), TID_ = F.wave * 64 + LANE_; (void)TID_;
    LAS float* XS = (LAS float*)(F.lds + P4_XS); LAS float* PART = (LAS float*)(F.lds + P4_PART);
    LAS int* SELE = (LAS int*)(F.lds + P4_SELE); LAS float* SELW = (LAS float*)(F.lds + P4_SELW); LAS int* SELL = (LAS int*)(F.lds + P4_SELL);
    LAS int* HIST = (LAS int*)(F.lds + P4_HIST); LAS int* BASE = (LAS int*)(F.lds + P4_BASE);
    const float* H1 = (const float*)(F.ws + WS_H1); unsigned char* XN = F.ws + WS_XN; const float* gf = fin(F, I_GFFN); const float* rb = fin(F, I_RBIAS);
    const bf16* WH = (const bf16*)(F.ws + WS_WRT); const bf16* WL = WH + (size_t)NE * D;
    const int lane = LANE_, wave = F.wave, ti = lane & 15, kk = lane >> 4;
    if (TID_ < 64) HIST[TID_] = 0;
    for (int tile = F.bx; tile < T / 32; tile += F.G) {
    f32x4 xr[2][8];
#pragma unroll
    for (int q = 0; q < 2; ++q) { const float* xrow = H1 + (size_t)(tile * 32 + 2 * wave + q) * D;
#pragma unroll
        for (int j = 0; j < 4; ++j) { xr[q][2 * j] = *(const f32x4*)(xrow + 512 * j + 8 * lane); xr[q][2 * j + 1] = *(const f32x4*)(xrow + 512 * j + 8 * lane + 4); } }
#pragma unroll 1
    for (int pass = 0; pass < 2; ++pass) {
#pragma unroll
        for (int q = 0; q < 2; ++q) { const int tl = 2 * wave + q; float s = 0.f;
#pragma unroll
            for (int j = 0; j < 8; ++j) { const f32x4 v = xr[q][j]; s += (v[0] * v[0] + v[1] * v[1]) + (v[2] * v[2] + v[3] * v[3]); }
            const float rstd = 1.0f / sqrtf(wave_sum(s) * (1.0f / D) + EPS);
#pragma unroll
            for (int j = 0; j < 4; ++j) { const f32x4 a = xr[q][2 * j] * rstd * *(const f32x4*)(gf + 512 * j + 8 * lane), b = xr[q][2 * j + 1] * rstd * *(const f32x4*)(gf + 512 * j + 8 * lane + 4);
                *(LAS f32x4*)(XS + tl * XS_STRIDE + 512 * j + 8 * lane) = a; *(LAS f32x4*)(XS + tl * XS_STRIDE + 512 * j + 8 * lane + 4) = b;
                v2u o; o.x = pk4_fp8(a[0], a[1], a[2], a[3]); o.y = pk4_fp8(b[0], b[1], b[2], b[3]);
                *(v2u*)(XN + (size_t)(tile * 32 + 16 * pass + tl) * D + 512 * j + 8 * lane) = o; } }
        if (pass == 0) {
#pragma unroll
            for (int q = 0; q < 2; ++q) { const float* xrow = H1 + (size_t)(tile * 32 + 16 + 2 * wave + q) * D;
#pragma unroll
                for (int j = 0; j < 4; ++j) { xr[q][2 * j] = *(const f32x4*)(xrow + 512 * j + 8 * lane); xr[q][2 * j + 1] = *(const f32x4*)(xrow + 512 * j + 8 * lane + 4); } } }
        f32x4 acc[4];
#pragma unroll
        for (int et = 0; et < 4; ++et) acc[et] = (f32x4){0.f, 0.f, 0.f, 0.f};
        bf16x8 wh0[4], wl0[4], wh1[4], wl1[4];
#define P4_LDW(WHX, WLX, st) do { const size_t fo_ = ((size_t)((8 * wave + (st)) * 4) * 16 + ti) * 32 + 8 * kk; _Pragma("unroll") for (int et = 0; et < 4; ++et) { WHX[et] = *(const bf16x8*)(WH + fo_ + et * 512); WLX[et] = *(const bf16x8*)(WL + fo_ + et * 512); } } while (0)
#define P4_STEP(WHX, WLX, st) do { const int k0_ = 256 * wave + 32 * (st) + 8 * kk; \
            const f32x4 xa = *(const LAS f32x4*)(XS + ti * XS_STRIDE + k0_), xb = *(const LAS f32x4*)(XS + ti * XS_STRIDE + k0_ + 4); v4u hw, lw; \
            hw.x = pk2(xa[0], xa[1]); hw.y = pk2(xa[2], xa[3]); hw.z = pk2(xb[0], xb[1]); hw.w = pk2(xb[2], xb[3]); \
            lw.x = pk2(xa[0] - bf_lo(hw.x), xa[1] - bf_hi(hw.x)); lw.y = pk2(xa[2] - bf_lo(hw.y), xa[3] - bf_hi(hw.y)); lw.z = pk2(xb[0] - bf_lo(hw.z), xb[1] - bf_hi(hw.z)); lw.w = pk2(xb[2] - bf_lo(hw.w), xb[3] - bf_hi(hw.w)); \
            const bf16x8 xh = __builtin_bit_cast(bf16x8, hw), xl = __builtin_bit_cast(bf16x8, lw); \
            _Pragma("unroll") for (int et = 0; et < 4; ++et) { acc[et] = __builtin_amdgcn_mfma_f32_16x16x32_bf16(xh, WHX[et], acc[et], 0, 0, 0); \
                acc[et] = __builtin_amdgcn_mfma_f32_16x16x32_bf16(xl, WHX[et], acc[et], 0, 0, 0); acc[et] = __builtin_amdgcn_mfma_f32_16x16x32_bf16(xh, WLX[et], acc[et], 0, 0, 0); } } while (0)
        P4_LDW(wh0, wl0, 0);
        __syncthreads();
#pragma unroll 1
        for (int st = 0; st < 8; st += 2) { P4_LDW(wh1, wl1, st + 1); P4_STEP(wh0, wl0, st); if (st + 2 < 8) P4_LDW(wh0, wl0, st + 2); P4_STEP(wh1, wl1, st + 1); }
#undef P4_LDW
#undef P4_STEP
        if (wave >= 4) {
#pragma unroll
            for (int et = 0; et < 4; ++et)
#pragma unroll
                for (int r = 0; r < 4; ++r) PART[(wave - 4) * 1024 + (4 * kk + r) * 64 + 16 * et + ti] = acc[et][r];
        }
        __syncthreads();
        if (wave < 4) {
#pragma unroll
            for (int et = 0; et < 4; ++et)
#pragma unroll
                for (int r = 0; r < 4; ++r) { LAS float* pp = PART + wave * 1024 + (4 * kk + r) * 64 + 16 * et + ti; *pp = *pp + acc[et][r]; }
        }
        __syncthreads();
#pragma unroll 1
        for (int q = 0; q < 2; ++q) {
            const int tl = 2 * wave + q, tw = pass * 16 + tl;
            const float lg = (PART[tl * 64 + lane] + PART[1024 + tl * 64 + lane]) + (PART[2048 + tl * 64 + lane] + PART[3072 + tl * 64 + lane]);
            const float score = 1.0f / (1.0f + expf(-lg)), biased = score + rb[lane];
            const int grp = lane >> 3;
            float m1 = biased; m1 = fmaxf(m1, __shfl_xor(m1, 1)); m1 = fmaxf(m1, __shfl_xor(m1, 2)); m1 = fmaxf(m1, __shfl_xor(m1, 4));
            const unsigned long long bm = __ballot(biased == m1); const unsigned gb = (unsigned)(bm >> (8 * grp)) & 0xffu; const int first = __builtin_ctz(gb);
            float v2 = ((lane & 7) == first) ? -3.0e38f : biased; float m2 = v2; m2 = fmaxf(m2, __shfl_xor(m2, 1)); m2 = fmaxf(m2, __shfl_xor(m2, 2)); m2 = fmaxf(m2, __shfl_xor(m2, 4));
            const unsigned gk = (fkey(m1 + m2) & ~7u) | (unsigned)(7 - grp);
            int grank = 0;
#pragma unroll
            for (int j = 0; j < 8; ++j) { const unsigned sj = (unsigned)__builtin_amdgcn_readlane((int)gk, 8 * j); grank += (sj > gk) ? 1 : 0; }
            const bool gsel = grank < 4;
            const unsigned key = gsel ? ((fkey(biased) & ~63u) | (unsigned)(63 - lane)) : (unsigned)(63 - lane);
            int rank = 0;
#pragma unroll
            for (int j = 0; j < 64; ++j) { const unsigned sj = (unsigned)__builtin_amdgcn_readlane((int)key, j); rank += (sj > key) ? 1 : 0; }
            const bool sel = gsel && (rank < 8);
            const float wsum = wave_sum(sel ? score : 0.f);
            const unsigned long long sm = __ballot(sel);
            if (sel) { const int k = __popcll(sm & ((1ull << lane) - 1ull)); const int li = atomicAdd((int*)&HIST[lane], 1);
                SELE[tw * 8 + k] = lane; SELW[tw * 8 + k] = score / wsum * 2.5f; SELL[tw * 8 + k] = li; }
        }
        __syncthreads();
    }
    if (TID_ < 64) BASE[TID_] = (int)__hip_atomic_fetch_add(F.ctl + CW_CNT + 32 * TID_, (unsigned)HIST[TID_], RLX_AGENT);
    __syncthreads();
    if (TID_ < 256) { const int e = SELE[TID_], pos = BASE[e] + SELL[TID_], tok = tile * 32 + (TID_ >> 3);
        ((int*)(F.ws + WS_TOKLIST))[(size_t)e * T + pos] = tok; ((float*)(F.ws + WS_WREC))[tok * 8 + (TID_ & 7)] = SELW[TID_]; ((int*)(F.ws + WS_REC))[tok * 8 + (TID_ & 7)] = e * T + pos; }
    __syncthreads();
    if (TID_ < 64) HIST[TID_] = 0;
    __syncthreads();
    }
}

__device__ __forceinline__ void p7_combine(Frame& F, bool dry) {
    const int LANE_ = pg8::lane_id();
    const LAS int* tab = (const LAS int*)(F.lds + TAB_OFF);
    const unsigned char* Y = F.ws + WS_Y; const int* rec = (const int*)(F.ws + WS_REC); const float* wrec = (const float*)(F.ws + WS_WREC);
    const float* H = (const float*)(F.ws + WS_H1); bf16* HO = dry ? (bf16*)(F.ws + WS_WGU) : (bf16*)(F.ws + WS_H2B); unsigned char* H2 = dry ? (F.ws + WS_WGU + 64 * MiB) : (F.ws + WS_H2F8);
    const int gw = F.bx * NWAVES + F.wave, NGW = F.G * NWAVES, lane = LANE_;
    for (int t = gw; t < T; t += NGW) {
        int rows[9]; float rwt[9];
#pragma unroll
        for (int k = 0; k < 8; ++k) { const int rc = rec[t * 8 + k]; const int e = rc >> 13, pos = rc & (T - 1); rows[k] = tab[TB_PAD + e] + pos; rwt[k] = wrec[t * 8 + k] * (1.0f / SY); }
        rows[8] = SH_ROW0 + t; rwt[8] = 1.0f / SY;
        v4u y[2][9]; f32x4 h[2][4];
#pragma unroll
        for (int j = 0; j < 2; ++j) { const int c0 = 1024 * j + 16 * lane;
#pragma unroll
            for (int q = 0; q < 4; ++q) h[j][q] = *(const f32x4*)(H + (size_t)t * D + c0 + 4 * q);
#pragma unroll
            for (int k = 0; k < 9; ++k) y[j][k] = *(const v4u*)(Y + (size_t)rows[k] * D + c0); }
#pragma unroll
        for (int j = 0; j < 2; ++j) { const int c0 = 1024 * j + 16 * lane;
#pragma unroll
            for (int k = 0; k < 9; ++k) { const float w = rwt[k]; float f[4];
                fp8x4_to_f32(y[j][k].x, f); h[j][0][0] += w * f[0]; h[j][0][1] += w * f[1]; h[j][0][2] += w * f[2]; h[j][0][3] += w * f[3];
                fp8x4_to_f32(y[j][k].y, f); h[j][1][0] += w * f[0]; h[j][1][1] += w * f[1]; h[j][1][2] += w * f[2]; h[j][1][3] += w * f[3];
                fp8x4_to_f32(y[j][k].z, f); h[j][2][0] += w * f[0]; h[j][2][1] += w * f[1]; h[j][2][2] += w * f[2]; h[j][2][3] += w * f[3];
                fp8x4_to_f32(y[j][k].w, f); h[j][3][0] += w * f[0]; h[j][3][1] += w * f[1]; h[j][3][2] += w * f[2]; h[j][3][3] += w * f[3]; }
            { v4u b0, b1; b0.x = pk2(h[j][0][0], h[j][0][1]); b0.y = pk2(h[j][0][2], h[j][0][3]); b0.z = pk2(h[j][1][0], h[j][1][1]); b0.w = pk2(h[j][1][2], h[j][1][3]);
              b1.x = pk2(h[j][2][0], h[j][2][1]); b1.y = pk2(h[j][2][2], h[j][2][3]); b1.z = pk2(h[j][3][0], h[j][3][1]); b1.w = pk2(h[j][3][2], h[j][3][3]);
              *(v4u*)(HO + (size_t)t * D + c0) = b0; *(v4u*)(HO + (size_t)t * D + c0 + 8) = b1; }
            v4u o; o.x = pk4_fp8(h[j][0][0], h[j][0][1], h[j][0][2], h[j][0][3]); o.y = pk4_fp8(h[j][1][0], h[j][1][1], h[j][1][2], h[j][1][3]);
            o.z = pk4_fp8(h[j][2][0], h[j][2][1], h[j][2][2], h[j][2][3]); o.w = pk4_fp8(h[j][3][0], h[j][3][1], h[j][3][2], h[j][3][3]);
            *(v4u*)(H2 + (size_t)t * D + c0) = o; }
    }
}
__device__ __forceinline__ void p9_final(Frame& F, bool dry) {
    const int LANE_ = pg8::lane_id();
    const int gw = F.bx * NWAVES + F.wave, NGW = F.G * NWAVES, lane = LANE_; const float* g = fin(F, I_GFINAL); const float* gp = fin(F, I_GPLE);
    const bf16* G = (const bf16*)(F.ws + WS_GBUF); const bf16* PP = (const bf16*)(F.ws + WS_PPROJ);
    for (int t = gw; t < T; t += NGW) {
        const bf16* row = (const bf16*)(F.ws + WS_H2B) + (size_t)t * D; float* orow = (dry ? (float*)(F.ws + WS_WGU) : F.out) + (size_t)t * D; f32x4 v[8]; v4u gg[4], pw[4];
#pragma unroll
        for (int j = 0; j < 4; ++j) { const v4u hw = *(const v4u*)(row + 512 * j + 8 * lane);
            v[2 * j] = (f32x4){bf_lo(hw.x), bf_hi(hw.x), bf_lo(hw.y), bf_hi(hw.y)}; v[2 * j + 1] = (f32x4){bf_lo(hw.z), bf_hi(hw.z), bf_lo(hw.w), bf_hi(hw.w)};
            gg[j] = *(const v4u*)(G + (size_t)t * D + 512 * j + 8 * lane); pw[j] = *(const v4u*)(PP + (size_t)t * D + 512 * j + 8 * lane); }
        float pf[4][8]; float ps = 0.f;
#pragma unroll
        for (int j = 0; j < 4; ++j) { pf[j][0] = bf_lo(pw[j].x); pf[j][1] = bf_hi(pw[j].x); pf[j][2] = bf_lo(pw[j].y); pf[j][3] = bf_hi(pw[j].y); pf[j][4] = bf_lo(pw[j].z); pf[j][5] = bf_hi(pw[j].z); pf[j][6] = bf_lo(pw[j].w); pf[j][7] = bf_hi(pw[j].w);
#pragma unroll
            for (int q = 0; q < 8; ++q) ps += pf[j][q] * pf[j][q]; }
        const float rsp = 1.0f / sqrtf(wave_sum(ps) * (1.0f / D) + EPS);
        float s = 0.f;
#pragma unroll
        for (int j = 0; j < 4; ++j) { const f32x4 g0 = *(const f32x4*)(gp + 512 * j + 8 * lane), g1 = *(const f32x4*)(gp + 512 * j + 8 * lane + 4);
            const float gl[8] = {bf_lo(gg[j].x), bf_hi(gg[j].x), bf_lo(gg[j].y), bf_hi(gg[j].y), bf_lo(gg[j].z), bf_hi(gg[j].z), bf_lo(gg[j].w), bf_hi(gg[j].w)};
#pragma unroll
            for (int q = 0; q < 4; ++q) { v[2 * j][q] += sigmoid_f(gl[q]) * pf[j][q] * rsp * g0[q]; v[2 * j + 1][q] += sigmoid_f(gl[4 + q]) * pf[j][4 + q] * rsp * g1[q]; }
            s += (v[2 * j][0] * v[2 * j][0] + v[2 * j][1] * v[2 * j][1]) + (v[2 * j][2] * v[2 * j][2] + v[2 * j][3] * v[2 * j][3]);
            s += (v[2 * j + 1][0] * v[2 * j + 1][0] + v[2 * j + 1][1] * v[2 * j + 1][1]) + (v[2 * j + 1][2] * v[2 * j + 1][2] + v[2 * j + 1][3] * v[2 * j + 1][3]); }
        const float rstd = 1.0f / sqrtf(wave_sum(s) * (1.0f / D) + EPS);
#pragma unroll
        for (int j = 0; j < 4; ++j) { const f32x4 g0 = *(const f32x4*)(g + 512 * j + 8 * lane), g1 = *(const f32x4*)(g + 512 * j + 8 * lane + 4);
            *(f32x4*)(orow + 512 * j + 8 * lane) = v[2 * j] * rstd * g0; *(f32x4*)(orow + 512 * j + 8 * lane + 4) = v[2 * j + 1] * rstd * g1; }
    }
}
__global__ void __launch_bounds__(NWAVES * 64, 2) fwd_kernel(Args args) {
    extern __shared__ __attribute__((aligned(16))) unsigned char lds[];
    Frame F;
    F.lds = (LAS unsigned char*)lds;
    F.MISC = (volatile LAS unsigned*)(F.lds + MISC_OFF);
    F.wave = __builtin_amdgcn_readfirstlane(threadIdx.x >> 6);
    F.G = gridDim.x; F.bx = blockIdx.x;
    F.ws = args.ws; F.ctl = (gu32*)(args.ws + WS_CTL); F.out = args.out;
    { const int TID_ = threadIdx.x;
    if (TID_ < 64) F.MISC[TID_] = 0u;
    if (TID_ >= 64 && TID_ < 64 + 22) ((LAS unsigned long long*)(F.lds + MISC_OFF + 256))[TID_ - 64] = ((const unsigned long long*)&args)[TID_ - 64]; }
    __syncthreads();
    XcdBarrier bar; bar.bar = (unsigned*)(F.ctl + CW_BAR); bar.x = 0; bar.st = nullptr;
    if (N_LAUNCHES == 1) bar = xcd_barrier_post((unsigned*)(F.ctl + CW_BAR), F.MISC + 8);
#define GRID_BAR() do { if (N_LAUNCHES == 1) xcd_barrier(bar); } while (0)
    const int lo = args.ph_lo, hi = args.ph_hi;
#ifndef PH_MASK
#define PH_MASK 0x3ff
#endif
#ifndef DUP_PHASE
#define DUP_PHASE -1
#endif
#define REPS(k) ((DUP_PHASE == (k)) ? 2 : 1)
#define IN(k) ((((PH_MASK) >> (k)) & 1) && lo <= (k) && (k) < hi)
#define BOTH(k) (IN(k) && IN((k) + 1))

    if (IN(0)) { _Pragma("unroll") for (int rep = 0; rep < REPS(0); ++rep) { p0_prologue(F); if (BOTH(0)) GRID_BAR(); } }

    if (IN(1)) { _Pragma("unroll") for (int rep = 0; rep < REPS(1); ++rep) {
        constexpr int G1 = 144;
        if (F.G == 256 && F.bx >= G1) {
            { pg8::Gemm g{(const bf16*)(F.ws + WS_PBF), (const bf16*)(F.ws + WS_WPP), PLE, PLE, PLE}; pg8::StaticOrder S; S.init(T, D, F.G - G1, F.bx - G1);
              EpiBf16Plain E{(bf16*)(F.ws + WS_PPROJ), D, 0, nullptr};
              pg8::gemm_phase<EpiBf16Plain, pg8::StaticOrder, false>(F.lds + RING_OFF, g, S, E, F.wave); }
            conv_dyn(F, 1);
        } else {
            const int gg = (F.G == 256) ? G1 : F.G;
            { pg8::Gemm g{(const bf16*)(F.ws + WS_ABF), (const bf16*)(F.ws + WS_WIN), D, D, D}; pg8::StaticOrder S; S.init(T, INW, gg, F.bx);
              EpiInProj E{F.ws};
              pg8::gemm_phase<EpiInProj, pg8::StaticOrder, false>(F.lds + RING_OFF, g, S, E, F.wave); }
            if (F.G == 256) conv_dyn(F, 1);
            if (F.G != 256) {
                { pg8::Gemm g{(const bf16*)(F.ws + WS_PBF), (const bf16*)(F.ws + WS_WPP), PLE, PLE, PLE}; pg8::StaticOrder S; S.init(T, D, F.G, F.bx);
                  EpiBf16Plain E{(bf16*)(F.ws + WS_PPROJ), D, 0, nullptr};
                  pg8::gemm_phase<EpiBf16Plain, pg8::StaticOrder, false>(F.lds + RING_OFF, g, S, E, F.wave); }
                conv_fp8_items(F, CONV_A, CONV_A + CONV_B, F.bx * NWAVES + F.wave, F.G * NWAVES);
            }
        }
        if (BOTH(1)) GRID_BAR();
    } }

    if (IN(2)) { _Pragma("unroll") for (int rep = 0; rep < REPS(2); ++rep) {
        if (F.G == 256) {
            if (F.bx < 128) pool_task(F, F.bx >> 2, F.bx & 3);
            else { attn_block(F, 2 * (F.bx - 128), true); attn_block(F, 2 * (F.bx - 128) + 1, false); }
        } else {
            for (int blk = F.bx; blk < 256; blk += F.G) attn_block(F, blk, true);
            for (int p = F.bx; p < 128; p += F.G) { __syncthreads(); pool_task(F, p >> 2, p & 3); }
        }
        if (BOTH(2)) GRID_BAR();
    } }

    if (IN(3)) { _Pragma("unroll") for (int rep = 0; rep < REPS(3); ++rep) {
        constexpr int G3 = 128;
        if (F.G == 256 && F.bx >= G3) conv_dyn(F, 2);
        else {
            pg8::Gemm g{(const bf16*)(F.ws + WS_MIX), (const bf16*)(F.ws + WS_WOUT), D, D, D}; pg8::StaticOrder S; S.init(T, D, (F.G == 256) ? G3 : F.G, F.bx);
            EpiResF32 E{fin(F, I_X), (float*)(F.ws + WS_H1)};
            pg8::gemm_phase<EpiResF32, pg8::StaticOrder, false>(F.lds + RING_OFF, g, S, E, F.wave);
            if (F.G == 256) conv_dyn(F, 2);
            if (F.G != 256) conv_fp8_items(F, CONV_A + CONV_B, CV_TOTAL, F.bx * NWAVES + F.wave, F.G * NWAVES);
        }
        if (BOTH(3)) GRID_BAR();
    } }

    if (IN(4)) { _Pragma("nounroll") for (int rep = 0; rep < ((DUP_PHASE == 4) ? 2 : 1); ++rep) { if (rep == 1) { GRID_BAR(); if (F.bx == 0 && threadIdx.x < NE) __hip_atomic_store(F.ctl + CW_CNT + 32 * threadIdx.x, 0u, RLX_AGENT); GRID_BAR(); }
        p4_route(F); } if (BOTH(4)) GRID_BAR(); }

    if (IN(5)) { _Pragma("unroll") for (int rep = 0; rep < REPS(5); ++rep) {
        moe_tables(F);
        pg8::Gemm g{F.ws + WS_XN, F.ws + WS_WGU, D, D, D};
        MoeOrder S{(const LAS int*)(F.lds + TAB_OFF), (const int*)(F.ws + WS_TOKLIST), F.bx & 7, F.bx >> 3, 4, F.G >> 3};
        EpiGateUp E{F.ws + WS_ACT};
        pg8::gemm_phase<EpiGateUp, MoeOrder, true, 1>(F.lds + RING_OFF, g, S, E, F.wave);
        if (BOTH(5)) GRID_BAR();
    } }

    if (IN(6)) { _Pragma("unroll") for (int rep = 0; rep < REPS(6); ++rep) {
        if (!IN(5)) moe_tables(F);
        pg8::Gemm g{F.ws + WS_ACT, F.ws + WS_WD, EFF, EFF, EFF};
        MoeOrder S{(const LAS int*)(F.lds + TAB_OFF), (const int*)(F.ws + WS_TOKLIST), F.bx & 7, F.bx >> 3, 8, F.G >> 3};
        EpiDown E{F.ws + WS_Y};
        pg8::gemm_phase<EpiDown, MoeOrder, false, 1>(F.lds + RING_OFF, g, S, E, F.wave);
        if (BOTH(6)) GRID_BAR();
    } }

    if (IN(7)) { if (!IN(6)) moe_tables(F); if (DUP_PHASE == 7) { p7_combine(F, true); GRID_BAR(); } p7_combine(F, false); if (BOTH(7)) GRID_BAR(); }

    if (IN(8)) {
        pg8::Gemm g{F.ws + WS_H2F8, F.ws + WS_WPG, D, D, D}; pg8::StaticOrder S; S.init(T, D, F.G, F.bx);
        EpiBf16Mul E{(bf16*)(F.ws + WS_GBUF), 1.0f / SW3};
        pg8::gemm_phase<EpiBf16Mul, pg8::StaticOrder, false, 1>(F.lds + RING_OFF, g, S, E, F.wave);
        if (BOTH(8)) GRID_BAR();
    }

    if (IN(9)) { if (DUP_PHASE == 9) { p9_final(F, true); GRID_BAR(); } p9_final(F, false); }
#undef IN
#undef BOTH
}

extern "C" void kernel_launch(void* const* d_in, const int* in_sizes, int n_in, void* d_out, int out_size, void* d_ws, size_t ws_size, hipStream_t stream) {
    static int grid = 0;
    if (grid == 0) {
        if (n_in != 22 || out_size != T * D || ws_size < WS_END) { fprintf(stderr, "kernel_launch: unexpected sizes n_in %d out %d ws %zu (need %zu)\n", n_in, out_size, ws_size, (size_t)WS_END); grid = -1; return; }
        int dev = 0, cus = 0, per_cu = 0;
        if (hipGetDevice(&dev) != hipSuccess || hipDeviceGetAttribute(&cus, hipDeviceAttributeMultiprocessorCount, dev) != hipSuccess) { grid = -1; return; }
        if (hipFuncSetAttribute((const void*)fwd_kernel, hipFuncAttributeMaxDynamicSharedMemorySize, LDS_BYTES) != hipSuccess) { fprintf(stderr, "kernel_launch: hipFuncSetAttribute failed\n"); grid = -1; return; }
        if (hipOccupancyMaxActiveBlocksPerMultiprocessor(&per_cu, (const void*)fwd_kernel, NWAVES * 64, LDS_BYTES) != hipSuccess || per_cu < 1) fprintf(stderr, "kernel_launch: occupancy query reports %d\n", per_cu);
        (void)hipGetLastError();
        grid = cus > 256 ? 256 : cus;
    }
    if (grid < 0) return;
    if (hipMemsetAsync((char*)d_ws + WS_CTL, 0, CTL_ZERO_BYTES, stream) != hipSuccess) return;
    Args a{};
    for (int i = 0; i < 22; ++i) a.in[i] = (const float*)d_in[i];
    a.out = (float*)d_out; a.ws = (unsigned char*)d_ws;
    for (int li = 0; li < N_LAUNCHES; ++li) {
        a.ph_lo = (N_LAUNCHES == 1) ? 0 : li; a.ph_hi = (N_LAUNCHES == 1) ? N_PHASES : li + 1; a.li = li;
        hipLaunchKernelGGL(fwd_kernel, dim3(grid), dim3(NWAVES * 64), LDS_BYTES, stream, a);
    }
}
```

```cpp
#include <hip/hip_runtime.h>
#include <cstdio>
#include <cstdint>

#ifndef MK_N_LAUNCHES
#define MK_N_LAUNCHES 1
#endif

namespace pg8 {
#define PG8_LAS __attribute__((address_space(3)))
typedef unsigned short bf16_t;
typedef short bf16x8 __attribute__((ext_vector_type(8)));
typedef float f32x4 __attribute__((ext_vector_type(4)));
typedef unsigned u32x4 __attribute__((ext_vector_type(4)));
typedef unsigned u32x2 __attribute__((ext_vector_type(2)));
constexpr int BM = 256, BK = 64, HALF = 128, HTB = HALF * BK * 2  , STAGE_BYTES = 8 * HTB, NXCD = 8, WGM = 8;

__host__ __device__ __forceinline__ int lds_byte(int r, int c) { const int st = (r >> 4) * 2 + (c >> 5), rr = r & 15, cc = c & 31, ob = rr * 64 + cc * 2; return st * 1024 + (ob ^ (((ob >> 9) & 1) << 5)); }
__host__ __device__ __forceinline__ void stage_rc(int b, int& R, int& C) { const int st = b / 1024, sb = b % 1024, swz = sb ^ (((sb >> 9) & 1) << 5); R = (st >> 1) * 16 + swz / 64; C = (st & 1) * 32 + (swz % 64) / 2; }
__host__ __device__ __forceinline__ int perm32(int rho) { const int n = rho >> 4, i = rho & 15; return 8 * (i >> 2) + 4 * n + (i & 3); }

struct Unit { int pm, pn, e, lt, half; };
struct Gemm { const void* A; const void* Bt; int lda, ldb, K; };
typedef int i32x8 __attribute__((ext_vector_type(8)));
typedef int i32x4 __attribute__((ext_vector_type(4)));
__device__ __forceinline__ i32x8 cat8(bf16x8 lo, bf16x8 hi) { const i32x4 a = __builtin_bit_cast(i32x4, lo), b = __builtin_bit_cast(i32x4, hi); return __builtin_shufflevector(a, b, 0, 1, 2, 3, 4, 5, 6, 7); }

struct StaticOrder {
    static constexpr bool HALVES = false;
    int nM, nN, nwg, G, c;
    __host__ __device__ void init(int M, int N, int G_, int c_) { nM = M / BM; nN = N / BM; nwg = nM * nN; G = G_; c = c_; }
    __host__ __device__ bool next(int i, Unit& u) const {
        const long L = (long)i * G + c; if (L >= nwg) return false;
        int wgid = (int)L; { const int q = nwg / NXCD, r = nwg % NXCD, xcd = wgid % NXCD, off = wgid / NXCD; wgid = (xcd < r ? xcd * (q + 1) : r * (q + 1) + (xcd - r) * q) + off; }
        const int nig = WGM * nN, gid = wgid / nig, fm = gid * WGM, gsz = (nM - fm) < WGM ? (nM - fm) : WGM;
        u.pm = fm + ((wgid % nig) % gsz); u.pn = (wgid % nig) / gsz; u.e = 0; u.lt = 0; u.half = 0; return true;
    }
    __device__ __forceinline__ int arow(const Unit&, int r) const { return r; }
};
struct SingleOrder {
    static constexpr bool HALVES = false;
    int pm, pn;
    __device__ bool next(int i, Unit& u) const { if (i > 0) return false; u.pm = pm; u.pn = pn; u.e = 0; u.lt = 0; u.half = 0; return true; }
    __device__ __forceinline__ int arow(const Unit&, int r) const { return r; }
};

__device__ __forceinline__ int lane_id() { int l; asm volatile("v_mbcnt_lo_u32_b32 %0, -1, 0\n\tv_mbcnt_hi_u32_b32 %0, -1, %0" : "=v"(l)); return l; }
__device__ __forceinline__ unsigned cvt_pk_bf16(float lo, float hi) { unsigned r; asm volatile("v_cvt_pk_bf16_f32 %0, %1, %2" : "=v"(r) : "v"(lo), "v"(hi)); return r; }

__host__ __device__ __forceinline__ int perm16(int R) { return 64 * (R >> 5) + 16 * ((R >> 2) & 3) + 4 * ((R >> 4) & 1) + (R & 3); }
template <class Epi, class Sched, bool GATHER, int ESZ = 2, bool ALIGN_EPI = true>
__device__ __forceinline__ void gemm_phase(PG8_LAS unsigned char* lds, const Gemm g, const Sched& S, const Epi& E, int wid) {
    const int lane = lane_id(), tid = wid * 64 + lane, wr = wid >> 2, wc = wid & 3, fr = lane & 15, fq = lane >> 4;
    const int nt = (g.K * ESZ) / 128;
    int Ra[2], Ca[2]; unsigned voffB[2];
#pragma unroll
    for (int i = 0; i < 2; ++i) { int R, C; stage_rc(tid * 16 + i * 8192, R, C); const int Rb = (Epi::PERM == 2) ? perm16(R) : (Epi::PERM ? ((R & ~31) + perm32(R & 31)) : R);
        Ra[i] = R; Ca[i] = C; voffB[i] = (unsigned)(Rb * g.ldb * ESZ + C * 2); }
    const size_t kstep = (size_t)(BK * 2);
    const size_t hstepB = (size_t)((Epi::PERM == 2) ? 8 : HALF) * g.ldb * ESZ, tstepB = (size_t)BM * g.ldb * ESZ;
    const size_t tstepA = (size_t)BM * g.lda * ESZ;
    const unsigned ldsw = (unsigned)wid * 1024u;
    const int aoff = lds_byte(wr * 64 + fr, fq * 8), boff = lds_byte(wc * 32 + fr, fq * 8);
#define PG8_SA(b, h) (((b) * 2 + (h)) * HTB)
#define PG8_SB(b, h) ((4 + (b) * 2 + (h)) * HTB)
#define PG8_STAGE(bufoff, gbase, v0, v1) do { \
        __builtin_amdgcn_global_load_lds((const unsigned*)((const char*)(gbase) + (v0)), (PG8_LAS unsigned*)(lds + (bufoff) + ldsw), 16, 0, 0); \
        __builtin_amdgcn_global_load_lds((const unsigned*)((const char*)(gbase) + (v1)), (PG8_LAS unsigned*)(lds + (bufoff) + ldsw + 8192), 16, 0, 0); } while (0)
#define PG8_STAGE_A0(bufoff, gbase, p0, p1) PG8_STAGE(bufoff, gbase, p0, p1)
#define PG8_STAGE_A1(bufoff, gbase, p0, p1, q0, q1) do { if constexpr (GATHER) { PG8_STAGE(bufoff, gbase, q0, q1); } else { PG8_STAGE(bufoff, (gbase) + hstepA, p0, p1); } } while (0)
#define PG8_LD16(off) (*(const PG8_LAS i32x4*)(lds + (off)))
#define PG8_LDA(dst, b, h) do { if constexpr (ESZ == 2) { _Pragma("unroll") for (int m = 0; m < 4; ++m) _Pragma("unroll") for (int k = 0; k < 2; ++k) dst[m][k] = *(const PG8_LAS bf16x8*)(lds + PG8_SA(b, h) + aoff + m * 2048 + k * 1024); } \
        else { _Pragma("unroll") for (int m = 0; m < 4; ++m) dst##8[m] = __builtin_shufflevector(PG8_LD16(PG8_SA(b, h) + aoff + m * 2048), PG8_LD16(PG8_SA(b, h) + aoff + m * 2048 + 1024), 0, 1, 2, 3, 4, 5, 6, 7); } } while (0)
#define PG8_LDB(dst, b, h) do { if constexpr (ESZ == 2) { _Pragma("unroll") for (int n = 0; n < 2; ++n) _Pragma("unroll") for (int k = 0; k < 2; ++k) dst[n][k] = *(const PG8_LAS bf16x8*)(lds + PG8_SB(b, h) + boff + n * 2048 + k * 1024); } \
        else { _Pragma("unroll") for (int n = 0; n < 2; ++n) dst##8[n] = __builtin_shufflevector(PG8_LD16(PG8_SB(b, h) + boff + n * 2048), PG8_LD16(PG8_SB(b, h) + boff + n * 2048 + 1024), 0, 1, 2, 3, 4, 5, 6, 7); } } while (0)
#define PG8_MMA(ai, bj, At, Bt) do { __builtin_amdgcn_s_setprio(1); \
        if constexpr (ESZ == 2) { _Pragma("unroll") for (int m = 0; m < 4; ++m) _Pragma("unroll") for (int n = 0; n < 2; ++n) _Pragma("unroll") for (int k = 0; k < 2; ++k) \
            acc[ai][bj][m][n] = __builtin_amdgcn_mfma_f32_16x16x32_bf16(Bt[n][k], At[m][k], acc[ai][bj][m][n], 0, 0, 0); } \
        else { _Pragma("unroll") for (int m = 0; m < 4; ++m) _Pragma("unroll") for (int n = 0; n < 2; ++n) \
            asm volatile("v_mfma_scale_f32_16x16x128_f8f6f4 %0, %1, %2, %0, %3, %3 op_sel_hi:[0,0,0]" : "+v"(acc[ai][bj][m][n]) : "v"(Bt##8[n]), "v"(At##8[m]), "v"(sc1)); } \
        __builtin_amdgcn_s_setprio(0); } while (0)
#define PG8_WAIT_V(n) asm volatile("s_waitcnt vmcnt(" #n ")" ::: "memory")
#define PG8_WAIT_L(n) asm volatile("s_waitcnt lgkmcnt(" #n ")" ::: "memory")
#define PG8_BAR __builtin_amdgcn_s_barrier()
#define PG8_SCHED __builtin_amdgcn_sched_barrier(0)
    Unit cur, nxt; int ui = 0;
    if (!S.next(0, cur)) return;
    f32x4 acc[2][2][4][2];
#pragma unroll
    for (int a = 0; a < 2; ++a)
#pragma unroll
        for (int b = 0; b < 2; ++b)
#pragma unroll
            for (int m = 0; m < 4; ++m)
#pragma unroll
                for (int n = 0; n < 2; ++n) acc[a][b][m][n] = (f32x4){0.f, 0.f, 0.f, 0.f};
    const int sc1 = 0x7F7F7F7F;
    bf16x8 At[4][2], B0[2][2], B1[2][2]; i32x8 At8[4], B08[2], B18[2];
    unsigned vA00, vA01, vA10, vA11, nA00, nA01, nA10, nA11;
    const size_t hstepA = GATHER ? (size_t)0 : (size_t)HALF * g.lda * ESZ;
    if constexpr (GATHER) {
        vA00 = (unsigned)(S.arow(cur, Ra[0]) * g.lda * ESZ + Ca[0] * 2); vA01 = (unsigned)(S.arow(cur, Ra[1]) * g.lda * ESZ + Ca[1] * 2);
        vA10 = (unsigned)(S.arow(cur, HALF + Ra[0]) * g.lda * ESZ + Ca[0] * 2); vA11 = (unsigned)(S.arow(cur, HALF + Ra[1]) * g.lda * ESZ + Ca[1] * 2);
    } else {
        vA00 = (unsigned)(Ra[0] * g.lda * ESZ + Ca[0] * 2); vA01 = (unsigned)(Ra[1] * g.lda * ESZ + Ca[1] * 2); vA10 = 0; vA11 = 0;
    }
    nA00 = vA00; nA01 = vA01; nA10 = vA10; nA11 = vA11;
    const char* cA = (const char*)g.A + (GATHER ? (size_t)0 : (size_t)cur.pm * tstepA); const char* cB = (const char*)g.Bt + (size_t)cur.pn * tstepB;
    PG8_STAGE(PG8_SB(0, 0), cB, voffB[0], voffB[1]); PG8_STAGE(PG8_SB(0, 1), cB + hstepB, voffB[0], voffB[1]); PG8_STAGE_A0(PG8_SA(0, 0), cA, vA00, vA01); PG8_STAGE_A1(PG8_SA(0, 1), cA, vA00, vA01, vA10, vA11);
    if (wr == 1) PG8_BAR;
    PG8_WAIT_V(2); PG8_BAR;
    PG8_STAGE(PG8_SB(1, 0), cB + kstep, voffB[0], voffB[1]); PG8_STAGE_A0(PG8_SA(1, 0), cA + kstep, vA00, vA01); PG8_STAGE(PG8_SB(1, 1), cB + hstepB + kstep, voffB[0], voffB[1]);
    PG8_WAIT_V(6); PG8_BAR;
    for (;;) {
        const bool has_next = S.next(ui + 1, nxt);
        const char* nA = has_next ? (const char*)g.A + (GATHER ? (size_t)0 : (size_t)nxt.pm * tstepA) : cA; const char* nB = has_next ? (const char*)g.Bt + (size_t)nxt.pn * tstepB : cB;
        if constexpr (GATHER) {
            if (has_next) {
                nA00 = (unsigned)(S.arow(nxt, Ra[0]) * g.lda * ESZ + Ca[0] * 2); nA01 = (unsigned)(S.arow(nxt, Ra[1]) * g.lda * ESZ + Ca[1] * 2);
                nA10 = (unsigned)(S.arow(nxt, HALF + Ra[0]) * g.lda * ESZ + Ca[0] * 2); nA11 = (unsigned)(S.arow(nxt, HALF + Ra[1]) * g.lda * ESZ + Ca[1] * 2);
            } else { nA00 = vA00; nA01 = vA01; nA10 = vA10; nA11 = vA11; }
        }
#pragma nounroll
        for (int t = 0; t < nt; t += 2) {
            const bool last = (t == nt - 2);
            const char* a1 = cA + (size_t)(t + 1) * kstep;
            const char* a2 = last ? nA : cA + (size_t)(t + 2) * kstep; const char* b2 = last ? nB : cB + (size_t)(t + 2) * kstep;
            const char* a3 = a2 + kstep; const char* b3 = b2 + kstep;
            asm volatile("" : "+v"(voffB[0]), "+v"(voffB[1]), "+v"(vA00), "+v"(vA01));
            if constexpr (GATHER) asm volatile("" : "+v"(vA10), "+v"(vA11));
            unsigned x00 = vA00, x01 = vA01, x10 = vA10, x11 = vA11;
            if constexpr (GATHER) { if (last) { x00 = nA00; x01 = nA01; x10 = nA10; x11 = nA11; } }
            const bool hf = Sched::HALVES && (cur.half != 0);
            PG8_LDB(B0, 0, 0); PG8_LDB(B1, 0, 1); PG8_SCHED; PG8_LDA(At, 0, 0); PG8_STAGE_A1(PG8_SA(1, 1), a1, vA00, vA01, vA10, vA11);
            PG8_WAIT_V(8); PG8_WAIT_L(0); PG8_BAR; PG8_MMA(0, 0, At, B0); PG8_MMA(0, 1, At, B1); PG8_BAR; PG8_SCHED;
            if (!hf) PG8_LDA(At, 0, 1); PG8_STAGE(PG8_SB(0, 0), b2, voffB[0], voffB[1]); PG8_STAGE(PG8_SB(0, 1), b2 + hstepB, voffB[0], voffB[1]); PG8_STAGE_A0(PG8_SA(0, 0), a2, x00, x01);
            PG8_WAIT_V(8); PG8_WAIT_L(0); PG8_BAR; if (!hf) { PG8_MMA(1, 0, At, B0); PG8_MMA(1, 1, At, B1); } PG8_BAR; PG8_SCHED;
            PG8_LDB(B0, 1, 0); PG8_LDB(B1, 1, 1); PG8_SCHED; PG8_LDA(At, 1, 0); PG8_STAGE_A1(PG8_SA(0, 1), a2, x00, x01, x10, x11);
            PG8_WAIT_V(8); PG8_WAIT_L(0); PG8_BAR; PG8_MMA(0, 0, At, B0); PG8_MMA(0, 1, At, B1); PG8_BAR; PG8_SCHED;
            if (!hf) PG8_LDA(At, 1, 1); PG8_STAGE(PG8_SB(1, 0), b3, voffB[0], voffB[1]); PG8_STAGE(PG8_SB(1, 1), b3 + hstepB, voffB[0], voffB[1]); PG8_STAGE_A0(PG8_SA(1, 0), a3, x00, x01);
            PG8_WAIT_V(8); PG8_WAIT_L(0); PG8_BAR; if (!hf) { PG8_MMA(1, 0, At, B0); PG8_MMA(1, 1, At, B1); } PG8_BAR; PG8_SCHED;
        }
        if constexpr (ALIGN_EPI) { if (wr == 0) PG8_BAR; }
        if constexpr (ESZ == 1) asm volatile("s_nop 15\n\ts_nop 15" ::: "memory");
        E(acc, cur, wr, wc, fr, fq);
        if (!has_next) break;
#pragma unroll
        for (int a = 0; a < 2; ++a)
#pragma unroll
            for (int b = 0; b < 2; ++b)
#pragma unroll
                for (int m = 0; m < 4; ++m)
#pragma unroll
                    for (int n = 0; n < 2; ++n) acc[a][b][m][n] = (f32x4){0.f, 0.f, 0.f, 0.f};
        cur = nxt; cA = nA; cB = nB; ++ui;
        if constexpr (GATHER) { vA00 = nA00; vA01 = nA01; vA10 = nA10; vA11 = nA11; }
        if constexpr (ALIGN_EPI) { if (wr == 1) PG8_BAR; }
    }
    PG8_WAIT_V(0);
    if constexpr (!ALIGN_EPI) { if (wr == 0) PG8_BAR; }
    PG8_BAR;
#undef PG8_SA
#undef PG8_SB
#undef PG8_STAGE
#undef PG8_LDA
#undef PG8_LD16
#undef PG8_STAGE_A0
#undef PG8_STAGE_A1
#undef PG8_LDB
#undef PG8_MMA
#undef PG8_WAIT_V
#undef PG8_WAIT_L
#undef PG8_BAR
#undef PG8_SCHED
}
}

constexpr int NWAVES = 8;
constexpr int T = 8192, SEQ = 2048, NB = 4, D = 2048, INW = 2304, POOLW = 1024, NH = 16, NKV = 2, HD = 64, KVW = 128;
constexpr int NE = 64, TOPK = 8, EFF = 512, PLE = 256;
constexpr int SH_ROW0 = T * TOPK + NE * 256;
constexpr int NROWS = SH_ROW0 + T;
constexpr float EPS = 1e-6f;
constexpr float SW1 = 32.0f, SW2 = 16.0f, SA = 4.0f, SY = 16.0f, SW3 = 32.0f;
constexpr int N_PHASES = 10;
constexpr int N_LAUNCHES = MK_N_LAUNCHES;

constexpr size_t MiB = 1u << 20;
constexpr size_t WS_CTL = 0, CTL_ZERO_BYTES = 64 * 1024;
constexpr size_t WS_MISC = 1 * MiB;
constexpr size_t WS_TOKLIST = WS_MISC;
constexpr size_t WS_REC = WS_TOKLIST + (size_t)NE * T * 4;
constexpr size_t WS_WREC = WS_REC + (size_t)T * TOPK * 4;
constexpr size_t WS_RSTDP = WS_WREC + (size_t)T * TOPK * 4;
constexpr size_t WS_PBF = 6 * MiB;
constexpr size_t WS_WRT = 10 * MiB;
constexpr size_t WS_WIN = 12 * MiB;
constexpr size_t WS_WPOOL = WS_WIN + (size_t)INW * D * 2;
constexpr size_t WS_WOUT = WS_WPOOL + (size_t)4 * 256 * 256 * 2;
constexpr size_t WS_WPP = WS_WOUT + (size_t)D * D * 2;
constexpr size_t WS_WPG = WS_WPP + (size_t)D * PLE * 2;
constexpr size_t WS_WGU = WS_WPG + (size_t)D * D * 2;
constexpr size_t WS_WD = WS_WGU + (size_t)65 * 1024 * D;
constexpr size_t WS_XN = WS_WD + (size_t)65 * D * EFF;
constexpr size_t WS_PPROJ = WS_XN + (size_t)T * D * 2;
constexpr size_t WS_ACT = WS_PPROJ + (size_t)T * D * 2;
constexpr size_t WS_H2F8 = WS_ACT;
constexpr size_t WS_H2B = WS_ACT + 16 * MiB;
constexpr size_t WS_GBUF = WS_XN;
constexpr size_t WS_Y = WS_ACT + (size_t)NROWS * EFF * 2;
constexpr size_t WS_ABF = WS_Y;
constexpr size_t WS_UBF = WS_ABF + (size_t)T * D * 2;
constexpr size_t WS_QBF = WS_UBF + (size_t)T * POOLW * 2;
constexpr size_t WS_KV = WS_QBF + (size_t)T * 1024 * 2;
constexpr size_t WS_POOLED = WS_KV + (size_t)T * 2 * KVW * 2;
constexpr size_t WS_MIX = WS_POOLED + (size_t)T * POOLW * 2;
constexpr size_t WS_H1 = WS_Y + (size_t)NROWS * D * 2;
constexpr size_t WS_END = WS_H1 + (size_t)T * D * 4;
static_assert(WS_MIX + (size_t)T * D * 2 <= WS_END, "early activations fit under Y");
static_assert(WS_RSTDP + (size_t)T * 4 <= WS_PBF && WS_PBF + (size_t)T * PLE * 2 <= WS_WIN, "misc fits");
static_assert(WS_END <= (size_t)1024 * MiB, "workspace must fit 1 GiB");
constexpr int CW_BAR = 1024;
constexpr int CW_CNT = 8192;
constexpr int CW_CONVQ = CW_CNT + 32 * NE;
static_assert((CW_CONVQ + 32 * 24) * 4 <= 48 * 1024, "CTL words inside the memset region (below the dummy line at 48 KiB)");

constexpr int RING_OFF = 0, RING_BYTES = 131072;
constexpr int LDS_BYTES = 163840;
constexpr int MISC_OFF = LDS_BYTES - 512;
constexpr int TAB_OFF = RING_BYTES;
constexpr int TB_CNT = 0, TB_PAD = 80, TB_XF = 160, TB_XH = 176, TB_SH0 = 192, TB_SHN = 193;

#define GAS __attribute__((address_space(1)))
#define LAS __attribute__((address_space(3)))
typedef unsigned short bf16;
typedef unsigned v4u __attribute__((ext_vector_type(4)));
typedef unsigned v2u __attribute__((ext_vector_type(2)));
typedef float f32x4 __attribute__((ext_vector_type(4)));
typedef short bf16x8 __attribute__((ext_vector_type(8)));
typedef GAS unsigned gu32;
#define RLX_AGENT __ATOMIC_RELAXED, __HIP_MEMORY_SCOPE_AGENT
#define LDS_WAIT() asm volatile("s_waitcnt lgkmcnt(0)" ::: "memory")
#define LDS_BARRIER() do { asm volatile("s_waitcnt lgkmcnt(0)" ::: "memory"); __builtin_amdgcn_s_barrier(); asm volatile("" ::: "memory"); } while (0)
#define VM_WAIT() asm volatile("s_waitcnt vmcnt(0)" ::: "memory")
__device__ __forceinline__ unsigned pk2(float lo, float hi) { return pg8::cvt_pk_bf16(lo, hi); }
__device__ __forceinline__ float bf_lo(unsigned w) { return __builtin_bit_cast(float, w << 16); }
__device__ __forceinline__ float bf_hi(unsigned w) { return __builtin_bit_cast(float, w & 0xffff0000u); }

#define XB_TMO      128
#define XB_XCNT(j)  (256  + 64 * (j))
#define XB_XSUB(j)  (1280 + 64 * (j))
#define XB_XGEN(j)  (2304 + 64 * (j))
#define XB_TOP      3328
#define XB_TOPGEN   3392
#define XCD_BAR_WORDS 3456
#define XB_SPIN_CAP (1u << 18)
__device__ __forceinline__ unsigned xb_ld(unsigned* p)              { return __hip_atomic_load(p, __ATOMIC_RELAXED, __HIP_MEMORY_SCOPE_AGENT); }
__device__ __forceinline__ unsigned xb_add(unsigned* p, unsigned v) { return __hip_atomic_fetch_add(p, v, __ATOMIC_RELAXED, __HIP_MEMORY_SCOPE_AGENT); }
__device__ __forceinline__ unsigned xb_xcc_id() { return (unsigned)__builtin_amdgcn_s_getreg((3 << 11) | 20) & 0xFu; }
#define XB_SPIN(cond, bar) do { unsigned _sp = 0; while (cond) { __builtin_amdgcn_s_sleep(1); \
    if ((++_sp & 255u) == 0u) { if (xb_ld(&(bar)[XB_TMO])) break; if (_sp > XB_SPIN_CAP) { atomicAdd(&(bar)[XB_TMO], 1u); break; } } } } while (0)
struct XcdBarrier { unsigned* bar; unsigned x; volatile LAS unsigned* st; };
__device__ __forceinline__ XcdBarrier xcd_barrier_post(unsigned* bar, volatile LAS unsigned* st) {
    XcdBarrier b; b.bar = bar; b.x = xb_xcc_id(); b.st = st;
    if (threadIdx.x == 0) (void)xb_add(&bar[XB_XCNT(b.x)], 1u);
    return b;
}
__device__ __forceinline__ void xcd_barrier_complete(unsigned* bar, unsigned x, unsigned& nloc, unsigned& nx) {
    const unsigned G = gridDim.x * gridDim.y * gridDim.z;
    unsigned sum, cnt, mine, sp = 0u;
    for (;;) {
        sum = 0u; cnt = 0u; mine = 0u;
#pragma unroll
        for (unsigned j = 0; j < 16; ++j) { const unsigned c = xb_ld(&bar[XB_XCNT(j)]); sum += c; cnt += (c > 0u) ? 1u : 0u; mine = (j == x) ? c : mine; }
        if (sum == G) break;
        __builtin_amdgcn_s_sleep(1);
        if ((++sp & 255u) == 0u) { if (xb_ld(&bar[XB_TMO])) break; if (sp > XB_SPIN_CAP) { atomicAdd(&bar[XB_TMO], 1u); break; } }
    }
    nloc = mine > 0u ? mine : 1u; nx = cnt > 0u ? cnt : 1u;
}
__device__ __forceinline__ void xcd_barrier(const XcdBarrier& b) {
    asm volatile("s_waitcnt vmcnt(0)" ::: "memory");
    __syncthreads();
    if (threadIdx.x == 0) {
        unsigned* bar = b.bar;
        __builtin_amdgcn_s_waitcnt(0);
        unsigned nloc = b.st[0], nx = b.st[1];
        if (nloc == 0u) { xcd_barrier_complete(bar, b.x, nloc, nx); b.st[0] = nloc; b.st[1] = nx; }
        const unsigned old = xb_add(&bar[XB_XSUB(b.x)], 1u);
        const unsigned gen = old / nloc;
        if (old + 1u == (gen + 1u) * nloc) {
            __builtin_amdgcn_fence(__ATOMIC_RELEASE, "agent");
            asm volatile("s_waitcnt vmcnt(0)" ::: "memory");
            const unsigned og = xb_add(&bar[XB_TOP], 1u);
            const unsigned tg = og / nx;
            if (og + 1u == (tg + 1u) * nx) xb_add(&bar[XB_TOPGEN], 1u);
            else XB_SPIN(xb_ld(&bar[XB_TOPGEN]) == tg, bar);
            __builtin_amdgcn_fence(__ATOMIC_ACQUIRE, "agent");
            xb_add(&bar[XB_XGEN(b.x)], 1u);
            asm volatile("s_waitcnt vmcnt(0)" ::: "memory");
        } else {
            XB_SPIN(xb_ld(&bar[XB_XGEN(b.x)]) == gen, bar);
            __builtin_amdgcn_fence(__ATOMIC_ACQUIRE, "agent");
            asm volatile("s_waitcnt vmcnt(0)" ::: "memory");
        }
    }
    __syncthreads();
}

struct Args { const float* in[22]; float* out; unsigned char* ws; int ph_lo, ph_hi, li, pad; };
struct Frame {
    LAS unsigned char* lds;
    volatile LAS unsigned* MISC;
    gu32* ctl;
    unsigned char* ws;
    int wave, G, bx;
    float* out;
};
__device__ __forceinline__ const float* fin(const Frame& F, int i) {
    const unsigned long long v = ((const LAS unsigned long long*)(F.lds + MISC_OFF + 256))[i];
    const unsigned lo = __builtin_amdgcn_readfirstlane((unsigned)v), hi = __builtin_amdgcn_readfirstlane((unsigned)(v >> 32));
    return (const float*)(const GAS float*)(((unsigned long long)hi << 32) | lo);
}
enum { I_X = 0, I_P, I_GMIX, I_WIN, I_WPOOL, I_PSCALE, I_SINKS, I_RPE, I_WOUT, I_GFFN, I_WROUTER, I_RBIAS, I_WGATE, I_WUP, I_WDOWN, I_WSGATE, I_WSUP, I_WSDOWN, I_WPLEPROJ, I_GPLE, I_WPLEGATE, I_GFINAL };

__device__ __forceinline__ float wave_sum(float v) {
#pragma unroll
    for (int o = 1; o < 64; o <<= 1) v += __shfl_xor(v, o);
    return v;
}

using pg8::Unit;
struct EpiInProj {
    static constexpr int PERM = 1;
    unsigned char* ws;
    __device__ __forceinline__ void operator()(const f32x4 (&acc)[2][2][4][2], const Unit& u, int wr, int wc, int fr, int fq) const {
        const int row0 = u.pm * 256 + wr * 64 + fr;
        const size_t boff = WS_UBF + (size_t)(u.pn >= 4 ? 1 : 0) * (WS_QBF - WS_UBF) + (size_t)(u.pn >= 8 ? 1 : 0) * (WS_KV - WS_QBF);
        bf16* base = (bf16*)(ws + boff); const int ldc = (u.pn < 8) ? 1024 : 256; const int col0 = (u.pn & 3) * 256 + wc * 32 + 8 * fq;
#pragma unroll
        for (int ai = 0; ai < 2; ++ai)
#pragma unroll
            for (int m = 0; m < 4; ++m) { bf16* rowp = base + (size_t)(row0 + ai * 128 + m * 16) * ldc + col0;
#pragma unroll
                for (int bj = 0; bj < 2; ++bj) { const f32x4 v0 = acc[ai][bj][m][0], v1 = acc[ai][bj][m][1];
                    v4u w; w.x = pk2(v0[0], v0[1]); w.y = pk2(v0[2], v0[3]); w.z = pk2(v1[0], v1[1]); w.w = pk2(v1[2], v1[3]);
                    *(v4u*)(rowp + bj * 128) = w; } }
    }
};
struct EpiBf16Plain {
    static constexpr int PERM = 1;
    bf16* O; int ldc; int col_off; const float* scale;
    __device__ __forceinline__ void operator()(const f32x4 (&acc)[2][2][4][2], const Unit& u, int wr, int wc, int fr, int fq) const {
        const int row0 = u.pm * 256 + wr * 64 + fr, colt = u.pn * 256 + wc * 32 + 8 * fq;
        f32x4 sv[2][2];
#pragma unroll
        for (int bj = 0; bj < 2; ++bj)
#pragma unroll
            for (int n = 0; n < 2; ++n) sv[bj][n] = scale ? *(const f32x4*)(scale + col_off + colt + bj * 128 + 4 * n) : (f32x4){1.f, 1.f, 1.f, 1.f};
#pragma unroll
        for (int ai = 0; ai < 2; ++ai)
#pragma unroll
            for (int m = 0; m < 4; ++m) { bf16* rowp = O + (size_t)(row0 + ai * 128 + m * 16) * ldc + col_off + colt;
#pragma unroll
                for (int bj = 0; bj < 2; ++bj) { const f32x4 v0 = acc[ai][bj][m][0] * sv[bj][0], v1 = acc[ai][bj][m][1] * sv[bj][1];
                    v4u w; w.x = pk2(v0[0], v0[1]); w.y = pk2(v0[2], v0[3]); w.z = pk2(v1[0], v1[1]); w.w = pk2(v1[2], v1[3]);
                    *(v4u*)(rowp + bj * 128) = w; } }
    }
};
struct EpiResF32 {
    static constexpr int PERM = 0;
    const float* base; float* C;
    __device__ __forceinline__ void operator()(const f32x4 (&acc)[2][2][4][2], const Unit& u, int wr, int wc, int fr, int fq) const {
        const int row0 = u.pm * 256 + wr * 64 + fr, col0 = u.pn * 256 + wc * 32 + 4 * fq;
#pragma unroll
        for (int ai = 0; ai < 2; ++ai)
#pragma unroll
            for (int mp = 0; mp < 2; ++mp) { f32x4 xb[2][2][2];
#pragma unroll
                for (int mm = 0; mm < 2; ++mm) { const size_t ro = (size_t)(row0 + ai * 128 + (2 * mp + mm) * 16) * D + col0;
#pragma unroll
                    for (int bj = 0; bj < 2; ++bj)
#pragma unroll
                        for (int n = 0; n < 2; ++n) xb[mm][bj][n] = *(const f32x4*)(base + ro + bj * 128 + n * 16); }
#pragma unroll
                for (int mm = 0; mm < 2; ++mm) { const size_t ro = (size_t)(row0 + ai * 128 + (2 * mp + mm) * 16) * D + col0;
#pragma unroll
                    for (int bj = 0; bj < 2; ++bj)
#pragma unroll
                        for (int n = 0; n < 2; ++n) *(f32x4*)(C + ro + bj * 128 + n * 16) = xb[mm][bj][n] + acc[ai][bj][2 * mp + mm][n]; } }
    }
};
__device__ __forceinline__ float sigmoid_f(float v) { return __builtin_amdgcn_rcpf(1.0f + __expf(-v)); }
__device__ __forceinline__ unsigned pk4_fp8(float a, float b, float c, float d) { int w = 0; w = __builtin_amdgcn_cvt_pk_fp8_f32(a, b, w, false); w = __builtin_amdgcn_cvt_pk_fp8_f32(c, d, w, true); return (unsigned)w; }
typedef float f32x2_ __attribute__((ext_vector_type(2)));
__device__ __forceinline__ void fp8x4_to_f32(unsigned w, float (&o)[4]) { const f32x2_ lo = __builtin_amdgcn_cvt_pk_f32_fp8((int)w, false), hi = __builtin_amdgcn_cvt_pk_f32_fp8((int)w, true); o[0] = lo[0]; o[1] = lo[1]; o[2] = hi[0]; o[3] = hi[1]; }
struct EpiGateUp {
    static constexpr int PERM = 1;
    unsigned char* ACT;
    __device__ __forceinline__ void operator()(const f32x4 (&acc)[2][2][4][2], const Unit& u, int wr, int wc, int fr, int fq) const {
        const int row0 = u.pm * 256 + wr * 64 + fr, col0 = (u.pn & 3) * 128 + wc * 32 + 8 * fq;
        constexpr float IS = 1.0f / SW1;
#pragma unroll
        for (int ai = 0; ai < 2; ++ai) { if (ai == 1 && u.half) break;
#pragma unroll
            for (int m = 0; m < 4; ++m) { float o[8];
#pragma unroll
                for (int n = 0; n < 2; ++n)
#pragma unroll
                    for (int j = 0; j < 4; ++j) { const float gte = acc[ai][0][m][n][j] * IS, up = acc[ai][1][m][n][j] * (IS * SA); o[4 * n + j] = gte * sigmoid_f(gte) * up; }
                v2u w; w.x = pk4_fp8(o[0], o[1], o[2], o[3]); w.y = pk4_fp8(o[4], o[5], o[6], o[7]);
                *(v2u*)(ACT + (size_t)(row0 + ai * 128 + m * 16) * EFF + col0) = w; } }
    }
};
struct EpiDown {
    static constexpr int PERM = 2;
    unsigned char* Y;
    __device__ __forceinline__ void operator()(const f32x4 (&acc)[2][2][4][2], const Unit& u, int wr, int wc, int fr, int fq) const {
        const int row0 = u.pm * 256 + wr * 64 + fr, col0 = (u.pn & 7) * 256 + wc * 64 + 16 * fq;
        constexpr float IS = SY / (SA * SW2);
#pragma unroll
        for (int ai = 0; ai < 2; ++ai) { if (ai == 1 && u.half) break;
#pragma unroll
            for (int m = 0; m < 4; ++m) { const f32x4 v0 = acc[ai][0][m][0] * IS, v1 = acc[ai][0][m][1] * IS, v2 = acc[ai][1][m][0] * IS, v3 = acc[ai][1][m][1] * IS;
                v4u w; w.x = pk4_fp8(v0[0], v0[1], v0[2], v0[3]); w.y = pk4_fp8(v1[0], v1[1], v1[2], v1[3]); w.z = pk4_fp8(v2[0], v2[1], v2[2], v2[3]); w.w = pk4_fp8(v3[0], v3[1], v3[2], v3[3]);
                *(v4u*)(Y + (size_t)(row0 + ai * 128 + m * 16) * D + col0) = w; } }
    }
};
struct EpiBf16Mul {
    static constexpr int PERM = 1;
    bf16* O; float mul;
    __device__ __forceinline__ void operator()(const f32x4 (&acc)[2][2][4][2], const Unit& u, int wr, int wc, int fr, int fq) const {
        const int row0 = u.pm * 256 + wr * 64 + fr, colt = u.pn * 256 + wc * 32 + 8 * fq;
#pragma unroll
        for (int ai = 0; ai < 2; ++ai)
#pragma unroll
            for (int m = 0; m < 4; ++m) { bf16* rowp = O + (size_t)(row0 + ai * 128 + m * 16) * D + colt;
#pragma unroll
                for (int bj = 0; bj < 2; ++bj) { const f32x4 v0 = acc[ai][bj][m][0] * mul, v1 = acc[ai][bj][m][1] * mul;
                    v4u w; w.x = pk2(v0[0], v0[1]); w.y = pk2(v0[2], v0[3]); w.z = pk2(v1[0], v1[1]); w.w = pk2(v1[2], v1[3]);
                    *(v4u*)(rowp + bj * 128) = w; } }
    }
};
struct MoeOrder {
    static constexpr bool HALVES = true;
    const LAS int* tab; const int* toklist; int x, r, npn, stride;
    __device__ __forceinline__ bool next(int i, Unit& u) const {
        const int L = i * stride + r; const int tl = L / npn, pn = L - tl * npn;
        const int nf = tab[TB_XF + 8], ns = tab[TB_SHN], nh = tab[TB_XH + 8];
        if (tl >= nf + ns + nh) return false;
        int e, lt, row0, half = 0;
        if (tl < nf) { int s = 0;
#pragma unroll
            for (int q = 1; q <= 7; ++q) s += (tl >= tab[TB_XF + q]) ? 1 : 0;
            lt = tl - tab[TB_XF + s]; e = x + 8 * s; row0 = tab[TB_PAD + e] + 256 * lt; }
        else if (tl < nf + ns) { lt = tab[TB_SH0] + (tl - nf); e = NE; row0 = SH_ROW0 + 256 * lt; }
        else { const int hi = tl - nf - ns; int s = 0;
#pragma unroll
            for (int q = 1; q <= 7; ++q) s += (hi >= tab[TB_XH + q]) ? 1 : 0;
            e = x + 8 * s; lt = tab[TB_XF + s + 1] - tab[TB_XF + s]; row0 = tab[TB_PAD + e] + 256 * lt; half = 1; }
        u.pm = __builtin_amdgcn_readfirstlane(row0 >> 8); u.pn = __builtin_amdgcn_readfirstlane(e * npn + pn); u.e = __builtin_amdgcn_readfirstlane(e); u.lt = __builtin_amdgcn_readfirstlane(lt);
        u.half = __builtin_amdgcn_readfirstlane(half); return true;
    }
    __device__ __forceinline__ int arow(const Unit& u, int r_) const {
        const int lr = u.lt * 256 + r_;
        const int ee = (u.e < NE) ? u.e : 0;
        const int tk = toklist[(size_t)ee * T + (lr < T - 1 ? lr : T - 1)];
        return (u.e == NE) ? lr : ((lr < tab[TB_CNT + ee]) ? tk : 0);
    }
};
__device__ __forceinline__ void moe_tables(Frame& F) {
    const int LANE_ = pg8::lane_id(), TID_ = F.wave * 64 + LANE_; (void)TID_;
    LAS int* tab = (LAS int*)(F.lds + TAB_OFF);
    const int x = F.bx & 7;
    if (F.wave == 0) {
        const int e = LANE_, c = (int)__hip_atomic_load(F.ctl + CW_CNT + 32 * e, RLX_AGENT), nt = (c + 255) >> 8;
        const int hf = (nt > 0 && (c - ((nt - 1) << 8)) <= 128) ? 1 : 0, fl = nt - hf;
        tab[TB_CNT + e] = c; if (e == 0) tab[TB_CNT + NE] = T;
        int inc = nt << 8;
#pragma unroll
        for (int o = 1; o < 64; o <<= 1) { const int v = __shfl_up(inc, o); inc += (e >= o) ? v : 0; }
        tab[TB_PAD + e] = inc - (nt << 8); if (e == 63) tab[TB_PAD + NE] = inc;
        int ld = 2 * fl + hf;
        ld += __shfl_xor(ld, 8); ld += __shfl_xor(ld, 16); ld += __shfl_xor(ld, 32);
        int cf = fl, ch = hf;
#pragma unroll
        for (int o = 8; o < 64; o <<= 1) { const int vf = __shfl_up(cf, o), vh = __shfl_up(ch, o); cf += (e >= o) ? vf : 0; ch += (e >= o) ? vh : 0; }
        if ((e & 7) == x) { tab[TB_XF + (e >> 3) + 1] = cf; tab[TB_XH + (e >> 3) + 1] = ch; }
        if (e == 0) { tab[TB_XF] = 0; tab[TB_XH] = 0; }
        int load[8], nsh[8];
#pragma unroll
        for (int l = 0; l < 8; ++l) { load[l] = __shfl(ld, l); nsh[l] = 0; }
        for (int j = 0; j < 32; ++j) { int best = 0, bl = load[0];
#pragma unroll
            for (int l = 1; l < 8; ++l) { const bool lt_ = load[l] < bl; best = lt_ ? l : best; bl = lt_ ? load[l] : bl; }
#pragma unroll
            for (int l = 0; l < 8; ++l) { nsh[l] += (l == best) ? 1 : 0; load[l] += (l == best) ? 2 : 0; } }
        int s0 = 0, sn = 0;
#pragma unroll
        for (int l = 0; l < 8; ++l) { s0 += (l < x) ? nsh[l] : 0; sn = (l == x) ? nsh[l] : sn; }
        if (e == 0) { tab[TB_SH0] = s0; tab[TB_SHN] = sn; }
    }
    __syncthreads();
}
struct ConvJob { const float* src; bf16* dst; int N, ldk, mode, item; };
struct ConvJob8 { const float* src; unsigned char* dst; int N, ldk, mode, item; float scale; };
__device__ __forceinline__ void conv8_load(const ConvJob8& j, int lane, f32x4 (&v)[16]) {
    const int nblk = j.N >> 5, kb = j.item / nblk, nb = j.item - kb * nblk, k0 = 128 * kb, n0 = 32 * nb;
    const float* src = j.src + (size_t)(k0 + 16 * (lane >> 3)) * j.N + n0 + 4 * (lane & 7);
#pragma unroll
    for (int i = 0; i < 16; ++i) v[i] = __builtin_nontemporal_load((const f32x4*)(src + (size_t)i * j.N));
}
__device__ __forceinline__ void conv8_store(const ConvJob8& j, int lane, const f32x4 (&v)[16]) {
    const int nblk = j.N >> 5, kb = j.item / nblk, nb = j.item - kb * nblk, k0 = 128 * kb, n0 = 32 * nb; const float scale = j.scale;
#pragma unroll
    for (int q = 0; q < 4; ++q) { const int n = n0 + 4 * (lane & 7) + q; int dr = n;
        if (j.mode == 5) dr = ((n >> 7) << 8) + (n & 127); else if (j.mode == 6) dr = ((n >> 7) << 8) + 128 + (n & 127);
        v4u o; o.x = pk4_fp8(v[0][q] * scale, v[1][q] * scale, v[2][q] * scale, v[3][q] * scale); o.y = pk4_fp8(v[4][q] * scale, v[5][q] * scale, v[6][q] * scale, v[7][q] * scale);
        o.z = pk4_fp8(v[8][q] * scale, v[9][q] * scale, v[10][q] * scale, v[11][q] * scale); o.w = pk4_fp8(v[12][q] * scale, v[13][q] * scale, v[14][q] * scale, v[15][q] * scale);
        __builtin_nontemporal_store(o, (v4u*)(j.dst + (size_t)dr * j.ldk + k0 + 16 * (lane >> 3))); }
}
__device__ __forceinline__ void conv_load(const ConvJob& j, int lane, f32x4 (&v)[8]) {
    const int nblk = j.N >> 5, kb = j.item / nblk, nb = j.item - kb * nblk, k0 = 64 * kb, n0 = 32 * nb;
    const float* src = j.src + (size_t)(k0 + 8 * (lane >> 3)) * j.N + n0 + 4 * (lane & 7);
#pragma unroll
    for (int i = 0; i < 8; ++i) v[i] = __builtin_nontemporal_load((const f32x4*)(src + (size_t)i * j.N));
}
__device__ __forceinline__ void conv_store(const ConvJob& j, int lane, const f32x4 (&v)[8]) {
    const int nblk = j.N >> 5, kb = j.item / nblk, nb = j.item - kb * nblk, k0 = 64 * kb, n0 = 32 * nb;
#pragma unroll
    for (int q = 0; q < 4; ++q) { const int n = n0 + 4 * (lane & 7) + q; int dr = n;
        if (j.mode == 1) dr = ((n >> 7) << 8) + (n & 127); else if (j.mode == 2) dr = ((n >> 7) << 8) + 128 + (n & 127);
        v4u o; o.x = pk2(v[0][q], v[1][q]); o.y = pk2(v[2][q], v[3][q]); o.z = pk2(v[4][q], v[5][q]); o.w = pk2(v[6][q], v[7][q]);
        *(v4u*)(j.dst + (size_t)dr * j.ldk + k0 + 8 * (lane >> 3)) = o; }
}
__device__ __forceinline__ void rms_row_to_bf16(const float* xrow, const float* g, bf16* orow, int lane) {
    f32x4 v[8]; float s = 0.f;
#pragma unroll
    for (int j = 0; j < 4; ++j) { v[2 * j] = *(const f32x4*)(xrow + 512 * j + 8 * lane); v[2 * j + 1] = *(const f32x4*)(xrow + 512 * j + 8 * lane + 4); }
#pragma unroll
    for (int j = 0; j < 8; ++j) s += (v[j][0] * v[j][0] + v[j][1] * v[j][1]) + (v[j][2] * v[j][2] + v[j][3] * v[j][3]);
    const float rstd = 1.0f / sqrtf(wave_sum(s) * (1.0f / D) + EPS);
#pragma unroll
    for (int j = 0; j < 4; ++j) { const f32x4 g0 = *(const f32x4*)(g + 512 * j + 8 * lane), g1 = *(const f32x4*)(g + 512 * j + 8 * lane + 4);
        const f32x4 a = v[2 * j] * rstd * g0, b = v[2 * j + 1] * rstd * g1;
        v4u o; o.x = pk2(a[0], a[1]); o.y = pk2(a[2], a[3]); o.z = pk2(b[0], b[1]); o.w = pk2(b[2], b[3]);
        *(v4u*)(orow + 512 * j + 8 * lane) = o; }
}
constexpr int CV_G1 = (D / 128) * (EFF / 32), CV_D1 = (EFF / 128) * (D / 32), CV_G = 65 * CV_G1, CV_DN = 65 * CV_D1, CV_PG = (D / 128) * (D / 32), CV_TOTAL = 2 * CV_G + CV_DN + CV_PG;
constexpr int CONV_B = 896 * 16, CONV_C = 1024 * 20, CONV_A = CV_TOTAL - CONV_B - CONV_C;
__device__ __forceinline__ ConvJob8 conv8_decode(Frame& F, int it) {
    unsigned char* WGU8 = F.ws + WS_WGU; unsigned char* WDN8 = F.ws + WS_WD;
    int r = it;
    if (r < CV_G) { const int e = r / CV_G1, li = r - e * CV_G1; const float* src = (e < NE) ? fin(F, I_WGATE) + (size_t)e * D * EFF : fin(F, I_WSGATE);
        return ConvJob8{src, WGU8 + (size_t)e * 1024 * D, EFF, D, 5, li, SW1}; } r -= CV_G;
    if (r < CV_G) { const int e = r / CV_G1, li = r - e * CV_G1; const float* src = (e < NE) ? fin(F, I_WUP) + (size_t)e * D * EFF : fin(F, I_WSUP);
        return ConvJob8{src, WGU8 + (size_t)e * 1024 * D, EFF, D, 6, li, SW1}; } r -= CV_G;
    if (r < CV_DN) { const int e = r / CV_D1, li = r - e * CV_D1; const float* src = (e < NE) ? fin(F, I_WDOWN) + (size_t)e * EFF * D : fin(F, I_WSDOWN);
        return ConvJob8{src, WDN8 + (size_t)e * D * EFF, D, EFF, 4, li, SW2}; } r -= CV_DN;
    return ConvJob8{fin(F, I_WPLEGATE), F.ws + WS_WPG, D, D, 4, r, SW3};
}
__device__ __forceinline__ void conv_fp8_items(Frame& F, int lo, int hi, int rank, int nranks) {
    const int LANE_ = pg8::lane_id();
    int it0 = lo + rank; if (it0 >= hi) return;
    f32x4 va[16], vb[16];
    ConvJob8 j0 = conv8_decode(F, it0), j1 = j0; conv8_load(j0, LANE_, va);
    for (;;) {
        const int it1 = it0 + nranks; const bool has1 = it1 < hi;
        if (has1) { j1 = conv8_decode(F, it1); conv8_load(j1, LANE_, vb); }
        conv8_store(j0, LANE_, va);
        if (!has1) break;
        it0 = it1 + nranks; const bool has0 = it0 < hi;
        if (has0) { j0 = conv8_decode(F, it0); conv8_load(j0, LANE_, va); }
        conv8_store(j1, LANE_, vb);
        if (!has0) break;
    }
}
constexpr int SEG_N0 = 14000, SEG_N1 = 16000, SEG_N2 = CV_TOTAL - SEG_N0 - SEG_N1;
static_assert(SEG_N0 % 8 == 0 && SEG_N1 % 8 == 0 && SEG_N2 % 8 == 0 && SEG_N2 > 0, "queue segments");
__device__ __forceinline__ void conv_dyn(Frame& F, int seg) {
    const int LANE_ = pg8::lane_id(); const bool t0 = (F.wave == 0 && LANE_ == 0);
    const int x = F.bx & 7;
    const int segn = (seg == 0 ? SEG_N0 : (seg == 1 ? SEG_N1 : SEG_N2)) / 8, lo = (seg == 0 ? 0 : (seg == 1 ? SEG_N0 : SEG_N0 + SEG_N1)) + x * segn;
    gu32* ctr = F.ctl + CW_CONVQ + 32 * (seg * 8 + x);
    volatile LAS unsigned* Q = F.MISC + 16;
    LDS_BARRIER();
    if (t0) { const unsigned a = __hip_atomic_fetch_add(ctr, 8u, RLX_AGENT), b = __hip_atomic_fetch_add(ctr, 8u, RLX_AGENT); Q[0] = a; Q[1] = b; }
    LDS_BARRIER();
    int c0 = __builtin_amdgcn_readfirstlane((int)Q[0]), c1 = __builtin_amdgcn_readfirstlane((int)Q[1]);
    f32x4 va[16], vb[16]; ConvJob8 ja, jb;
    bool ha = (c0 + F.wave) < segn, hb = false;
    ja = conv8_decode(F, lo + (ha ? c0 + F.wave : 0)); jb = ja;
    if (ha) conv8_load(ja, LANE_, va);
    for (;;) {
        unsigned vn = 0u; if (t0) vn = __hip_atomic_fetch_add(ctr, 8u, RLX_AGENT);
        hb = (c1 + F.wave) < segn; if (hb) { jb = conv8_decode(F, lo + c1 + F.wave); conv8_load(jb, LANE_, vb); }
        if (ha) conv8_store(ja, LANE_, va);
        if (c0 >= segn) break;
        LDS_BARRIER(); if (t0) Q[0] = vn; LDS_BARRIER();
        c0 = __builtin_amdgcn_readfirstlane((int)Q[0]);
        vn = 0u; if (t0) vn = __hip_atomic_fetch_add(ctr, 8u, RLX_AGENT);
        ha = (c0 + F.wave) < segn; if (ha) { ja = conv8_decode(F, lo + c0 + F.wave); conv8_load(ja, LANE_, va); }
        if (hb) conv8_store(jb, LANE_, vb);
        if (c1 >= segn) break;
        LDS_BARRIER(); if (t0) Q[1] = vn; LDS_BARRIER();
        c1 = __builtin_amdgcn_readfirstlane((int)Q[1]);
    }
    LDS_BARRIER();
}
constexpr int WI_G1 = (D / 256) * (EFF / 128), WI_D1 = (EFF / 256) * (D / 128), WI_G = 65 * WI_G1, WI_DN = 65 * WI_D1, WI_PG = (D / 256) * (D / 128), WI_TOTAL = 2 * WI_G + WI_DN + WI_PG;
constexpr int SEGW0 = 1752, SEGW1 = 2000, SEGW2 = WI_TOTAL - SEGW0 - SEGW1;
static_assert(SEGW0 % 8 == 0 && SEGW1 % 8 == 0 && SEGW2 % 8 == 0 && SEGW2 > 0, "queue segments");
struct ConvJobW { const float* src; unsigned char* dst; int N, ldk, mode, k0, n0; float scale; };
__device__ __forceinline__ ConvJobW convw_decode(Frame& F, int it) {
    unsigned char* WGU8 = F.ws + WS_WGU; unsigned char* WDN8 = F.ws + WS_WD;
    int r = it;
    if (r < WI_G) { const int e = r / WI_G1, li = r - e * WI_G1; const float* src = (e < NE) ? fin(F, I_WGATE) + (size_t)e * D * EFF : fin(F, I_WSGATE);
        return ConvJobW{src, WGU8 + (size_t)e * 1024 * D, EFF, D, 5, 256 * (li >> 2), 128 * (li & 3), SW1}; } r -= WI_G;
    if (r < WI_G) { const int e = r / WI_G1, li = r - e * WI_G1; const float* src = (e < NE) ? fin(F, I_WUP) + (size_t)e * D * EFF : fin(F, I_WSUP);
        return ConvJobW{src, WGU8 + (size_t)e * 1024 * D, EFF, D, 6, 256 * (li >> 2), 128 * (li & 3), SW1}; } r -= WI_G;
    if (r < WI_DN) { const int e = r / WI_D1, li = r - e * WI_D1; const float* src = (e < NE) ? fin(F, I_WDOWN) + (size_t)e * EFF * D : fin(F, I_WSDOWN);
        return ConvJobW{src, WDN8 + (size_t)e * D * EFF, D, EFF, 4, 256 * (li >> 4), 128 * (li & 15), SW2}; } r -= WI_DN;
    return ConvJobW{fin(F, I_WPLEGATE), F.ws + WS_WPG, D, D, 4, 256 * (r >> 4), 128 * (r & 15), SW3};
}
__device__ __forceinline__ void conv_wg_dyn(Frame& F, int seg) {
    const int LANE_ = pg8::lane_id(), TID_ = F.wave * 64 + LANE_; const bool t0 = (TID_ == 0);
    const int x = F.bx & 7;
    const int segn = (seg == 0 ? SEGW0 : (seg == 1 ? SEGW1 : SEGW2)) / 8, lo = (seg == 0 ? 0 : (seg == 1 ? SEGW0 : SEGW0 + SEGW1)) + x * segn;
    gu32* ctr = F.ctl + CW_CONVQ + 32 * (seg * 8 + x);
    volatile LAS unsigned* Q = F.MISC + 16;
    LAS unsigned char* TL = F.lds + RING_OFF;
    LDS_BARRIER();
    if (t0) Q[0] = __hip_atomic_fetch_add(ctr, 1u, RLX_AGENT);
    LDS_BARRIER();
    int cur = __builtin_amdgcn_readfirstlane((int)Q[0]);
    if (cur >= segn) return;
    const int hh = LANE_ >> 5, n4 = LANE_ & 31;
    ConvJobW j = convw_decode(F, lo + cur);
    f32x4 v[16];
    { const float* src = j.src + (size_t)(j.k0 + 32 * F.wave + 16 * hh) * j.N + j.n0 + 4 * n4;
#pragma unroll
      for (int i = 0; i < 16; ++i) v[i] = __builtin_nontemporal_load((const f32x4*)(src + (size_t)i * j.N)); }
    for (;;) {
        unsigned vn = 0u; if (t0) vn = __hip_atomic_fetch_add(ctr, 1u, RLX_AGENT);
        { const float sc = j.scale;
#pragma unroll
          for (int g = 0; g < 4; ++g)
#pragma unroll
              for (int q = 0; q < 4; ++q) { const int n = 4 * n4 + q, kd = (8 * F.wave + 4 * hh + g + 4 * (n4 & 15)) & 63;
                  *(LAS unsigned*)(TL + n * 256 + kd * 4) = pk4_fp8(v[4 * g][q] * sc, v[4 * g + 1][q] * sc, v[4 * g + 2][q] * sc, v[4 * g + 3][q] * sc); } }
        if (t0) Q[0] = vn;
        LDS_BARRIER();
        const int nxt = __builtin_amdgcn_readfirstlane((int)Q[0]);
        const ConvJobW jc = j;
        if (nxt < segn) { j = convw_decode(F, lo + nxt);
            const float* src = j.src + (size_t)(j.k0 + 32 * F.wave + 16 * hh) * j.N + j.n0 + 4 * n4;
#pragma unroll
            for (int i = 0; i < 16; ++i) v[i] = __builtin_nontemporal_load((const f32x4*)(src + (size_t)i * j.N)); }
#pragma unroll
        for (int i = 0; i < 4; ++i) { const int id = TID_ + 512 * i, n = id >> 4, c16 = id & 15, kd = (4 * c16 + 4 * ((n >> 2) & 15)) & 63;
            const v4u o = *(const LAS v4u*)(TL + n * 256 + kd * 4);
            const int nn = jc.n0 + n; int dr = nn;
            if (jc.mode == 5) dr = ((nn >> 7) << 8) + (nn & 127); else if (jc.mode == 6) dr = ((nn >> 7) << 8) + 128 + (nn & 127);
            __builtin_nontemporal_store(o, (v4u*)(jc.dst + (size_t)dr * jc.ldk + jc.k0 + 16 * c16)); }
        LDS_BARRIER();
        if (nxt >= segn) break;
    }
}
__device__ __forceinline__ void p0_prologue(Frame& F) {
    const int LANE_ = pg8::lane_id(), TID_ = F.wave * 64 + LANE_; (void)TID_;
    const int gw = F.bx * NWAVES + F.wave, NGW = F.G * NWAVES;
    bf16* WIN = (bf16*)(F.ws + WS_WIN); bf16* WPOOL = (bf16*)(F.ws + WS_WPOOL); bf16* WOUT = (bf16*)(F.ws + WS_WOUT); bf16* WPP = (bf16*)(F.ws + WS_WPP);
    constexpr int I_IN = (D / 64) * (INW / 32), I_PL = 4 * (256 / 64) * (256 / 32), I_OUT = (D / 64) * (D / 32), I_PP = (PLE / 64) * (D / 32), I_PG = (D / 64) * (D / 32);
    constexpr int I_SMALL = I_IN + I_PL + I_OUT + I_PP; (void)I_PG;
    auto decode = [&](int it) -> ConvJob {
        int r = it;
        if (r < I_IN) return ConvJob{fin(F, I_WIN), WIN, INW, D, 0, r}; r -= I_IN;
        if (r < I_PL) { const int gq = r >> 5; return ConvJob{fin(F, I_WPOOL) + (size_t)gq * 65536, WPOOL + (size_t)gq * 65536, 256, 256, 0, r & 31}; } r -= I_PL;
        if (r < I_OUT) return ConvJob{fin(F, I_WOUT), WOUT, D, D, 0, r}; r -= I_OUT;
        return ConvJob{fin(F, I_WPLEPROJ), WPP, D, PLE, 0, r};
    };
    for (int it = gw; it < I_SMALL; it += 2 * NGW) {
        const ConvJob j0 = decode(it); const bool two = (it + NGW) < I_SMALL; const ConvJob j1 = decode(two ? it + NGW : it);
        f32x4 v0[8], v1[8];
        conv_load(j0, LANE_, v0); conv_load(j1, LANE_, v1);
        conv_store(j0, LANE_, v0); if (two) conv_store(j1, LANE_, v1);
    }
    if (F.G != 256) conv_fp8_items(F, 0, CONV_A, gw, NGW);
    { const float* WR = fin(F, I_WROUTER); bf16* WH = (bf16*)(F.ws + WS_WRT); bf16* WL = WH + (size_t)NE * D;
      for (int i = gw * 64 + LANE_; i < NE * (D / 8); i += NGW * 64) { const int e = i & 63, k0 = (i >> 6) * 8; float x[8]; unsigned hh[8], ll[8];
#pragma unroll
          for (int j = 0; j < 8; ++j) x[j] = WR[(size_t)(k0 + j) * NE + e];
#pragma unroll
          for (int j = 0; j < 8; ++j) { hh[j] = pk2(x[j], 0.f) & 0xffffu; ll[j] = pk2(x[j] - bf_lo(hh[j]), 0.f) & 0xffffu; }
          v4u oh, ol; oh.x = hh[0] | (hh[1] << 16); oh.y = hh[2] | (hh[3] << 16); oh.z = hh[4] | (hh[5] << 16); oh.w = hh[6] | (hh[7] << 16);
          ol.x = ll[0] | (ll[1] << 16); ol.y = ll[2] | (ll[3] << 16); ol.z = ll[4] | (ll[5] << 16); ol.w = ll[6] | (ll[7] << 16);
          const size_t fo = ((size_t)((k0 >> 5) * 4 + (e >> 4)) * 16 + (e & 15)) * 32 + (k0 & 31);
          *(v4u*)(WH + fo) = oh; *(v4u*)(WL + fo) = ol; } }
    { const float* P = fin(F, I_P); bf16* PB = (bf16*)(F.ws + WS_PBF);
      for (int i = gw * 64 + LANE_; i < T * PLE / 8; i += NGW * 64) { const f32x4 a = *(const f32x4*)(P + (size_t)i * 8), b = *(const f32x4*)(P + (size_t)i * 8 + 4);
          v4u o; o.x = pk2(a[0], a[1]); o.y = pk2(a[2], a[3]); o.z = pk2(b[0], b[1]); o.w = pk2(b[2], b[3]); *(v4u*)(PB + (size_t)i * 8) = o; } }
    bf16* ABF = (bf16*)(F.ws + WS_ABF);
    for (int m = gw; m < T; m += NGW) rms_row_to_bf16(fin(F, I_X) + (size_t)m * D, fin(F, I_GMIX), ABF + (size_t)m * D, LANE_);
    if (F.G == 256) conv_wg_dyn(F, 0);
}

__device__ __forceinline__ int t5_bucket(int n) {
    if (n < 16) return n;
    const int large = 16 + (int)(logf((float)n * (1.0f / 16.0f)) / logf(8.0f) * 16.0f);
    return large < 31 ? large : 31;
}
constexpr int VT_LD = 216, VT_KEYS = 208, KT_LD = 72;
constexpr int ATT_KT_OFF = 0, ATT_VT_OFF = VT_KEYS * KT_LD * 2;
__device__ __forceinline__ void attn_task(Frame& F, const LAS float* btab, const LAS bf16* ktl, const LAS bf16* vtl, int b, int kvh, int hg, int qt, const bf16x8 (&qf)[2]) {
    const int LANE_ = pg8::lane_id();
    bf16* MIX = (bf16*)(F.ws + WS_MIX);
    const int lane = LANE_, qi = lane & 15, g = lane >> 4, h = kvh * 8 + hg;
    const int q0 = qt * 16, tok0 = b * SEQ, kl0 = 16 * (qt & 3);
    f32x4 s[5][2];
#pragma unroll
    for (int kb = 0; kb < 5; ++kb)
#pragma unroll
        for (int t = 0; t < 2; ++t) {
            const LAS bf16* kp = ktl + (kl0 + 32 * kb + 16 * t + qi) * KT_LD + 8 * g;
            const bf16x8 k0f = *(const LAS bf16x8*)(kp), k1f = *(const LAS bf16x8*)(kp + 32);
            f32x4 a = (f32x4){0.f, 0.f, 0.f, 0.f};
            a = __builtin_amdgcn_mfma_f32_16x16x32_bf16(k0f, qf[0], a, 0, 0, 0);
            a = __builtin_amdgcn_mfma_f32_16x16x32_bf16(k1f, qf[1], a, 0, 0, 0);
            s[kb][t] = a;
        }
    const float sink = fin(F, I_SINKS)[h];
    const LAS float* bt = btab + hg * 128;
    float mx = sink;
#pragma unroll
    for (int kb = 0; kb < 5; ++kb)
#pragma unroll
        for (int t = 0; t < 2; ++t)
#pragma unroll
            for (int r = 0; r < 4; ++r) {
                const int key = q0 - 128 + 32 * kb + 16 * t + 4 * g + r, dist = q0 + qi - key;
                const bool valid = (dist >= 0) && (dist < 128) && (key >= 0);
                const float lg = valid ? s[kb][t][r] * 0.125f + bt[dist & 127] : -3.0e38f;
                s[kb][t][r] = lg; mx = fmaxf(mx, lg);
            }
    mx = fmaxf(mx, __shfl_xor(mx, 16)); mx = fmaxf(mx, __shfl_xor(mx, 32));
    float sum = 0.f;
#pragma unroll
    for (int kb = 0; kb < 5; ++kb)
#pragma unroll
        for (int t = 0; t < 2; ++t)
#pragma unroll
            for (int r = 0; r < 4; ++r) { const float lg = s[kb][t][r]; const float p = (lg > -1.0e38f) ? __expf(lg - mx) : 0.f; s[kb][t][r] = p; sum += p; }
    sum += __shfl_xor(sum, 16); sum += __shfl_xor(sum, 32);
    const float inv = 1.0f / (sum + __expf(sink - mx));
    f32x4 o[4];
#pragma unroll
    for (int dt = 0; dt < 4; ++dt) o[dt] = (f32x4){0.f, 0.f, 0.f, 0.f};
#pragma unroll
    for (int kb = 0; kb < 5; ++kb) {
        v4u pw; pw.x = pk2(s[kb][0][0], s[kb][0][1]); pw.y = pk2(s[kb][0][2], s[kb][0][3]); pw.z = pk2(s[kb][1][0], s[kb][1][1]); pw.w = pk2(s[kb][1][2], s[kb][1][3]);
        const bf16x8 pf = __builtin_bit_cast(bf16x8, pw);
        const int kkl = kl0 + 32 * kb + 4 * g;
#pragma unroll
        for (int dt = 0; dt < 4; ++dt) {
            const LAS bf16* vp = vtl + (16 * dt + qi) * VT_LD + kkl;
            const v2u lo = *(const LAS v2u*)(vp), hi = *(const LAS v2u*)(vp + 16);
            const v4u vw = (v4u){lo.x, lo.y, hi.x, hi.y};
            o[dt] = __builtin_amdgcn_mfma_f32_16x16x32_bf16(__builtin_bit_cast(bf16x8, vw), pf, o[dt], 0, 0, 0);
        }
    }
    bf16* op = MIX + (size_t)(tok0 + q0 + qi) * D + POOLW + h * 64 + 4 * g;
#pragma unroll
    for (int dt = 0; dt < 4; ++dt) { v2u w; w.x = pk2(o[dt][0] * inv, o[dt][1] * inv); w.y = pk2(o[dt][2] * inv, o[dt][3] * inv); *(v2u*)(op + 16 * dt) = w; }
}
__device__ __forceinline__ void attn_block(Frame& F, int blk, bool fill_btab) {
    const int TID_ = F.wave * 64 + pg8::lane_id();
    LAS float* btab = (LAS float*)(F.lds + TAB_OFF + 2048);
    LAS bf16* ktl = (LAS bf16*)(F.lds + RING_OFF + ATT_KT_OFF); LAS bf16* vtl = (LAS bf16*)(F.lds + RING_OFF + ATT_VT_OFF);
    const int b = blk >> 6, kvh = (blk >> 5) & 1, qg = blk & 31;
    const bf16* Q = (const bf16*)(F.ws + WS_QBF); const bf16* KVp = (const bf16*)(F.ws + WS_KV);
    const bf16* qbase = Q + (size_t)(b * SEQ + 64 * qg + ((TID_ & 63) & 15)) * 1024 + (kvh * 8 + F.wave) * 64 + 8 * ((TID_ & 63) >> 4);
    bf16x8 qc[2], qn[2];
    qc[0] = *(const bf16x8*)(qbase); qc[1] = *(const bf16x8*)(qbase + 32);
    v4u kv[4], vv[4];
#pragma unroll
    for (int it = 0; it < 4; ++it) { const int idx = TID_ + it * NWAVES * 64, kl = idx >> 3, c = idx & 7, key = 64 * qg - 128 + kl;
        kv[it] = (v4u){0u, 0u, 0u, 0u}; vv[it] = (v4u){0u, 0u, 0u, 0u};
        if (idx < VT_KEYS * 8 && key >= 0 && key < SEQ) { const bf16* rp = KVp + (size_t)(b * SEQ + key) * (2 * KVW) + kvh * 64 + 8 * c; kv[it] = *(const v4u*)(rp); vv[it] = *(const v4u*)(rp + KVW); } }
    LDS_BARRIER();
    if (fill_btab) for (int i = TID_; i < 1024; i += NWAVES * 64) { const int hg = i >> 7, dist = i & 127; btab[i] = fin(F, I_RPE)[t5_bucket(dist) * NH + kvh * 8 + hg]; }
#pragma unroll
    for (int it = 0; it < 4; ++it) { const int idx = TID_ + it * NWAVES * 64, kl = idx >> 3, c = idx & 7;
        if (idx < VT_KEYS * 8) { const v4u v = vv[it];
            *(LAS v4u*)(ktl + kl * KT_LD + 8 * c) = kv[it];
            LAS bf16* d0 = vtl + (8 * c) * VT_LD + kl;
            d0[0 * VT_LD] = (bf16)(v.x & 0xffffu); d0[1 * VT_LD] = (bf16)(v.x >> 16); d0[2 * VT_LD] = (bf16)(v.y & 0xffffu); d0[3 * VT_LD] = (bf16)(v.y >> 16);
            d0[4 * VT_LD] = (bf16)(v.z & 0xffffu); d0[5 * VT_LD] = (bf16)(v.z >> 16); d0[6 * VT_LD] = (bf16)(v.w & 0xffffu); d0[7 * VT_LD] = (bf16)(v.w >> 16); } }
    LDS_BARRIER();
#pragma unroll 1
    for (int i = 0; i < 4; ++i) {
        const bf16* qb2 = qbase + (size_t)((i < 3 ? i + 1 : i) * 16) * 1024;
        qn[0] = *(const bf16x8*)(qb2); qn[1] = *(const bf16x8*)(qb2 + 32);
        attn_task(F, btab, ktl, vtl, b, kvh, F.wave, 4 * qg + i, qc);
        qc[0] = qn[0]; qc[1] = qn[1];
    }
}
__device__ __forceinline__ void pool_task(Frame& F, int mt, int gq) {
    const int LANE_ = pg8::lane_id(), TID_ = F.wave * 64 + LANE_;
    const bf16* U = (const bf16*)(F.ws + WS_UBF); bf16* PO = (bf16*)(F.ws + WS_POOLED);
    LAS v4u* UL = (LAS v4u*)(F.lds + RING_OFF);
    const int w = 2 << gq;
    for (int hh = 0; hh < 2; ++hh) {
        const int tbase = mt * 256 + 128 * hh, pos0 = tbase & (SEQ - 1);
        LDS_BARRIER();
        for (int idx = TID_; idx < 143 * 32; idx += NWAVES * 64) { const int r = idx >> 5, c = idx & 31;
            v4u x = (v4u){0u, 0u, 0u, 0u}; if (pos0 - 15 + r >= 0) x = *(const v4u*)(U + (size_t)(tbase - 15 + r) * POOLW + gq * 256 + 8 * c);
            UL[idx] = x; }
        LDS_BARRIER();
        const int c = TID_ & 31, i0 = (TID_ >> 5) * 8;
        float run[8];
#pragma unroll
        for (int q = 0; q < 8; ++q) run[q] = 0.f;
        for (int j = 1; j < w; ++j) { const v4u x = UL[(15 + i0 - j) * 32 + c];
            run[0] += bf_lo(x.x); run[1] += bf_hi(x.x); run[2] += bf_lo(x.y); run[3] += bf_hi(x.y); run[4] += bf_lo(x.z); run[5] += bf_hi(x.z); run[6] += bf_lo(x.w); run[7] += bf_hi(x.w); }
#pragma unroll
        for (int i = 0; i < 8; ++i) {
            const int pos = pos0 + i0 + i; const v4u x = UL[(15 + i0 + i) * 32 + c], y = UL[(15 + i0 + i - w + 1) * 32 + c];
            const float uv[8] = {bf_lo(x.x), bf_hi(x.x), bf_lo(x.y), bf_hi(x.y), bf_lo(x.z), bf_hi(x.z), bf_lo(x.w), bf_hi(x.w)};
            const float ic = 1.0f / (float)((pos + 1) < w ? (pos + 1) : w);
            float o[8];
#pragma unroll
            for (int q = 0; q < 8; ++q) { run[q] += uv[q]; o[q] = run[q] * ic - uv[q]; }
            v4u ow; ow.x = pk2(o[0], o[1]); ow.y = pk2(o[2], o[3]); ow.z = pk2(o[4], o[5]); ow.w = pk2(o[6], o[7]);
            *(v4u*)(PO + (size_t)(tbase + i0 + i) * POOLW + gq * 256 + 8 * c) = ow;
            run[0] -= bf_lo(y.x); run[1] -= bf_hi(y.x); run[2] -= bf_lo(y.y); run[3] -= bf_hi(y.y); run[4] -= bf_lo(y.z); run[5] -= bf_hi(y.z); run[6] -= bf_lo(y.w); run[7] -= bf_hi(y.w);
        }
    }
    VM_WAIT(); __syncthreads();
    pg8::Gemm g{(const bf16*)PO + gq * 256, (const bf16*)(F.ws + WS_WPOOL) + (size_t)gq * 65536, POOLW, 256, 256};
    pg8::SingleOrder S{mt, 0};
    EpiBf16Plain E{(bf16*)(F.ws + WS_MIX), D, gq * 256, fin(F, I_PSCALE)};
    pg8::gemm_phase<EpiBf16Plain, pg8::SingleOrder, false>(F.lds + RING_OFF, g, S, E, F.wave);
}

constexpr int XS_STRIDE = 2052;
constexpr int P4_XS = 0, P4_PART = 16 * XS_STRIDE * 4, P4_SELE = P4_PART + 4 * 16 * 64 * 4, P4_SELW = P4_SELE + 32 * 8 * 4, P4_SELL = P4_SELW + 32 * 8 * 4, P4_HIST = P4_SELL + 32 * 8 * 4, P4_BASE = P4_HIST + 256, P4_END = P4_BASE + 256;
static_assert(P4_END <= MISC_OFF, "P4 LDS map");
__device__ __forceinline__ unsigned fkey(float f) { const unsigned u = __builtin_bit_cast(unsigned, f); return (u & 0x80000000u) ? ~u : (u | 0x80000000u); }
__device__ __forceinline__ void p4_route(Frame& F) {
    const int LANE_ = pg8::lane_id(), TID_ = F.wave * 64 + LANE_; (void)TID_;
    LAS float* XS = (LAS float*)(F.lds + P4_XS); LAS float* PART = (LAS float*)(F.lds + P4_PART);
    LAS int* SELE = (LAS int*)(F.lds + P4_SELE); LAS float* SELW = (LAS float*)(F.lds + P4_SELW); LAS int* SELL = (LAS int*)(F.lds + P4_SELL);
    LAS int* HIST = (LAS int*)(F.lds + P4_HIST); LAS int* BASE = (LAS int*)(F.lds + P4_BASE);
    const float* H1 = (const float*)(F.ws + WS_H1); unsigned char* XN = F.ws + WS_XN; const float* gf = fin(F, I_GFFN); const float* rb = fin(F, I_RBIAS);
    const bf16* WH = (const bf16*)(F.ws + WS_WRT); const bf16* WL = WH + (size_t)NE * D;
    const int lane = LANE_, wave = F.wave, ti = lane & 15, kk = lane >> 4;
    if (TID_ < 64) HIST[TID_] = 0;
    for (int tile = F.bx; tile < T / 32; tile += F.G) {
    f32x4 xr[2][8];
#pragma unroll
    for (int q = 0; q < 2; ++q) { const float* xrow = H1 + (size_t)(tile * 32 + 2 * wave + q) * D;
#pragma unroll
        for (int j = 0; j < 4; ++j) { xr[q][2 * j] = *(const f32x4*)(xrow + 512 * j + 8 * lane); xr[q][2 * j + 1] = *(const f32x4*)(xrow + 512 * j + 8 * lane + 4); } }
#pragma unroll 1
    for (int pass = 0; pass < 2; ++pass) {
#pragma unroll
        for (int q = 0; q < 2; ++q) { const int tl = 2 * wave + q; float s = 0.f;
#pragma unroll
            for (int j = 0; j < 8; ++j) { const f32x4 v = xr[q][j]; s += (v[0] * v[0] + v[1] * v[1]) + (v[2] * v[2] + v[3] * v[3]); }
            const float rstd = 1.0f / sqrtf(wave_sum(s) * (1.0f / D) + EPS);
#pragma unroll
            for (int j = 0; j < 4; ++j) { const f32x4 a = xr[q][2 * j] * rstd * *(const f32x4*)(gf + 512 * j + 8 * lane), b = xr[q][2 * j + 1] * rstd * *(const f32x4*)(gf + 512 * j + 8 * lane + 4);
                *(LAS f32x4*)(XS + tl * XS_STRIDE + 512 * j + 8 * lane) = a; *(LAS f32x4*)(XS + tl * XS_STRIDE + 512 * j + 8 * lane + 4) = b;
                v2u o; o.x = pk4_fp8(a[0], a[1], a[2], a[3]); o.y = pk4_fp8(b[0], b[1], b[2], b[3]);
                *(v2u*)(XN + (size_t)(tile * 32 + 16 * pass + tl) * D + 512 * j + 8 * lane) = o; } }
        if (pass == 0) {
#pragma unroll
            for (int q = 0; q < 2; ++q) { const float* xrow = H1 + (size_t)(tile * 32 + 16 + 2 * wave + q) * D;
#pragma unroll
                for (int j = 0; j < 4; ++j) { xr[q][2 * j] = *(const f32x4*)(xrow + 512 * j + 8 * lane); xr[q][2 * j + 1] = *(const f32x4*)(xrow + 512 * j + 8 * lane + 4); } } }
        f32x4 acc[4];
#pragma unroll
        for (int et = 0; et < 4; ++et) acc[et] = (f32x4){0.f, 0.f, 0.f, 0.f};
        bf16x8 wh0[4], wl0[4], wh1[4], wl1[4];
#define P4_LDW(WHX, WLX, st) do { const size_t fo_ = ((size_t)((8 * wave + (st)) * 4) * 16 + ti) * 32 + 8 * kk; _Pragma("unroll") for (int et = 0; et < 4; ++et) { WHX[et] = *(const bf16x8*)(WH + fo_ + et * 512); WLX[et] = *(const bf16x8*)(WL + fo_ + et * 512); } } while (0)
#define P4_STEP(WHX, WLX, st) do { const int k0_ = 256 * wave + 32 * (st) + 8 * kk; \
            const f32x4 xa = *(const LAS f32x4*)(XS + ti * XS_STRIDE + k0_), xb = *(const LAS f32x4*)(XS + ti * XS_STRIDE + k0_ + 4); v4u hw, lw; \
            hw.x = pk2(xa[0], xa[1]); hw.y = pk2(xa[2], xa[3]); hw.z = pk2(xb[0], xb[1]); hw.w = pk2(xb[2], xb[3]); \
            lw.x = pk2(xa[0] - bf_lo(hw.x), xa[1] - bf_hi(hw.x)); lw.y = pk2(xa[2] - bf_lo(hw.y), xa[3] - bf_hi(hw.y)); lw.z = pk2(xb[0] - bf_lo(hw.z), xb[1] - bf_hi(hw.z)); lw.w = pk2(xb[2] - bf_lo(hw.w), xb[3] - bf_hi(hw.w)); \
            const bf16x8 xh = __builtin_bit_cast(bf16x8, hw), xl = __builtin_bit_cast(bf16x8, lw); \
            _Pragma("unroll") for (int et = 0; et < 4; ++et) { acc[et] = __builtin_amdgcn_mfma_f32_16x16x32_bf16(xh, WHX[et], acc[et], 0, 0, 0); \
                acc[et] = __builtin_amdgcn_mfma_f32_16x16x32_bf16(xl, WHX[et], acc[et], 0, 0, 0); acc[et] = __builtin_amdgcn_mfma_f32_16x16x32_bf16(xh, WLX[et], acc[et], 0, 0, 0); } } while (0)
        P4_LDW(wh0, wl0, 0);
        LDS_BARRIER();
#pragma unroll 1
        for (int st = 0; st < 8; st += 2) { P4_LDW(wh1, wl1, st + 1); P4_STEP(wh0, wl0, st); if (st + 2 < 8) P4_LDW(wh0, wl0, st + 2); P4_STEP(wh1, wl1, st + 1); }
#undef P4_LDW
#undef P4_STEP
        if (wave >= 4) {
#pragma unroll
            for (int et = 0; et < 4; ++et)
#pragma unroll
                for (int r = 0; r < 4; ++r) PART[(wave - 4) * 1024 + (4 * kk + r) * 64 + 16 * et + ti] = acc[et][r];
        }
        LDS_BARRIER();
        if (wave < 4) {
#pragma unroll
            for (int et = 0; et < 4; ++et)
#pragma unroll
                for (int r = 0; r < 4; ++r) { LAS float* pp = PART + wave * 1024 + (4 * kk + r) * 64 + 16 * et + ti; *pp = *pp + acc[et][r]; }
        }
        LDS_BARRIER();
#pragma unroll 1
        for (int q = 0; q < 2; ++q) {
            const int tl = 2 * wave + q, tw = pass * 16 + tl;
            const float lg = (PART[tl * 64 + lane] + PART[1024 + tl * 64 + lane]) + (PART[2048 + tl * 64 + lane] + PART[3072 + tl * 64 + lane]);
            const float score = 1.0f / (1.0f + expf(-lg)), biased = score + rb[lane];
            const int grp = lane >> 3;
            float m1 = biased; m1 = fmaxf(m1, __shfl_xor(m1, 1)); m1 = fmaxf(m1, __shfl_xor(m1, 2)); m1 = fmaxf(m1, __shfl_xor(m1, 4));
            const unsigned long long bm = __ballot(biased == m1); const unsigned gb = (unsigned)(bm >> (8 * grp)) & 0xffu; const int first = __builtin_ctz(gb);
            float v2 = ((lane & 7) == first) ? -3.0e38f : biased; float m2 = v2; m2 = fmaxf(m2, __shfl_xor(m2, 1)); m2 = fmaxf(m2, __shfl_xor(m2, 2)); m2 = fmaxf(m2, __shfl_xor(m2, 4));
            const unsigned gk = (fkey(m1 + m2) & ~7u) | (unsigned)(7 - grp);
            int grank = 0;
#pragma unroll
            for (int j = 0; j < 8; ++j) { const unsigned sj = (unsigned)__builtin_amdgcn_readlane((int)gk, 8 * j); grank += (sj > gk) ? 1 : 0; }
            const bool gsel = grank < 4;
            const unsigned key = gsel ? ((fkey(biased) & ~63u) | (unsigned)(63 - lane)) : (unsigned)(63 - lane);
            int rank = 0;
#pragma unroll
            for (int j = 0; j < 64; ++j) { const unsigned sj = (unsigned)__builtin_amdgcn_readlane((int)key, j); rank += (sj > key) ? 1 : 0; }
            const bool sel = gsel && (rank < 8);
            const float wsum = wave_sum(sel ? score : 0.f);
            const unsigned long long sm = __ballot(sel);
            if (sel) { const int k = __popcll(sm & ((1ull << lane) - 1ull)); const int li = atomicAdd((int*)&HIST[lane], 1);
                SELE[tw * 8 + k] = lane; SELW[tw * 8 + k] = score / wsum * 2.5f; SELL[tw * 8 + k] = li; }
        }
        LDS_BARRIER();
    }
    if (TID_ < 64) BASE[TID_] = (int)__hip_atomic_fetch_add(F.ctl + CW_CNT + 32 * TID_, (unsigned)HIST[TID_], RLX_AGENT);
    LDS_BARRIER();
    if (TID_ < 256) { const int e = SELE[TID_], pos = BASE[e] + SELL[TID_], tok = tile * 32 + (TID_ >> 3);
        ((int*)(F.ws + WS_TOKLIST))[(size_t)e * T + pos] = tok; ((float*)(F.ws + WS_WREC))[tok * 8 + (TID_ & 7)] = SELW[TID_]; ((int*)(F.ws + WS_REC))[tok * 8 + (TID_ & 7)] = e * T + pos; }
    LDS_BARRIER();
    if (TID_ < 64) HIST[TID_] = 0;
    LDS_BARRIER();
    }
}

__device__ __forceinline__ void p7_combine(Frame& F, bool dry) {
    const int LANE_ = pg8::lane_id();
    const LAS int* tab = (const LAS int*)(F.lds + TAB_OFF);
    const unsigned char* Y = F.ws + WS_Y; const int* rec = (const int*)(F.ws + WS_REC); const float* wrec = (const float*)(F.ws + WS_WREC);
    const float* H = (const float*)(F.ws + WS_H1); bf16* HO = dry ? (bf16*)(F.ws + WS_WGU) : (bf16*)(F.ws + WS_H2B); unsigned char* H2 = dry ? (F.ws + WS_WGU + 64 * MiB) : (F.ws + WS_H2F8);
    const int gw = F.bx * NWAVES + F.wave, NGW = F.G * NWAVES, lane = LANE_;
    for (int t = gw; t < T; t += NGW) {
        int rows[9]; float rwt[9];
#pragma unroll
        for (int k = 0; k < 8; ++k) { const int rc = rec[t * 8 + k]; const int e = rc >> 13, pos = rc & (T - 1); rows[k] = tab[TB_PAD + e] + pos; rwt[k] = wrec[t * 8 + k] * (1.0f / SY); }
        rows[8] = SH_ROW0 + t; rwt[8] = 1.0f / SY;
        v4u y[2][9]; f32x4 h[2][4];
#pragma unroll
        for (int j = 0; j < 2; ++j) { const int c0 = 1024 * j + 16 * lane;
#pragma unroll
            for (int q = 0; q < 4; ++q) h[j][q] = *(const f32x4*)(H + (size_t)t * D + c0 + 4 * q);
#pragma unroll
            for (int k = 0; k < 9; ++k) y[j][k] = *(const v4u*)(Y + (size_t)rows[k] * D + c0); }
#pragma unroll
        for (int j = 0; j < 2; ++j) { const int c0 = 1024 * j + 16 * lane;
#pragma unroll
            for (int k = 0; k < 9; ++k) { const float w = rwt[k]; float f[4];
                fp8x4_to_f32(y[j][k].x, f); h[j][0][0] += w * f[0]; h[j][0][1] += w * f[1]; h[j][0][2] += w * f[2]; h[j][0][3] += w * f[3];
                fp8x4_to_f32(y[j][k].y, f); h[j][1][0] += w * f[0]; h[j][1][1] += w * f[1]; h[j][1][2] += w * f[2]; h[j][1][3] += w * f[3];
                fp8x4_to_f32(y[j][k].z, f); h[j][2][0] += w * f[0]; h[j][2][1] += w * f[1]; h[j][2][2] += w * f[2]; h[j][2][3] += w * f[3];
                fp8x4_to_f32(y[j][k].w, f); h[j][3][0] += w * f[0]; h[j][3][1] += w * f[1]; h[j][3][2] += w * f[2]; h[j][3][3] += w * f[3]; }
            { v4u b0, b1; b0.x = pk2(h[j][0][0], h[j][0][1]); b0.y = pk2(h[j][0][2], h[j][0][3]); b0.z = pk2(h[j][1][0], h[j][1][1]); b0.w = pk2(h[j][1][2], h[j][1][3]);
              b1.x = pk2(h[j][2][0], h[j][2][1]); b1.y = pk2(h[j][2][2], h[j][2][3]); b1.z = pk2(h[j][3][0], h[j][3][1]); b1.w = pk2(h[j][3][2], h[j][3][3]);
              *(v4u*)(HO + (size_t)t * D + c0) = b0; *(v4u*)(HO + (size_t)t * D + c0 + 8) = b1; }
            v4u o; o.x = pk4_fp8(h[j][0][0], h[j][0][1], h[j][0][2], h[j][0][3]); o.y = pk4_fp8(h[j][1][0], h[j][1][1], h[j][1][2], h[j][1][3]);
            o.z = pk4_fp8(h[j][2][0], h[j][2][1], h[j][2][2], h[j][2][3]); o.w = pk4_fp8(h[j][3][0], h[j][3][1], h[j][3][2], h[j][3][3]);
            *(v4u*)(H2 + (size_t)t * D + c0) = o; }
    }
}
__device__ __forceinline__ void p9_final(Frame& F, bool dry) {
    const int LANE_ = pg8::lane_id();
    const int gw = F.bx * NWAVES + F.wave, NGW = F.G * NWAVES, lane = LANE_; const float* g = fin(F, I_GFINAL); const float* gp = fin(F, I_GPLE);
    const bf16* G = (const bf16*)(F.ws + WS_GBUF); const bf16* PP = (const bf16*)(F.ws + WS_PPROJ);
    for (int t = gw; t < T; t += NGW) {
        const bf16* row = (const bf16*)(F.ws + WS_H2B) + (size_t)t * D; float* orow = (dry ? (float*)(F.ws + WS_WGU) : F.out) + (size_t)t * D; f32x4 v[8]; v4u gg[4], pw[4];
#pragma unroll
        for (int j = 0; j < 4; ++j) { const v4u hw = *(const v4u*)(row + 512 * j + 8 * lane);
            v[2 * j] = (f32x4){bf_lo(hw.x), bf_hi(hw.x), bf_lo(hw.y), bf_hi(hw.y)}; v[2 * j + 1] = (f32x4){bf_lo(hw.z), bf_hi(hw.z), bf_lo(hw.w), bf_hi(hw.w)};
            gg[j] = *(const v4u*)(G + (size_t)t * D + 512 * j + 8 * lane); pw[j] = *(const v4u*)(PP + (size_t)t * D + 512 * j + 8 * lane); }
        float pf[4][8]; float ps = 0.f;
#pragma unroll
        for (int j = 0; j < 4; ++j) { pf[j][0] = bf_lo(pw[j].x); pf[j][1] = bf_hi(pw[j].x); pf[j][2] = bf_lo(pw[j].y); pf[j][3] = bf_hi(pw[j].y); pf[j][4] = bf_lo(pw[j].z); pf[j][5] = bf_hi(pw[j].z); pf[j][6] = bf_lo(pw[j].w); pf[j][7] = bf_hi(pw[j].w);
#pragma unroll
            for (int q = 0; q < 8; ++q) ps += pf[j][q] * pf[j][q]; }
        const float rsp = 1.0f / sqrtf(wave_sum(ps) * (1.0f / D) + EPS);
        float s = 0.f;
#pragma unroll
        for (int j = 0; j < 4; ++j) { const f32x4 g0 = *(const f32x4*)(gp + 512 * j + 8 * lane), g1 = *(const f32x4*)(gp + 512 * j + 8 * lane + 4);
            const float gl[8] = {bf_lo(gg[j].x), bf_hi(gg[j].x), bf_lo(gg[j].y), bf_hi(gg[j].y), bf_lo(gg[j].z), bf_hi(gg[j].z), bf_lo(gg[j].w), bf_hi(gg[j].w)};
#pragma unroll
            for (int q = 0; q < 4; ++q) { v[2 * j][q] += sigmoid_f(gl[q]) * pf[j][q] * rsp * g0[q]; v[2 * j + 1][q] += sigmoid_f(gl[4 + q]) * pf[j][4 + q] * rsp * g1[q]; }
            s += (v[2 * j][0] * v[2 * j][0] + v[2 * j][1] * v[2 * j][1]) + (v[2 * j][2] * v[2 * j][2] + v[2 * j][3] * v[2 * j][3]);
            s += (v[2 * j + 1][0] * v[2 * j + 1][0] + v[2 * j + 1][1] * v[2 * j + 1][1]) + (v[2 * j + 1][2] * v[2 * j + 1][2] + v[2 * j + 1][3] * v[2 * j + 1][3]); }
        const float rstd = 1.0f / sqrtf(wave_sum(s) * (1.0f / D) + EPS);
#pragma unroll
        for (int j = 0; j < 4; ++j) { const f32x4 g0 = *(const f32x4*)(g + 512 * j + 8 * lane), g1 = *(const f32x4*)(g + 512 * j + 8 * lane + 4);
            *(f32x4*)(orow + 512 * j + 8 * lane) = v[2 * j] * rstd * g0; *(f32x4*)(orow + 512 * j + 8 * lane + 4) = v[2 * j + 1] * rstd * g1; }
    }
}
__global__ void __launch_bounds__(NWAVES * 64, 2) fwd_kernel(Args args) {
    extern __shared__ __attribute__((aligned(16))) unsigned char lds[];
    Frame F;
    F.lds = (LAS unsigned char*)lds;
    F.MISC = (volatile LAS unsigned*)(F.lds + MISC_OFF);
    F.wave = __builtin_amdgcn_readfirstlane(threadIdx.x >> 6);
    F.G = gridDim.x; F.bx = blockIdx.x;
    F.ws = args.ws; F.ctl = (gu32*)(args.ws + WS_CTL); F.out = args.out;
    { const int TID_ = threadIdx.x;
    if (TID_ < 64) F.MISC[TID_] = 0u;
    if (TID_ >= 64 && TID_ < 64 + 22) ((LAS unsigned long long*)(F.lds + MISC_OFF + 256))[TID_ - 64] = ((const unsigned long long*)&args)[TID_ - 64]; }
    __syncthreads();
    XcdBarrier bar; bar.bar = (unsigned*)(F.ctl + CW_BAR); bar.x = 0; bar.st = nullptr;
    if (N_LAUNCHES == 1) bar = xcd_barrier_post((unsigned*)(F.ctl + CW_BAR), F.MISC + 8);
#define GRID_BAR() do { if (N_LAUNCHES == 1) xcd_barrier(bar); } while (0)
    const int lo = args.ph_lo, hi = args.ph_hi;
#ifndef PH_MASK
#define PH_MASK 0x3ff
#endif
#ifndef DUP_PHASE
#define DUP_PHASE -1
#endif
#define REPS(k) ((DUP_PHASE == (k)) ? 2 : 1)
#define IN(k) ((((PH_MASK) >> (k)) & 1) && lo <= (k) && (k) < hi)
#define BOTH(k) (IN(k) && IN((k) + 1))

    if (IN(0)) { _Pragma("unroll") for (int rep = 0; rep < REPS(0); ++rep) { p0_prologue(F); if (BOTH(0)) GRID_BAR(); } }

    if (IN(1)) { _Pragma("unroll") for (int rep = 0; rep < REPS(1); ++rep) {
        constexpr int G1 = 144;
        if (F.G == 256 && F.bx >= G1) {
            { pg8::Gemm g{(const bf16*)(F.ws + WS_PBF), (const bf16*)(F.ws + WS_WPP), PLE, PLE, PLE}; pg8::StaticOrder S; S.init(T, D, F.G - G1, F.bx - G1);
              EpiBf16Plain E{(bf16*)(F.ws + WS_PPROJ), D, 0, nullptr};
              pg8::gemm_phase<EpiBf16Plain, pg8::StaticOrder, false>(F.lds + RING_OFF, g, S, E, F.wave); }
            conv_wg_dyn(F, 1);
        } else {
            const int gg = (F.G == 256) ? G1 : F.G;
            { pg8::Gemm g{(const bf16*)(F.ws + WS_ABF), (const bf16*)(F.ws + WS_WIN), D, D, D}; pg8::StaticOrder S; S.init(T, INW, gg, F.bx);
              EpiInProj E{F.ws};
              pg8::gemm_phase<EpiInProj, pg8::StaticOrder, false>(F.lds + RING_OFF, g, S, E, F.wave); }
            if (F.G == 256) conv_wg_dyn(F, 1);
            if (F.G != 256) {
                { pg8::Gemm g{(const bf16*)(F.ws + WS_PBF), (const bf16*)(F.ws + WS_WPP), PLE, PLE, PLE}; pg8::StaticOrder S; S.init(T, D, F.G, F.bx);
                  EpiBf16Plain E{(bf16*)(F.ws + WS_PPROJ), D, 0, nullptr};
                  pg8::gemm_phase<EpiBf16Plain, pg8::StaticOrder, false>(F.lds + RING_OFF, g, S, E, F.wave); }
                conv_fp8_items(F, CONV_A, CONV_A + CONV_B, F.bx * NWAVES + F.wave, F.G * NWAVES);
            }
        }
        if (BOTH(1)) GRID_BAR();
    } }

    if (IN(2)) { _Pragma("unroll") for (int rep = 0; rep < REPS(2); ++rep) {
        if (F.G == 256) {
            if (F.bx < 128) pool_task(F, F.bx >> 2, F.bx & 3);
            else {
#pragma unroll 1
                for (int j = 0; j < 2; ++j) attn_block(F, 2 * (F.bx - 128) + j, j == 0); }
        } else {
            for (int blk = F.bx; blk < 256; blk += F.G) attn_block(F, blk, true);
            for (int p = F.bx; p < 128; p += F.G) { __syncthreads(); pool_task(F, p >> 2, p & 3); }
        }
        if (BOTH(2)) GRID_BAR();
    } }

    if (IN(3)) { _Pragma("unroll") for (int rep = 0; rep < REPS(3); ++rep) {
        constexpr int G3 = 128;
        if (F.G == 256 && F.bx >= G3) conv_wg_dyn(F, 2);
        else {
            pg8::Gemm g{(const bf16*)(F.ws + WS_MIX), (const bf16*)(F.ws + WS_WOUT), D, D, D}; pg8::StaticOrder S; S.init(T, D, (F.G == 256) ? G3 : F.G, F.bx);
            EpiResF32 E{fin(F, I_X), (float*)(F.ws + WS_H1)};
            pg8::gemm_phase<EpiResF32, pg8::StaticOrder, false>(F.lds + RING_OFF, g, S, E, F.wave);
            if (F.G == 256) conv_wg_dyn(F, 2);
            if (F.G != 256) conv_fp8_items(F, CONV_A + CONV_B, CV_TOTAL, F.bx * NWAVES + F.wave, F.G * NWAVES);
        }
        if (BOTH(3)) GRID_BAR();
    } }

    if (IN(4)) { _Pragma("nounroll") for (int rep = 0; rep < ((DUP_PHASE == 4) ? 2 : 1); ++rep) { if (rep == 1) { GRID_BAR(); if (F.bx == 0 && threadIdx.x < NE) __hip_atomic_store(F.ctl + CW_CNT + 32 * threadIdx.x, 0u, RLX_AGENT); GRID_BAR(); }
        p4_route(F); } if (BOTH(4)) GRID_BAR(); }

    if (IN(5)) { _Pragma("unroll") for (int rep = 0; rep < REPS(5); ++rep) {
        moe_tables(F);
        pg8::Gemm g{F.ws + WS_XN, F.ws + WS_WGU, D, D, D};
        MoeOrder S{(const LAS int*)(F.lds + TAB_OFF), (const int*)(F.ws + WS_TOKLIST), F.bx & 7, F.bx >> 3, 4, F.G >> 3};
        EpiGateUp E{F.ws + WS_ACT};
        pg8::gemm_phase<EpiGateUp, MoeOrder, true, 1>(F.lds + RING_OFF, g, S, E, F.wave);
        if (BOTH(5)) GRID_BAR();
    } }

    if (IN(6)) { _Pragma("unroll") for (int rep = 0; rep < REPS(6); ++rep) {
        if (!IN(5)) moe_tables(F);
        pg8::Gemm g{F.ws + WS_ACT, F.ws + WS_WD, EFF, EFF, EFF};
        MoeOrder S{(const LAS int*)(F.lds + TAB_OFF), (const int*)(F.ws + WS_TOKLIST), F.bx & 7, F.bx >> 3, 8, F.G >> 3};
        EpiDown E{F.ws + WS_Y};
        pg8::gemm_phase<EpiDown, MoeOrder, false, 1>(F.lds + RING_OFF, g, S, E, F.wave);
        if (BOTH(6)) GRID_BAR();
    } }

    if (IN(7)) { if (!IN(6)) moe_tables(F); if (DUP_PHASE == 7) { p7_combine(F, true); GRID_BAR(); } p7_combine(F, false); if (BOTH(7)) GRID_BAR(); }

    if (IN(8)) {
        pg8::Gemm g{F.ws + WS_H2F8, F.ws + WS_WPG, D, D, D}; pg8::StaticOrder S; S.init(T, D, F.G, F.bx);
        EpiBf16Mul E{(bf16*)(F.ws + WS_GBUF), 1.0f / SW3};
        pg8::gemm_phase<EpiBf16Mul, pg8::StaticOrder, false, 1>(F.lds + RING_OFF, g, S, E, F.wave);
        if (BOTH(8)) GRID_BAR();
    }

    if (IN(9)) { if (DUP_PHASE == 9) { p9_final(F, true); GRID_BAR(); } p9_final(F, false); }
#undef IN
#undef BOTH
}

extern "C" void kernel_launch(void* const* d_in, const int* in_sizes, int n_in, void* d_out, int out_size, void* d_ws, size_t ws_size, hipStream_t stream) {
    static int grid = 0;
    if (grid == 0) {
        if (n_in != 22 || out_size != T * D || ws_size < WS_END) { fprintf(stderr, "kernel_launch: unexpected sizes n_in %d out %d ws %zu (need %zu)\n", n_in, out_size, ws_size, (size_t)WS_END); grid = -1; return; }
        int dev = 0, cus = 0, per_cu = 0;
        if (hipGetDevice(&dev) != hipSuccess || hipDeviceGetAttribute(&cus, hipDeviceAttributeMultiprocessorCount, dev) != hipSuccess) { grid = -1; return; }
        if (hipFuncSetAttribute((const void*)fwd_kernel, hipFuncAttributeMaxDynamicSharedMemorySize, LDS_BYTES) != hipSuccess) { fprintf(stderr, "kernel_launch: hipFuncSetAttribute failed\n"); grid = -1; return; }
        if (hipOccupancyMaxActiveBlocksPerMultiprocessor(&per_cu, (const void*)fwd_kernel, NWAVES * 64, LDS_BYTES) != hipSuccess || per_cu < 1) fprintf(stderr, "kernel_launch: occupancy query reports %d\n", per_cu);
        (void)hipGetLastError();
        grid = cus > 256 ? 256 : cus;
    }
    if (grid < 0) return;
    if (hipMemsetAsync((char*)d_ws + WS_CTL, 0, CTL_ZERO_BYTES, stream) != hipSuccess) return;
    Args a{};
    for (int i = 0; i < 22; ++i) a.in[i] = (const float*)d_in[i];
    a.out = (float*)d_out; a.ws = (unsigned char*)d_ws;
    for (int li = 0; li < N_LAUNCHES; ++li) {
        a.ph_lo = (N_LAUNCHES == 1) ? 0 : li; a.ph_hi = (N_LAUNCHES == 1) ? N_PHASES : li + 1; a.li = li;
        hipLaunchKernelGGL(fwd_kernel, dim3(grid), dim3(NWAVES * 64), LDS_BYTES, stream, a);
    }
}
```

```cpp
#include <hip/hip_runtime.h>
#include <cstdio>
#include <cstdint>

#ifndef MK_N_LAUNCHES
#define MK_N_LAUNCHES 1
#endif

namespace pg8 {
#define PG8_LAS __attribute__((address_space(3)))
typedef unsigned short bf16_t;
typedef short bf16x8 __attribute__((ext_vector_type(8)));
typedef float f32x4 __attribute__((ext_vector_type(4)));
typedef unsigned u32x4 __attribute__((ext_vector_type(4)));
typedef unsigned u32x2 __attribute__((ext_vector_type(2)));
constexpr int BM = 256, BK = 64, HALF = 128, HTB = HALF * BK * 2  , STAGE_BYTES = 8 * HTB, NXCD = 8, WGM = 8;

__host__ __device__ __forceinline__ int lds_byte(int r, int c) { const int st = (r >> 4) * 2 + (c >> 5), rr = r & 15, cc = c & 31, ob = rr * 64 + cc * 2; return st * 1024 + (ob ^ (((ob >> 9) & 1) << 5)); }
__host__ __device__ __forceinline__ void stage_rc(int b, int& R, int& C) { const int st = b / 1024, sb = b % 1024, swz = sb ^ (((sb >> 9) & 1) << 5); R = (st >> 1) * 16 + swz / 64; C = (st & 1) * 32 + (swz % 64) / 2; }
__host__ __device__ __forceinline__ int perm32(int rho) { const int n = rho >> 4, i = rho & 15; return 8 * (i >> 2) + 4 * n + (i & 3); }

struct Unit { int pm, pn, e, lt, half; };
struct Gemm { const void* A; const void* Bt; int lda, ldb, K; };
typedef int i32x8 __attribute__((ext_vector_type(8)));
typedef int i32x4 __attribute__((ext_vector_type(4)));
__device__ __forceinline__ i32x8 cat8(bf16x8 lo, bf16x8 hi) { const i32x4 a = __builtin_bit_cast(i32x4, lo), b = __builtin_bit_cast(i32x4, hi); return __builtin_shufflevector(a, b, 0, 1, 2, 3, 4, 5, 6, 7); }

struct StaticOrder {
    static constexpr bool HALVES = false;
    int nM, nN, nwg, G, c;
    __host__ __device__ void init(int M, int N, int G_, int c_) { nM = M / BM; nN = N / BM; nwg = nM * nN; G = G_; c = c_; }
    __host__ __device__ bool next(int i, Unit& u) const {
        const long L = (long)i * G + c; if (L >= nwg) return false;
        int wgid = (int)L; { const int q = nwg / NXCD, r = nwg % NXCD, xcd = wgid % NXCD, off = wgid / NXCD; wgid = (xcd < r ? xcd * (q + 1) : r * (q + 1) + (xcd - r) * q) + off; }
        const int nig = WGM * nN, gid = wgid / nig, fm = gid * WGM, gsz = (nM - fm) < WGM ? (nM - fm) : WGM;
        u.pm = fm + ((wgid % nig) % gsz); u.pn = (wgid % nig) / gsz; u.e = 0; u.lt = 0; u.half = 0; return true;
    }
    __device__ __forceinline__ int arow(const Unit&, int r) const { return r; }
};
struct SingleOrder {
    static constexpr bool HALVES = false;
    int pm, pn;
    __device__ bool next(int i, Unit& u) const { if (i > 0) return false; u.pm = pm; u.pn = pn; u.e = 0; u.lt = 0; u.half = 0; return true; }
    __device__ __forceinline__ int arow(const Unit&, int r) const { return r; }
};

__device__ __forceinline__ int lane_id() { int l; asm volatile("v_mbcnt_lo_u32_b32 %0, -1, 0\n\tv_mbcnt_hi_u32_b32 %0, -1, %0" : "=v"(l)); return l; }
__device__ __forceinline__ unsigned cvt_pk_bf16(float lo, float hi) { unsigned r; asm volatile("v_cvt_pk_bf16_f32 %0, %1, %2" : "=v"(r) : "v"(lo), "v"(hi)); return r; }

__host__ __device__ __forceinline__ int perm16(int R) { return 64 * (R >> 5) + 16 * ((R >> 2) & 3) + 4 * ((R >> 4) & 1) + (R & 3); }
template <class Epi, class Sched, bool GATHER, int ESZ = 2, bool ALIGN_EPI = true>
__device__ __forceinline__ void gemm_phase(PG8_LAS unsigned char* lds, const Gemm g, const Sched& S, const Epi& E, int wid) {
    const int lane = lane_id(), tid = wid * 64 + lane, wr = wid >> 2, wc = wid & 3, fr = lane & 15, fq = lane >> 4;
    const int nt = (g.K * ESZ) / 128;
    int Ra[2], Ca[2]; unsigned voffB[2];
#pragma unroll
    for (int i = 0; i < 2; ++i) { int R, C; stage_rc(tid * 16 + i * 8192, R, C); const int Rb = (Epi::PERM == 2) ? perm16(R) : (Epi::PERM ? ((R & ~31) + perm32(R & 31)) : R);
        Ra[i] = R; Ca[i] = C; voffB[i] = (unsigned)(Rb * g.ldb * ESZ + C * 2); }
    const size_t kstep = (size_t)(BK * 2);
    const size_t hstepB = (size_t)((Epi::PERM == 2) ? 8 : HALF) * g.ldb * ESZ, tstepB = (size_t)BM * g.ldb * ESZ;
    const size_t tstepA = (size_t)BM * g.lda * ESZ;
    const unsigned ldsw = (unsigned)wid * 1024u;
    const int aoff = lds_byte(wr * 64 + fr, fq * 8), boff = lds_byte(wc * 32 + fr, fq * 8);
#define PG8_SA(b, h) (((b) * 2 + (h)) * HTB)
#define PG8_SB(b, h) ((4 + (b) * 2 + (h)) * HTB)
#define PG8_STAGE(bufoff, gbase, v0, v1) do { \
        __builtin_amdgcn_global_load_lds((const unsigned*)((const char*)(gbase) + (v0)), (PG8_LAS unsigned*)(lds + (bufoff) + ldsw), 16, 0, 0); \
        __builtin_amdgcn_global_load_lds((const unsigned*)((const char*)(gbase) + (v1)), (PG8_LAS unsigned*)(lds + (bufoff) + ldsw + 8192), 16, 0, 0); } while (0)
#define PG8_STAGE_A0(bufoff, gbase, p0, p1) PG8_STAGE(bufoff, gbase, p0, p1)
#define PG8_STAGE_A1(bufoff, gbase, p0, p1, q0, q1) do { if constexpr (GATHER) { PG8_STAGE(bufoff, gbase, q0, q1); } else { PG8_STAGE(bufoff, (gbase) + hstepA, p0, p1); } } while (0)
#define PG8_LD16(off) (*(const PG8_LAS i32x4*)(lds + (off)))
#define PG8_LDA(dst, b, h) do { if constexpr (ESZ == 2) { _Pragma("unroll") for (int m = 0; m < 4; ++m) _Pragma("unroll") for (int k = 0; k < 2; ++k) dst[m][k] = *(const PG8_LAS bf16x8*)(lds + PG8_SA(b, h) + aoff + m * 2048 + k * 1024); } \
        else { _Pragma("unroll") for (int m = 0; m < 4; ++m) dst##8[m] = __builtin_shufflevector(PG8_LD16(PG8_SA(b, h) + aoff + m * 2048), PG8_LD16(PG8_SA(b, h) + aoff + m * 2048 + 1024), 0, 1, 2, 3, 4, 5, 6, 7); } } while (0)
#define PG8_LDB(dst, b, h) do { if constexpr (ESZ == 2) { _Pragma("unroll") for (int n = 0; n < 2; ++n) _Pragma("unroll") for (int k = 0; k < 2; ++k) dst[n][k] = *(const PG8_LAS bf16x8*)(lds + PG8_SB(b, h) + boff + n * 2048 + k * 1024); } \
        else { _Pragma("unroll") for (int n = 0; n < 2; ++n) dst##8[n] = __builtin_shufflevector(PG8_LD16(PG8_SB(b, h) + boff + n * 2048), PG8_LD16(PG8_SB(b, h) + boff + n * 2048 + 1024), 0, 1, 2, 3, 4, 5, 6, 7); } } while (0)
#define PG8_MMA(ai, bj, At, Bt) do { __builtin_amdgcn_s_setprio(1); \
        if constexpr (ESZ == 2) { _Pragma("unroll") for (int m = 0; m < 4; ++m) _Pragma("unroll") for (int n = 0; n < 2; ++n) _Pragma("unroll") for (int k = 0; k < 2; ++k) \
            acc[ai][bj][m][n] = __builtin_amdgcn_mfma_f32_16x16x32_bf16(Bt[n][k], At[m][k], acc[ai][bj][m][n], 0, 0, 0); } \
        else { _Pragma("unroll") for (int m = 0; m < 4; ++m) _Pragma("unroll") for (int n = 0; n < 2; ++n) \
            asm volatile("v_mfma_scale_f32_16x16x128_f8f6f4 %0, %1, %2, %0, %3, %3 op_sel_hi:[0,0,0]" : "+v"(acc[ai][bj][m][n]) : "v"(Bt##8[n]), "v"(At##8[m]), "v"(sc1)); } \
        __builtin_amdgcn_s_setprio(0); } while (0)
#define PG8_WAIT_V(n) asm volatile("s_waitcnt vmcnt(" #n ")" ::: "memory")
#define PG8_WAIT_L(n) asm volatile("s_waitcnt lgkmcnt(" #n ")" ::: "memory")
#define PG8_BAR __builtin_amdgcn_s_barrier()
#define PG8_SCHED __builtin_amdgcn_sched_barrier(0)
    Unit cur, nxt; int ui = 0;
    if (!S.next(0, cur)) return;
    f32x4 acc[2][2][4][2];
#pragma unroll
    for (int a = 0; a < 2; ++a)
#pragma unroll
        for (int b = 0; b < 2; ++b)
#pragma unroll
            for (int m = 0; m < 4; ++m)
#pragma unroll
                for (int n = 0; n < 2; ++n) acc[a][b][m][n] = (f32x4){0.f, 0.f, 0.f, 0.f};
    const int sc1 = 0x7F7F7F7F;
    bf16x8 At[4][2], B0[2][2], B1[2][2]; i32x8 At8[4], B08[2], B18[2];
    unsigned vA00, vA01, vA10, vA11, nA00, nA01, nA10, nA11;
    const size_t hstepA = GATHER ? (size_t)0 : (size_t)HALF * g.lda * ESZ;
    if constexpr (GATHER) {
        vA00 = (unsigned)(S.arow(cur, Ra[0]) * g.lda * ESZ + Ca[0] * 2); vA01 = (unsigned)(S.arow(cur, Ra[1]) * g.lda * ESZ + Ca[1] * 2);
        vA10 = (unsigned)(S.arow(cur, HALF + Ra[0]) * g.lda * ESZ + Ca[0] * 2); vA11 = (unsigned)(S.arow(cur, HALF + Ra[1]) * g.lda * ESZ + Ca[1] * 2);
    } else {
        vA00 = (unsigned)(Ra[0] * g.lda * ESZ + Ca[0] * 2); vA01 = (unsigned)(Ra[1] * g.lda * ESZ + Ca[1] * 2); vA10 = 0; vA11 = 0;
    }
    nA00 = vA00; nA01 = vA01; nA10 = vA10; nA11 = vA11;
    const char* cA = (const char*)g.A + (GATHER ? (size_t)0 : (size_t)cur.pm * tstepA); const char* cB = (const char*)g.Bt + (size_t)cur.pn * tstepB;
    PG8_STAGE(PG8_SB(0, 0), cB, voffB[0], voffB[1]); PG8_STAGE(PG8_SB(0, 1), cB + hstepB, voffB[0], voffB[1]); PG8_STAGE_A0(PG8_SA(0, 0), cA, vA00, vA01); PG8_STAGE_A1(PG8_SA(0, 1), cA, vA00, vA01, vA10, vA11);
    if (wr == 1) PG8_BAR;
    PG8_WAIT_V(2); PG8_BAR;
    PG8_STAGE(PG8_SB(1, 0), cB + kstep, voffB[0], voffB[1]); PG8_STAGE_A0(PG8_SA(1, 0), cA + kstep, vA00, vA01); PG8_STAGE(PG8_SB(1, 1), cB + hstepB + kstep, voffB[0], voffB[1]);
    PG8_WAIT_V(6); PG8_BAR;
    for (;;) {
        const bool has_next = S.next(ui + 1, nxt);
        const char* nA = has_next ? (const char*)g.A + (GATHER ? (size_t)0 : (size_t)nxt.pm * tstepA) : cA; const char* nB = has_next ? (const char*)g.Bt + (size_t)nxt.pn * tstepB : cB;
        if constexpr (GATHER) {
            if (has_next) {
                nA00 = (unsigned)(S.arow(nxt, Ra[0]) * g.lda * ESZ + Ca[0] * 2); nA01 = (unsigned)(S.arow(nxt, Ra[1]) * g.lda * ESZ + Ca[1] * 2);
                nA10 = (unsigned)(S.arow(nxt, HALF + Ra[0]) * g.lda * ESZ + Ca[0] * 2); nA11 = (unsigned)(S.arow(nxt, HALF + Ra[1]) * g.lda * ESZ + Ca[1] * 2);
            } else { nA00 = vA00; nA01 = vA01; nA10 = vA10; nA11 = vA11; }
        }
#pragma nounroll
        for (int t = 0; t < nt; t += 2) {
            const bool last = (t == nt - 2);
            const char* a1 = cA + (size_t)(t + 1) * kstep;
            const char* a2 = last ? nA : cA + (size_t)(t + 2) * kstep; const char* b2 = last ? nB : cB + (size_t)(t + 2) * kstep;
            const char* a3 = a2 + kstep; const char* b3 = b2 + kstep;
            asm volatile("" : "+v"(voffB[0]), "+v"(voffB[1]), "+v"(vA00), "+v"(vA01));
            if constexpr (GATHER) asm volatile("" : "+v"(vA10), "+v"(vA11));
            unsigned x00 = vA00, x01 = vA01, x10 = vA10, x11 = vA11;
            if constexpr (GATHER) { if (last) { x00 = nA00; x01 = nA01; x10 = nA10; x11 = nA11; } }
            const bool hf = Sched::HALVES && (cur.half != 0);
            PG8_LDB(B0, 0, 0); PG8_LDB(B1, 0, 1); PG8_SCHED; PG8_LDA(At, 0, 0); PG8_STAGE_A1(PG8_SA(1, 1), a1, vA00, vA01, vA10, vA11);
            PG8_WAIT_V(8); PG8_WAIT_L(0); PG8_BAR; PG8_MMA(0, 0, At, B0); PG8_MMA(0, 1, At, B1); PG8_BAR; PG8_SCHED;
            if (!hf) PG8_LDA(At, 0, 1); PG8_STAGE(PG8_SB(0, 0), b2, voffB[0], voffB[1]); PG8_STAGE(PG8_SB(0, 1), b2 + hstepB, voffB[0], voffB[1]); PG8_STAGE_A0(PG8_SA(0, 0), a2, x00, x01);
            PG8_WAIT_V(8); PG8_WAIT_L(0); PG8_BAR; if (!hf) { PG8_MMA(1, 0, At, B0); PG8_MMA(1, 1, At, B1); } PG8_BAR; PG8_SCHED;
            PG8_LDB(B0, 1, 0); PG8_LDB(B1, 1, 1); PG8_SCHED; PG8_LDA(At, 1, 0); PG8_STAGE_A1(PG8_SA(0, 1), a2, x00, x01, x10, x11);
            PG8_WAIT_V(8); PG8_WAIT_L(0); PG8_BAR; PG8_MMA(0, 0, At, B0); PG8_MMA(0, 1, At, B1); PG8_BAR; PG8_SCHED;
            if (!hf) PG8_LDA(At, 1, 1); PG8_STAGE(PG8_SB(1, 0), b3, voffB[0], voffB[1]); PG8_STAGE(PG8_SB(1, 1), b3 + hstepB, voffB[0], voffB[1]); PG8_STAGE_A0(PG8_SA(1, 0), a3, x00, x01);
            PG8_WAIT_V(8); PG8_WAIT_L(0); PG8_BAR; if (!hf) { PG8_MMA(1, 0, At, B0); PG8_MMA(1, 1, At, B1); } PG8_BAR; PG8_SCHED;
        }
        if constexpr (ALIGN_EPI) { if (wr == 0) PG8_BAR; }
        if constexpr (ESZ == 1) asm volatile("s_nop 15\n\ts_nop 15" ::: "memory");
        E(acc, cur, wr, wc, fr, fq);
        if (!has_next) break;
#pragma unroll
        for (int a = 0; a < 2; ++a)
#pragma unroll
            for (int b = 0; b < 2; ++b)
#pragma unroll
                for (int m = 0; m < 4; ++m)
#pragma unroll
                    for (int n = 0; n < 2; ++n) acc[a][b][m][n] = (f32x4){0.f, 0.f, 0.f, 0.f};
        cur = nxt; cA = nA; cB = nB; ++ui;
        if constexpr (GATHER) { vA00 = nA00; vA01 = nA01; vA10 = nA10; vA11 = nA11; }
        if constexpr (ALIGN_EPI) { if (wr == 1) PG8_BAR; }
    }
    PG8_WAIT_V(0);
    if constexpr (!ALIGN_EPI) { if (wr == 0) PG8_BAR; }
    PG8_BAR;
#undef PG8_SA
#undef PG8_SB
#undef PG8_STAGE
#undef PG8_LDA
#undef PG8_LD16
#undef PG8_STAGE_A0
#undef PG8_STAGE_A1
#undef PG8_LDB
#undef PG8_MMA
#undef PG8_WAIT_V
#undef PG8_WAIT_L
#undef PG8_BAR
#undef PG8_SCHED
}
}

constexpr int NWAVES = 8;
constexpr int T = 8192, SEQ = 2048, NB = 4, D = 2048, INW = 2304, POOLW = 1024, NH = 16, NKV = 2, HD = 64, KVW = 128;
constexpr int NE = 64, TOPK = 8, EFF = 512, PLE = 256;
constexpr int SH_ROW0 = T * TOPK + NE * 256;
constexpr int NROWS = SH_ROW0 + T;
constexpr float EPS = 1e-6f;
constexpr float SW1 = 32.0f, SW2 = 16.0f, SA = 4.0f, SY = 16.0f, SW3 = 32.0f;
constexpr int N_PHASES = 10;
constexpr int N_LAUNCHES = MK_N_LAUNCHES;

constexpr size_t MiB = 1u << 20;
constexpr size_t WS_CTL = 0, CTL_ZERO_BYTES = 64 * 1024;
constexpr size_t WS_MISC = 1 * MiB;
constexpr size_t WS_TOKLIST = WS_MISC;
constexpr size_t WS_REC = WS_TOKLIST + (size_t)NE * T * 4;
constexpr size_t WS_WREC = WS_REC + (size_t)T * TOPK * 4;
constexpr size_t WS_RSTDP = WS_WREC + (size_t)T * TOPK * 4;
constexpr size_t WS_PBF = 6 * MiB;
constexpr size_t WS_WRT = 10 * MiB;
constexpr size_t WS_WIN = 12 * MiB;
constexpr size_t WS_WPOOL = WS_WIN + (size_t)INW * D * 2;
constexpr size_t WS_WOUT = WS_WPOOL + (size_t)4 * 256 * 256 * 2;
constexpr size_t WS_WPP = WS_WOUT + (size_t)D * D * 2;
constexpr size_t WS_WPG = WS_WPP + (size_t)D * PLE * 2;
constexpr size_t WS_WGU = WS_WPG + (size_t)D * D * 2;
constexpr size_t WS_WD = WS_WGU + (size_t)65 * 1024 * D;
constexpr size_t WS_XN = WS_WD + (size_t)65 * D * EFF;
constexpr size_t WS_PPROJ = WS_XN + (size_t)T * D * 2;
constexpr size_t WS_ACT = WS_PPROJ + (size_t)T * D * 2;
constexpr size_t WS_H2F8 = WS_ACT;
constexpr size_t WS_H2B = WS_ACT + 16 * MiB;
constexpr size_t WS_GBUF = WS_XN;
constexpr size_t WS_Y = WS_ACT + (size_t)NROWS * EFF * 2;
constexpr size_t WS_ABF = WS_Y;
constexpr size_t WS_UBF = WS_ABF + (size_t)T * D * 2;
constexpr size_t WS_QBF = WS_UBF + (size_t)T * POOLW * 2;
constexpr size_t WS_KV = WS_QBF + (size_t)T * 1024 * 2;
constexpr size_t WS_POOLED = WS_KV + (size_t)T * 2 * KVW * 2;
constexpr size_t WS_MIX = WS_POOLED + (size_t)T * POOLW * 2;
constexpr size_t WS_H1 = WS_Y + (size_t)NROWS * D * 2;
constexpr size_t WS_END = WS_H1 + (size_t)T * D * 4;
static_assert(WS_MIX + (size_t)T * D * 2 <= WS_END, "early activations fit under Y");
static_assert(WS_RSTDP + (size_t)T * 4 <= WS_PBF && WS_PBF + (size_t)T * PLE * 2 <= WS_WIN, "misc fits");
static_assert(WS_END <= (size_t)1024 * MiB, "workspace must fit 1 GiB");
constexpr int CW_BAR = 1024;
constexpr int CW_CNT = 8192;
constexpr int CW_CONVQ = CW_CNT + 32 * NE;
static_assert((CW_CONVQ + 32 * 24) * 4 <= 48 * 1024, "CTL words inside the memset region (below the dummy line at 48 KiB)");

constexpr int RING_OFF = 0, RING_BYTES = 131072;
constexpr int LDS_BYTES = 163840;
constexpr int MISC_OFF = LDS_BYTES - 512;
constexpr int TAB_OFF = RING_BYTES;
constexpr int TB_CNT = 0, TB_PAD = 80, TB_XF = 160, TB_XH = 176, TB_SH0 = 192, TB_SHN = 193;

#define GAS __attribute__((address_space(1)))
#define LAS __attribute__((address_space(3)))
typedef unsigned short bf16;
typedef unsigned v4u __attribute__((ext_vector_type(4)));
typedef unsigned v2u __attribute__((ext_vector_type(2)));
typedef float f32x4 __attribute__((ext_vector_type(4)));
typedef short bf16x8 __attribute__((ext_vector_type(8)));
typedef GAS unsigned gu32;
#define RLX_AGENT __ATOMIC_RELAXED, __HIP_MEMORY_SCOPE_AGENT
#define LDS_WAIT() asm volatile("s_waitcnt lgkmcnt(0)" ::: "memory")
#define LDS_BARRIER() do { asm volatile("s_waitcnt lgkmcnt(0)" ::: "memory"); __builtin_amdgcn_s_barrier(); asm volatile("" ::: "memory"); } while (0)
#define VM_WAIT() asm volatile("s_waitcnt vmcnt(0)" ::: "memory")
__device__ __forceinline__ unsigned pk2(float lo, float hi) { return pg8::cvt_pk_bf16(lo, hi); }
__device__ __forceinline__ float bf_lo(unsigned w) { return __builtin_bit_cast(float, w << 16); }
__device__ __forceinline__ float bf_hi(unsigned w) { return __builtin_bit_cast(float, w & 0xffff0000u); }

#define XB_TMO      128
#define XB_XCNT(j)  (256  + 64 * (j))
#define XB_XSUB(j)  (1280 + 64 * (j))
#define XB_XGEN(j)  (2304 + 64 * (j))
#define XB_TOP      3328
#define XB_TOPGEN   3392
#define XCD_BAR_WORDS 3456
#define XB_SPIN_CAP (1u << 18)
__device__ __forceinline__ unsigned xb_ld(unsigned* p)              { return __hip_atomic_load(p, __ATOMIC_RELAXED, __HIP_MEMORY_SCOPE_AGENT); }
__device__ __forceinline__ unsigned xb_add(unsigned* p, unsigned v) { return __hip_atomic_fetch_add(p, v, __ATOMIC_RELAXED, __HIP_MEMORY_SCOPE_AGENT); }
__device__ __forceinline__ unsigned xb_xcc_id() { return (unsigned)__builtin_amdgcn_s_getreg((3 << 11) | 20) & 0xFu; }
#define XB_SPIN(cond, bar) do { unsigned _sp = 0; while (cond) { __builtin_amdgcn_s_sleep(1); \
    if ((++_sp & 255u) == 0u) { if (xb_ld(&(bar)[XB_TMO])) break; if (_sp > XB_SPIN_CAP) { atomicAdd(&(bar)[XB_TMO], 1u); break; } } } } while (0)
struct XcdBarrier { unsigned* bar; unsigned x; volatile LAS unsigned* st; };
__device__ __forceinline__ XcdBarrier xcd_barrier_post(unsigned* bar, volatile LAS unsigned* st) {
    XcdBarrier b; b.bar = bar; b.x = xb_xcc_id(); b.st = st;
    if (threadIdx.x == 0) (void)xb_add(&bar[XB_XCNT(b.x)], 1u);
    return b;
}
__device__ __forceinline__ void xcd_barrier_complete(unsigned* bar, unsigned x, unsigned& nloc, unsigned& nx) {
    const unsigned G = gridDim.x * gridDim.y * gridDim.z;
    unsigned sum, cnt, mine, sp = 0u;
    for (;;) {
        sum = 0u; cnt = 0u; mine = 0u;
#pragma unroll
        for (unsigned j = 0; j < 16; ++j) { const unsigned c = xb_ld(&bar[XB_XCNT(j)]); sum += c; cnt += (c > 0u) ? 1u : 0u; mine = (j == x) ? c : mine; }
        if (sum == G) break;
        __builtin_amdgcn_s_sleep(1);
        if ((++sp & 255u) == 0u) { if (xb_ld(&bar[XB_TMO])) break; if (sp > XB_SPIN_CAP) { atomicAdd(&bar[XB_TMO], 1u); break; } }
    }
    nloc = mine > 0u ? mine : 1u; nx = cnt > 0u ? cnt : 1u;
}
__device__ __forceinline__ void xcd_barrier(const XcdBarrier& b) {
    asm volatile("s_waitcnt vmcnt(0)" ::: "memory");
    __syncthreads();
    if (threadIdx.x == 0) {
        unsigned* bar = b.bar;
        __builtin_amdgcn_s_waitcnt(0);
        unsigned nloc = b.st[0], nx = b.st[1];
        if (nloc == 0u) { xcd_barrier_complete(bar, b.x, nloc, nx); b.st[0] = nloc; b.st[1] = nx; }
        const unsigned old = xb_add(&bar[XB_XSUB(b.x)], 1u);
        const unsigned gen = old / nloc;
        if (old + 1u == (gen + 1u) * nloc) {
            __builtin_amdgcn_fence(__ATOMIC_RELEASE, "agent");
            asm volatile("s_waitcnt vmcnt(0)" ::: "memory");
            const unsigned og = xb_add(&bar[XB_TOP], 1u);
            const unsigned tg = og / nx;
            if (og + 1u == (tg + 1u) * nx) xb_add(&bar[XB_TOPGEN], 1u);
            else XB_SPIN(xb_ld(&bar[XB_TOPGEN]) == tg, bar);
            __builtin_amdgcn_fence(__ATOMIC_ACQUIRE, "agent");
            xb_add(&bar[XB_XGEN(b.x)], 1u);
            asm volatile("s_waitcnt vmcnt(0)" ::: "memory");
        } else {
            XB_SPIN(xb_ld(&bar[XB_XGEN(b.x)]) == gen, bar);
            __builtin_amdgcn_fence(__ATOMIC_ACQUIRE, "agent");
            asm volatile("s_waitcnt vmcnt(0)" ::: "memory");
        }
    }
    __syncthreads();
}

struct Args { const float* in[22]; float* out; unsigned char* ws; int ph_lo, ph_hi, li, pad; };
struct Frame {
    LAS unsigned char* lds;
    volatile LAS unsigned* MISC;
    gu32* ctl;
    unsigned char* ws;
    int wave, G, bx;
    float* out;
};
__device__ __forceinline__ const float* fin(const Frame& F, int i) {
    const unsigned long long v = ((const LAS unsigned long long*)(F.lds + MISC_OFF + 256))[i];
    const unsigned lo = __builtin_amdgcn_readfirstlane((unsigned)v), hi = __builtin_amdgcn_readfirstlane((unsigned)(v >> 32));
    return (const float*)(const GAS float*)(((unsigned long long)hi << 32) | lo);
}
enum { I_X = 0, I_P, I_GMIX, I_WIN, I_WPOOL, I_PSCALE, I_SINKS, I_RPE, I_WOUT, I_GFFN, I_WROUTER, I_RBIAS, I_WGATE, I_WUP, I_WDOWN, I_WSGATE, I_WSUP, I_WSDOWN, I_WPLEPROJ, I_GPLE, I_WPLEGATE, I_GFINAL };

__device__ __forceinline__ float wave_sum(float v) {
#pragma unroll
    for (int o = 1; o < 64; o <<= 1) v += __shfl_xor(v, o);
    return v;
}

using pg8::Unit;
struct EpiInProj {
    static constexpr int PERM = 1;
    unsigned char* ws;
    __device__ __forceinline__ void operator()(const f32x4 (&acc)[2][2][4][2], const Unit& u, int wr, int wc, int fr, int fq) const {
        const int row0 = u.pm * 256 + wr * 64 + fr;
        const size_t boff = WS_UBF + (size_t)(u.pn >= 4 ? 1 : 0) * (WS_QBF - WS_UBF) + (size_t)(u.pn >= 8 ? 1 : 0) * (WS_KV - WS_QBF);
        bf16* base = (bf16*)(ws + boff); const int ldc = (u.pn < 8) ? 1024 : 256; const int col0 = (u.pn & 3) * 256 + wc * 32 + 8 * fq;
#pragma unroll
        for (int ai = 0; ai < 2; ++ai)
#pragma unroll
            for (int m = 0; m < 4; ++m) { bf16* rowp = base + (size_t)(row0 + ai * 128 + m * 16) * ldc + col0;
#pragma unroll
                for (int bj = 0; bj < 2; ++bj) { const f32x4 v0 = acc[ai][bj][m][0], v1 = acc[ai][bj][m][1];
                    v4u w; w.x = pk2(v0[0], v0[1]); w.y = pk2(v0[2], v0[3]); w.z = pk2(v1[0], v1[1]); w.w = pk2(v1[2], v1[3]);
                    *(v4u*)(rowp + bj * 128) = w; } }
    }
};
struct EpiBf16Plain {
    static constexpr int PERM = 1;
    bf16* O; int ldc; int col_off; const float* scale;
    __device__ __forceinline__ void operator()(const f32x4 (&acc)[2][2][4][2], const Unit& u, int wr, int wc, int fr, int fq) const {
        const int row0 = u.pm * 256 + wr * 64 + fr, colt = u.pn * 256 + wc * 32 + 8 * fq;
        f32x4 sv[2][2];
#pragma unroll
        for (int bj = 0; bj < 2; ++bj)
#pragma unroll
            for (int n = 0; n < 2; ++n) sv[bj][n] = scale ? *(const f32x4*)(scale + col_off + colt + bj * 128 + 4 * n) : (f32x4){1.f, 1.f, 1.f, 1.f};
#pragma unroll
        for (int ai = 0; ai < 2; ++ai)
#pragma unroll
            for (int m = 0; m < 4; ++m) { bf16* rowp = O + (size_t)(row0 + ai * 128 + m * 16) * ldc + col_off + colt;
#pragma unroll
                for (int bj = 0; bj < 2; ++bj) { const f32x4 v0 = acc[ai][bj][m][0] * sv[bj][0], v1 = acc[ai][bj][m][1] * sv[bj][1];
                    v4u w; w.x = pk2(v0[0], v0[1]); w.y = pk2(v0[2], v0[3]); w.z = pk2(v1[0], v1[1]); w.w = pk2(v1[2], v1[3]);
                    *(v4u*)(rowp + bj * 128) = w; } }
    }
};
struct EpiResF32 {
    static constexpr int PERM = 0;
    const float* base; float* C;
    __device__ __forceinline__ void operator()(const f32x4 (&acc)[2][2][4][2], const Unit& u, int wr, int wc, int fr, int fq) const {
        const int row0 = u.pm * 256 + wr * 64 + fr, col0 = u.pn * 256 + wc * 32 + 4 * fq;
#pragma unroll
        for (int ai = 0; ai < 2; ++ai)
#pragma unroll
            for (int mp = 0; mp < 2; ++mp) { f32x4 xb[2][2][2];
#pragma unroll
                for (int mm = 0; mm < 2; ++mm) { const size_t ro = (size_t)(row0 + ai * 128 + (2 * mp + mm) * 16) * D + col0;
#pragma unroll
                    for (int bj = 0; bj < 2; ++bj)
#pragma unroll
                        for (int n = 0; n < 2; ++n) xb[mm][bj][n] = *(const f32x4*)(base + ro + bj * 128 + n * 16); }
#pragma unroll
                for (int mm = 0; mm < 2; ++mm) { const size_t ro = (size_t)(row0 + ai * 128 + (2 * mp + mm) * 16) * D + col0;
#pragma unroll
                    for (int bj = 0; bj < 2; ++bj)
#pragma unroll
                        for (int n = 0; n < 2; ++n) *(f32x4*)(C + ro + bj * 128 + n * 16) = xb[mm][bj][n] + acc[ai][bj][2 * mp + mm][n]; } }
    }
};
__device__ __forceinline__ float sigmoid_f(float v) { return __builtin_amdgcn_rcpf(1.0f + __expf(-v)); }
__device__ __forceinline__ unsigned pk4_fp8(float a, float b, float c, float d) { int w = 0; w = __builtin_amdgcn_cvt_pk_fp8_f32(a, b, w, false); w = __builtin_amdgcn_cvt_pk_fp8_f32(c, d, w, true); return (unsigned)w; }
typedef float f32x2_ __attribute__((ext_vector_type(2)));
__device__ __forceinline__ void fp8x4_to_f32(unsigned w, float (&o)[4]) { const f32x2_ lo = __builtin_amdgcn_cvt_pk_f32_fp8((int)w, false), hi = __builtin_amdgcn_cvt_pk_f32_fp8((int)w, true); o[0] = lo[0]; o[1] = lo[1]; o[2] = hi[0]; o[3] = hi[1]; }
struct EpiGateUp {
    static constexpr int PERM = 1;
    unsigned char* ACT;
    __device__ __forceinline__ void operator()(const f32x4 (&acc)[2][2][4][2], const Unit& u, int wr, int wc, int fr, int fq) const {
        const int row0 = u.pm * 256 + wr * 64 + fr, col0 = (u.pn & 3) * 128 + wc * 32 + 8 * fq;
        constexpr float IS = 1.0f / SW1;
#pragma unroll
        for (int ai = 0; ai < 2; ++ai) { if (ai == 1 && u.half) break;
#pragma unroll
            for (int m = 0; m < 4; ++m) { float o[8];
#pragma unroll
                for (int n = 0; n < 2; ++n)
#pragma unroll
                    for (int j = 0; j < 4; ++j) { const float gte = acc[ai][0][m][n][j] * IS, up = acc[ai][1][m][n][j] * (IS * SA); o[4 * n + j] = gte * sigmoid_f(gte) * up; }
                v2u w; w.x = pk4_fp8(o[0], o[1], o[2], o[3]); w.y = pk4_fp8(o[4], o[5], o[6], o[7]);
                *(v2u*)(ACT + (size_t)(row0 + ai * 128 + m * 16) * EFF + col0) = w; } }
    }
};
struct EpiDown {
    static constexpr int PERM = 2;
    unsigned char* Y;
    __device__ __forceinline__ void operator()(const f32x4 (&acc)[2][2][4][2], const Unit& u, int wr, int wc, int fr, int fq) const {
        const int row0 = u.pm * 256 + wr * 64 + fr, col0 = (u.pn & 7) * 256 + wc * 64 + 16 * fq;
        constexpr float IS = SY / (SA * SW2);
#pragma unroll
        for (int ai = 0; ai < 2; ++ai) { if (ai == 1 && u.half) break;
#pragma unroll
            for (int m = 0; m < 4; ++m) { const f32x4 v0 = acc[ai][0][m][0] * IS, v1 = acc[ai][0][m][1] * IS, v2 = acc[ai][1][m][0] * IS, v3 = acc[ai][1][m][1] * IS;
                v4u w; w.x = pk4_fp8(v0[0], v0[1], v0[2], v0[3]); w.y = pk4_fp8(v1[0], v1[1], v1[2], v1[3]); w.z = pk4_fp8(v2[0], v2[1], v2[2], v2[3]); w.w = pk4_fp8(v3[0], v3[1], v3[2], v3[3]);
                *(v4u*)(Y + (size_t)(row0 + ai * 128 + m * 16) * D + col0) = w; } }
    }
};
struct EpiBf16Mul {
    static constexpr int PERM = 1;
    bf16* O; float mul;
    __device__ __forceinline__ void operator()(const f32x4 (&acc)[2][2][4][2], const Unit& u, int wr, int wc, int fr, int fq) const {
        const int row0 = u.pm * 256 + wr * 64 + fr, colt = u.pn * 256 + wc * 32 + 8 * fq;
#pragma unroll
        for (int ai = 0; ai < 2; ++ai)
#pragma unroll
            for (int m = 0; m < 4; ++m) { bf16* rowp = O + (size_t)(row0 + ai * 128 + m * 16) * D + colt;
#pragma unroll
                for (int bj = 0; bj < 2; ++bj) { const f32x4 v0 = acc[ai][bj][m][0] * mul, v1 = acc[ai][bj][m][1] * mul;
                    v4u w; w.x = pk2(v0[0], v0[1]); w.y = pk2(v0[2], v0[3]); w.z = pk2(v1[0], v1[1]); w.w = pk2(v1[2], v1[3]);
                    *(v4u*)(rowp + bj * 128) = w; } }
    }
};
struct MoeOrder {
    static constexpr bool HALVES = true;
    const LAS int* tab; const int* toklist; int x, r, npn, stride;
    __device__ __forceinline__ bool next(int i, Unit& u) const {
        const int L = i * stride + r; const int tl = L / npn, pn = L - tl * npn;
        const int nf = tab[TB_XF + 8], ns = tab[TB_SHN], nh = tab[TB_XH + 8];
        if (tl >= nf + ns + nh) return false;
        int e, lt, row0, half = 0;
        if (tl < nf) { int s = 0;
#pragma unroll
            for (int q = 1; q <= 7; ++q) s += (tl >= tab[TB_XF + q]) ? 1 : 0;
            lt = tl - tab[TB_XF + s]; e = x + 8 * s; row0 = tab[TB_PAD + e] + 256 * lt; }
        else if (tl < nf + ns) { lt = tab[TB_SH0] + (tl - nf); e = NE; row0 = SH_ROW0 + 256 * lt; }
        else { const int hi = tl - nf - ns; int s = 0;
#pragma unroll
            for (int q = 1; q <= 7; ++q) s += (hi >= tab[TB_XH + q]) ? 1 : 0;
            e = x + 8 * s; lt = tab[TB_XF + s + 1] - tab[TB_XF + s]; row0 = tab[TB_PAD + e] + 256 * lt; half = 1; }
        u.pm = __builtin_amdgcn_readfirstlane(row0 >> 8); u.pn = __builtin_amdgcn_readfirstlane(e * npn + pn); u.e = __builtin_amdgcn_readfirstlane(e); u.lt = __builtin_amdgcn_readfirstlane(lt);
        u.half = __builtin_amdgcn_readfirstlane(half); return true;
    }
    __device__ __forceinline__ int arow(const Unit& u, int r_) const {
        const int lr = u.lt * 256 + r_;
        const int ee = (u.e < NE) ? u.e : 0;
        const int tk = toklist[(size_t)ee * T + (lr < T - 1 ? lr : T - 1)];
        return (u.e == NE) ? lr : ((lr < tab[TB_CNT + ee]) ? tk : 0);
    }
};
__device__ __forceinline__ void moe_tables(Frame& F) {
    const int LANE_ = pg8::lane_id(), TID_ = F.wave * 64 + LANE_; (void)TID_;
    LAS int* tab = (LAS int*)(F.lds + TAB_OFF);
    const int x = F.bx & 7;
    if (F.wave == 0) {
        const int e = LANE_, c = (int)__hip_atomic_load(F.ctl + CW_CNT + 32 * e, RLX_AGENT), nt = (c + 255) >> 8;
        const int hf = (nt > 0 && (c - ((nt - 1) << 8)) <= 128) ? 1 : 0, fl = nt - hf;
        tab[TB_CNT + e] = c; if (e == 0) tab[TB_CNT + NE] = T;
        int inc = nt << 8;
#pragma unroll
        for (int o = 1; o < 64; o <<= 1) { const int v = __shfl_up(inc, o); inc += (e >= o) ? v : 0; }
        tab[TB_PAD + e] = inc - (nt << 8); if (e == 63) tab[TB_PAD + NE] = inc;
        int ld = 2 * fl + hf;
        ld += __shfl_xor(ld, 8); ld += __shfl_xor(ld, 16); ld += __shfl_xor(ld, 32);
        int cf = fl, ch = hf;
#pragma unroll
        for (int o = 8; o < 64; o <<= 1) { const int vf = __shfl_up(cf, o), vh = __shfl_up(ch, o); cf += (e >= o) ? vf : 0; ch += (e >= o) ? vh : 0; }
        if ((e & 7) == x) { tab[TB_XF + (e >> 3) + 1] = cf; tab[TB_XH + (e >> 3) + 1] = ch; }
        if (e == 0) { tab[TB_XF] = 0; tab[TB_XH] = 0; }
        int load[8], nsh[8];
#pragma unroll
        for (int l = 0; l < 8; ++l) { load[l] = __shfl(ld, l); nsh[l] = 0; }
        for (int j = 0; j < 32; ++j) { int best = 0, bl = load[0];
#pragma unroll
            for (int l = 1; l < 8; ++l) { const bool lt_ = load[l] < bl; best = lt_ ? l : best; bl = lt_ ? load[l] : bl; }
#pragma unroll
            for (int l = 0; l < 8; ++l) { nsh[l] += (l == best) ? 1 : 0; load[l] += (l == best) ? 2 : 0; } }
        int s0 = 0, sn = 0;
#pragma unroll
        for (int l = 0; l < 8; ++l) { s0 += (l < x) ? nsh[l] : 0; sn = (l == x) ? nsh[l] : sn; }
        if (e == 0) { tab[TB_SH0] = s0; tab[TB_SHN] = sn; }
    }
    __syncthreads();
}
struct ConvJob { const float* src; bf16* dst; int N, ldk, mode, item; };
struct ConvJob8 { const float* src; unsigned char* dst; int N, ldk, mode, item; float scale; };
__device__ __forceinline__ void conv8_load(const ConvJob8& j, int lane, f32x4 (&v)[16]) {
    const int nblk = j.N >> 5, kb = j.item / nblk, nb = j.item - kb * nblk, k0 = 128 * kb, n0 = 32 * nb;
    const float* src = j.src + (size_t)(k0 + 16 * (lane >> 3)) * j.N + n0 + 4 * (lane & 7);
#pragma unroll
    for (int i = 0; i < 16; ++i) v[i] = __builtin_nontemporal_load((const f32x4*)(src + (size_t)i * j.N));
}
__device__ __forceinline__ void conv8_store(const ConvJob8& j, int lane, const f32x4 (&v)[16]) {
    const int nblk = j.N >> 5, kb = j.item / nblk, nb = j.item - kb * nblk, k0 = 128 * kb, n0 = 32 * nb; const float scale = j.scale;
#pragma unroll
    for (int q = 0; q < 4; ++q) { const int n = n0 + 4 * (lane & 7) + q; int dr = n;
        if (j.mode == 5) dr = ((n >> 7) << 8) + (n & 127); else if (j.mode == 6) dr = ((n >> 7) << 8) + 128 + (n & 127);
        v4u o; o.x = pk4_fp8(v[0][q] * scale, v[1][q] * scale, v[2][q] * scale, v[3][q] * scale); o.y = pk4_fp8(v[4][q] * scale, v[5][q] * scale, v[6][q] * scale, v[7][q] * scale);
        o.z = pk4_fp8(v[8][q] * scale, v[9][q] * scale, v[10][q] * scale, v[11][q] * scale); o.w = pk4_fp8(v[12][q] * scale, v[13][q] * scale, v[14][q] * scale, v[15][q] * scale);
        __builtin_nontemporal_store(o, (v4u*)(j.dst + (size_t)dr * j.ldk + k0 + 16 * (lane >> 3))); }
}
__device__ __forceinline__ void conv_load(const ConvJob& j, int lane, f32x4 (&v)[8]) {
    const int nblk = j.N >> 5, kb = j.item / nblk, nb = j.item - kb * nblk, k0 = 64 * kb, n0 = 32 * nb;
    const float* src = j.src + (size_t)(k0 + 8 * (lane >> 3)) * j.N + n0 + 4 * (lane & 7);
#pragma unroll
    for (int i = 0; i < 8; ++i) v[i] = __builtin_nontemporal_load((const f32x4*)(src + (size_t)i * j.N));
}
__device__ __forceinline__ void conv_store(const ConvJob& j, int lane, const f32x4 (&v)[8]) {
    const int nblk = j.N >> 5, kb = j.item / nblk, nb = j.item - kb * nblk, k0 = 64 * kb, n0 = 32 * nb;
#pragma unroll
    for (int q = 0; q < 4; ++q) { const int n = n0 + 4 * (lane & 7) + q; int dr = n;
        if (j.mode == 1) dr = ((n >> 7) << 8) + (n & 127); else if (j.mode == 2) dr = ((n >> 7) << 8) + 128 + (n & 127);
        v4u o; o.x = pk2(v[0][q], v[1][q]); o.y = pk2(v[2][q], v[3][q]); o.z = pk2(v[4][q], v[5][q]); o.w = pk2(v[6][q], v[7][q]);
        *(v4u*)(j.dst + (size_t)dr * j.ldk + k0 + 8 * (lane >> 3)) = o; }
}
__device__ __forceinline__ void rms_row_to_bf16(const float* xrow, const float* g, bf16* orow, int lane) {
    f32x4 v[8]; float s = 0.f;
#pragma unroll
    for (int j = 0; j < 4; ++j) { v[2 * j] = *(const f32x4*)(xrow + 512 * j + 8 * lane); v[2 * j + 1] = *(const f32x4*)(xrow + 512 * j + 8 * lane + 4); }
#pragma unroll
    for (int j = 0; j < 8; ++j) s += (v[j][0] * v[j][0] + v[j][1] * v[j][1]) + (v[j][2] * v[j][2] + v[j][3] * v[j][3]);
    const float rstd = 1.0f / sqrtf(wave_sum(s) * (1.0f / D) + EPS);
#pragma unroll
    for (int j = 0; j < 4; ++j) { const f32x4 g0 = *(const f32x4*)(g + 512 * j + 8 * lane), g1 = *(const f32x4*)(g + 512 * j + 8 * lane + 4);
        const f32x4 a = v[2 * j] * rstd * g0, b = v[2 * j + 1] * rstd * g1;
        v4u o; o.x = pk2(a[0], a[1]); o.y = pk2(a[2], a[3]); o.z = pk2(b[0], b[1]); o.w = pk2(b[2], b[3]);
        *(v4u*)(orow + 512 * j + 8 * lane) = o; }
}
constexpr int CV_G1 = (D / 128) * (EFF / 32), CV_D1 = (EFF / 128) * (D / 32), CV_G = 65 * CV_G1, CV_DN = 65 * CV_D1, CV_PG = (D / 128) * (D / 32), CV_TOTAL = 2 * CV_G + CV_DN + CV_PG;
constexpr int CONV_B = 896 * 16, CONV_C = 1024 * 20, CONV_A = CV_TOTAL - CONV_B - CONV_C;
__device__ __forceinline__ ConvJob8 conv8_decode(Frame& F, int it) {
    unsigned char* WGU8 = F.ws + WS_WGU; unsigned char* WDN8 = F.ws + WS_WD;
    int r = it;
    if (r < CV_G) { const int e = r / CV_G1, li = r - e * CV_G1; const float* src = (e < NE) ? fin(F, I_WGATE) + (size_t)e * D * EFF : fin(F, I_WSGATE);
        return ConvJob8{src, WGU8 + (size_t)e * 1024 * D, EFF, D, 5, li, SW1}; } r -= CV_G;
    if (r < CV_G) { const int e = r / CV_G1, li = r - e * CV_G1; const float* src = (e < NE) ? fin(F, I_WUP) + (size_t)e * D * EFF : fin(F, I_WSUP);
        return ConvJob8{src, WGU8 + (size_t)e * 1024 * D, EFF, D, 6, li, SW1}; } r -= CV_G;
    if (r < CV_DN) { const int e = r / CV_D1, li = r - e * CV_D1; const float* src = (e < NE) ? fin(F, I_WDOWN) + (size_t)e * EFF * D : fin(F, I_WSDOWN);
        return ConvJob8{src, WDN8 + (size_t)e * D * EFF, D, EFF, 4, li, SW2}; } r -= CV_DN;
    return ConvJob8{fin(F, I_WPLEGATE), F.ws + WS_WPG, D, D, 4, r, SW3};
}
__device__ __forceinline__ void conv_fp8_items(Frame& F, int lo, int hi, int rank, int nranks) {
    const int LANE_ = pg8::lane_id();
    int it0 = lo + rank; if (it0 >= hi) return;
    f32x4 va[16], vb[16];
    ConvJob8 j0 = conv8_decode(F, it0), j1 = j0; conv8_load(j0, LANE_, va);
    for (;;) {
        const int it1 = it0 + nranks; const bool has1 = it1 < hi;
        if (has1) { j1 = conv8_decode(F, it1); conv8_load(j1, LANE_, vb); }
        conv8_store(j0, LANE_, va);
        if (!has1) break;
        it0 = it1 + nranks; const bool has0 = it0 < hi;
        if (has0) { j0 = conv8_decode(F, it0); conv8_load(j0, LANE_, va); }
        conv8_store(j1, LANE_, vb);
        if (!has0) break;
    }
}
constexpr int SEG_N0 = 14000, SEG_N1 = 16000, SEG_N2 = CV_TOTAL - SEG_N0 - SEG_N1;
static_assert(SEG_N0 % 8 == 0 && SEG_N1 % 8 == 0 && SEG_N2 % 8 == 0 && SEG_N2 > 0, "queue segments");
__device__ __forceinline__ void conv_dyn(Frame& F, int seg) {
    const int LANE_ = pg8::lane_id(); const bool t0 = (F.wave == 0 && LANE_ == 0);
    const int x = F.bx & 7;
    const int segn = (seg == 0 ? SEG_N0 : (seg == 1 ? SEG_N1 : SEG_N2)) / 8, lo = (seg == 0 ? 0 : (seg == 1 ? SEG_N0 : SEG_N0 + SEG_N1)) + x * segn;
    gu32* ctr = F.ctl + CW_CONVQ + 32 * (seg * 8 + x);
    volatile LAS unsigned* Q = F.MISC + 16;
    LDS_BARRIER();
    if (t0) { const unsigned a = __hip_atomic_fetch_add(ctr, 8u, RLX_AGENT), b = __hip_atomic_fetch_add(ctr, 8u, RLX_AGENT); Q[0] = a; Q[1] = b; }
    LDS_BARRIER();
    int c0 = __builtin_amdgcn_readfirstlane((int)Q[0]), c1 = __builtin_amdgcn_readfirstlane((int)Q[1]);
    f32x4 va[16], vb[16]; ConvJob8 ja, jb;
    bool ha = (c0 + F.wave) < segn, hb = false;
    ja = conv8_decode(F, lo + (ha ? c0 + F.wave : 0)); jb = ja;
    if (ha) conv8_load(ja, LANE_, va);
    for (;;) {
        unsigned vn = 0u; if (t0) vn = __hip_atomic_fetch_add(ctr, 8u, RLX_AGENT);
        hb = (c1 + F.wave) < segn; if (hb) { jb = conv8_decode(F, lo + c1 + F.wave); conv8_load(jb, LANE_, vb); }
        if (ha) conv8_store(ja, LANE_, va);
        if (c0 >= segn) break;
        LDS_BARRIER(); if (t0) Q[0] = vn; LDS_BARRIER();
        c0 = __builtin_amdgcn_readfirstlane((int)Q[0]);
        vn = 0u; if (t0) vn = __hip_atomic_fetch_add(ctr, 8u, RLX_AGENT);
        ha = (c0 + F.wave) < segn; if (ha) { ja = conv8_decode(F, lo + c0 + F.wave); conv8_load(ja, LANE_, va); }
        if (hb) conv8_store(jb, LANE_, vb);
        if (c1 >= segn) break;
        LDS_BARRIER(); if (t0) Q[1] = vn; LDS_BARRIER();
        c1 = __builtin_amdgcn_readfirstlane((int)Q[1]);
    }
    LDS_BARRIER();
}
constexpr int WI_G1 = (D / 256) * (EFF / 128), WI_D1 = (EFF / 256) * (D / 128), WI_G = 65 * WI_G1, WI_DN = 65 * WI_D1, WI_PG = (D / 256) * (D / 128), WI_TOTAL = 2 * WI_G + WI_DN + WI_PG;
constexpr int SEGW0 = 1752, SEGW1 = 2000, SEGW2 = WI_TOTAL - SEGW0 - SEGW1;
static_assert(SEGW0 % 8 == 0 && SEGW1 % 8 == 0 && SEGW2 % 8 == 0 && SEGW2 > 0, "queue segments");
struct ConvJobW { const float* src; unsigned char* dst; int N, ldk, mode, k0, n0; float scale; };
__device__ __forceinline__ ConvJobW convw_decode(Frame& F, int it) {
    unsigned char* WGU8 = F.ws + WS_WGU; unsigned char* WDN8 = F.ws + WS_WD;
    int r = it;
    if (r < WI_G) { const int e = r / WI_G1, li = r - e * WI_G1; const float* src = (e < NE) ? fin(F, I_WGATE) + (size_t)e * D * EFF : fin(F, I_WSGATE);
        return ConvJobW{src, WGU8 + (size_t)e * 1024 * D, EFF, D, 5, 256 * (li >> 2), 128 * (li & 3), SW1}; } r -= WI_G;
    if (r < WI_G) { const int e = r / WI_G1, li = r - e * WI_G1; const float* src = (e < NE) ? fin(F, I_WUP) + (size_t)e * D * EFF : fin(F, I_WSUP);
        return ConvJobW{src, WGU8 + (size_t)e * 1024 * D, EFF, D, 6, 256 * (li >> 2), 128 * (li & 3), SW1}; } r -= WI_G;
    if (r < WI_DN) { const int e = r / WI_D1, li = r - e * WI_D1; const float* src = (e < NE) ? fin(F, I_WDOWN) + (size_t)e * EFF * D : fin(F, I_WSDOWN);
        return ConvJobW{src, WDN8 + (size_t)e * D * EFF, D, EFF, 4, 256 * (li >> 4), 128 * (li & 15), SW2}; } r -= WI_DN;
    return ConvJobW{fin(F, I_WPLEGATE), F.ws + WS_WPG, D, D, 4, 256 * (r >> 4), 128 * (r & 15), SW3};
}
__device__ __forceinline__ void conv_wg_dyn(Frame& F, int seg) {
    const int LANE_ = pg8::lane_id(), TID_ = F.wave * 64 + LANE_; const bool t0 = (TID_ == 0);
    const int x = F.bx & 7;
    const int segn = (seg == 0 ? SEGW0 : (seg == 1 ? SEGW1 : SEGW2)) / 8, lo = (seg == 0 ? 0 : (seg == 1 ? SEGW0 : SEGW0 + SEGW1)) + x * segn;
    gu32* ctr = F.ctl + CW_CONVQ + 32 * (seg * 8 + x);
    volatile LAS unsigned* Q = F.MISC + 16;
    LAS unsigned char* TL = F.lds + RING_OFF;
    LDS_BARRIER();
    if (t0) Q[0] = __hip_atomic_fetch_add(ctr, 1u, RLX_AGENT);
    LDS_BARRIER();
    int cur = __builtin_amdgcn_readfirstlane((int)Q[0]);
    if (cur >= segn) return;
    const int hh = LANE_ >> 5, n4 = LANE_ & 31;
    ConvJobW j = convw_decode(F, lo + cur);
    f32x4 v[16];
    { const float* src = j.src + (size_t)(j.k0 + 32 * F.wave + 16 * hh) * j.N + j.n0 + 4 * n4;
#pragma unroll
      for (int i = 0; i < 16; ++i) v[i] = __builtin_nontemporal_load((const f32x4*)(src + (size_t)i * j.N)); }
    for (;;) {
        unsigned vn = 0u; if (t0) vn = __hip_atomic_fetch_add(ctr, 1u, RLX_AGENT);
        { const float sc = j.scale;
#pragma unroll
          for (int g = 0; g < 4; ++g)
#pragma unroll
              for (int q = 0; q < 4; ++q) { const int n = 4 * n4 + q, kd = (8 * F.wave + 4 * hh + g + 4 * (n4 & 15)) & 63;
                  *(LAS unsigned*)(TL + n * 256 + kd * 4) = pk4_fp8(v[4 * g][q] * sc, v[4 * g + 1][q] * sc, v[4 * g + 2][q] * sc, v[4 * g + 3][q] * sc); } }
        if (t0) Q[0] = vn;
        LDS_BARRIER();
        const int nxt = __builtin_amdgcn_readfirstlane((int)Q[0]);
        const ConvJobW jc = j;
        if (nxt < segn) { j = convw_decode(F, lo + nxt);
            const float* src = j.src + (size_t)(j.k0 + 32 * F.wave + 16 * hh) * j.N + j.n0 + 4 * n4;
#pragma unroll
            for (int i = 0; i < 16; ++i) v[i] = __builtin_nontemporal_load((const f32x4*)(src + (size_t)i * j.N)); }
#pragma unroll
        for (int i = 0; i < 4; ++i) { const int id = TID_ + 512 * i, n = id >> 4, c16 = id & 15, kd = (4 * c16 + 4 * ((n >> 2) & 15)) & 63;
            const v4u o = *(const LAS v4u*)(TL + n * 256 + kd * 4);
            const int nn = jc.n0 + n; int dr = nn;
            if (jc.mode == 5) dr = ((nn >> 7) << 8) + (nn & 127); else if (jc.mode == 6) dr = ((nn >> 7) << 8) + 128 + (nn & 127);
            __builtin_nontemporal_store(o, (v4u*)(jc.dst + (size_t)dr * jc.ldk + jc.k0 + 16 * c16)); }
        LDS_BARRIER();
        if (nxt >= segn) break;
    }
}
__device__ __forceinline__ void p0_prologue(Frame& F) {
    const int LANE_ = pg8::lane_id(), TID_ = F.wave * 64 + LANE_; (void)TID_;
    const int gw = F.bx * NWAVES + F.wave, NGW = F.G * NWAVES;
    bf16* WIN = (bf16*)(F.ws + WS_WIN); bf16* WPOOL = (bf16*)(F.ws + WS_WPOOL); bf16* WOUT = (bf16*)(F.ws + WS_WOUT); bf16* WPP = (bf16*)(F.ws + WS_WPP);
    constexpr int I_IN = (D / 64) * (INW / 32), I_PL = 4 * (256 / 64) * (256 / 32), I_OUT = (D / 64) * (D / 32), I_PP = (PLE / 64) * (D / 32), I_PG = (D / 64) * (D / 32);
    constexpr int I_SMALL = I_IN + I_PL + I_OUT + I_PP; (void)I_PG;
    auto decode = [&](int it) -> ConvJob {
        int r = it;
        if (r < I_IN) return ConvJob{fin(F, I_WIN), WIN, INW, D, 0, r}; r -= I_IN;
        if (r < I_PL) { const int gq = r >> 5; return ConvJob{fin(F, I_WPOOL) + (size_t)gq * 65536, WPOOL + (size_t)gq * 65536, 256, 256, 0, r & 31}; } r -= I_PL;
        if (r < I_OUT) return ConvJob{fin(F, I_WOUT), WOUT, D, D, 0, r}; r -= I_OUT;
        return ConvJob{fin(F, I_WPLEPROJ), WPP, D, PLE, 0, r};
    };
    for (int it = gw; it < I_SMALL; it += 2 * NGW) {
        const ConvJob j0 = decode(it); const bool two = (it + NGW) < I_SMALL; const ConvJob j1 = decode(two ? it + NGW : it);
        f32x4 v0[8], v1[8];
        conv_load(j0, LANE_, v0); conv_load(j1, LANE_, v1);
        conv_store(j0, LANE_, v0); if (two) conv_store(j1, LANE_, v1);
    }
    if (F.G != 256) conv_fp8_items(F, 0, CONV_A, gw, NGW);
    { const float* WR = fin(F, I_WROUTER); bf16* WH = (bf16*)(F.ws + WS_WRT); bf16* WL = WH + (size_t)NE * D;
      for (int i = gw * 64 + LANE_; i < NE * (D / 8); i += NGW * 64) { const int e = i & 63, k0 = (i >> 6) * 8; float x[8]; unsigned hh[8], ll[8];
#pragma unroll
          for (int j = 0; j < 8; ++j) x[j] = WR[(size_t)(k0 + j) * NE + e];
#pragma unroll
          for (int j = 0; j < 8; ++j) { hh[j] = pk2(x[j], 0.f) & 0xffffu; ll[j] = pk2(x[j] - bf_lo(hh[j]), 0.f) & 0xffffu; }
          v4u oh, ol; oh.x = hh[0] | (hh[1] << 16); oh.y = hh[2] | (hh[3] << 16); oh.z = hh[4] | (hh[5] << 16); oh.w = hh[6] | (hh[7] << 16);
          ol.x = ll[0] | (ll[1] << 16); ol.y = ll[2] | (ll[3] << 16); ol.z = ll[4] | (ll[5] << 16); ol.w = ll[6] | (ll[7] << 16);
          const size_t fo = ((size_t)((k0 >> 5) * 4 + (e >> 4)) * 16 + (e & 15)) * 32 + (k0 & 31);
          *(v4u*)(WH + fo) = oh; *(v4u*)(WL + fo) = ol; } }
    { const float* P = fin(F, I_P); bf16* PB = (bf16*)(F.ws + WS_PBF);
      for (int i = gw * 64 + LANE_; i < T * PLE / 8; i += NGW * 64) { const f32x4 a = *(const f32x4*)(P + (size_t)i * 8), b = *(const f32x4*)(P + (size_t)i * 8 + 4);
          v4u o; o.x = pk2(a[0], a[1]); o.y = pk2(a[2], a[3]); o.z = pk2(b[0], b[1]); o.w = pk2(b[2], b[3]); *(v4u*)(PB + (size_t)i * 8) = o; } }
    bf16* ABF = (bf16*)(F.ws + WS_ABF);
    for (int m = gw; m < T; m += NGW) rms_row_to_bf16(fin(F, I_X) + (size_t)m * D, fin(F, I_GMIX), ABF + (size_t)m * D, LANE_);
    if (F.G == 256) conv_wg_dyn(F, 0);
}

__device__ __forceinline__ int t5_bucket(int n) {
    if (n < 16) return n;
    const int large = 16 + (int)(logf((float)n * (1.0f / 16.0f)) / logf(8.0f) * 16.0f);
    return large < 31 ? large : 31;
}
constexpr int VT_LD = 216, VT_KEYS = 208, KT_LD = 72;
constexpr int ATT_KT_OFF = 0, ATT_VT_OFF = VT_KEYS * KT_LD * 2;
__device__ __forceinline__ void attn_task(Frame& F, const LAS float* btab, const LAS bf16* ktl, const LAS bf16* vtl, int b, int kvh, int hg, int qt, const bf16x8 (&qf)[2]) {
    const int LANE_ = pg8::lane_id();
    bf16* MIX = (bf16*)(F.ws + WS_MIX);
    const int lane = LANE_, qi = lane & 15, g = lane >> 4, h = kvh * 8 + hg;
    const int q0 = qt * 16, tok0 = b * SEQ, kl0 = 16 * (qt & 3);
    f32x4 s[5][2];
#pragma unroll
    for (int kb = 0; kb < 5; ++kb)
#pragma unroll
        for (int t = 0; t < 2; ++t) {
            const LAS bf16* kp = ktl + (kl0 + 32 * kb + 16 * t + qi) * KT_LD + 8 * g;
            const bf16x8 k0f = *(const LAS bf16x8*)(kp), k1f = *(const LAS bf16x8*)(kp + 32);
            f32x4 a = (f32x4){0.f, 0.f, 0.f, 0.f};
            a = __builtin_amdgcn_mfma_f32_16x16x32_bf16(k0f, qf[0], a, 0, 0, 0);
            a = __builtin_amdgcn_mfma_f32_16x16x32_bf16(k1f, qf[1], a, 0, 0, 0);
            s[kb][t] = a;
        }
    const float sink = fin(F, I_SINKS)[h];
    const LAS float* bt = btab + hg * 128;
    float mx = sink;
#pragma unroll
    for (int kb = 0; kb < 5; ++kb)
#pragma unroll
        for (int t = 0; t < 2; ++t)
#pragma unroll
            for (int r = 0; r < 4; ++r) {
                const int key = q0 - 128 + 32 * kb + 16 * t + 4 * g + r, dist = q0 + qi - key;
                const bool valid = (dist >= 0) && (dist < 128) && (key >= 0);
                const float lg = valid ? s[kb][t][r] * 0.125f + bt[dist & 127] : -3.0e38f;
                s[kb][t][r] = lg; mx = fmaxf(mx, lg);
            }
    mx = fmaxf(mx, __shfl_xor(mx, 16)); mx = fmaxf(mx, __shfl_xor(mx, 32));
    float sum = 0.f;
#pragma unroll
    for (int kb = 0; kb < 5; ++kb)
#pragma unroll
        for (int t = 0; t < 2; ++t)
#pragma unroll
            for (int r = 0; r < 4; ++r) { const float lg = s[kb][t][r]; const float p = (lg > -1.0e38f) ? __expf(lg - mx) : 0.f; s[kb][t][r] = p; sum += p; }
    sum += __shfl_xor(sum, 16); sum += __shfl_xor(sum, 32);
    const float inv = 1.0f / (sum + __expf(sink - mx));
    f32x4 o[4];
#pragma unroll
    for (int dt = 0; dt < 4; ++dt) o[dt] = (f32x4){0.f, 0.f, 0.f, 0.f};
#pragma unroll
    for (int kb = 0; kb < 5; ++kb) {
        v4u pw; pw.x = pk2(s[kb][0][0], s[kb][0][1]); pw.y = pk2(s[kb][0][2], s[kb][0][3]); pw.z = pk2(s[kb][1][0], s[kb][1][1]); pw.w = pk2(s[kb][1][2], s[kb][1][3]);
        const bf16x8 pf = __builtin_bit_cast(bf16x8, pw);
        const int kkl = kl0 + 32 * kb + 4 * g;
#pragma unroll
        for (int dt = 0; dt < 4; ++dt) {
            const LAS bf16* vp = vtl + (16 * dt + qi) * VT_LD + kkl;
            const v2u lo = *(const LAS v2u*)(vp), hi = *(const LAS v2u*)(vp + 16);
            const v4u vw = (v4u){lo.x, lo.y, hi.x, hi.y};
            o[dt] = __builtin_amdgcn_mfma_f32_16x16x32_bf16(__builtin_bit_cast(bf16x8, vw), pf, o[dt], 0, 0, 0);
        }
    }
    bf16* op = MIX + (size_t)(tok0 + q0 + qi) * D + POOLW + h * 64 + 4 * g;
#pragma unroll
    for (int dt = 0; dt < 4; ++dt) { v2u w; w.x = pk2(o[dt][0] * inv, o[dt][1] * inv); w.y = pk2(o[dt][2] * inv, o[dt][3] * inv); *(v2u*)(op + 16 * dt) = w; }
}
__device__ __forceinline__ void attn_block(Frame& F, int blk, bool fill_btab) {
    const int TID_ = F.wave * 64 + pg8::lane_id();
    LAS float* btab = (LAS float*)(F.lds + TAB_OFF + 2048);
    LAS bf16* ktl = (LAS bf16*)(F.lds + RING_OFF + ATT_KT_OFF); LAS bf16* vtl = (LAS bf16*)(F.lds + RING_OFF + ATT_VT_OFF);
    const int b = blk >> 6, kvh = (blk >> 5) & 1, qg = blk & 31;
    const bf16* Q = (const bf16*)(F.ws + WS_QBF); const bf16* KVp = (const bf16*)(F.ws + WS_KV);
    const bf16* qbase = Q + (size_t)(b * SEQ + 64 * qg + ((TID_ & 63) & 15)) * 1024 + (kvh * 8 + F.wave) * 64 + 8 * ((TID_ & 63) >> 4);
    bf16x8 qc[2], qn[2];
    qc[0] = *(const bf16x8*)(qbase); qc[1] = *(const bf16x8*)(qbase + 32);
    v4u kv[4], vv[4];
#pragma unroll
    for (int it = 0; it < 4; ++it) { const int idx = TID_ + it * NWAVES * 64, kl = idx >> 3, c = idx & 7, key = 64 * qg - 128 + kl;
        kv[it] = (v4u){0u, 0u, 0u, 0u}; vv[it] = (v4u){0u, 0u, 0u, 0u};
        if (idx < VT_KEYS * 8 && key >= 0 && key < SEQ) { const bf16* rp = KVp + (size_t)(b * SEQ + key) * (2 * KVW) + kvh * 64 + 8 * c; kv[it] = *(const v4u*)(rp); vv[it] = *(const v4u*)(rp + KVW); } }
    LDS_BARRIER();
    if (fill_btab) for (int i = TID_; i < 1024; i += NWAVES * 64) { const int hg = i >> 7, dist = i & 127; btab[i] = fin(F, I_RPE)[t5_bucket(dist) * NH + kvh * 8 + hg]; }
#pragma unroll
    for (int it = 0; it < 4; ++it) { const int idx = TID_ + it * NWAVES * 64, kl = idx >> 3, c = idx & 7;
        if (idx < VT_KEYS * 8) { const v4u v = vv[it];
            *(LAS v4u*)(ktl + kl * KT_LD + 8 * c) = kv[it];
            LAS bf16* d0 = vtl + (8 * c) * VT_LD + kl;
            d0[0 * VT_LD] = (bf16)(v.x & 0xffffu); d0[1 * VT_LD] = (bf16)(v.x >> 16); d0[2 * VT_LD] = (bf16)(v.y & 0xffffu); d0[3 * VT_LD] = (bf16)(v.y >> 16);
            d0[4 * VT_LD] = (bf16)(v.z & 0xffffu); d0[5 * VT_LD] = (bf16)(v.z >> 16); d0[6 * VT_LD] = (bf16)(v.w & 0xffffu); d0[7 * VT_LD] = (bf16)(v.w >> 16); } }
    LDS_BARRIER();
#pragma unroll 1
    for (int i = 0; i < 4; ++i) {
        const bf16* qb2 = qbase + (size_t)((i < 3 ? i + 1 : i) * 16) * 1024;
        qn[0] = *(const bf16x8*)(qb2); qn[1] = *(const bf16x8*)(qb2 + 32);
        attn_task(F, btab, ktl, vtl, b, kvh, F.wave, 4 * qg + i, qc);
        qc[0] = qn[0]; qc[1] = qn[1];
    }
}
__device__ __forceinline__ void pool_task(Frame& F, int mt, int gq) {
    const int LANE_ = pg8::lane_id(), TID_ = F.wave * 64 + LANE_;
    const bf16* U = (const bf16*)(F.ws + WS_UBF); bf16* PO = (bf16*)(F.ws + WS_POOLED);
    LAS v4u* UL = (LAS v4u*)(F.lds + RING_OFF);
    const int w = 2 << gq;
    for (int hh = 0; hh < 2; ++hh) {
        const int tbase = mt * 256 + 128 * hh, pos0 = tbase & (SEQ - 1);
        LDS_BARRIER();
        for (int idx = TID_; idx < 143 * 32; idx += NWAVES * 64) { const int r = idx >> 5, c = idx & 31;
            v4u x = (v4u){0u, 0u, 0u, 0u}; if (pos0 - 15 + r >= 0) x = *(const v4u*)(U + (size_t)(tbase - 15 + r) * POOLW + gq * 256 + 8 * c);
            UL[idx] = x; }
        LDS_BARRIER();
        const int c = TID_ & 31, i0 = (TID_ >> 5) * 8;
        float run[8];
#pragma unroll
        for (int q = 0; q < 8; ++q) run[q] = 0.f;
        for (int j = 1; j < w; ++j) { const v4u x = UL[(15 + i0 - j) * 32 + c];
            run[0] += bf_lo(x.x); run[1] += bf_hi(x.x); run[2] += bf_lo(x.y); run[3] += bf_hi(x.y); run[4] += bf_lo(x.z); run[5] += bf_hi(x.z); run[6] += bf_lo(x.w); run[7] += bf_hi(x.w); }
#pragma unroll
        for (int i = 0; i < 8; ++i) {
            const int pos = pos0 + i0 + i; const v4u x = UL[(15 + i0 + i) * 32 + c], y = UL[(15 + i0 + i - w + 1) * 32 + c];
            const float uv[8] = {bf_lo(x.x), bf_hi(x.x), bf_lo(x.y), bf_hi(x.y), bf_lo(x.z), bf_hi(x.z), bf_lo(x.w), bf_hi(x.w)};
            const float ic = 1.0f / (float)((pos + 1) < w ? (pos + 1) : w);
            float o[8];
#pragma unroll
            for (int q = 0; q < 8; ++q) { run[q] += uv[q]; o[q] = run[q] * ic - uv[q]; }
            v4u ow; ow.x = pk2(o[0], o[1]); ow.y = pk2(o[2], o[3]); ow.z = pk2(o[4], o[5]); ow.w = pk2(o[6], o[7]);
            *(v4u*)(PO + (size_t)(tbase + i0 + i) * POOLW + gq * 256 + 8 * c) = ow;
            run[0] -= bf_lo(y.x); run[1] -= bf_hi(y.x); run[2] -= bf_lo(y.y); run[3] -= bf_hi(y.y); run[4] -= bf_lo(y.z); run[5] -= bf_hi(y.z); run[6] -= bf_lo(y.w); run[7] -= bf_hi(y.w);
        }
    }
    VM_WAIT(); __syncthreads();
    pg8::Gemm g{(const bf16*)PO + gq * 256, (const bf16*)(F.ws + WS_WPOOL) + (size_t)gq * 65536, POOLW, 256, 256};
    pg8::SingleOrder S{mt, 0};
    EpiBf16Plain E{(bf16*)(F.ws + WS_MIX), D, gq * 256, fin(F, I_PSCALE)};
    pg8::gemm_phase<EpiBf16Plain, pg8::SingleOrder, false>(F.lds + RING_OFF, g, S, E, F.wave);
}

constexpr int XS_STRIDE = 2052;
constexpr int P4_XS = 0, P4_PART = 16 * XS_STRIDE * 4, P4_SELE = P4_PART + 4 * 16 * 64 * 4, P4_SELW = P4_SELE + 32 * 8 * 4, P4_SELL = P4_SELW + 32 * 8 * 4, P4_HIST = P4_SELL + 32 * 8 * 4, P4_BASE = P4_HIST + 256, P4_END = P4_BASE + 256;
static_assert(P4_END <= MISC_OFF, "P4 LDS map");
__device__ __forceinline__ unsigned fkey(float f) { const unsigned u = __builtin_bit_cast(unsigned, f); return (u & 0x80000000u) ? ~u : (u | 0x80000000u); }
__device__ __forceinline__ void p4_route(Frame& F) {
    const int LANE_ = pg8::lane_id(), TID_ = F.wave * 64 + LANE_; (void)TID_;
    LAS float* XS = (LAS float*)(F.lds + P4_XS); LAS float* PART = (LAS float*)(F.lds + P4_PART);
    LAS int* SELE = (LAS int*)(F.lds + P4_SELE); LAS float* SELW = (LAS float*)(F.lds + P4_SELW); LAS int* SELL = (LAS int*)(F.lds + P4_SELL);
    LAS int* HIST = (LAS int*)(F.lds + P4_HIST); LAS int* BASE = (LAS int*)(F.lds + P4_BASE);
    const float* H1 = (const float*)(F.ws + WS_H1); unsigned char* XN = F.ws + WS_XN; const float* gf = fin(F, I_GFFN); const float* rb = fin(F, I_RBIAS);
    const bf16* WH = (const bf16*)(F.ws + WS_WRT); const bf16* WL = WH + (size_t)NE * D;
    const int lane = LANE_, wave = F.wave, ti = lane & 15, kk = lane >> 4;
    if (TID_ < 64) HIST[TID_] = 0;
    for (int tile = F.bx; tile < T / 32; tile += F.G) {
    f32x4 xr[2][8];
#pragma unroll
    for (int q = 0; q < 2; ++q) { const float* xrow = H1 + (size_t)(tile * 32 + 2 * wave + q) * D;
#pragma unroll
        for (int j = 0; j < 4; ++j) { xr[q][2 * j] = *(const f32x4*)(xrow + 512 * j + 8 * lane); xr[q][2 * j + 1] = *(const f32x4*)(xrow + 512 * j + 8 * lane + 4); } }
#pragma unroll 1
    for (int pass = 0; pass < 2; ++pass) {
#pragma unroll
        for (int q = 0; q < 2; ++q) { const int tl = 2 * wave + q; float s = 0.f;
#pragma unroll
            for (int j = 0; j < 8; ++j) { const f32x4 v = xr[q][j]; s += (v[0] * v[0] + v[1] * v[1]) + (v[2] * v[2] + v[3] * v[3]); }
            const float rstd = 1.0f / sqrtf(wave_sum(s) * (1.0f / D) + EPS);
#pragma unroll
            for (int j = 0; j < 4; ++j) { const f32x4 a = xr[q][2 * j] * rstd * *(const f32x4*)(gf + 512 * j + 8 * lane), b = xr[q][2 * j + 1] * rstd * *(const f32x4*)(gf + 512 * j + 8 * lane + 4);
                *(LAS f32x4*)(XS + tl * XS_STRIDE + 512 * j + 8 * lane) = a; *(LAS f32x4*)(XS + tl * XS_STRIDE + 512 * j + 8 * lane + 4) = b;
                v2u o; o.x = pk4_fp8(a[0], a[1], a[2], a[3]); o.y = pk4_fp8(b[0], b[1], b[2], b[3]);
                *(v2u*)(XN + (size_t)(tile * 32 + 16 * pass + tl) * D + 512 * j + 8 * lane) = o; } }
        if (pass == 0) {
#pragma unroll
            for (int q = 0; q < 2; ++q) { const float* xrow = H1 + (size_t)(tile * 32 + 16 + 2 * wave + q) * D;
#pragma unroll
                for (int j = 0; j < 4; ++j) { xr[q][2 * j] = *(const f32x4*)(xrow + 512 * j + 8 * lane); xr[q][2 * j + 1] = *(const f32x4*)(xrow + 512 * j + 8 * lane + 4); } } }
        f32x4 acc[4];
#pragma unroll
        for (int et = 0; et < 4; ++et) acc[et] = (f32x4){0.f, 0.f, 0.f, 0.f};
        bf16x8 wh0[4], wl0[4], wh1[4], wl1[4];
#define P4_LDW(WHX, WLX, st) do { const size_t fo_ = ((size_t)((8 * wave + (st)) * 4) * 16 + ti) * 32 + 8 * kk; _Pragma("unroll") for (int et = 0; et < 4; ++et) { WHX[et] = *(const bf16x8*)(WH + fo_ + et * 512); WLX[et] = *(const bf16x8*)(WL + fo_ + et * 512); } } while (0)
#define P4_STEP(WHX, WLX, st) do { const int k0_ = 256 * wave + 32 * (st) + 8 * kk; \
            const f32x4 xa = *(const LAS f32x4*)(XS + ti * XS_STRIDE + k0_), xb = *(const LAS f32x4*)(XS + ti * XS_STRIDE + k0_ + 4); v4u hw, lw; \
            hw.x = pk2(xa[0], xa[1]); hw.y = pk2(xa[2], xa[3]); hw.z = pk2(xb[0], xb[1]); hw.w = pk2(xb[2], xb[3]); \
            lw.x = pk2(xa[0] - bf_lo(hw.x), xa[1] - bf_hi(hw.x)); lw.y = pk2(xa[2] - bf_lo(hw.y), xa[3] - bf_hi(hw.y)); lw.z = pk2(xb[0] - bf_lo(hw.z), xb[1] - bf_hi(hw.z)); lw.w = pk2(xb[2] - bf_lo(hw.w), xb[3] - bf_hi(hw.w)); \
            const bf16x8 xh = __builtin_bit_cast(bf16x8, hw), xl = __builtin_bit_cast(bf16x8, lw); \
            _Pragma("unroll") for (int et = 0; et < 4; ++et) { acc[et] = __builtin_amdgcn_mfma_f32_16x16x32_bf16(xh, WHX[et], acc[et], 0, 0, 0); \
                acc[et] = __builtin_amdgcn_mfma_f32_16x16x32_bf16(xl, WHX[et], acc[et], 0, 0, 0); acc[et] = __builtin_amdgcn_mfma_f32_16x16x32_bf16(xh, WLX[et], acc[et], 0, 0, 0); } } while (0)
        P4_LDW(wh0, wl0, 0);
        LDS_BARRIER();
#pragma unroll 1
        for (int st = 0; st < 8; st += 2) { P4_LDW(wh1, wl1, st + 1); P4_STEP(wh0, wl0, st); if (st + 2 < 8) P4_LDW(wh0, wl0, st + 2); P4_STEP(wh1, wl1, st + 1); }
#undef P4_LDW
#undef P4_STEP
        if (wave >= 4) {
#pragma unroll
            for (int et = 0; et < 4; ++et)
#pragma unroll
                for (int r = 0; r < 4; ++r) PART[(wave - 4) * 1024 + (4 * kk + r) * 64 + 16 * et + ti] = acc[et][r];
        }
        LDS_BARRIER();
        if (wave < 4) {
#pragma unroll
            for (int et = 0; et < 4; ++et)
#pragma unroll
                for (int r = 0; r < 4; ++r) { LAS float* pp = PART + wave * 1024 + (4 * kk + r) * 64 + 16 * et + ti; *pp = *pp + acc[et][r]; }
        }
        LDS_BARRIER();
#pragma unroll 1
        for (int q = 0; q < 2; ++q) {
            const int tl = 2 * wave + q, tw = pass * 16 + tl;
            const float lg = (PART[tl * 64 + lane] + PART[1024 + tl * 64 + lane]) + (PART[2048 + tl * 64 + lane] + PART[3072 + tl * 64 + lane]);
            const float score = 1.0f / (1.0f + expf(-lg)), biased = score + rb[lane];
            const int grp = lane >> 3;
            float m1 = biased; m1 = fmaxf(m1, __shfl_xor(m1, 1)); m1 = fmaxf(m1, __shfl_xor(m1, 2)); m1 = fmaxf(m1, __shfl_xor(m1, 4));
            const unsigned long long bm = __ballot(biased == m1); const unsigned gb = (unsigned)(bm >> (8 * grp)) & 0xffu; const int first = __builtin_ctz(gb);
            float v2 = ((lane & 7) == first) ? -3.0e38f : biased; float m2 = v2; m2 = fmaxf(m2, __shfl_xor(m2, 1)); m2 = fmaxf(m2, __shfl_xor(m2, 2)); m2 = fmaxf(m2, __shfl_xor(m2, 4));
            const unsigned gk = (fkey(m1 + m2) & ~7u) | (unsigned)(7 - grp);
            int grank = 0;
#pragma unroll
            for (int j = 0; j < 8; ++j) { const unsigned sj = (unsigned)__builtin_amdgcn_readlane((int)gk, 8 * j); grank += (sj > gk) ? 1 : 0; }
            const bool gsel = grank < 4;
            const unsigned key = gsel ? ((fkey(biased) & ~63u) | (unsigned)(63 - lane)) : (unsigned)(63 - lane);
            int rank = 0;
#pragma unroll
            for (int j = 0; j < 64; ++j) { const unsigned sj = (unsigned)__builtin_amdgcn_readlane((int)key, j); rank += (sj > key) ? 1 : 0; }
            const bool sel = gsel && (rank < 8);
            const float wsum = wave_sum(sel ? score : 0.f);
            const unsigned long long sm = __ballot(sel);
            if (sel) { const int k = __popcll(sm & ((1ull << lane) - 1ull)); const int li = atomicAdd((int*)&HIST[lane], 1);
                SELE[tw * 8 + k] = lane; SELW[tw * 8 + k] = score / wsum * 2.5f; SELL[tw * 8 + k] = li; }
        }
        LDS_BARRIER();
    }
    if (TID_ < 64) BASE[TID_] = (int)__hip_atomic_fetch_add(F.ctl + CW_CNT + 32 * TID_, (unsigned)HIST[TID_], RLX_AGENT);
    LDS_BARRIER();
    if (TID_ < 256) { const int e = SELE[TID_], pos = BASE[e] + SELL[TID_], tok = tile * 32 + (TID_ >> 3);
        ((int*)(F.ws + WS_TOKLIST))[(size_t)e * T + pos] = tok; ((float*)(F.ws + WS_WREC))[tok * 8 + (TID_ & 7)] = SELW[TID_]; ((int*)(F.ws + WS_REC))[tok * 8 + (TID_ & 7)] = e * T + pos; }
    LDS_BARRIER();
    if (TID_ < 64) HIST[TID_] = 0;
    LDS_BARRIER();
    }
}

__device__ __forceinline__ void p7_combine(Frame& F, bool dry) {
    const int LANE_ = pg8::lane_id();
    const LAS int* tab = (const LAS int*)(F.lds + TAB_OFF);
    const unsigned char* Y = F.ws + WS_Y; const int* rec = (const int*)(F.ws + WS_REC); const float* wrec = (const float*)(F.ws + WS_WREC);
    const float* H = (const float*)(F.ws + WS_H1); bf16* HO = dry ? (bf16*)(F.ws + WS_WGU) : (bf16*)(F.ws + WS_H2B); unsigned char* H2 = dry ? (F.ws + WS_WGU + 64 * MiB) : (F.ws + WS_H2F8);
    const int gw = F.bx * NWAVES + F.wave, NGW = F.G * NWAVES, lane = LANE_;
    for (int t = gw; t < T; t += NGW) {
        int rows[9]; float rwt[9];
#pragma unroll
        for (int k = 0; k < 8; ++k) { const int rc = rec[t * 8 + k]; const int e = rc >> 13, pos = rc & (T - 1); rows[k] = tab[TB_PAD + e] + pos; rwt[k] = wrec[t * 8 + k] * (1.0f / SY); }
        rows[8] = SH_ROW0 + t; rwt[8] = 1.0f / SY;
        v4u y[2][9]; f32x4 h[2][4];
#pragma unroll
        for (int j = 0; j < 2; ++j) { const int c0 = 1024 * j + 16 * lane;
#pragma unroll
            for (int q = 0; q < 4; ++q) h[j][q] = *(const f32x4*)(H + (size_t)t * D + c0 + 4 * q);
#pragma unroll
            for (int k = 0; k < 9; ++k) y[j][k] = *(const v4u*)(Y + (size_t)rows[k] * D + c0); }
#pragma unroll
        for (int j = 0; j < 2; ++j) { const int c0 = 1024 * j + 16 * lane;
#pragma unroll
            for (int k = 0; k < 9; ++k) { const float w = rwt[k]; float f[4];
                fp8x4_to_f32(y[j][k].x, f); h[j][0][0] += w * f[0]; h[j][0][1] += w * f[1]; h[j][0][2] += w * f[2]; h[j][0][3] += w * f[3];
                fp8x4_to_f32(y[j][k].y, f); h[j][1][0] += w * f[0]; h[j][1][1] += w * f[1]; h[j][1][2] += w * f[2]; h[j][1][3] += w * f[3];
                fp8x4_to_f32(y[j][k].z, f); h[j][2][0] += w * f[0]; h[j][2][1] += w * f[1]; h[j][2][2] += w * f[2]; h[j][2][3] += w * f[3];
                fp8x4_to_f32(y[j][k].w, f); h[j][3][0] += w * f[0]; h[j][3][1] += w * f[1]; h[j][3][2] += w * f[2]; h[j][3][3] += w * f[3]; }
            { v4u b0, b1; b0.x = pk2(h[j][0][0], h[j][0][1]); b0.y = pk2(h[j][0][2], h[j][0][3]); b0.z = pk2(h[j][1][0], h[j][1][1]); b0.w = pk2(h[j][1][2], h[j][1][3]);
              b1.x = pk2(h[j][2][0], h[j][2][1]); b1.y = pk2(h[j][2][2], h[j][2][3]); b1.z = pk2(h[j][3][0], h[j][3][1]); b1.w = pk2(h[j][3][2], h[j][3][3]);
              *(v4u*)(HO + (size_t)t * D + c0) = b0; *(v4u*)(HO + (size_t)t * D + c0 + 8) = b1; }
            v4u o; o.x = pk4_fp8(h[j][0][0], h[j][0][1], h[j][0][2], h[j][0][3]); o.y = pk4_fp8(h[j][1][0], h[j][1][1], h[j][1][2], h[j][1][3]);
            o.z = pk4_fp8(h[j][2][0], h[j][2][1], h[j][2][2], h[j][2][3]); o.w = pk4_fp8(h[j][3][0], h[j][3][1], h[j][3][2], h[j][3][3]);
            *(v4u*)(H2 + (size_t)t * D + c0) = o; }
    }
}
__device__ __forceinline__ void p9_final(Frame& F, bool dry) {
    const int LANE_ = pg8::lane_id();
    const int gw = F.bx * NWAVES + F.wave, NGW = F.G * NWAVES, lane = LANE_; const float* g = fin(F, I_GFINAL); const float* gp = fin(F, I_GPLE);
    const bf16* G = (const bf16*)(F.ws + WS_GBUF); const bf16* PP = (const bf16*)(F.ws + WS_PPROJ); const bf16* H2 = (const bf16*)(F.ws + WS_H2B);
    v4u hq[4], gq[4], pq[4];
    if (gw < T) {
#pragma unroll
        for (int j = 0; j < 4; ++j) { const size_t o = (size_t)gw * D + 512 * j + 8 * lane; hq[j] = *(const v4u*)(H2 + o); gq[j] = *(const v4u*)(G + o); pq[j] = *(const v4u*)(PP + o); } }
    for (int t = gw; t < T; t += NGW) {
        float* orow = (dry ? (float*)(F.ws + WS_WGU) : F.out) + (size_t)t * D; f32x4 v[8]; v4u gg[4], pw[4];
#pragma unroll
        for (int j = 0; j < 4; ++j) { const v4u hw = hq[j];
            v[2 * j] = (f32x4){bf_lo(hw.x), bf_hi(hw.x), bf_lo(hw.y), bf_hi(hw.y)}; v[2 * j + 1] = (f32x4){bf_lo(hw.z), bf_hi(hw.z), bf_lo(hw.w), bf_hi(hw.w)};
            gg[j] = gq[j]; pw[j] = pq[j]; }
        if (t + NGW < T) {
#pragma unroll
            for (int j = 0; j < 4; ++j) { const size_t o = (size_t)(t + NGW) * D + 512 * j + 8 * lane; hq[j] = *(const v4u*)(H2 + o); gq[j] = *(const v4u*)(G + o); pq[j] = *(const v4u*)(PP + o); } }
        float pf[4][8]; float ps = 0.f;
#pragma unroll
        for (int j = 0; j < 4; ++j) { pf[j][0] = bf_lo(pw[j].x); pf[j][1] = bf_hi(pw[j].x); pf[j][2] = bf_lo(pw[j].y); pf[j][3] = bf_hi(pw[j].y); pf[j][4] = bf_lo(pw[j].z); pf[j][5] = bf_hi(pw[j].z); pf[j][6] = bf_lo(pw[j].w); pf[j][7] = bf_hi(pw[j].w);
#pragma unroll
            for (int q = 0; q < 8; ++q) ps += pf[j][q] * pf[j][q]; }
        const float rsp = 1.0f / sqrtf(wave_sum(ps) * (1.0f / D) + EPS);
        float s = 0.f;
#pragma unroll
        for (int j = 0; j < 4; ++j) { const f32x4 g0 = *(const f32x4*)(gp + 512 * j + 8 * lane), g1 = *(const f32x4*)(gp + 512 * j + 8 * lane + 4);
            const float gl[8] = {bf_lo(gg[j].x), bf_hi(gg[j].x), bf_lo(gg[j].y), bf_hi(gg[j].y), bf_lo(gg[j].z), bf_hi(gg[j].z), bf_lo(gg[j].w), bf_hi(gg[j].w)};
#pragma unroll
            for (int q = 0; q < 4; ++q) { v[2 * j][q] += sigmoid_f(gl[q]) * pf[j][q] * rsp * g0[q]; v[2 * j + 1][q] += sigmoid_f(gl[4 + q]) * pf[j][4 + q] * rsp * g1[q]; }
            s += (v[2 * j][0] * v[2 * j][0] + v[2 * j][1] * v[2 * j][1]) + (v[2 * j][2] * v[2 * j][2] + v[2 * j][3] * v[2 * j][3]);
            s += (v[2 * j + 1][0] * v[2 * j + 1][0] + v[2 * j + 1][1] * v[2 * j + 1][1]) + (v[2 * j + 1][2] * v[2 * j + 1][2] + v[2 * j + 1][3] * v[2 * j + 1][3]); }
        const float rstd = 1.0f / sqrtf(wave_sum(s) * (1.0f / D) + EPS);
#pragma unroll
        for (int j = 0; j < 4; ++j) { const f32x4 g0 = *(const f32x4*)(g + 512 * j + 8 * lane), g1 = *(const f32x4*)(g + 512 * j + 8 * lane + 4);
            __builtin_nontemporal_store(v[2 * j] * rstd * g0, (f32x4*)(orow + 512 * j + 8 * lane)); __builtin_nontemporal_store(v[2 * j + 1] * rstd * g1, (f32x4*)(orow + 512 * j + 8 * lane + 4)); }
    }
}
__global__ void __launch_bounds__(NWAVES * 64, 2) fwd_kernel(Args args) {
    extern __shared__ __attribute__((aligned(16))) unsigned char lds[];
    Frame F;
    F.lds = (LAS unsigned char*)lds;
    F.MISC = (volatile LAS unsigned*)(F.lds + MISC_OFF);
    F.wave = __builtin_amdgcn_readfirstlane(threadIdx.x >> 6);
    F.G = gridDim.x; F.bx = blockIdx.x;
    F.ws = args.ws; F.ctl = (gu32*)(args.ws + WS_CTL); F.out = args.out;
    { const int TID_ = threadIdx.x;
    if (TID_ < 64) F.MISC[TID_] = 0u;
    if (TID_ >= 64 && TID_ < 64 + 22) ((LAS unsigned long long*)(F.lds + MISC_OFF + 256))[TID_ - 64] = ((const unsigned long long*)&args)[TID_ - 64]; }
    __syncthreads();
    XcdBarrier bar; bar.bar = (unsigned*)(F.ctl + CW_BAR); bar.x = 0; bar.st = nullptr;
    if (N_LAUNCHES == 1) bar = xcd_barrier_post((unsigned*)(F.ctl + CW_BAR), F.MISC + 8);
#define GRID_BAR() do { if (N_LAUNCHES == 1) xcd_barrier(bar); } while (0)
    const int lo = args.ph_lo, hi = args.ph_hi;
#ifndef PH_MASK
#define PH_MASK 0x3ff
#endif
#ifndef DUP_PHASE
#define DUP_PHASE -1
#endif
#define REPS(k) ((DUP_PHASE == (k)) ? 2 : 1)
#define IN(k) ((((PH_MASK) >> (k)) & 1) && lo <= (k) && (k) < hi)
#define BOTH(k) (IN(k) && IN((k) + 1))

    if (IN(0)) { _Pragma("unroll") for (int rep = 0; rep < REPS(0); ++rep) { p0_prologue(F); if (BOTH(0)) GRID_BAR(); } }

    if (IN(1)) { _Pragma("unroll") for (int rep = 0; rep < REPS(1); ++rep) {
        constexpr int G1 = 144;
        if (F.G == 256 && F.bx >= G1) {
            { pg8::Gemm g{(const bf16*)(F.ws + WS_PBF), (const bf16*)(F.ws + WS_WPP), PLE, PLE, PLE}; pg8::StaticOrder S; S.init(T, D, F.G - G1, F.bx - G1);
              EpiBf16Plain E{(bf16*)(F.ws + WS_PPROJ), D, 0, nullptr};
              pg8::gemm_phase<EpiBf16Plain, pg8::StaticOrder, false>(F.lds + RING_OFF, g, S, E, F.wave); }
            conv_wg_dyn(F, 1);
        } else {
            const int gg = (F.G == 256) ? G1 : F.G;
            { pg8::Gemm g{(const bf16*)(F.ws + WS_ABF), (const bf16*)(F.ws + WS_WIN), D, D, D}; pg8::StaticOrder S; S.init(T, INW, gg, F.bx);
              EpiInProj E{F.ws};
              pg8::gemm_phase<EpiInProj, pg8::StaticOrder, false>(F.lds + RING_OFF, g, S, E, F.wave); }
            if (F.G == 256) conv_wg_dyn(F, 1);
            if (F.G != 256) {
                { pg8::Gemm g{(const bf16*)(F.ws + WS_PBF), (const bf16*)(F.ws + WS_WPP), PLE, PLE, PLE}; pg8::StaticOrder S; S.init(T, D, F.G, F.bx);
                  EpiBf16Plain E{(bf16*)(F.ws + WS_PPROJ), D, 0, nullptr};
                  pg8::gemm_phase<EpiBf16Plain, pg8::StaticOrder, false>(F.lds + RING_OFF, g, S, E, F.wave); }
                conv_fp8_items(F, CONV_A, CONV_A + CONV_B, F.bx * NWAVES + F.wave, F.G * NWAVES);
            }
        }
        if (BOTH(1)) GRID_BAR();
    } }

    if (IN(2)) { _Pragma("unroll") for (int rep = 0; rep < REPS(2); ++rep) {
        if (F.G == 256) {
            if (F.bx < 128) pool_task(F, F.bx >> 2, F.bx & 3);
            else {
#pragma unroll 1
                for (int j = 0; j < 2; ++j) attn_block(F, 2 * (F.bx - 128) + j, j == 0); }
        } else {
            for (int blk = F.bx; blk < 256; blk += F.G) attn_block(F, blk, true);
            for (int p = F.bx; p < 128; p += F.G) { __syncthreads(); pool_task(F, p >> 2, p & 3); }
        }
        if (BOTH(2)) GRID_BAR();
    } }

    if (IN(3)) { _Pragma("unroll") for (int rep = 0; rep < REPS(3); ++rep) {
        constexpr int G3 = 128;
        if (F.G == 256 && F.bx >= G3) conv_wg_dyn(F, 2);
        else {
            pg8::Gemm g{(const bf16*)(F.ws + WS_MIX), (const bf16*)(F.ws + WS_WOUT), D, D, D}; pg8::StaticOrder S; S.init(T, D, (F.G == 256) ? G3 : F.G, F.bx);
            EpiResF32 E{fin(F, I_X), (float*)(F.ws + WS_H1)};
            pg8::gemm_phase<EpiResF32, pg8::StaticOrder, false>(F.lds + RING_OFF, g, S, E, F.wave);
            if (F.G == 256) conv_wg_dyn(F, 2);
            if (F.G != 256) conv_fp8_items(F, CONV_A + CONV_B, CV_TOTAL, F.bx * NWAVES + F.wave, F.G * NWAVES);
        }
        if (BOTH(3)) GRID_BAR();
    } }

    if (IN(4)) { _Pragma("nounroll") for (int rep = 0; rep < ((DUP_PHASE == 4) ? 2 : 1); ++rep) { if (rep == 1) { GRID_BAR(); if (F.bx == 0 && threadIdx.x < NE) __hip_atomic_store(F.ctl + CW_CNT + 32 * threadIdx.x, 0u, RLX_AGENT); GRID_BAR(); }
        p4_route(F); } if (BOTH(4)) GRID_BAR(); }

    if (IN(5)) { _Pragma("unroll") for (int rep = 0; rep < REPS(5); ++rep) {
        moe_tables(F);
        pg8::Gemm g{F.ws + WS_XN, F.ws + WS_WGU, D, D, D};
        MoeOrder S{(const LAS int*)(F.lds + TAB_OFF), (const int*)(F.ws + WS_TOKLIST), F.bx & 7, F.bx >> 3, 4, F.G >> 3};
        EpiGateUp E{F.ws + WS_ACT};
        pg8::gemm_phase<EpiGateUp, MoeOrder, true, 1>(F.lds + RING_OFF, g, S, E, F.wave);
        if (BOTH(5)) GRID_BAR();
    } }

    if (IN(6)) { _Pragma("unroll") for (int rep = 0; rep < REPS(6); ++rep) {
        if (!IN(5)) moe_tables(F);
        pg8::Gemm g{F.ws + WS_ACT, F.ws + WS_WD, EFF, EFF, EFF};
        MoeOrder S{(const LAS int*)(F.lds + TAB_OFF), (const int*)(F.ws + WS_TOKLIST), F.bx & 7, F.bx >> 3, 8, F.G >> 3};
        EpiDown E{F.ws + WS_Y};
        pg8::gemm_phase<EpiDown, MoeOrder, false, 1>(F.lds + RING_OFF, g, S, E, F.wave);
        if (BOTH(6)) GRID_BAR();
    } }

    if (IN(7)) { if (!IN(6)) moe_tables(F); if (DUP_PHASE == 7) { p7_combine(F, true); GRID_BAR(); } p7_combine(F, false); if (BOTH(7)) GRID_BAR(); }

    if (IN(8)) {
        pg8::Gemm g{F.ws + WS_H2F8, F.ws + WS_WPG, D, D, D}; pg8::StaticOrder S; S.init(T, D, F.G, F.bx);
        EpiBf16Mul E{(bf16*)(F.ws + WS_GBUF), 1.0f / SW3};
        pg8::gemm_phase<EpiBf16Mul, pg8::StaticOrder, false, 1>(F.lds + RING_OFF, g, S, E, F.wave);
        if (BOTH(8)) GRID_BAR();
    }

    if (IN(9)) { if (DUP_PHASE == 9) { p9_final(F, true); GRID_BAR(); } p9_final(F, false); }
#undef IN
#undef BOTH
}

extern "C" void kernel_launch(void* const* d_in, const int* in_sizes, int n_in, void* d_out, int out_size, void* d_ws, size_t ws_size, hipStream_t stream) {
    static int grid = 0;
    if (grid == 0) {
        if (n_in != 22 || out_size != T * D || ws_size < WS_END) { fprintf(stderr, "kernel_launch: unexpected sizes n_in %d out %d ws %zu (need %zu)\n", n_in, out_size, ws_size, (size_t)WS_END); grid = -1; return; }
        int dev = 0, cus = 0, per_cu = 0;
        if (hipGetDevice(&dev) != hipSuccess || hipDeviceGetAttribute(&cus, hipDeviceAttributeMultiprocessorCount, dev) != hipSuccess) { grid = -1; return; }
        if (hipFuncSetAttribute((const void*)fwd_kernel, hipFuncAttributeMaxDynamicSharedMemorySize, LDS_BYTES) != hipSuccess) { fprintf(stderr, "kernel_launch: hipFuncSetAttribute failed\n"); grid = -1; return; }
        if (hipOccupancyMaxActiveBlocksPerMultiprocessor(&per_cu, (const void*)fwd_kernel, NWAVES * 64, LDS_BYTES) != hipSuccess || per_cu < 1) fprintf(stderr, "kernel_launch: occupancy query reports %d\n", per_cu);
        (void)hipGetLastError();
        grid = cus > 256 ? 256 : cus;
    }
    if (grid < 0) return;
    if (hipMemsetAsync((char*)d_ws + WS_CTL, 0, CTL_ZERO_BYTES, stream) != hipSuccess) return;
    Args a{};
    for (int i = 0; i < 22; ++i) a.in[i] = (const float*)d_in[i];
    a.out = (float*)d_out; a.ws = (unsigned char*)d_ws;
    for (int li = 0; li < N_LAUNCHES; ++li) {
        a.ph_lo = (N_LAUNCHES == 1) ? 0 : li; a.ph_hi = (N_LAUNCHES == 1) ? N_PHASES : li + 1; a.li = li;
        hipLaunchKernelGGL(fwd_kernel, dim3(grid), dim3(NWAVES * 64), LDS_BYTES, stream, a);
    }
}
```

```cpp
#include <hip/hip_runtime.h>
#include <cstdio>
#include <cstdint>

#ifndef MK_N_LAUNCHES
#define MK_N_LAUNCHES 1
#endif

namespace pg8 {
#define PG8_LAS __attribute__((address_space(3)))
typedef unsigned short bf16_t;
typedef short bf16x8 __attribute__((ext_vector_type(8)));
typedef float f32x4 __attribute__((ext_vector_type(4)));
typedef unsigned u32x4 __attribute__((ext_vector_type(4)));
typedef unsigned u32x2 __attribute__((ext_vector_type(2)));
constexpr int BM = 256, BK = 64, HALF = 128, HTB = HALF * BK * 2  , STAGE_BYTES = 8 * HTB, NXCD = 8, WGM = 8;

__host__ __device__ __forceinline__ int lds_byte(int r, int c) { const int st = (r >> 4) * 2 + (c >> 5), rr = r & 15, cc = c & 31, ob = rr * 64 + cc * 2; return st * 1024 + (ob ^ (((ob >> 9) & 1) << 5)); }
__host__ __device__ __forceinline__ void stage_rc(int b, int& R, int& C) { const int st = b / 1024, sb = b % 1024, swz = sb ^ (((sb >> 9) & 1) << 5); R = (st >> 1) * 16 + swz / 64; C = (st & 1) * 32 + (swz % 64) / 2; }
__host__ __device__ __forceinline__ int perm32(int rho) { const int n = rho >> 4, i = rho & 15; return 8 * (i >> 2) + 4 * n + (i & 3); }

struct Unit { int pm, pn, e, lt, half; };
struct Gemm { const void* A; const void* Bt; int lda, ldb, K; };
typedef int i32x8 __attribute__((ext_vector_type(8)));
typedef int i32x4 __attribute__((ext_vector_type(4)));
__device__ __forceinline__ i32x8 cat8(bf16x8 lo, bf16x8 hi) { const i32x4 a = __builtin_bit_cast(i32x4, lo), b = __builtin_bit_cast(i32x4, hi); return __builtin_shufflevector(a, b, 0, 1, 2, 3, 4, 5, 6, 7); }

struct StaticOrder {
    static constexpr bool HALVES = false;
    int nM, nN, nwg, G, c;
    __host__ __device__ void init(int M, int N, int G_, int c_) { nM = M / BM; nN = N / BM; nwg = nM * nN; G = G_; c = c_; }
    __host__ __device__ bool next(int i, Unit& u) const {
        const long L = (long)i * G + c; if (L >= nwg) return false;
        int wgid = (int)L; { const int q = nwg / NXCD, r = nwg % NXCD, xcd = wgid % NXCD, off = wgid / NXCD; wgid = (xcd < r ? xcd * (q + 1) : r * (q + 1) + (xcd - r) * q) + off; }
        const int nig = WGM * nN, gid = wgid / nig, fm = gid * WGM, gsz = (nM - fm) < WGM ? (nM - fm) : WGM;
        u.pm = fm + ((wgid % nig) % gsz); u.pn = (wgid % nig) / gsz; u.e = 0; u.lt = 0; u.half = 0; return true;
    }
    __device__ __forceinline__ int arow(const Unit&, int r) const { return r; }
};
struct SingleOrder {
    static constexpr bool HALVES = false;
    int pm, pn;
    __device__ bool next(int i, Unit& u) const { if (i > 0) return false; u.pm = pm; u.pn = pn; u.e = 0; u.lt = 0; u.half = 0; return true; }
    __device__ __forceinline__ int arow(const Unit&, int r) const { return r; }
};

__device__ __forceinline__ int lane_id() { int l; asm volatile("v_mbcnt_lo_u32_b32 %0, -1, 0\n\tv_mbcnt_hi_u32_b32 %0, -1, %0" : "=v"(l)); return l; }
__device__ __forceinline__ unsigned cvt_pk_bf16(float lo, float hi) { unsigned r; asm volatile("v_cvt_pk_bf16_f32 %0, %1, %2" : "=v"(r) : "v"(lo), "v"(hi)); return r; }

__host__ __device__ __forceinline__ int perm16(int R) { return 64 * (R >> 5) + 16 * ((R >> 2) & 3) + 4 * ((R >> 4) & 1) + (R & 3); }
template <class Epi, class Sched, bool GATHER, int ESZ = 2, bool ALIGN_EPI = true>
__device__ __forceinline__ void gemm_phase(PG8_LAS unsigned char* lds, const Gemm g, const Sched& S, const Epi& E, int wid) {
    const int lane = lane_id(), tid = wid * 64 + lane, wr = wid >> 2, wc = wid & 3, fr = lane & 15, fq = lane >> 4;
    const int nt = (g.K * ESZ) / 128;
    int Ra[2], Ca[2]; unsigned voffB[2];
#pragma unroll
    for (int i = 0; i < 2; ++i) { int R, C; stage_rc(tid * 16 + i * 8192, R, C); const int Rb = (Epi::PERM == 2) ? perm16(R) : (Epi::PERM ? ((R & ~31) + perm32(R & 31)) : R);
        Ra[i] = R; Ca[i] = C; voffB[i] = (unsigned)(Rb * g.ldb * ESZ + C * 2); }
    const size_t kstep = (size_t)(BK * 2);
    const size_t hstepB = (size_t)((Epi::PERM == 2) ? 8 : HALF) * g.ldb * ESZ, tstepB = (size_t)BM * g.ldb * ESZ;
    const size_t tstepA = (size_t)BM * g.lda * ESZ;
    const unsigned ldsw = (unsigned)wid * 1024u;
    const int aoff = lds_byte(wr * 64 + fr, fq * 8), boff = lds_byte(wc * 32 + fr, fq * 8);
#define PG8_SA(b, h) (((b) * 2 + (h)) * HTB)
#define PG8_SB(b, h) ((4 + (b) * 2 + (h)) * HTB)
#define PG8_STAGE(bufoff, gbase, v0, v1) do { \
        __builtin_amdgcn_global_load_lds((const unsigned*)((const char*)(gbase) + (v0)), (PG8_LAS unsigned*)(lds + (bufoff) + ldsw), 16, 0, 0); \
        __builtin_amdgcn_global_load_lds((const unsigned*)((const char*)(gbase) + (v1)), (PG8_LAS unsigned*)(lds + (bufoff) + ldsw + 8192), 16, 0, 0); } while (0)
#define PG8_STAGE_A0(bufoff, gbase, p0, p1) PG8_STAGE(bufoff, gbase, p0, p1)
#define PG8_STAGE_A1(bufoff, gbase, p0, p1, q0, q1) do { if constexpr (GATHER) { PG8_STAGE(bufoff, gbase, q0, q1); } else { PG8_STAGE(bufoff, (gbase) + hstepA, p0, p1); } } while (0)
#define PG8_LD16(off) (*(const PG8_LAS i32x4*)(lds + (off)))
#define PG8_LDA(dst, b, h) do { if constexpr (ESZ == 2) { _Pragma("unroll") for (int m = 0; m < 4; ++m) _Pragma("unroll") for (int k = 0; k < 2; ++k) dst[m][k] = *(const PG8_LAS bf16x8*)(lds + PG8_SA(b, h) + aoff + m * 2048 + k * 1024); } \
        else { _Pragma("unroll") for (int m = 0; m < 4; ++m) dst##8[m] = __builtin_shufflevector(PG8_LD16(PG8_SA(b, h) + aoff + m * 2048), PG8_LD16(PG8_SA(b, h) + aoff + m * 2048 + 1024), 0, 1, 2, 3, 4, 5, 6, 7); } } while (0)
#define PG8_LDB(dst, b, h) do { if constexpr (ESZ == 2) { _Pragma("unroll") for (int n = 0; n < 2; ++n) _Pragma("unroll") for (int k = 0; k < 2; ++k) dst[n][k] = *(const PG8_LAS bf16x8*)(lds + PG8_SB(b, h) + boff + n * 2048 + k * 1024); } \
        else { _Pragma("unroll") for (int n = 0; n < 2; ++n) dst##8[n] = __builtin_shufflevector(PG8_LD16(PG8_SB(b, h) + boff + n * 2048), PG8_LD16(PG8_SB(b, h) + boff + n * 2048 + 1024), 0, 1, 2, 3, 4, 5, 6, 7); } } while (0)
#define PG8_MMA(ai, bj, At, Bt) do { __builtin_amdgcn_s_setprio(1); \
        if constexpr (ESZ == 2) { _Pragma("unroll") for (int m = 0; m < 4; ++m) _Pragma("unroll") for (int n = 0; n < 2; ++n) _Pragma("unroll") for (int k = 0; k < 2; ++k) \
            acc[ai][bj][m][n] = __builtin_amdgcn_mfma_f32_16x16x32_bf16(Bt[n][k], At[m][k], acc[ai][bj][m][n], 0, 0, 0); } \
        else { _Pragma("unroll") for (int m = 0; m < 4; ++m) _Pragma("unroll") for (int n = 0; n < 2; ++n) \
            asm volatile("v_mfma_scale_f32_16x16x128_f8f6f4 %0, %1, %2, %0, %3, %3 op_sel_hi:[0,0,0]" : "+v"(acc[ai][bj][m][n]) : "v"(Bt##8[n]), "v"(At##8[m]), "v"(sc1)); } \
        __builtin_amdgcn_s_setprio(0); } while (0)
#define PG8_WAIT_V(n) asm volatile("s_waitcnt vmcnt(" #n ")" ::: "memory")
#define PG8_WAIT_L(n) asm volatile("s_waitcnt lgkmcnt(" #n ")" ::: "memory")
#define PG8_BAR __builtin_amdgcn_s_barrier()
#define PG8_SCHED __builtin_amdgcn_sched_barrier(0)
    Unit cur, nxt; int ui = 0;
    if (!S.next(0, cur)) return;
    f32x4 acc[2][2][4][2];
#pragma unroll
    for (int a = 0; a < 2; ++a)
#pragma unroll
        for (int b = 0; b < 2; ++b)
#pragma unroll
            for (int m = 0; m < 4; ++m)
#pragma unroll
                for (int n = 0; n < 2; ++n) acc[a][b][m][n] = (f32x4){0.f, 0.f, 0.f, 0.f};
    const int sc1 = 0x7F7F7F7F;
    bf16x8 At[4][2], B0[2][2], B1[2][2]; i32x8 At8[4], B08[2], B18[2];
    unsigned vA00, vA01, vA10, vA11, nA00, nA01, nA10, nA11;
    const size_t hstepA = GATHER ? (size_t)0 : (size_t)HALF * g.lda * ESZ;
    if constexpr (GATHER) {
        vA00 = (unsigned)(S.arow(cur, Ra[0]) * g.lda * ESZ + Ca[0] * 2); vA01 = (unsigned)(S.arow(cur, Ra[1]) * g.lda * ESZ + Ca[1] * 2);
        vA10 = (unsigned)(S.arow(cur, HALF + Ra[0]) * g.lda * ESZ + Ca[0] * 2); vA11 = (unsigned)(S.arow(cur, HALF + Ra[1]) * g.lda * ESZ + Ca[1] * 2);
    } else {
        vA00 = (unsigned)(Ra[0] * g.lda * ESZ + Ca[0] * 2); vA01 = (unsigned)(Ra[1] * g.lda * ESZ + Ca[1] * 2); vA10 = 0; vA11 = 0;
    }
    nA00 = vA00; nA01 = vA01; nA10 = vA10; nA11 = vA11;
    const char* cA = (const char*)g.A + (GATHER ? (size_t)0 : (size_t)cur.pm * tstepA); const char* cB = (const char*)g.Bt + (size_t)cur.pn * tstepB;
    PG8_STAGE(PG8_SB(0, 0), cB, voffB[0], voffB[1]); PG8_STAGE(PG8_SB(0, 1), cB + hstepB, voffB[0], voffB[1]); PG8_STAGE_A0(PG8_SA(0, 0), cA, vA00, vA01); PG8_STAGE_A1(PG8_SA(0, 1), cA, vA00, vA01, vA10, vA11);
    if (wr == 1) PG8_BAR;
    PG8_WAIT_V(2); PG8_BAR;
    PG8_STAGE(PG8_SB(1, 0), cB + kstep, voffB[0], voffB[1]); PG8_STAGE_A0(PG8_SA(1, 0), cA + kstep, vA00, vA01); PG8_STAGE(PG8_SB(1, 1), cB + hstepB + kstep, voffB[0], voffB[1]);
    PG8_WAIT_V(6); PG8_BAR;
    for (;;) {
        const bool has_next = S.next(ui + 1, nxt);
        const char* nA = has_next ? (const char*)g.A + (GATHER ? (size_t)0 : (size_t)nxt.pm * tstepA) : cA; const char* nB = has_next ? (const char*)g.Bt + (size_t)nxt.pn * tstepB : cB;
        if constexpr (GATHER) {
            if (has_next) {
                nA00 = (unsigned)(S.arow(nxt, Ra[0]) * g.lda * ESZ + Ca[0] * 2); nA01 = (unsigned)(S.arow(nxt, Ra[1]) * g.lda * ESZ + Ca[1] * 2);
                nA10 = (unsigned)(S.arow(nxt, HALF + Ra[0]) * g.lda * ESZ + Ca[0] * 2); nA11 = (unsigned)(S.arow(nxt, HALF + Ra[1]) * g.lda * ESZ + Ca[1] * 2);
            } else { nA00 = vA00; nA01 = vA01; nA10 = vA10; nA11 = vA11; }
        }
#pragma nounroll
        for (int t = 0; t < nt; t += 2) {
            const bool last = (t == nt - 2);
            const char* a1 = cA + (size_t)(t + 1) * kstep;
            const char* a2 = last ? nA : cA + (size_t)(t + 2) * kstep; const char* b2 = last ? nB : cB + (size_t)(t + 2) * kstep;
            const char* a3 = a2 + kstep; const char* b3 = b2 + kstep;
            asm volatile("" : "+v"(voffB[0]), "+v"(voffB[1]), "+v"(vA00), "+v"(vA01));
            if constexpr (GATHER) asm volatile("" : "+v"(vA10), "+v"(vA11));
            unsigned x00 = vA00, x01 = vA01, x10 = vA10, x11 = vA11;
            if constexpr (GATHER) { if (last) { x00 = nA00; x01 = nA01; x10 = nA10; x11 = nA11; } }
            const bool hf = Sched::HALVES && (cur.half != 0);
            PG8_LDB(B0, 0, 0); PG8_LDB(B1, 0, 1); PG8_SCHED; PG8_LDA(At, 0, 0); PG8_STAGE_A1(PG8_SA(1, 1), a1, vA00, vA01, vA10, vA11);
            PG8_WAIT_V(8); PG8_WAIT_L(0); PG8_BAR; PG8_MMA(0, 0, At, B0); PG8_MMA(0, 1, At, B1); PG8_BAR; PG8_SCHED;
            if (!hf) PG8_LDA(At, 0, 1); PG8_STAGE(PG8_SB(0, 0), b2, voffB[0], voffB[1]); PG8_STAGE(PG8_SB(0, 1), b2 + hstepB, voffB[0], voffB[1]); PG8_STAGE_A0(PG8_SA(0, 0), a2, x00, x01);
            PG8_WAIT_V(8); PG8_WAIT_L(0); PG8_BAR; if (!hf) { PG8_MMA(1, 0, At, B0); PG8_MMA(1, 1, At, B1); } PG8_BAR; PG8_SCHED;
            PG8_LDB(B0, 1, 0); PG8_LDB(B1, 1, 1); PG8_SCHED; PG8_LDA(At, 1, 0); PG8_STAGE_A1(PG8_SA(0, 1), a2, x00, x01, x10, x11);
            PG8_WAIT_V(8); PG8_WAIT_L(0); PG8_BAR; PG8_MMA(0, 0, At, B0); PG8_MMA(0, 1, At, B1); PG8_BAR; PG8_SCHED;
            if (!hf) PG8_LDA(At, 1, 1); PG8_STAGE(PG8_SB(1, 0), b3, voffB[0], voffB[1]); PG8_STAGE(PG8_SB(1, 1), b3 + hstepB, voffB[0], voffB[1]); PG8_STAGE_A0(PG8_SA(1, 0), a3, x00, x01);
            PG8_WAIT_V(8); PG8_WAIT_L(0); PG8_BAR; if (!hf) { PG8_MMA(1, 0, At, B0); PG8_MMA(1, 1, At, B1); } PG8_BAR; PG8_SCHED;
        }
        if constexpr (ALIGN_EPI) { if (wr == 0) PG8_BAR; }
        if constexpr (ESZ == 1) asm volatile("s_nop 15\n\ts_nop 15" ::: "memory");
        E(acc, cur, wr, wc, fr, fq);
        if (!has_next) break;
#pragma unroll
        for (int a = 0; a < 2; ++a)
#pragma unroll
            for (int b = 0; b < 2; ++b)
#pragma unroll
                for (int m = 0; m < 4; ++m)
#pragma unroll
                    for (int n = 0; n < 2; ++n) acc[a][b][m][n] = (f32x4){0.f, 0.f, 0.f, 0.f};
        cur = nxt; cA = nA; cB = nB; ++ui;
        if constexpr (GATHER) { vA00 = nA00; vA01 = nA01; vA10 = nA10; vA11 = nA11; }
        if constexpr (ALIGN_EPI) { if (wr == 1) PG8_BAR; }
    }
    PG8_WAIT_V(0);
    if constexpr (!ALIGN_EPI) { if (wr == 0) PG8_BAR; }
    PG8_BAR;
#undef PG8_SA
#undef PG8_SB
#undef PG8_STAGE
#undef PG8_LDA
#undef PG8_LD16
#undef PG8_STAGE_A0
#undef PG8_STAGE_A1
#undef PG8_LDB
#undef PG8_MMA
#undef PG8_WAIT_V
#undef PG8_WAIT_L
#undef PG8_BAR
#undef PG8_SCHED
}
}

constexpr int NWAVES = 8;
constexpr int T = 8192, SEQ = 2048, NB = 4, D = 2048, INW = 2304, POOLW = 1024, NH = 16, NKV = 2, HD = 64, KVW = 128;
constexpr int NE = 64, TOPK = 8, EFF = 512, PLE = 256;
constexpr int SH_ROW0 = T * TOPK + NE * 256;
constexpr int NROWS = SH_ROW0 + T;
constexpr float EPS = 1e-6f;
constexpr float SW1 = 32.0f, SW2 = 16.0f, SA = 4.0f, SY = 16.0f, SW3 = 32.0f;
constexpr int N_PHASES = 10;
constexpr int N_LAUNCHES = MK_N_LAUNCHES;

constexpr size_t MiB = 1u << 20;
constexpr size_t WS_CTL = 0, CTL_ZERO_BYTES = 64 * 1024;
constexpr size_t WS_MISC = 1 * MiB;
constexpr size_t WS_TOKLIST = WS_MISC;
constexpr size_t WS_REC = WS_TOKLIST + (size_t)NE * T * 4;
constexpr size_t WS_WREC = WS_REC + (size_t)T * TOPK * 4;
constexpr size_t WS_RSTDP = WS_WREC + (size_t)T * TOPK * 4;
constexpr size_t WS_PBF = 6 * MiB;
constexpr size_t WS_WRT = 10 * MiB;
constexpr size_t WS_WIN = 12 * MiB;
constexpr size_t WS_WPOOL = WS_WIN + (size_t)INW * D * 2;
constexpr size_t WS_WOUT = WS_WPOOL + (size_t)4 * 256 * 256 * 2;
constexpr size_t WS_WPP = WS_WOUT + (size_t)D * D * 2;
constexpr size_t WS_WPG = WS_WPP + (size_t)D * PLE * 2;
constexpr size_t WS_WGU = WS_WPG + (size_t)D * D * 2;
constexpr size_t WS_WD = WS_WGU + (size_t)65 * 1024 * D;
constexpr size_t WS_XN = WS_WD + (size_t)65 * D * EFF;
constexpr size_t WS_PPROJ = WS_XN + (size_t)T * D * 2;
constexpr size_t WS_ACT = WS_PPROJ + (size_t)T * D * 2;
constexpr size_t WS_H2F8 = WS_ACT;
constexpr size_t WS_H2B = WS_ACT + 16 * MiB;
constexpr size_t WS_GBUF = WS_XN;
constexpr size_t WS_Y = WS_ACT + (size_t)NROWS * EFF * 2;
constexpr size_t WS_ABF = WS_Y;
constexpr size_t WS_UBF = WS_ABF + (size_t)T * D * 2;
constexpr size_t WS_QBF = WS_UBF + (size_t)T * POOLW * 2;
constexpr size_t WS_KV = WS_QBF + (size_t)T * 1024 * 2;
constexpr size_t WS_POOLED = WS_KV + (size_t)T * 2 * KVW * 2;
constexpr size_t WS_MIX = WS_POOLED + (size_t)T * POOLW * 2;
constexpr size_t WS_H1 = WS_Y + (size_t)NROWS * D * 2;
constexpr size_t WS_END = WS_H1 + (size_t)T * D * 4;
static_assert(WS_MIX + (size_t)T * D * 2 <= WS_END, "early activations fit under Y");
static_assert(WS_RSTDP + (size_t)T * 4 <= WS_PBF && WS_PBF + (size_t)T * PLE * 2 <= WS_WIN, "misc fits");
static_assert(WS_END <= (size_t)1024 * MiB, "workspace must fit 1 GiB");
constexpr int CW_BAR = 1024;
constexpr int CW_CNT = 8192;
constexpr int CW_CONVQ = CW_CNT + 32 * NE;
static_assert((CW_CONVQ + 32 * 24) * 4 <= 48 * 1024, "CTL words inside the memset region (below the dummy line at 48 KiB)");

constexpr int RING_OFF = 0, RING_BYTES = 131072;
constexpr int LDS_BYTES = 163840;
constexpr int MISC_OFF = LDS_BYTES - 512;
constexpr int TAB_OFF = RING_BYTES;
constexpr int TB_CNT = 0, TB_PAD = 80, TB_XF = 160, TB_XH = 176, TB_SH0 = 192, TB_SHN = 193;

#define GAS __attribute__((address_space(1)))
#define LAS __attribute__((address_space(3)))
typedef unsigned short bf16;
typedef unsigned v4u __attribute__((ext_vector_type(4)));
typedef unsigned v2u __attribute__((ext_vector_type(2)));
typedef float f32x4 __attribute__((ext_vector_type(4)));
typedef short bf16x8 __attribute__((ext_vector_type(8)));
typedef GAS unsigned gu32;
#define RLX_AGENT __ATOMIC_RELAXED, __HIP_MEMORY_SCOPE_AGENT
#define LDS_WAIT() asm volatile("s_waitcnt lgkmcnt(0)" ::: "memory")
#define LDS_BARRIER() do { asm volatile("s_waitcnt lgkmcnt(0)" ::: "memory"); __builtin_amdgcn_s_barrier(); asm volatile("" ::: "memory"); } while (0)
#define VM_WAIT() asm volatile("s_waitcnt vmcnt(0)" ::: "memory")
__device__ __forceinline__ unsigned pk2(float lo, float hi) { return pg8::cvt_pk_bf16(lo, hi); }
__device__ __forceinline__ float bf_lo(unsigned w) { return __builtin_bit_cast(float, w << 16); }
__device__ __forceinline__ float bf_hi(unsigned w) { return __builtin_bit_cast(float, w & 0xffff0000u); }

#define XB_TMO      128
#define XB_XCNT(j)  (256  + 64 * (j))
#define XB_XSUB(j)  (1280 + 64 * (j))
#define XB_XGEN(j)  (2304 + 64 * (j))
#define XB_TOP      3328
#define XB_TOPGEN   3392
#define XCD_BAR_WORDS 3456
#define XB_SPIN_CAP (1u << 18)
__device__ __forceinline__ unsigned xb_ld(unsigned* p)              { return __hip_atomic_load(p, __ATOMIC_RELAXED, __HIP_MEMORY_SCOPE_AGENT); }
__device__ __forceinline__ unsigned xb_add(unsigned* p, unsigned v) { return __hip_atomic_fetch_add(p, v, __ATOMIC_RELAXED, __HIP_MEMORY_SCOPE_AGENT); }
__device__ __forceinline__ unsigned xb_xcc_id() { return (unsigned)__builtin_amdgcn_s_getreg((3 << 11) | 20) & 0xFu; }
#define XB_SPIN(cond, bar) do { unsigned _sp = 0; while (cond) { __builtin_amdgcn_s_sleep(1); \
    if ((++_sp & 255u) == 0u) { if (xb_ld(&(bar)[XB_TMO])) break; if (_sp > XB_SPIN_CAP) { atomicAdd(&(bar)[XB_TMO], 1u); break; } } } } while (0)
struct XcdBarrier { unsigned* bar; unsigned x; volatile LAS unsigned* st; };
__device__ __forceinline__ XcdBarrier xcd_barrier_post(unsigned* bar, volatile LAS unsigned* st) {
    XcdBarrier b; b.bar = bar; b.x = xb_xcc_id(); b.st = st;
    if (threadIdx.x == 0) (void)xb_add(&bar[XB_XCNT(b.x)], 1u);
    return b;
}
__device__ __forceinline__ void xcd_barrier_complete(unsigned* bar, unsigned x, unsigned& nloc, unsigned& nx) {
    const unsigned G = gridDim.x * gridDim.y * gridDim.z;
    unsigned sum, cnt, mine, sp = 0u;
    for (;;) {
        sum = 0u; cnt = 0u; mine = 0u;
#pragma unroll
        for (unsigned j = 0; j < 16; ++j) { const unsigned c = xb_ld(&bar[XB_XCNT(j)]); sum += c; cnt += (c > 0u) ? 1u : 0u; mine = (j == x) ? c : mine; }
        if (sum == G) break;
        __builtin_amdgcn_s_sleep(1);
        if ((++sp & 255u) == 0u) { if (xb_ld(&bar[XB_TMO])) break; if (sp > XB_SPIN_CAP) { atomicAdd(&bar[XB_TMO], 1u); break; } }
    }
    nloc = mine > 0u ? mine : 1u; nx = cnt > 0u ? cnt : 1u;
}
__device__ __forceinline__ void xcd_barrier(const XcdBarrier& b) {
    asm volatile("s_waitcnt vmcnt(0)" ::: "memory");
    __syncthreads();
    if (threadIdx.x == 0) {
        unsigned* bar = b.bar;
        __builtin_amdgcn_s_waitcnt(0);
        unsigned nloc = b.st[0], nx = b.st[1];
        if (nloc == 0u) { xcd_barrier_complete(bar, b.x, nloc, nx); b.st[0] = nloc; b.st[1] = nx; }
        const unsigned old = xb_add(&bar[XB_XSUB(b.x)], 1u);
        const unsigned gen = old / nloc;
        if (old + 1u == (gen + 1u) * nloc) {
            __builtin_amdgcn_fence(__ATOMIC_RELEASE, "agent");
            asm volatile("s_waitcnt vmcnt(0)" ::: "memory");
            const unsigned og = xb_add(&bar[XB_TOP], 1u);
            const unsigned tg = og / nx;
            if (og + 1u == (tg + 1u) * nx) xb_add(&bar[XB_TOPGEN], 1u);
            else XB_SPIN(xb_ld(&bar[XB_TOPGEN]) == tg, bar);
            __builtin_amdgcn_fence(__ATOMIC_ACQUIRE, "agent");
            xb_add(&bar[XB_XGEN(b.x)], 1u);
            asm volatile("s_waitcnt vmcnt(0)" ::: "memory");
        } else {
            XB_SPIN(xb_ld(&bar[XB_XGEN(b.x)]) == gen, bar);
            __builtin_amdgcn_fence(__ATOMIC_ACQUIRE, "agent");
            asm volatile("s_waitcnt vmcnt(0)" ::: "memory");
        }
    }
    __syncthreads();
}

struct Args { const float* in[22]; float* out; unsigned char* ws; int ph_lo, ph_hi, li, pad; };
struct Frame {
    LAS unsigned char* lds;
    volatile LAS unsigned* MISC;
    gu32* ctl;
    unsigned char* ws;
    int wave, G, bx;
    float* out;
};
__device__ __forceinline__ const float* fin(const Frame& F, int i) {
    const unsigned long long v = ((const LAS unsigned long long*)(F.lds + MISC_OFF + 256))[i];
    const unsigned lo = __builtin_amdgcn_readfirstlane((unsigned)v), hi = __builtin_amdgcn_readfirstlane((unsigned)(v >> 32));
    return (const float*)(const GAS float*)(((unsigned long long)hi << 32) | lo);
}
enum { I_X = 0, I_P, I_GMIX, I_WIN, I_WPOOL, I_PSCALE, I_SINKS, I_RPE, I_WOUT, I_GFFN, I_WROUTER, I_RBIAS, I_WGATE, I_WUP, I_WDOWN, I_WSGATE, I_WSUP, I_WSDOWN, I_WPLEPROJ, I_GPLE, I_WPLEGATE, I_GFINAL };

__device__ __forceinline__ float wave_sum(float v) {
#pragma unroll
    for (int o = 1; o < 64; o <<= 1) v += __shfl_xor(v, o);
    return v;
}

using pg8::Unit;
struct EpiInProj {
    static constexpr int PERM = 1;
    unsigned char* ws;
    __device__ __forceinline__ void operator()(const f32x4 (&acc)[2][2][4][2], const Unit& u, int wr, int wc, int fr, int fq) const {
        const int row0 = u.pm * 256 + wr * 64 + fr;
        const size_t boff = WS_UBF + (size_t)(u.pn >= 4 ? 1 : 0) * (WS_QBF - WS_UBF) + (size_t)(u.pn >= 8 ? 1 : 0) * (WS_KV - WS_QBF);
        bf16* base = (bf16*)(ws + boff); const int ldc = (u.pn < 8) ? 1024 : 256; const int col0 = (u.pn & 3) * 256 + wc * 32 + 8 * fq;
#pragma unroll
        for (int ai = 0; ai < 2; ++ai)
#pragma unroll
            for (int m = 0; m < 4; ++m) { bf16* rowp = base + (size_t)(row0 + ai * 128 + m * 16) * ldc + col0;
#pragma unroll
                for (int bj = 0; bj < 2; ++bj) { const f32x4 v0 = acc[ai][bj][m][0], v1 = acc[ai][bj][m][1];
                    v4u w; w.x = pk2(v0[0], v0[1]); w.y = pk2(v0[2], v0[3]); w.z = pk2(v1[0], v1[1]); w.w = pk2(v1[2], v1[3]);
                    *(v4u*)(rowp + bj * 128) = w; } }
    }
};
struct EpiBf16Plain {
    static constexpr int PERM = 1;
    bf16* O; int ldc; int col_off; const float* scale;
    __device__ __forceinline__ void operator()(const f32x4 (&acc)[2][2][4][2], const Unit& u, int wr, int wc, int fr, int fq) const {
        const int row0 = u.pm * 256 + wr * 64 + fr, colt = u.pn * 256 + wc * 32 + 8 * fq;
        f32x4 sv[2][2];
#pragma unroll
        for (int bj = 0; bj < 2; ++bj)
#pragma unroll
            for (int n = 0; n < 2; ++n) sv[bj][n] = scale ? *(const f32x4*)(scale + col_off + colt + bj * 128 + 4 * n) : (f32x4){1.f, 1.f, 1.f, 1.f};
#pragma unroll
        for (int ai = 0; ai < 2; ++ai)
#pragma unroll
            for (int m = 0; m < 4; ++m) { bf16* rowp = O + (size_t)(row0 + ai * 128 + m * 16) * ldc + col_off + colt;
#pragma unroll
                for (int bj = 0; bj < 2; ++bj) { const f32x4 v0 = acc[ai][bj][m][0] * sv[bj][0], v1 = acc[ai][bj][m][1] * sv[bj][1];
                    v4u w; w.x = pk2(v0[0], v0[1]); w.y = pk2(v0[2], v0[3]); w.z = pk2(v1[0], v1[1]); w.w = pk2(v1[2], v1[3]);
                    *(v4u*)(rowp + bj * 128) = w; } }
    }
};
struct EpiResF32 {
    static constexpr int PERM = 0;
    const float* base; float* C;
    __device__ __forceinline__ void operator()(const f32x4 (&acc)[2][2][4][2], const Unit& u, int wr, int wc, int fr, int fq) const {
        const int row0 = u.pm * 256 + wr * 64 + fr, col0 = u.pn * 256 + wc * 32 + 4 * fq;
#pragma unroll
        for (int ai = 0; ai < 2; ++ai)
#pragma unroll
            for (int mp = 0; mp < 2; ++mp) { f32x4 xb[2][2][2];
#pragma unroll
                for (int mm = 0; mm < 2; ++mm) { const size_t ro = (size_t)(row0 + ai * 128 + (2 * mp + mm) * 16) * D + col0;
#pragma unroll
                    for (int bj = 0; bj < 2; ++bj)
#pragma unroll
                        for (int n = 0; n < 2; ++n) xb[mm][bj][n] = *(const f32x4*)(base + ro + bj * 128 + n * 16); }
#pragma unroll
                for (int mm = 0; mm < 2; ++mm) { const size_t ro = (size_t)(row0 + ai * 128 + (2 * mp + mm) * 16) * D + col0;
#pragma unroll
                    for (int bj = 0; bj < 2; ++bj)
#pragma unroll
                        for (int n = 0; n < 2; ++n) *(f32x4*)(C + ro + bj * 128 + n * 16) = xb[mm][bj][n] + acc[ai][bj][2 * mp + mm][n]; } }
    }
};
__device__ __forceinline__ float sigmoid_f(float v) { return __builtin_amdgcn_rcpf(1.0f + __expf(-v)); }
__device__ __forceinline__ unsigned pk4_fp8(float a, float b, float c, float d) { int w = 0; w = __builtin_amdgcn_cvt_pk_fp8_f32(a, b, w, false); w = __builtin_amdgcn_cvt_pk_fp8_f32(c, d, w, true); return (unsigned)w; }
typedef float f32x2_ __attribute__((ext_vector_type(2)));
__device__ __forceinline__ void fp8x4_to_f32(unsigned w, float (&o)[4]) { const f32x2_ lo = __builtin_amdgcn_cvt_pk_f32_fp8((int)w, false), hi = __builtin_amdgcn_cvt_pk_f32_fp8((int)w, true); o[0] = lo[0]; o[1] = lo[1]; o[2] = hi[0]; o[3] = hi[1]; }
struct EpiGateUp {
    static constexpr int PERM = 1;
    unsigned char* ACT;
    __device__ __forceinline__ void operator()(const f32x4 (&acc)[2][2][4][2], const Unit& u, int wr, int wc, int fr, int fq) const {
        const int row0 = u.pm * 256 + wr * 64 + fr, col0 = (u.pn & 3) * 128 + wc * 32 + 8 * fq;
        constexpr float IS = 1.0f / SW1;
#pragma unroll
        for (int ai = 0; ai < 2; ++ai) { if (ai == 1 && u.half) break;
#pragma unroll
            for (int m = 0; m < 4; ++m) { float o[8];
#pragma unroll
                for (int n = 0; n < 2; ++n)
#pragma unroll
                    for (int j = 0; j < 4; ++j) { const float gte = acc[ai][0][m][n][j] * IS, up = acc[ai][1][m][n][j] * (IS * SA); o[4 * n + j] = gte * sigmoid_f(gte) * up; }
                v2u w; w.x = pk4_fp8(o[0], o[1], o[2], o[3]); w.y = pk4_fp8(o[4], o[5], o[6], o[7]);
                *(v2u*)(ACT + (size_t)(row0 + ai * 128 + m * 16) * EFF + col0) = w; } }
    }
};
struct EpiDown {
    static constexpr int PERM = 2;
    unsigned char* Y;
    __device__ __forceinline__ void operator()(const f32x4 (&acc)[2][2][4][2], const Unit& u, int wr, int wc, int fr, int fq) const {
        const int row0 = u.pm * 256 + wr * 64 + fr, col0 = (u.pn & 7) * 256 + wc * 64 + 16 * fq;
        constexpr float IS = SY / (SA * SW2);
#pragma unroll
        for (int ai = 0; ai < 2; ++ai) { if (ai == 1 && u.half) break;
#pragma unroll
            for (int m = 0; m < 4; ++m) { const f32x4 v0 = acc[ai][0][m][0] * IS, v1 = acc[ai][0][m][1] * IS, v2 = acc[ai][1][m][0] * IS, v3 = acc[ai][1][m][1] * IS;
                v4u w; w.x = pk4_fp8(v0[0], v0[1], v0[2], v0[3]); w.y = pk4_fp8(v1[0], v1[1], v1[2], v1[3]); w.z = pk4_fp8(v2[0], v2[1], v2[2], v2[3]); w.w = pk4_fp8(v3[0], v3[1], v3[2], v3[3]);
                *(v4u*)(Y + (size_t)(row0 + ai * 128 + m * 16) * D + col0) = w; } }
    }
};
struct EpiBf16Mul {
    static constexpr int PERM = 1;
    bf16* O; float mul;
    __device__ __forceinline__ void operator()(const f32x4 (&acc)[2][2][4][2], const Unit& u, int wr, int wc, int fr, int fq) const {
        const int row0 = u.pm * 256 + wr * 64 + fr, colt = u.pn * 256 + wc * 32 + 8 * fq;
#pragma unroll
        for (int ai = 0; ai < 2; ++ai)
#pragma unroll
            for (int m = 0; m < 4; ++m) { bf16* rowp = O + (size_t)(row0 + ai * 128 + m * 16) * D + colt;
#pragma unroll
                for (int bj = 0; bj < 2; ++bj) { const f32x4 v0 = acc[ai][bj][m][0] * mul, v1 = acc[ai][bj][m][1] * mul;
                    v4u w; w.x = pk2(v0[0], v0[1]); w.y = pk2(v0[2], v0[3]); w.z = pk2(v1[0], v1[1]); w.w = pk2(v1[2], v1[3]);
                    *(v4u*)(rowp + bj * 128) = w; } }
    }
};
struct MoeOrder {
    static constexpr bool HALVES = true;
    const LAS int* tab; const int* toklist; int x, r, npn, stride;
    __device__ __forceinline__ bool next(int i, Unit& u) const {
        const int L = i * stride + r; const int tl = L / npn, pn = L - tl * npn;
        const int nf = tab[TB_XF + 8], ns = tab[TB_SHN], nh = tab[TB_XH + 8];
        if (tl >= nf + ns + nh) return false;
        int e, lt, row0, half = 0;
        if (tl < nf) { int s = 0;
#pragma unroll
            for (int q = 1; q <= 7; ++q) s += (tl >= tab[TB_XF + q]) ? 1 : 0;
            lt = tl - tab[TB_XF + s]; e = x + 8 * s; row0 = tab[TB_PAD + e] + 256 * lt; }
        else if (tl < nf + ns) { lt = tab[TB_SH0] + (tl - nf); e = NE; row0 = SH_ROW0 + 256 * lt; }
        else { const int hi = tl - nf - ns; int s = 0;
#pragma unroll
            for (int q = 1; q <= 7; ++q) s += (hi >= tab[TB_XH + q]) ? 1 : 0;
            e = x + 8 * s; lt = tab[TB_XF + s + 1] - tab[TB_XF + s]; row0 = tab[TB_PAD + e] + 256 * lt; half = 1; }
        u.pm = __builtin_amdgcn_readfirstlane(row0 >> 8); u.pn = __builtin_amdgcn_readfirstlane(e * npn + pn); u.e = __builtin_amdgcn_readfirstlane(e); u.lt = __builtin_amdgcn_readfirstlane(lt);
        u.half = __builtin_amdgcn_readfirstlane(half); return true;
    }
    __device__ __forceinline__ int arow(const Unit& u, int r_) const {
        const int lr = u.lt * 256 + r_;
        const int ee = (u.e < NE) ? u.e : 0;
        const int tk = toklist[(size_t)ee * T + (lr < T - 1 ? lr : T - 1)];
        return (u.e == NE) ? lr : ((lr < tab[TB_CNT + ee]) ? tk : 0);
    }
};
__device__ __forceinline__ void moe_tables(Frame& F) {
    const int LANE_ = pg8::lane_id(), TID_ = F.wave * 64 + LANE_; (void)TID_;
    LAS int* tab = (LAS int*)(F.lds + TAB_OFF);
    const int x = F.bx & 7;
    if (F.wave == 0) {
        const int e = LANE_, c = (int)__hip_atomic_load(F.ctl + CW_CNT + 32 * e, RLX_AGENT), nt = (c + 255) >> 8;
        const int hf = (nt > 0 && (c - ((nt - 1) << 8)) <= 128) ? 1 : 0, fl = nt - hf;
        tab[TB_CNT + e] = c; if (e == 0) tab[TB_CNT + NE] = T;
        int inc = nt << 8;
#pragma unroll
        for (int o = 1; o < 64; o <<= 1) { const int v = __shfl_up(inc, o); inc += (e >= o) ? v : 0; }
        tab[TB_PAD + e] = inc - (nt << 8); if (e == 63) tab[TB_PAD + NE] = inc;
        int ld = 2 * fl + hf;
        ld += __shfl_xor(ld, 8); ld += __shfl_xor(ld, 16); ld += __shfl_xor(ld, 32);
        int cf = fl, ch = hf;
#pragma unroll
        for (int o = 8; o < 64; o <<= 1) { const int vf = __shfl_up(cf, o), vh = __shfl_up(ch, o); cf += (e >= o) ? vf : 0; ch += (e >= o) ? vh : 0; }
        if ((e & 7) == x) { tab[TB_XF + (e >> 3) + 1] = cf; tab[TB_XH + (e >> 3) + 1] = ch; }
        if (e == 0) { tab[TB_XF] = 0; tab[TB_XH] = 0; }
        int load[8], nsh[8];
#pragma unroll
        for (int l = 0; l < 8; ++l) { load[l] = __shfl(ld, l); nsh[l] = 0; }
        for (int j = 0; j < 32; ++j) { int best = 0, bl = load[0];
#pragma unroll
            for (int l = 1; l < 8; ++l) { const bool lt_ = load[l] < bl; best = lt_ ? l : best; bl = lt_ ? load[l] : bl; }
#pragma unroll
            for (int l = 0; l < 8; ++l) { nsh[l] += (l == best) ? 1 : 0; load[l] += (l == best) ? 2 : 0; } }
        int s0 = 0, sn = 0;
#pragma unroll
        for (int l = 0; l < 8; ++l) { s0 += (l < x) ? nsh[l] : 0; sn = (l == x) ? nsh[l] : sn; }
        if (e == 0) { tab[TB_SH0] = s0; tab[TB_SHN] = sn; }
    }
    __syncthreads();
}
struct ConvJob { const float* src; bf16* dst; int N, ldk, mode, item; };
struct ConvJob8 { const float* src; unsigned char* dst; int N, ldk, mode, item; float scale; };
__device__ __forceinline__ void conv8_load(const ConvJob8& j, int lane, f32x4 (&v)[16]) {
    const int nblk = j.N >> 5, kb = j.item / nblk, nb = j.item - kb * nblk, k0 = 128 * kb, n0 = 32 * nb;
    const float* src = j.src + (size_t)(k0 + 16 * (lane >> 3)) * j.N + n0 + 4 * (lane & 7);
#pragma unroll
    for (int i = 0; i < 16; ++i) v[i] = __builtin_nontemporal_load((const f32x4*)(src + (size_t)i * j.N));
}
__device__ __forceinline__ void conv8_store(const ConvJob8& j, int lane, const f32x4 (&v)[16]) {
    const int nblk = j.N >> 5, kb = j.item / nblk, nb = j.item - kb * nblk, k0 = 128 * kb, n0 = 32 * nb; const float scale = j.scale;
#pragma unroll
    for (int q = 0; q < 4; ++q) { const int n = n0 + 4 * (lane & 7) + q; int dr = n;
        if (j.mode == 5) dr = ((n >> 7) << 8) + (n & 127); else if (j.mode == 6) dr = ((n >> 7) << 8) + 128 + (n & 127);
        v4u o; o.x = pk4_fp8(v[0][q] * scale, v[1][q] * scale, v[2][q] * scale, v[3][q] * scale); o.y = pk4_fp8(v[4][q] * scale, v[5][q] * scale, v[6][q] * scale, v[7][q] * scale);
        o.z = pk4_fp8(v[8][q] * scale, v[9][q] * scale, v[10][q] * scale, v[11][q] * scale); o.w = pk4_fp8(v[12][q] * scale, v[13][q] * scale, v[14][q] * scale, v[15][q] * scale);
        __builtin_nontemporal_store(o, (v4u*)(j.dst + (size_t)dr * j.ldk + k0 + 16 * (lane >> 3))); }
}
__device__ __forceinline__ void conv_load(const ConvJob& j, int lane, f32x4 (&v)[8]) {
    const int nblk = j.N >> 5, kb = j.item / nblk, nb = j.item - kb * nblk, k0 = 64 * kb, n0 = 32 * nb;
    const float* src = j.src + (size_t)(k0 + 8 * (lane >> 3)) * j.N + n0 + 4 * (lane & 7);
#pragma unroll
    for (int i = 0; i < 8; ++i) v[i] = __builtin_nontemporal_load((const f32x4*)(src + (size_t)i * j.N));
}
__device__ __forceinline__ void conv_store(const ConvJob& j, int lane, const f32x4 (&v)[8]) {
    const int nblk = j.N >> 5, kb = j.item / nblk, nb = j.item - kb * nblk, k0 = 64 * kb, n0 = 32 * nb;
#pragma unroll
    for (int q = 0; q < 4; ++q) { const int n = n0 + 4 * (lane & 7) + q; int dr = n;
        if (j.mode == 1) dr = ((n >> 7) << 8) + (n & 127); else if (j.mode == 2) dr = ((n >> 7) << 8) + 128 + (n & 127);
        v4u o; o.x = pk2(v[0][q], v[1][q]); o.y = pk2(v[2][q], v[3][q]); o.z = pk2(v[4][q], v[5][q]); o.w = pk2(v[6][q], v[7][q]);
        *(v4u*)(j.dst + (size_t)dr * j.ldk + k0 + 8 * (lane >> 3)) = o; }
}
__device__ __forceinline__ void rms_row_to_bf16(const float* xrow, const float* g, bf16* orow, int lane) {
    f32x4 v[8]; float s = 0.f;
#pragma unroll
    for (int j = 0; j < 4; ++j) { v[2 * j] = *(const f32x4*)(xrow + 512 * j + 8 * lane); v[2 * j + 1] = *(const f32x4*)(xrow + 512 * j + 8 * lane + 4); }
#pragma unroll
    for (int j = 0; j < 8; ++j) s += (v[j][0] * v[j][0] + v[j][1] * v[j][1]) + (v[j][2] * v[j][2] + v[j][3] * v[j][3]);
    const float rstd = 1.0f / sqrtf(wave_sum(s) * (1.0f / D) + EPS);
#pragma unroll
    for (int j = 0; j < 4; ++j) { const f32x4 g0 = *(const f32x4*)(g + 512 * j + 8 * lane), g1 = *(const f32x4*)(g + 512 * j + 8 * lane + 4);
        const f32x4 a = v[2 * j] * rstd * g0, b = v[2 * j + 1] * rstd * g1;
        v4u o; o.x = pk2(a[0], a[1]); o.y = pk2(a[2], a[3]); o.z = pk2(b[0], b[1]); o.w = pk2(b[2], b[3]);
        *(v4u*)(orow + 512 * j + 8 * lane) = o; }
}
constexpr int CV_G1 = (D / 128) * (EFF / 32), CV_D1 = (EFF / 128) * (D / 32), CV_G = 65 * CV_G1, CV_DN = 65 * CV_D1, CV_PG = (D / 128) * (D / 32), CV_TOTAL = 2 * CV_G + CV_DN + CV_PG;
constexpr int CONV_B = 896 * 16, CONV_C = 1024 * 20, CONV_A = CV_TOTAL - CONV_B - CONV_C;
__device__ __forceinline__ ConvJob8 conv8_decode(Frame& F, int it) {
    unsigned char* WGU8 = F.ws + WS_WGU; unsigned char* WDN8 = F.ws + WS_WD;
    int r = it;
    if (r < CV_G) { const int e = r / CV_G1, li = r - e * CV_G1; const float* src = (e < NE) ? fin(F, I_WGATE) + (size_t)e * D * EFF : fin(F, I_WSGATE);
        return ConvJob8{src, WGU8 + (size_t)e * 1024 * D, EFF, D, 5, li, SW1}; } r -= CV_G;
    if (r < CV_G) { const int e = r / CV_G1, li = r - e * CV_G1; const float* src = (e < NE) ? fin(F, I_WUP) + (size_t)e * D * EFF : fin(F, I_WSUP);
        return ConvJob8{src, WGU8 + (size_t)e * 1024 * D, EFF, D, 6, li, SW1}; } r -= CV_G;
    if (r < CV_DN) { const int e = r / CV_D1, li = r - e * CV_D1; const float* src = (e < NE) ? fin(F, I_WDOWN) + (size_t)e * EFF * D : fin(F, I_WSDOWN);
        return ConvJob8{src, WDN8 + (size_t)e * D * EFF, D, EFF, 4, li, SW2}; } r -= CV_DN;
    return ConvJob8{fin(F, I_WPLEGATE), F.ws + WS_WPG, D, D, 4, r, SW3};
}
__device__ __forceinline__ void conv_fp8_items(Frame& F, int lo, int hi, int rank, int nranks) {
    const int LANE_ = pg8::lane_id();
    int it0 = lo + rank; if (it0 >= hi) return;
    f32x4 va[16], vb[16];
    ConvJob8 j0 = conv8_decode(F, it0), j1 = j0; conv8_load(j0, LANE_, va);
    for (;;) {
        const int it1 = it0 + nranks; const bool has1 = it1 < hi;
        if (has1) { j1 = conv8_decode(F, it1); conv8_load(j1, LANE_, vb); }
        conv8_store(j0, LANE_, va);
        if (!has1) break;
        it0 = it1 + nranks; const bool has0 = it0 < hi;
        if (has0) { j0 = conv8_decode(F, it0); conv8_load(j0, LANE_, va); }
        conv8_store(j1, LANE_, vb);
        if (!has0) break;
    }
}
constexpr int SEG_N0 = 14000, SEG_N1 = 16000, SEG_N2 = CV_TOTAL - SEG_N0 - SEG_N1;
static_assert(SEG_N0 % 8 == 0 && SEG_N1 % 8 == 0 && SEG_N2 % 8 == 0 && SEG_N2 > 0, "queue segments");
__device__ __forceinline__ void conv_dyn(Frame& F, int seg) {
    const int LANE_ = pg8::lane_id(); const bool t0 = (F.wave == 0 && LANE_ == 0);
    const int x = F.bx & 7;
    const int segn = (seg == 0 ? SEG_N0 : (seg == 1 ? SEG_N1 : SEG_N2)) / 8, lo = (seg == 0 ? 0 : (seg == 1 ? SEG_N0 : SEG_N0 + SEG_N1)) + x * segn;
    gu32* ctr = F.ctl + CW_CONVQ + 32 * (seg * 8 + x);
    volatile LAS unsigned* Q = F.MISC + 16;
    LDS_BARRIER();
    if (t0) { const unsigned a = __hip_atomic_fetch_add(ctr, 8u, RLX_AGENT), b = __hip_atomic_fetch_add(ctr, 8u, RLX_AGENT); Q[0] = a; Q[1] = b; }
    LDS_BARRIER();
    int c0 = __builtin_amdgcn_readfirstlane((int)Q[0]), c1 = __builtin_amdgcn_readfirstlane((int)Q[1]);
    f32x4 va[16], vb[16]; ConvJob8 ja, jb;
    bool ha = (c0 + F.wave) < segn, hb = false;
    ja = conv8_decode(F, lo + (ha ? c0 + F.wave : 0)); jb = ja;
    if (ha) conv8_load(ja, LANE_, va);
    for (;;) {
        unsigned vn = 0u; if (t0) vn = __hip_atomic_fetch_add(ctr, 8u, RLX_AGENT);
        hb = (c1 + F.wave) < segn; if (hb) { jb = conv8_decode(F, lo + c1 + F.wave); conv8_load(jb, LANE_, vb); }
        if (ha) conv8_store(ja, LANE_, va);
        if (c0 >= segn) break;
        LDS_BARRIER(); if (t0) Q[0] = vn; LDS_BARRIER();
        c0 = __builtin_amdgcn_readfirstlane((int)Q[0]);
        vn = 0u; if (t0) vn = __hip_atomic_fetch_add(ctr, 8u, RLX_AGENT);
        ha = (c0 + F.wave) < segn; if (ha) { ja = conv8_decode(F, lo + c0 + F.wave); conv8_load(ja, LANE_, va); }
        if (hb) conv8_store(jb, LANE_, vb);
        if (c1 >= segn) break;
        LDS_BARRIER(); if (t0) Q[1] = vn; LDS_BARRIER();
        c1 = __builtin_amdgcn_readfirstlane((int)Q[1]);
    }
    LDS_BARRIER();
}
constexpr int WI_G1 = (D / 256) * (EFF / 128), WI_D1 = (EFF / 256) * (D / 128), WI_G = 65 * WI_G1, WI_DN = 65 * WI_D1, WI_PG = (D / 256) * (D / 128), WI_TOTAL = 2 * WI_G + WI_DN + WI_PG;
constexpr int SEGW0 = 1752, SEGW1 = 2000, SEGW2 = WI_TOTAL - SEGW0 - SEGW1;
static_assert(SEGW0 % 8 == 0 && SEGW1 % 8 == 0 && SEGW2 % 8 == 0 && SEGW2 > 0, "queue segments");
struct ConvJobW { const float* src; unsigned char* dst; int N, ldk, mode, k0, n0; float scale; };
__device__ __forceinline__ ConvJobW convw_decode(Frame& F, int it) {
    unsigned char* WGU8 = F.ws + WS_WGU; unsigned char* WDN8 = F.ws + WS_WD;
    int r = it;
    if (r < WI_G) { const int e = r / WI_G1, li = r - e * WI_G1; const float* src = (e < NE) ? fin(F, I_WGATE) + (size_t)e * D * EFF : fin(F, I_WSGATE);
        return ConvJobW{src, WGU8 + (size_t)e * 1024 * D, EFF, D, 5, 256 * (li >> 2), 128 * (li & 3), SW1}; } r -= WI_G;
    if (r < WI_G) { const int e = r / WI_G1, li = r - e * WI_G1; const float* src = (e < NE) ? fin(F, I_WUP) + (size_t)e * D * EFF : fin(F, I_WSUP);
        return ConvJobW{src, WGU8 + (size_t)e * 1024 * D, EFF, D, 6, 256 * (li >> 2), 128 * (li & 3), SW1}; } r -= WI_G;
    if (r < WI_DN) { const int e = r / WI_D1, li = r - e * WI_D1; const float* src = (e < NE) ? fin(F, I_WDOWN) + (size_t)e * EFF * D : fin(F, I_WSDOWN);
        return ConvJobW{src, WDN8 + (size_t)e * D * EFF, D, EFF, 4, 256 * (li >> 4), 128 * (li & 15), SW2}; } r -= WI_DN;
    return ConvJobW{fin(F, I_WPLEGATE), F.ws + WS_WPG, D, D, 4, 256 * (r >> 4), 128 * (r & 15), SW3};
}
__device__ __forceinline__ void conv_wg_dyn(Frame& F, int seg) {
    const int LANE_ = pg8::lane_id(), TID_ = F.wave * 64 + LANE_; const bool t0 = (TID_ == 0);
    const int x = F.bx & 7;
    const int segn = (seg == 0 ? SEGW0 : (seg == 1 ? SEGW1 : SEGW2)) / 8, lo = (seg == 0 ? 0 : (seg == 1 ? SEGW0 : SEGW0 + SEGW1)) + x * segn;
    gu32* ctr = F.ctl + CW_CONVQ + 32 * (seg * 8 + x);
    volatile LAS unsigned* Q = F.MISC + 16;
    LAS unsigned char* TL = F.lds + RING_OFF;
    LDS_BARRIER();
    if (t0) Q[0] = __hip_atomic_fetch_add(ctr, 1u, RLX_AGENT);
    LDS_BARRIER();
    int cur = __builtin_amdgcn_readfirstlane((int)Q[0]);
    if (cur >= segn) return;
    const int hh = LANE_ >> 5, n4 = LANE_ & 31;
    ConvJobW j = convw_decode(F, lo + cur);
    f32x4 v[16];
    { const float* src = j.src + (size_t)(j.k0 + 32 * F.wave + 16 * hh) * j.N + j.n0 + 4 * n4;
#pragma unroll
      for (int i = 0; i < 16; ++i) v[i] = __builtin_nontemporal_load((const f32x4*)(src + (size_t)i * j.N)); }
    for (;;) {
        unsigned vn = 0u; if (t0) vn = __hip_atomic_fetch_add(ctr, 1u, RLX_AGENT);
        { const float sc = j.scale;
#pragma unroll
          for (int g = 0; g < 4; ++g)
#pragma unroll
              for (int q = 0; q < 4; ++q) { const int n = 4 * n4 + q, kd = (8 * F.wave + 4 * hh + g + 4 * (n4 & 15)) & 63;
                  *(LAS unsigned*)(TL + n * 256 + kd * 4) = pk4_fp8(v[4 * g][q] * sc, v[4 * g + 1][q] * sc, v[4 * g + 2][q] * sc, v[4 * g + 3][q] * sc); } }
        if (t0) Q[0] = vn;
        LDS_BARRIER();
        const int nxt = __builtin_amdgcn_readfirstlane((int)Q[0]);
        const ConvJobW jc = j;
        if (nxt < segn) { j = convw_decode(F, lo + nxt);
            const float* src = j.src + (size_t)(j.k0 + 32 * F.wave + 16 * hh) * j.N + j.n0 + 4 * n4;
#pragma unroll
            for (int i = 0; i < 16; ++i) v[i] = __builtin_nontemporal_load((const f32x4*)(src + (size_t)i * j.N)); }
#pragma unroll
        for (int i = 0; i < 4; ++i) { const int id = TID_ + 512 * i, n = id >> 4, c16 = id & 15, kd = (4 * c16 + 4 * ((n >> 2) & 15)) & 63;
            const v4u o = *(const LAS v4u*)(TL + n * 256 + kd * 4);
            const int nn = jc.n0 + n; int dr = nn;
            if (jc.mode == 5) dr = ((nn >> 7) << 8) + (nn & 127); else if (jc.mode == 6) dr = ((nn >> 7) << 8) + 128 + (nn & 127);
            __builtin_nontemporal_store(o, (v4u*)(jc.dst + (size_t)dr * jc.ldk + jc.k0 + 16 * c16)); }
        LDS_BARRIER();
        if (nxt >= segn) break;
    }
}
__device__ __forceinline__ void p0_prologue(Frame& F) {
    const int LANE_ = pg8::lane_id(), TID_ = F.wave * 64 + LANE_; (void)TID_;
    const int gw = F.bx * NWAVES + F.wave, NGW = F.G * NWAVES;
    bf16* WIN = (bf16*)(F.ws + WS_WIN); bf16* WPOOL = (bf16*)(F.ws + WS_WPOOL); bf16* WOUT = (bf16*)(F.ws + WS_WOUT); bf16* WPP = (bf16*)(F.ws + WS_WPP);
    constexpr int I_IN = (D / 64) * (INW / 32), I_PL = 4 * (256 / 64) * (256 / 32), I_OUT = (D / 64) * (D / 32), I_PP = (PLE / 64) * (D / 32), I_PG = (D / 64) * (D / 32);
    constexpr int I_SMALL = I_IN + I_PL + I_OUT + I_PP; (void)I_PG;
    auto decode = [&](int it) -> ConvJob {
        int r = it;
        if (r < I_IN) return ConvJob{fin(F, I_WIN), WIN, INW, D, 0, r}; r -= I_IN;
        if (r < I_PL) { const int gq = r >> 5; return ConvJob{fin(F, I_WPOOL) + (size_t)gq * 65536, WPOOL + (size_t)gq * 65536, 256, 256, 0, r & 31}; } r -= I_PL;
        if (r < I_OUT) return ConvJob{fin(F, I_WOUT), WOUT, D, D, 0, r}; r -= I_OUT;
        return ConvJob{fin(F, I_WPLEPROJ), WPP, D, PLE, 0, r};
    };
    for (int it = gw; it < I_SMALL; it += 2 * NGW) {
        const ConvJob j0 = decode(it); const bool two = (it + NGW) < I_SMALL; const ConvJob j1 = decode(two ? it + NGW : it);
        f32x4 v0[8], v1[8];
        conv_load(j0, LANE_, v0); conv_load(j1, LANE_, v1);
        conv_store(j0, LANE_, v0); if (two) conv_store(j1, LANE_, v1);
    }
    if (F.G != 256) conv_fp8_items(F, 0, CONV_A, gw, NGW);
    { const float* WR = fin(F, I_WROUTER); bf16* WH = (bf16*)(F.ws + WS_WRT); bf16* WL = WH + (size_t)NE * D;
      for (int i = gw * 64 + LANE_; i < NE * (D / 8); i += NGW * 64) { const int e = i & 63, k0 = (i >> 6) * 8; float x[8]; unsigned hh[8], ll[8];
#pragma unroll
          for (int j = 0; j < 8; ++j) x[j] = WR[(size_t)(k0 + j) * NE + e];
#pragma unroll
          for (int j = 0; j < 8; ++j) { hh[j] = pk2(x[j], 0.f) & 0xffffu; ll[j] = pk2(x[j] - bf_lo(hh[j]), 0.f) & 0xffffu; }
          v4u oh, ol; oh.x = hh[0] | (hh[1] << 16); oh.y = hh[2] | (hh[3] << 16); oh.z = hh[4] | (hh[5] << 16); oh.w = hh[6] | (hh[7] << 16);
          ol.x = ll[0] | (ll[1] << 16); ol.y = ll[2] | (ll[3] << 16); ol.z = ll[4] | (ll[5] << 16); ol.w = ll[6] | (ll[7] << 16);
          const size_t fo = ((size_t)((k0 >> 5) * 4 + (e >> 4)) * 16 + (e & 15)) * 32 + (k0 & 31);
          *(v4u*)(WH + fo) = oh; *(v4u*)(WL + fo) = ol; } }
    { const float* P = fin(F, I_P); bf16* PB = (bf16*)(F.ws + WS_PBF);
      for (int i = gw * 64 + LANE_; i < T * PLE / 8; i += NGW * 64) { const f32x4 a = *(const f32x4*)(P + (size_t)i * 8), b = *(const f32x4*)(P + (size_t)i * 8 + 4);
          v4u o; o.x = pk2(a[0], a[1]); o.y = pk2(a[2], a[3]); o.z = pk2(b[0], b[1]); o.w = pk2(b[2], b[3]); *(v4u*)(PB + (size_t)i * 8) = o; } }
    bf16* ABF = (bf16*)(F.ws + WS_ABF);
    { const float* X = fin(F, I_X); const float* gm = fin(F, I_GMIX);
      f32x4 nx[8];
      if (gw < T) {
#pragma unroll
          for (int j = 0; j < 4; ++j) { nx[2 * j] = __builtin_nontemporal_load((const f32x4*)(X + (size_t)gw * D + 512 * j + 8 * LANE_)); nx[2 * j + 1] = __builtin_nontemporal_load((const f32x4*)(X + (size_t)gw * D + 512 * j + 8 * LANE_ + 4)); } }
      for (int m = gw; m < T; m += NGW) {
          f32x4 v[8]; float sq = 0.f;
#pragma unroll
          for (int j = 0; j < 8; ++j) v[j] = nx[j];
          if (m + NGW < T) {
#pragma unroll
              for (int j = 0; j < 4; ++j) { nx[2 * j] = __builtin_nontemporal_load((const f32x4*)(X + (size_t)(m + NGW) * D + 512 * j + 8 * LANE_)); nx[2 * j + 1] = __builtin_nontemporal_load((const f32x4*)(X + (size_t)(m + NGW) * D + 512 * j + 8 * LANE_ + 4)); } }
#pragma unroll
          for (int j = 0; j < 8; ++j) sq += (v[j][0] * v[j][0] + v[j][1] * v[j][1]) + (v[j][2] * v[j][2] + v[j][3] * v[j][3]);
          const float rstd = 1.0f / sqrtf(wave_sum(sq) * (1.0f / D) + EPS);
#pragma unroll
          for (int j = 0; j < 4; ++j) { const f32x4 g0 = *(const f32x4*)(gm + 512 * j + 8 * LANE_), g1 = *(const f32x4*)(gm + 512 * j + 8 * LANE_ + 4);
              const f32x4 a = v[2 * j] * rstd * g0, b = v[2 * j + 1] * rstd * g1;
              v4u o; o.x = pk2(a[0], a[1]); o.y = pk2(a[2], a[3]); o.z = pk2(b[0], b[1]); o.w = pk2(b[2], b[3]);
              *(v4u*)(ABF + (size_t)m * D + 512 * j + 8 * LANE_) = o; } } }
    if (F.G == 256) conv_wg_dyn(F, 0);
}

__device__ __forceinline__ int t5_bucket(int n) {
    if (n < 16) return n;
    const int large = 16 + (int)(logf((float)n * (1.0f / 16.0f)) / logf(8.0f) * 16.0f);
    return large < 31 ? large : 31;
}
constexpr int VT_LD = 216, VT_KEYS = 208, KT_LD = 72;
constexpr int ATT_KT_OFF = 0, ATT_VT_OFF = VT_KEYS * KT_LD * 2;
__device__ __forceinline__ void attn_task(Frame& F, const LAS float* btab, const LAS bf16* ktl, const LAS bf16* vtl, int b, int kvh, int hg, int qt, const bf16x8 (&qf)[2]) {
    const int LANE_ = pg8::lane_id();
    bf16* MIX = (bf16*)(F.ws + WS_MIX);
    const int lane = LANE_, qi = lane & 15, g = lane >> 4, h = kvh * 8 + hg;
    const int q0 = qt * 16, tok0 = b * SEQ, kl0 = 16 * (qt & 3);
    f32x4 s[5][2];
#pragma unroll
    for (int kb = 0; kb < 5; ++kb)
#pragma unroll
        for (int t = 0; t < 2; ++t) {
            const LAS bf16* kp = ktl + (kl0 + 32 * kb + 16 * t + qi) * KT_LD + 8 * g;
            const bf16x8 k0f = *(const LAS bf16x8*)(kp), k1f = *(const LAS bf16x8*)(kp + 32);
            f32x4 a = (f32x4){0.f, 0.f, 0.f, 0.f};
            a = __builtin_amdgcn_mfma_f32_16x16x32_bf16(k0f, qf[0], a, 0, 0, 0);
            a = __builtin_amdgcn_mfma_f32_16x16x32_bf16(k1f, qf[1], a, 0, 0, 0);
            s[kb][t] = a;
        }
    const float sink = fin(F, I_SINKS)[h];
    const LAS float* bt = btab + hg * 128;
    float mx = sink;
#pragma unroll
    for (int kb = 0; kb < 5; ++kb)
#pragma unroll
        for (int t = 0; t < 2; ++t)
#pragma unroll
            for (int r = 0; r < 4; ++r) {
                const int key = q0 - 128 + 32 * kb + 16 * t + 4 * g + r, dist = q0 + qi - key;
                const bool valid = (dist >= 0) && (dist < 128) && (key >= 0);
                const float lg = valid ? s[kb][t][r] * 0.125f + bt[dist & 127] : -3.0e38f;
                s[kb][t][r] = lg; mx = fmaxf(mx, lg);
            }
    mx = fmaxf(mx, __shfl_xor(mx, 16)); mx = fmaxf(mx, __shfl_xor(mx, 32));
    float sum = 0.f;
#pragma unroll
    for (int kb = 0; kb < 5; ++kb)
#pragma unroll
        for (int t = 0; t < 2; ++t)
#pragma unroll
            for (int r = 0; r < 4; ++r) { const float lg = s[kb][t][r]; const float p = (lg > -1.0e38f) ? __expf(lg - mx) : 0.f; s[kb][t][r] = p; sum += p; }
    sum += __shfl_xor(sum, 16); sum += __shfl_xor(sum, 32);
    const float inv = 1.0f / (sum + __expf(sink - mx));
    f32x4 o[4];
#pragma unroll
    for (int dt = 0; dt < 4; ++dt) o[dt] = (f32x4){0.f, 0.f, 0.f, 0.f};
#pragma unroll
    for (int kb = 0; kb < 5; ++kb) {
        v4u pw; pw.x = pk2(s[kb][0][0], s[kb][0][1]); pw.y = pk2(s[kb][0][2], s[kb][0][3]); pw.z = pk2(s[kb][1][0], s[kb][1][1]); pw.w = pk2(s[kb][1][2], s[kb][1][3]);
        const bf16x8 pf = __builtin_bit_cast(bf16x8, pw);
        const int kkl = kl0 + 32 * kb + 4 * g;
#pragma unroll
        for (int dt = 0; dt < 4; ++dt) {
            const LAS bf16* vp = vtl + (16 * dt + qi) * VT_LD + kkl;
            const v2u lo = *(const LAS v2u*)(vp), hi = *(const LAS v2u*)(vp + 16);
            const v4u vw = (v4u){lo.x, lo.y, hi.x, hi.y};
            o[dt] = __builtin_amdgcn_mfma_f32_16x16x32_bf16(__builtin_bit_cast(bf16x8, vw), pf, o[dt], 0, 0, 0);
        }
    }
    bf16* op = MIX + (size_t)(tok0 + q0 + qi) * D + POOLW + h * 64 + 4 * g;
#pragma unroll
    for (int dt = 0; dt < 4; ++dt) { v2u w; w.x = pk2(o[dt][0] * inv, o[dt][1] * inv); w.y = pk2(o[dt][2] * inv, o[dt][3] * inv); *(v2u*)(op + 16 * dt) = w; }
}
__device__ __forceinline__ void attn_block(Frame& F, int blk, bool fill_btab) {
    const int TID_ = F.wave * 64 + pg8::lane_id();
    LAS float* btab = (LAS float*)(F.lds + TAB_OFF + 2048);
    LAS bf16* ktl = (LAS bf16*)(F.lds + RING_OFF + ATT_KT_OFF); LAS bf16* vtl = (LAS bf16*)(F.lds + RING_OFF + ATT_VT_OFF);
    const int b = blk >> 6, kvh = (blk >> 5) & 1, qg = blk & 31;
    const bf16* Q = (const bf16*)(F.ws + WS_QBF); const bf16* KVp = (const bf16*)(F.ws + WS_KV);
    const bf16* qbase = Q + (size_t)(b * SEQ + 64 * qg + ((TID_ & 63) & 15)) * 1024 + (kvh * 8 + F.wave) * 64 + 8 * ((TID_ & 63) >> 4);
    bf16x8 qc[2], qn[2];
    qc[0] = *(const bf16x8*)(qbase); qc[1] = *(const bf16x8*)(qbase + 32);
    v4u kv[4], vv[4];
#pragma unroll
    for (int it = 0; it < 4; ++it) { const int idx = TID_ + it * NWAVES * 64, kl = idx >> 3, c = idx & 7, key = 64 * qg - 128 + kl;
        kv[it] = (v4u){0u, 0u, 0u, 0u}; vv[it] = (v4u){0u, 0u, 0u, 0u};
        if (idx < VT_KEYS * 8 && key >= 0 && key < SEQ) { const bf16* rp = KVp + (size_t)(b * SEQ + key) * (2 * KVW) + kvh * 64 + 8 * c; kv[it] = *(const v4u*)(rp); vv[it] = *(const v4u*)(rp + KVW); } }
    LDS_BARRIER();
    if (fill_btab) for (int i = TID_; i < 1024; i += NWAVES * 64) { const int hg = i >> 7, dist = i & 127; btab[i] = fin(F, I_RPE)[t5_bucket(dist) * NH + kvh * 8 + hg]; }
#pragma unroll
    for (int it = 0; it < 4; ++it) { const int idx = TID_ + it * NWAVES * 64, kl = idx >> 3, c = idx & 7;
        if (idx < VT_KEYS * 8) { const v4u v = vv[it];
            *(LAS v4u*)(ktl + kl * KT_LD + 8 * c) = kv[it];
            LAS bf16* d0 = vtl + (8 * c) * VT_LD + kl;
            d0[0 * VT_LD] = (bf16)(v.x & 0xffffu); d0[1 * VT_LD] = (bf16)(v.x >> 16); d0[2 * VT_LD] = (bf16)(v.y & 0xffffu); d0[3 * VT_LD] = (bf16)(v.y >> 16);
            d0[4 * VT_LD] = (bf16)(v.z & 0xffffu); d0[5 * VT_LD] = (bf16)(v.z >> 16); d0[6 * VT_LD] = (bf16)(v.w & 0xffffu); d0[7 * VT_LD] = (bf16)(v.w >> 16); } }
    LDS_BARRIER();
#pragma unroll 1
    for (int i = 0; i < 4; ++i) {
        const bf16* qb2 = qbase + (size_t)((i < 3 ? i + 1 : i) * 16) * 1024;
        qn[0] = *(const bf16x8*)(qb2); qn[1] = *(const bf16x8*)(qb2 + 32);
        attn_task(F, btab, ktl, vtl, b, kvh, F.wave, 4 * qg + i, qc);
        qc[0] = qn[0]; qc[1] = qn[1];
    }
}
__device__ __forceinline__ void pool_task(Frame& F, int mt, int gq) {
    const int LANE_ = pg8::lane_id(), TID_ = F.wave * 64 + LANE_;
    const bf16* U = (const bf16*)(F.ws + WS_UBF); bf16* PO = (bf16*)(F.ws + WS_POOLED);
    LAS v4u* UL = (LAS v4u*)(F.lds + RING_OFF);
    const int w = 2 << gq;
    for (int hh = 0; hh < 2; ++hh) {
        const int tbase = mt * 256 + 128 * hh, pos0 = tbase & (SEQ - 1);
        LDS_BARRIER();
        for (int idx = TID_; idx < 143 * 32; idx += NWAVES * 64) { const int r = idx >> 5, c = idx & 31;
            v4u x = (v4u){0u, 0u, 0u, 0u}; if (pos0 - 15 + r >= 0) x = *(const v4u*)(U + (size_t)(tbase - 15 + r) * POOLW + gq * 256 + 8 * c);
            UL[idx] = x; }
        LDS_BARRIER();
        const int c = TID_ & 31, i0 = (TID_ >> 5) * 8;
        float run[8];
#pragma unroll
        for (int q = 0; q < 8; ++q) run[q] = 0.f;
        for (int j = 1; j < w; ++j) { const v4u x = UL[(15 + i0 - j) * 32 + c];
            run[0] += bf_lo(x.x); run[1] += bf_hi(x.x); run[2] += bf_lo(x.y); run[3] += bf_hi(x.y); run[4] += bf_lo(x.z); run[5] += bf_hi(x.z); run[6] += bf_lo(x.w); run[7] += bf_hi(x.w); }
#pragma unroll
        for (int i = 0; i < 8; ++i) {
            const int pos = pos0 + i0 + i; const v4u x = UL[(15 + i0 + i) * 32 + c], y = UL[(15 + i0 + i - w + 1) * 32 + c];
            const float uv[8] = {bf_lo(x.x), bf_hi(x.x), bf_lo(x.y), bf_hi(x.y), bf_lo(x.z), bf_hi(x.z), bf_lo(x.w), bf_hi(x.w)};
            const float ic = 1.0f / (float)((pos + 1) < w ? (pos + 1) : w);
            float o[8];
#pragma unroll
            for (int q = 0; q < 8; ++q) { run[q] += uv[q]; o[q] = run[q] * ic - uv[q]; }
            v4u ow; ow.x = pk2(o[0], o[1]); ow.y = pk2(o[2], o[3]); ow.z = pk2(o[4], o[5]); ow.w = pk2(o[6], o[7]);
            *(v4u*)(PO + (size_t)(tbase + i0 + i) * POOLW + gq * 256 + 8 * c) = ow;
            run[0] -= bf_lo(y.x); run[1] -= bf_hi(y.x); run[2] -= bf_lo(y.y); run[3] -= bf_hi(y.y); run[4] -= bf_lo(y.z); run[5] -= bf_hi(y.z); run[6] -= bf_lo(y.w); run[7] -= bf_hi(y.w);
        }
    }
    VM_WAIT(); __syncthreads();
    pg8::Gemm g{(const bf16*)PO + gq * 256, (const bf16*)(F.ws + WS_WPOOL) + (size_t)gq * 65536, POOLW, 256, 256};
    pg8::SingleOrder S{mt, 0};
    EpiBf16Plain E{(bf16*)(F.ws + WS_MIX), D, gq * 256, fin(F, I_PSCALE)};
    pg8::gemm_phase<EpiBf16Plain, pg8::SingleOrder, false>(F.lds + RING_OFF, g, S, E, F.wave);
}

constexpr int XS_STRIDE = 2052;
constexpr int P4_XS = 0, P4_PART = 16 * XS_STRIDE * 4, P4_SELE = P4_PART + 4 * 16 * 64 * 4, P4_SELW = P4_SELE + 32 * 8 * 4, P4_SELL = P4_SELW + 32 * 8 * 4, P4_HIST = P4_SELL + 32 * 8 * 4, P4_BASE = P4_HIST + 256, P4_END = P4_BASE + 256;
static_assert(P4_END <= MISC_OFF, "P4 LDS map");
__device__ __forceinline__ unsigned fkey(float f) { const unsigned u = __builtin_bit_cast(unsigned, f); return (u & 0x80000000u) ? ~u : (u | 0x80000000u); }
__device__ __forceinline__ void p4_route(Frame& F) {
    const int LANE_ = pg8::lane_id(), TID_ = F.wave * 64 + LANE_; (void)TID_;
    LAS float* XS = (LAS float*)(F.lds + P4_XS); LAS float* PART = (LAS float*)(F.lds + P4_PART);
    LAS int* SELE = (LAS int*)(F.lds + P4_SELE); LAS float* SELW = (LAS float*)(F.lds + P4_SELW); LAS int* SELL = (LAS int*)(F.lds + P4_SELL);
    LAS int* HIST = (LAS int*)(F.lds + P4_HIST); LAS int* BASE = (LAS int*)(F.lds + P4_BASE);
    const float* H1 = (const float*)(F.ws + WS_H1); unsigned char* XN = F.ws + WS_XN; const float* gf = fin(F, I_GFFN); const float* rb = fin(F, I_RBIAS);
    const bf16* WH = (const bf16*)(F.ws + WS_WRT); const bf16* WL = WH + (size_t)NE * D;
    const int lane = LANE_, wave = F.wave, ti = lane & 15, kk = lane >> 4;
    if (TID_ < 64) HIST[TID_] = 0;
    for (int tile = F.bx; tile < T / 32; tile += F.G) {
    f32x4 xr[2][8];
#pragma unroll
    for (int q = 0; q < 2; ++q) { const float* xrow = H1 + (size_t)(tile * 32 + 2 * wave + q) * D;
#pragma unroll
        for (int j = 0; j < 4; ++j) { xr[q][2 * j] = *(const f32x4*)(xrow + 512 * j + 8 * lane); xr[q][2 * j + 1] = *(const f32x4*)(xrow + 512 * j + 8 * lane + 4); } }
#pragma unroll 1
    for (int pass = 0; pass < 2; ++pass) {
#pragma unroll
        for (int q = 0; q < 2; ++q) { const int tl = 2 * wave + q; float s = 0.f;
#pragma unroll
            for (int j = 0; j < 8; ++j) { const f32x4 v = xr[q][j]; s += (v[0] * v[0] + v[1] * v[1]) + (v[2] * v[2] + v[3] * v[3]); }
            const float rstd = 1.0f / sqrtf(wave_sum(s) * (1.0f / D) + EPS);
#pragma unroll
            for (int j = 0; j < 4; ++j) { const f32x4 a = xr[q][2 * j] * rstd * *(const f32x4*)(gf + 512 * j + 8 * lane), b = xr[q][2 * j + 1] * rstd * *(const f32x4*)(gf + 512 * j + 8 * lane + 4);
                *(LAS f32x4*)(XS + tl * XS_STRIDE + 512 * j + 8 * lane) = a; *(LAS f32x4*)(XS + tl * XS_STRIDE + 512 * j + 8 * lane + 4) = b;
                v2u o; o.x = pk4_fp8(a[0], a[1], a[2], a[3]); o.y = pk4_fp8(b[0], b[1], b[2], b[3]);
                *(v2u*)(XN + (size_t)(tile * 32 + 16 * pass + tl) * D + 512 * j + 8 * lane) = o; } }
        if (pass == 0) {
#pragma unroll
            for (int q = 0; q < 2; ++q) { const float* xrow = H1 + (size_t)(tile * 32 + 16 + 2 * wave + q) * D;
#pragma unroll
                for (int j = 0; j < 4; ++j) { xr[q][2 * j] = *(const f32x4*)(xrow + 512 * j + 8 * lane); xr[q][2 * j + 1] = *(const f32x4*)(xrow + 512 * j + 8 * lane + 4); } } }
        f32x4 acc[4];
#pragma unroll
        for (int et = 0; et < 4; ++et) acc[et] = (f32x4){0.f, 0.f, 0.f, 0.f};
        bf16x8 wh0[4], wl0[4], wh1[4], wl1[4];
#define P4_LDW(WHX, WLX, st) do { const size_t fo_ = ((size_t)((8 * wave + (st)) * 4) * 16 + ti) * 32 + 8 * kk; _Pragma("unroll") for (int et = 0; et < 4; ++et) { WHX[et] = *(const bf16x8*)(WH + fo_ + et * 512); WLX[et] = *(const bf16x8*)(WL + fo_ + et * 512); } } while (0)
#define P4_STEP(WHX, WLX, st) do { const int k0_ = 256 * wave + 32 * (st) + 8 * kk; \
            const f32x4 xa = *(const LAS f32x4*)(XS + ti * XS_STRIDE + k0_), xb = *(const LAS f32x4*)(XS + ti * XS_STRIDE + k0_ + 4); v4u hw, lw; \
            hw.x = pk2(xa[0], xa[1]); hw.y = pk2(xa[2], xa[3]); hw.z = pk2(xb[0], xb[1]); hw.w = pk2(xb[2], xb[3]); \
            lw.x = pk2(xa[0] - bf_lo(hw.x), xa[1] - bf_hi(hw.x)); lw.y = pk2(xa[2] - bf_lo(hw.y), xa[3] - bf_hi(hw.y)); lw.z = pk2(xb[0] - bf_lo(hw.z), xb[1] - bf_hi(hw.z)); lw.w = pk2(xb[2] - bf_lo(hw.w), xb[3] - bf_hi(hw.w)); \
            const bf16x8 xh = __builtin_bit_cast(bf16x8, hw), xl = __builtin_bit_cast(bf16x8, lw); \
            _Pragma("unroll") for (int et = 0; et < 4; ++et) { acc[et] = __builtin_amdgcn_mfma_f32_16x16x32_bf16(xh, WHX[et], acc[et], 0, 0, 0); \
                acc[et] = __builtin_amdgcn_mfma_f32_16x16x32_bf16(xl, WHX[et], acc[et], 0, 0, 0); acc[et] = __builtin_amdgcn_mfma_f32_16x16x32_bf16(xh, WLX[et], acc[et], 0, 0, 0); } } while (0)
        P4_LDW(wh0, wl0, 0);
        LDS_BARRIER();
#pragma unroll 1
        for (int st = 0; st < 8; st += 2) { P4_LDW(wh1, wl1, st + 1); P4_STEP(wh0, wl0, st); if (st + 2 < 8) P4_LDW(wh0, wl0, st + 2); P4_STEP(wh1, wl1, st + 1); }
#undef P4_LDW
#undef P4_STEP
        if (wave >= 4) {
#pragma unroll
            for (int et = 0; et < 4; ++et)
#pragma unroll
                for (int r = 0; r < 4; ++r) PART[(wave - 4) * 1024 + (4 * kk + r) * 64 + 16 * et + ti] = acc[et][r];
        }
        LDS_BARRIER();
        if (wave < 4) {
#pragma unroll
            for (int et = 0; et < 4; ++et)
#pragma unroll
                for (int r = 0; r < 4; ++r) { LAS float* pp = PART + wave * 1024 + (4 * kk + r) * 64 + 16 * et + ti; *pp = *pp + acc[et][r]; }
        }
        LDS_BARRIER();
#pragma unroll 1
        for (int q = 0; q < 2; ++q) {
            const int tl = 2 * wave + q, tw = pass * 16 + tl;
            const float lg = (PART[tl * 64 + lane] + PART[1024 + tl * 64 + lane]) + (PART[2048 + tl * 64 + lane] + PART[3072 + tl * 64 + lane]);
            const float score = 1.0f / (1.0f + expf(-lg)), biased = score + rb[lane];
            const int grp = lane >> 3;
            float m1 = biased; m1 = fmaxf(m1, __shfl_xor(m1, 1)); m1 = fmaxf(m1, __shfl_xor(m1, 2)); m1 = fmaxf(m1, __shfl_xor(m1, 4));
            const unsigned long long bm = __ballot(biased == m1); const unsigned gb = (unsigned)(bm >> (8 * grp)) & 0xffu; const int first = __builtin_ctz(gb);
            float v2 = ((lane & 7) == first) ? -3.0e38f : biased; float m2 = v2; m2 = fmaxf(m2, __shfl_xor(m2, 1)); m2 = fmaxf(m2, __shfl_xor(m2, 2)); m2 = fmaxf(m2, __shfl_xor(m2, 4));
            const unsigned gk = (fkey(m1 + m2) & ~7u) | (unsigned)(7 - grp);
            int grank = 0;
#pragma unroll
            for (int j = 0; j < 8; ++j) { const unsigned sj = (unsigned)__builtin_amdgcn_readlane((int)gk, 8 * j); grank += (sj > gk) ? 1 : 0; }
            const bool gsel = grank < 4;
            const unsigned key = gsel ? ((fkey(biased) & ~63u) | (unsigned)(63 - lane)) : (unsigned)(63 - lane);
            int rank = 0;
#pragma unroll
            for (int j = 0; j < 64; ++j) { const unsigned sj = (unsigned)__builtin_amdgcn_readlane((int)key, j); rank += (sj > key) ? 1 : 0; }
            const bool sel = gsel && (rank < 8);
            const float wsum = wave_sum(sel ? score : 0.f);
            const unsigned long long sm = __ballot(sel);
            if (sel) { const int k = __popcll(sm & ((1ull << lane) - 1ull)); const int li = atomicAdd((int*)&HIST[lane], 1);
                SELE[tw * 8 + k] = lane; SELW[tw * 8 + k] = score / wsum * 2.5f; SELL[tw * 8 + k] = li; }
        }
        LDS_BARRIER();
    }
    if (TID_ < 64) BASE[TID_] = (int)__hip_atomic_fetch_add(F.ctl + CW_CNT + 32 * TID_, (unsigned)HIST[TID_], RLX_AGENT);
    LDS_BARRIER();
    if (TID_ < 256) { const int e = SELE[TID_], pos = BASE[e] + SELL[TID_], tok = tile * 32 + (TID_ >> 3);
        ((int*)(F.ws + WS_TOKLIST))[(size_t)e * T + pos] = tok; ((float*)(F.ws + WS_WREC))[tok * 8 + (TID_ & 7)] = SELW[TID_]; ((int*)(F.ws + WS_REC))[tok * 8 + (TID_ & 7)] = e * T + pos; }
    LDS_BARRIER();
    if (TID_ < 64) HIST[TID_] = 0;
    LDS_BARRIER();
    }
}

__device__ __forceinline__ void p7_combine(Frame& F, bool dry) {
    const int LANE_ = pg8::lane_id();
    const LAS int* tab = (const LAS int*)(F.lds + TAB_OFF);
    const unsigned char* Y = F.ws + WS_Y; const int* rec = (const int*)(F.ws + WS_REC); const float* wrec = (const float*)(F.ws + WS_WREC);
    const float* H = (const float*)(F.ws + WS_H1); bf16* HO = dry ? (bf16*)(F.ws + WS_WGU) : (bf16*)(F.ws + WS_H2B); unsigned char* H2 = dry ? (F.ws + WS_WGU + 64 * MiB) : (F.ws + WS_H2F8);
    const int gw = F.bx * NWAVES + F.wave, NGW = F.G * NWAVES, lane = LANE_;
    for (int t = gw; t < T; t += NGW) {
        int rows[9]; float rwt[9];
#pragma unroll
        for (int k = 0; k < 8; ++k) { const int rc = rec[t * 8 + k]; const int e = rc >> 13, pos = rc & (T - 1); rows[k] = tab[TB_PAD + e] + pos; rwt[k] = wrec[t * 8 + k] * (1.0f / SY); }
        rows[8] = SH_ROW0 + t; rwt[8] = 1.0f / SY;
        v4u y[2][9]; f32x4 h[2][4];
#pragma unroll
        for (int j = 0; j < 2; ++j) { const int c0 = 1024 * j + 16 * lane;
#pragma unroll
            for (int q = 0; q < 4; ++q) h[j][q] = *(const f32x4*)(H + (size_t)t * D + c0 + 4 * q);
#pragma unroll
            for (int k = 0; k < 9; ++k) y[j][k] = *(const v4u*)(Y + (size_t)rows[k] * D + c0); }
#pragma unroll
        for (int j = 0; j < 2; ++j) { const int c0 = 1024 * j + 16 * lane;
#pragma unroll
            for (int k = 0; k < 9; ++k) { const float w = rwt[k]; float f[4];
                fp8x4_to_f32(y[j][k].x, f); h[j][0][0] += w * f[0]; h[j][0][1] += w * f[1]; h[j][0][2] += w * f[2]; h[j][0][3] += w * f[3];
                fp8x4_to_f32(y[j][k].y, f); h[j][1][0] += w * f[0]; h[j][1][1] += w * f[1]; h[j][1][2] += w * f[2]; h[j][1][3] += w * f[3];
                fp8x4_to_f32(y[j][k].z, f); h[j][2][0] += w * f[0]; h[j][2][1] += w * f[1]; h[j][2][2] += w * f[2]; h[j][2][3] += w * f[3];
                fp8x4_to_f32(y[j][k].w, f); h[j][3][0] += w * f[0]; h[j][3][1] += w * f[1]; h[j][3][2] += w * f[2]; h[j][3][3] += w * f[3]; }
            { v4u b0, b1; b0.x = pk2(h[j][0][0], h[j][0][1]); b0.y = pk2(h[j][0][2], h[j][0][3]); b0.z = pk2(h[j][1][0], h[j][1][1]); b0.w = pk2(h[j][1][2], h[j][1][3]);
              b1.x = pk2(h[j][2][0], h[j][2][1]); b1.y = pk2(h[j][2][2], h[j][2][3]); b1.z = pk2(h[j][3][0], h[j][3][1]); b1.w = pk2(h[j][3][2], h[j][3][3]);
              *(v4u*)(HO + (size_t)t * D + c0) = b0; *(v4u*)(HO + (size_t)t * D + c0 + 8) = b1; }
            v4u o; o.x = pk4_fp8(h[j][0][0], h[j][0][1], h[j][0][2], h[j][0][3]); o.y = pk4_fp8(h[j][1][0], h[j][1][1], h[j][1][2], h[j][1][3]);
            o.z = pk4_fp8(h[j][2][0], h[j][2][1], h[j][2][2], h[j][2][3]); o.w = pk4_fp8(h[j][3][0], h[j][3][1], h[j][3][2], h[j][3][3]);
            *(v4u*)(H2 + (size_t)t * D + c0) = o; }
    }
}
__device__ __forceinline__ void p9_final(Frame& F, bool dry) {
    const int LANE_ = pg8::lane_id();
    const int gw = F.bx * NWAVES + F.wave, NGW = F.G * NWAVES, lane = LANE_; const float* g = fin(F, I_GFINAL); const float* gp = fin(F, I_GPLE);
    const bf16* G = (const bf16*)(F.ws + WS_GBUF); const bf16* PP = (const bf16*)(F.ws + WS_PPROJ); const bf16* H2 = (const bf16*)(F.ws + WS_H2B);
    v4u hq[4], gq[4], pq[4];
    if (gw < T) {
#pragma unroll
        for (int j = 0; j < 4; ++j) { const size_t o = (size_t)gw * D + 512 * j + 8 * lane; hq[j] = *(const v4u*)(H2 + o); gq[j] = *(const v4u*)(G + o); pq[j] = *(const v4u*)(PP + o); } }
    for (int t = gw; t < T; t += NGW) {
        float* orow = (dry ? (float*)(F.ws + WS_WGU) : F.out) + (size_t)t * D; f32x4 v[8]; v4u gg[4], pw[4];
#pragma unroll
        for (int j = 0; j < 4; ++j) { const v4u hw = hq[j];
            v[2 * j] = (f32x4){bf_lo(hw.x), bf_hi(hw.x), bf_lo(hw.y), bf_hi(hw.y)}; v[2 * j + 1] = (f32x4){bf_lo(hw.z), bf_hi(hw.z), bf_lo(hw.w), bf_hi(hw.w)};
            gg[j] = gq[j]; pw[j] = pq[j]; }
        if (t + NGW < T) {
#pragma unroll
            for (int j = 0; j < 4; ++j) { const size_t o = (size_t)(t + NGW) * D + 512 * j + 8 * lane; hq[j] = *(const v4u*)(H2 + o); gq[j] = *(const v4u*)(G + o); pq[j] = *(const v4u*)(PP + o); } }
        float pf[4][8]; float ps = 0.f;
#pragma unroll
        for (int j = 0; j < 4; ++j) { pf[j][0] = bf_lo(pw[j].x); pf[j][1] = bf_hi(pw[j].x); pf[j][2] = bf_lo(pw[j].y); pf[j][3] = bf_hi(pw[j].y); pf[j][4] = bf_lo(pw[j].z); pf[j][5] = bf_hi(pw[j].z); pf[j][6] = bf_lo(pw[j].w); pf[j][7] = bf_hi(pw[j].w);
#pragma unroll
            for (int q = 0; q < 8; ++q) ps += pf[j][q] * pf[j][q]; }
        const float rsp = 1.0f / sqrtf(wave_sum(ps) * (1.0f / D) + EPS);
        float s = 0.f;
#pragma unroll
        for (int j = 0; j < 4; ++j) { const f32x4 g0 = *(const f32x4*)(gp + 512 * j + 8 * lane), g1 = *(const f32x4*)(gp + 512 * j + 8 * lane + 4);
            const float gl[8] = {bf_lo(gg[j].x), bf_hi(gg[j].x), bf_lo(gg[j].y), bf_hi(gg[j].y), bf_lo(gg[j].z), bf_hi(gg[j].z), bf_lo(gg[j].w), bf_hi(gg[j].w)};
#pragma unroll
            for (int q = 0; q < 4; ++q) { v[2 * j][q] += sigmoid_f(gl[q]) * pf[j][q] * rsp * g0[q]; v[2 * j + 1][q] += sigmoid_f(gl[4 + q]) * pf[j][4 + q] * rsp * g1[q]; }
            s += (v[2 * j][0] * v[2 * j][0] + v[2 * j][1] * v[2 * j][1]) + (v[2 * j][2] * v[2 * j][2] + v[2 * j][3] * v[2 * j][3]);
            s += (v[2 * j + 1][0] * v[2 * j + 1][0] + v[2 * j + 1][1] * v[2 * j + 1][1]) + (v[2 * j + 1][2] * v[2 * j + 1][2] + v[2 * j + 1][3] * v[2 * j + 1][3]); }
        const float rstd = 1.0f / sqrtf(wave_sum(s) * (1.0f / D) + EPS);
#pragma unroll
        for (int j = 0; j < 4; ++j) { const f32x4 g0 = *(const f32x4*)(g + 512 * j + 8 * lane), g1 = *(const f32x4*)(g + 512 * j + 8 * lane + 4);
            __builtin_nontemporal_store(v[2 * j] * rstd * g0, (f32x4*)(orow + 512 * j + 8 * lane)); __builtin_nontemporal_store(v[2 * j + 1] * rstd * g1, (f32x4*)(orow + 512 * j + 8 * lane + 4)); }
    }
}
__global__ void __launch_bounds__(NWAVES * 64, 2) fwd_kernel(Args args) {
    extern __shared__ __attribute__((aligned(16))) unsigned char lds[];
    Frame F;
    F.lds = (LAS unsigned char*)lds;
    F.MISC = (volatile LAS unsigned*)(F.lds + MISC_OFF);
    F.wave = __builtin_amdgcn_readfirstlane(threadIdx.x >> 6);
    F.G = gridDim.x; F.bx = blockIdx.x;
    F.ws = args.ws; F.ctl = (gu32*)(args.ws + WS_CTL); F.out = args.out;
    { const int TID_ = threadIdx.x;
    if (TID_ < 64) F.MISC[TID_] = 0u;
    if (TID_ >= 64 && TID_ < 64 + 22) ((LAS unsigned long long*)(F.lds + MISC_OFF + 256))[TID_ - 64] = ((const unsigned long long*)&args)[TID_ - 64]; }
    __syncthreads();
    XcdBarrier bar; bar.bar = (unsigned*)(F.ctl + CW_BAR); bar.x = 0; bar.st = nullptr;
    if (N_LAUNCHES == 1) bar = xcd_barrier_post((unsigned*)(F.ctl + CW_BAR), F.MISC + 8);
#define GRID_BAR() do { if (N_LAUNCHES == 1) xcd_barrier(bar); } while (0)
    const int lo = args.ph_lo, hi = args.ph_hi;
#ifndef PH_MASK
#define PH_MASK 0x3ff
#endif
#ifndef DUP_PHASE
#define DUP_PHASE -1
#endif
#define REPS(k) ((DUP_PHASE == (k)) ? 2 : 1)
#define IN(k) ((((PH_MASK) >> (k)) & 1) && lo <= (k) && (k) < hi)
#define BOTH(k) (IN(k) && IN((k) + 1))

    if (IN(0)) { _Pragma("unroll") for (int rep = 0; rep < REPS(0); ++rep) { p0_prologue(F); if (BOTH(0)) GRID_BAR(); } }

    if (IN(1)) { _Pragma("unroll") for (int rep = 0; rep < REPS(1); ++rep) {
        constexpr int G1 = 144;
        if (F.G == 256 && F.bx >= G1) {
            { pg8::Gemm g{(const bf16*)(F.ws + WS_PBF), (const bf16*)(F.ws + WS_WPP), PLE, PLE, PLE}; pg8::StaticOrder S; S.init(T, D, F.G - G1, F.bx - G1);
              EpiBf16Plain E{(bf16*)(F.ws + WS_PPROJ), D, 0, nullptr};
              pg8::gemm_phase<EpiBf16Plain, pg8::StaticOrder, false>(F.lds + RING_OFF, g, S, E, F.wave); }
            conv_wg_dyn(F, 1);
        } else {
            const int gg = (F.G == 256) ? G1 : F.G;
            { pg8::Gemm g{(const bf16*)(F.ws + WS_ABF), (const bf16*)(F.ws + WS_WIN), D, D, D}; pg8::StaticOrder S; S.init(T, INW, gg, F.bx);
              EpiInProj E{F.ws};
              pg8::gemm_phase<EpiInProj, pg8::StaticOrder, false>(F.lds + RING_OFF, g, S, E, F.wave); }
            if (F.G == 256) conv_wg_dyn(F, 1);
            if (F.G != 256) {
                { pg8::Gemm g{(const bf16*)(F.ws + WS_PBF), (const bf16*)(F.ws + WS_WPP), PLE, PLE, PLE}; pg8::StaticOrder S; S.init(T, D, F.G, F.bx);
                  EpiBf16Plain E{(bf16*)(F.ws + WS_PPROJ), D, 0, nullptr};
                  pg8::gemm_phase<EpiBf16Plain, pg8::StaticOrder, false>(F.lds + RING_OFF, g, S, E, F.wave); }
                conv_fp8_items(F, CONV_A, CONV_A + CONV_B, F.bx * NWAVES + F.wave, F.G * NWAVES);
            }
        }
        if (BOTH(1)) GRID_BAR();
    } }

    if (IN(2)) { _Pragma("unroll") for (int rep = 0; rep < REPS(2); ++rep) {
        if (F.G == 256) {
            if (F.bx < 128) pool_task(F, F.bx >> 2, F.bx & 3);
            else {
#pragma unroll 1
                for (int j = 0; j < 2; ++j) attn_block(F, 2 * (F.bx - 128) + j, j == 0); }
        } else {
            for (int blk = F.bx; blk < 256; blk += F.G) attn_block(F, blk, true);
            for (int p = F.bx; p < 128; p += F.G) { __syncthreads(); pool_task(F, p >> 2, p & 3); }
        }
        if (BOTH(2)) GRID_BAR();
    } }

    if (IN(3)) { _Pragma("unroll") for (int rep = 0; rep < REPS(3); ++rep) {
        constexpr int G3 = 128;
        if (F.G == 256 && F.bx >= G3) conv_wg_dyn(F, 2);
        else {
            pg8::Gemm g{(const bf16*)(F.ws + WS_MIX), (const bf16*)(F.ws + WS_WOUT), D, D, D}; pg8::StaticOrder S; S.init(T, D, (F.G == 256) ? G3 : F.G, F.bx);
            EpiResF32 E{fin(F, I_X), (float*)(F.ws + WS_H1)};
            pg8::gemm_phase<EpiResF32, pg8::StaticOrder, false>(F.lds + RING_OFF, g, S, E, F.wave);
            if (F.G == 256) conv_wg_dyn(F, 2);
            if (F.G != 256) conv_fp8_items(F, CONV_A + CONV_B, CV_TOTAL, F.bx * NWAVES + F.wave, F.G * NWAVES);
        }
        if (BOTH(3)) GRID_BAR();
    } }

    if (IN(4)) { _Pragma("nounroll") for (int rep = 0; rep < ((DUP_PHASE == 4) ? 2 : 1); ++rep) { if (rep == 1) { GRID_BAR(); if (F.bx == 0 && threadIdx.x < NE) __hip_atomic_store(F.ctl + CW_CNT + 32 * threadIdx.x, 0u, RLX_AGENT); GRID_BAR(); }
        p4_route(F); } if (BOTH(4)) GRID_BAR(); }

    if (IN(5)) { _Pragma("unroll") for (int rep = 0; rep < REPS(5); ++rep) {
        moe_tables(F);
        pg8::Gemm g{F.ws + WS_XN, F.ws + WS_WGU, D, D, D};
        MoeOrder S{(const LAS int*)(F.lds + TAB_OFF), (const int*)(F.ws + WS_TOKLIST), F.bx & 7, F.bx >> 3, 4, F.G >> 3};
        EpiGateUp E{F.ws + WS_ACT};
        pg8::gemm_phase<EpiGateUp, MoeOrder, true, 1>(F.lds + RING_OFF, g, S, E, F.wave);
        if (BOTH(5)) GRID_BAR();
    } }

    if (IN(6)) { _Pragma("unroll") for (int rep = 0; rep < REPS(6); ++rep) {
        if (!IN(5)) moe_tables(F);
        pg8::Gemm g{F.ws + WS_ACT, F.ws + WS_WD, EFF, EFF, EFF};
        MoeOrder S{(const LAS int*)(F.lds + TAB_OFF), (const int*)(F.ws + WS_TOKLIST), F.bx & 7, F.bx >> 3, 8, F.G >> 3};
        EpiDown E{F.ws + WS_Y};
        pg8::gemm_phase<EpiDown, MoeOrder, false, 1>(F.lds + RING_OFF, g, S, E, F.wave);
        if (BOTH(6)) GRID_BAR();
    } }

    if (IN(7)) { if (!IN(6)) moe_tables(F); if (DUP_PHASE == 7) { p7_combine(F, true); GRID_BAR(); } p7_combine(F, false); if (BOTH(7)) GRID_BAR(); }

    if (IN(8)) {
        pg8::Gemm g{F.ws + WS_H2F8, F.ws + WS_WPG, D, D, D}; pg8::StaticOrder S; S.init(T, D, F.G, F.bx);
        EpiBf16Mul E{(bf16*)(F.ws + WS_GBUF), 1.0f / SW3};
        pg8::gemm_phase<EpiBf16Mul, pg8::StaticOrder, false, 1>(F.lds + RING_OFF, g, S, E, F.wave);
        if (BOTH(8)) GRID_BAR();
    }

    if (IN(9)) { if (DUP_PHASE == 9) { p9_final(F, true); GRID_BAR(); } p9_final(F, false); }
#undef IN
#undef BOTH
}

extern "C" void kernel_launch(void* const* d_in, const int* in_sizes, int n_in, void* d_out, int out_size, void* d_ws, size_t ws_size, hipStream_t stream) {
    static int grid = 0;
    if (grid == 0) {
        if (n_in != 22 || out_size != T * D || ws_size < WS_END) { fprintf(stderr, "kernel_launch: unexpected sizes n_in %d out %d ws %zu (need %zu)\n", n_in, out_size, ws_size, (size_t)WS_END); grid = -1; return; }
        int dev = 0, cus = 0, per_cu = 0;
        if (hipGetDevice(&dev) != hipSuccess || hipDeviceGetAttribute(&cus, hipDeviceAttributeMultiprocessorCount, dev) != hipSuccess) { grid = -1; return; }
        if (hipFuncSetAttribute((const void*)fwd_kernel, hipFuncAttributeMaxDynamicSharedMemorySize, LDS_BYTES) != hipSuccess) { fprintf(stderr, "kernel_launch: hipFuncSetAttribute failed\n"); grid = -1; return; }
        if (hipOccupancyMaxActiveBlocksPerMultiprocessor(&per_cu, (const void*)fwd_kernel, NWAVES * 64, LDS_BYTES) != hipSuccess || per_cu < 1) fprintf(stderr, "kernel_launch: occupancy query reports %d\n", per_cu);
        (void)hipGetLastError();
        grid = cus > 256 ? 256 : cus;
    }
    if (grid < 0) return;
    if (hipMemsetAsync((char*)d_ws + WS_CTL, 0, CTL_ZERO_BYTES, stream) != hipSuccess) return;
    Args a{};
    for (int i = 0; i < 22; ++i) a.in[i] = (const float*)d_in[i];
    a.out = (float*)d_out; a.ws = (unsigned char*)d_ws;
    for (int li = 0; li < N_LAUNCHES; ++li) {
        a.ph_lo = (N_LAUNCHES == 1) ? 0 : li; a.ph_hi = (N_LAUNCHES == 1) ? N_PHASES : li + 1; a.li = li;
        hipLaunchKernelGGL(fwd_kernel, dim3(grid), dim3(NWAVES * 64), LDS_BYTES, stream, a);
    }
}
```

```cpp
#include <hip/hip_runtime.h>
#include <cstdio>
#include <cstdint>

#ifndef MK_N_LAUNCHES
#define MK_N_LAUNCHES 1
#endif

namespace pg8 {
#define PG8_LAS __attribute__((address_space(3)))
typedef unsigned short bf16_t;
typedef short bf16x8 __attribute__((ext_vector_type(8)));
typedef float f32x4 __attribute__((ext_vector_type(4)));
typedef unsigned u32x4 __attribute__((ext_vector_type(4)));
typedef unsigned u32x2 __attribute__((ext_vector_type(2)));
constexpr int BM = 256, BK = 64, HALF = 128, HTB = HALF * BK * 2  , STAGE_BYTES = 8 * HTB, NXCD = 8, WGM = 8;

__host__ __device__ __forceinline__ int lds_byte(int r, int c) { const int st = (r >> 4) * 2 + (c >> 5), rr = r & 15, cc = c & 31, ob = rr * 64 + cc * 2; return st * 1024 + (ob ^ (((ob >> 9) & 1) << 5)); }
__host__ __device__ __forceinline__ void stage_rc(int b, int& R, int& C) { const int st = b / 1024, sb = b % 1024, swz = sb ^ (((sb >> 9) & 1) << 5); R = (st >> 1) * 16 + swz / 64; C = (st & 1) * 32 + (swz % 64) / 2; }
__host__ __device__ __forceinline__ int perm32(int rho) { const int n = rho >> 4, i = rho & 15; return 8 * (i >> 2) + 4 * n + (i & 3); }

struct Unit { int pm, pn, e, lt, half; };
struct Gemm { const void* A; const void* Bt; int lda, ldb, K; };
typedef int i32x8 __attribute__((ext_vector_type(8)));
typedef int i32x4 __attribute__((ext_vector_type(4)));
__device__ __forceinline__ i32x8 cat8(bf16x8 lo, bf16x8 hi) { const i32x4 a = __builtin_bit_cast(i32x4, lo), b = __builtin_bit_cast(i32x4, hi); return __builtin_shufflevector(a, b, 0, 1, 2, 3, 4, 5, 6, 7); }

struct StaticOrder {
    static constexpr bool HALVES = false;
    int nM, nN, nwg, G, c;
    __host__ __device__ void init(int M, int N, int G_, int c_) { nM = M / BM; nN = N / BM; nwg = nM * nN; G = G_; c = c_; }
    __host__ __device__ bool next(int i, Unit& u) const {
        const long L = (long)i * G + c; if (L >= nwg) return false;
        int wgid = (int)L; { const int q = nwg / NXCD, r = nwg % NXCD, xcd = wgid % NXCD, off = wgid / NXCD; wgid = (xcd < r ? xcd * (q + 1) : r * (q + 1) + (xcd - r) * q) + off; }
        const int nig = WGM * nN, gid = wgid / nig, fm = gid * WGM, gsz = (nM - fm) < WGM ? (nM - fm) : WGM;
        u.pm = fm + ((wgid % nig) % gsz); u.pn = (wgid % nig) / gsz; u.e = 0; u.lt = 0; u.half = 0; return true;
    }
    __device__ __forceinline__ int arow(const Unit&, int r) const { return r; }
};
struct SingleOrder {
    static constexpr bool HALVES = false;
    int pm, pn;
    __device__ bool next(int i, Unit& u) const { if (i > 0) return false; u.pm = pm; u.pn = pn; u.e = 0; u.lt = 0; u.half = 0; return true; }
    __device__ __forceinline__ int arow(const Unit&, int r) const { return r; }
};

__device__ __forceinline__ int lane_id() { int l; asm volatile("v_mbcnt_lo_u32_b32 %0, -1, 0\n\tv_mbcnt_hi_u32_b32 %0, -1, %0" : "=v"(l)); return l; }
__device__ __forceinline__ unsigned cvt_pk_bf16(float lo, float hi) { unsigned r; asm volatile("v_cvt_pk_bf16_f32 %0, %1, %2" : "=v"(r) : "v"(lo), "v"(hi)); return r; }

__host__ __device__ __forceinline__ int perm16(int R) { return 64 * (R >> 5) + 16 * ((R >> 2) & 3) + 4 * ((R >> 4) & 1) + (R & 3); }
template <class Epi, class Sched, bool GATHER, int ESZ = 2, bool ALIGN_EPI = true>
__device__ __forceinline__ void gemm_phase(PG8_LAS unsigned char* lds, const Gemm g, const Sched& S, const Epi& E, int wid) {
    const int lane = lane_id(), tid = wid * 64 + lane, wr = wid >> 2, wc = wid & 3, fr = lane & 15, fq = lane >> 4;
    const int nt = (g.K * ESZ) / 128;
    int Ra[2], Ca[2]; unsigned voffB[2];
#pragma unroll
    for (int i = 0; i < 2; ++i) { int R, C; stage_rc(tid * 16 + i * 8192, R, C); const int Rb = (Epi::PERM == 2) ? perm16(R) : (Epi::PERM ? ((R & ~31) + perm32(R & 31)) : R);
        Ra[i] = R; Ca[i] = C; voffB[i] = (unsigned)(Rb * g.ldb * ESZ + C * 2); }
    const size_t kstep = (size_t)(BK * 2);
    const size_t hstepB = (size_t)((Epi::PERM == 2) ? 8 : HALF) * g.ldb * ESZ, tstepB = (size_t)BM * g.ldb * ESZ;
    const size_t tstepA = (size_t)BM * g.lda * ESZ;
    const unsigned ldsw = (unsigned)wid * 1024u;
    const int aoff = lds_byte(wr * 64 + fr, fq * 8), boff = lds_byte(wc * 32 + fr, fq * 8);
#define PG8_SA(b, h) (((b) * 2 + (h)) * HTB)
#define PG8_SB(b, h) ((4 + (b) * 2 + (h)) * HTB)
#define PG8_STAGE(bufoff, gbase, v0, v1) do { \
        __builtin_amdgcn_global_load_lds((const unsigned*)((const char*)(gbase) + (v0)), (PG8_LAS unsigned*)(lds + (bufoff) + ldsw), 16, 0, 0); \
        __builtin_amdgcn_global_load_lds((const unsigned*)((const char*)(gbase) + (v1)), (PG8_LAS unsigned*)(lds + (bufoff) + ldsw + 8192), 16, 0, 0); } while (0)
#define PG8_STAGE_A0(bufoff, gbase, p0, p1) PG8_STAGE(bufoff, gbase, p0, p1)
#define PG8_STAGE_A1(bufoff, gbase, p0, p1, q0, q1) do { if constexpr (GATHER) { PG8_STAGE(bufoff, gbase, q0, q1); } else { PG8_STAGE(bufoff, (gbase) + hstepA, p0, p1); } } while (0)
#define PG8_LD16(off) (*(const PG8_LAS i32x4*)(lds + (off)))
#define PG8_LDA(dst, b, h) do { if constexpr (ESZ == 2) { _Pragma("unroll") for (int m = 0; m < 4; ++m) _Pragma("unroll") for (int k = 0; k < 2; ++k) dst[m][k] = *(const PG8_LAS bf16x8*)(lds + PG8_SA(b, h) + aoff + m * 2048 + k * 1024); } \
        else { _Pragma("unroll") for (int m = 0; m < 4; ++m) dst##8[m] = __builtin_shufflevector(PG8_LD16(PG8_SA(b, h) + aoff + m * 2048), PG8_LD16(PG8_SA(b, h) + aoff + m * 2048 + 1024), 0, 1, 2, 3, 4, 5, 6, 7); } } while (0)
#define PG8_LDB(dst, b, h) do { if constexpr (ESZ == 2) { _Pragma("unroll") for (int n = 0; n < 2; ++n) _Pragma("unroll") for (int k = 0; k < 2; ++k) dst[n][k] = *(const PG8_LAS bf16x8*)(lds + PG8_SB(b, h) + boff + n * 2048 + k * 1024); } \
        else { _Pragma("unroll") for (int n = 0; n < 2; ++n) dst##8[n] = __builtin_shufflevector(PG8_LD16(PG8_SB(b, h) + boff + n * 2048), PG8_LD16(PG8_SB(b, h) + boff + n * 2048 + 1024), 0, 1, 2, 3, 4, 5, 6, 7); } } while (0)
#define PG8_MMA(ai, bj, At, Bt) do { __builtin_amdgcn_s_setprio(1); \
        if constexpr (ESZ == 2) { _Pragma("unroll") for (int m = 0; m < 4; ++m) _Pragma("unroll") for (int n = 0; n < 2; ++n) _Pragma("unroll") for (int k = 0; k < 2; ++k) \
            acc[ai][bj][m][n] = __builtin_amdgcn_mfma_f32_16x16x32_bf16(Bt[n][k], At[m][k], acc[ai][bj][m][n], 0, 0, 0); } \
        else { _Pragma("unroll") for (int m = 0; m < 4; ++m) _Pragma("unroll") for (int n = 0; n < 2; ++n) \
            asm volatile("v_mfma_scale_f32_16x16x128_f8f6f4 %0, %1, %2, %0, %3, %3 op_sel_hi:[0,0,0]" : "+v"(acc[ai][bj][m][n]) : "v"(Bt##8[n]), "v"(At##8[m]), "v"(sc1)); } \
        __builtin_amdgcn_s_setprio(0); } while (0)
#define PG8_WAIT_V(n) asm volatile("s_waitcnt vmcnt(" #n ")" ::: "memory")
#define PG8_WAIT_L(n) asm volatile("s_waitcnt lgkmcnt(" #n ")" ::: "memory")
#define PG8_BAR __builtin_amdgcn_s_barrier()
#define PG8_SCHED __builtin_amdgcn_sched_barrier(0)
    Unit cur, nxt; int ui = 0;
    if (!S.next(0, cur)) return;
    f32x4 acc[2][2][4][2];
#pragma unroll
    for (int a = 0; a < 2; ++a)
#pragma unroll
        for (int b = 0; b < 2; ++b)
#pragma unroll
            for (int m = 0; m < 4; ++m)
#pragma unroll
                for (int n = 0; n < 2; ++n) acc[a][b][m][n] = (f32x4){0.f, 0.f, 0.f, 0.f};
    const int sc1 = 0x7F7F7F7F;
    bf16x8 At[4][2], B0[2][2], B1[2][2]; i32x8 At8[4], B08[2], B18[2];
    unsigned vA00, vA01, vA10, vA11, nA00, nA01, nA10, nA11;
    const size_t hstepA = GATHER ? (size_t)0 : (size_t)HALF * g.lda * ESZ;
    if constexpr (GATHER) {
        vA00 = (unsigned)(S.arow(cur, Ra[0]) * g.lda * ESZ + Ca[0] * 2); vA01 = (unsigned)(S.arow(cur, Ra[1]) * g.lda * ESZ + Ca[1] * 2);
        vA10 = (unsigned)(S.arow(cur, HALF + Ra[0]) * g.lda * ESZ + Ca[0] * 2); vA11 = (unsigned)(S.arow(cur, HALF + Ra[1]) * g.lda * ESZ + Ca[1] * 2);
    } else {
        vA00 = (unsigned)(Ra[0] * g.lda * ESZ + Ca[0] * 2); vA01 = (unsigned)(Ra[1] * g.lda * ESZ + Ca[1] * 2); vA10 = 0; vA11 = 0;
    }
    nA00 = vA00; nA01 = vA01; nA10 = vA10; nA11 = vA11;
    const char* cA = (const char*)g.A + (GATHER ? (size_t)0 : (size_t)cur.pm * tstepA); const char* cB = (const char*)g.Bt + (size_t)cur.pn * tstepB;
    PG8_STAGE(PG8_SB(0, 0), cB, voffB[0], voffB[1]); PG8_STAGE(PG8_SB(0, 1), cB + hstepB, voffB[0], voffB[1]); PG8_STAGE_A0(PG8_SA(0, 0), cA, vA00, vA01); PG8_STAGE_A1(PG8_SA(0, 1), cA, vA00, vA01, vA10, vA11);
    if (wr == 1) PG8_BAR;
    PG8_WAIT_V(2); PG8_BAR;
    PG8_STAGE(PG8_SB(1, 0), cB + kstep, voffB[0], voffB[1]); PG8_STAGE_A0(PG8_SA(1, 0), cA + kstep, vA00, vA01); PG8_STAGE(PG8_SB(1, 1), cB + hstepB + kstep, voffB[0], voffB[1]);
    PG8_WAIT_V(6); PG8_BAR;
    for (;;) {
        const bool has_next = S.next(ui + 1, nxt);
        const char* nA = has_next ? (const char*)g.A + (GATHER ? (size_t)0 : (size_t)nxt.pm * tstepA) : cA; const char* nB = has_next ? (const char*)g.Bt + (size_t)nxt.pn * tstepB : cB;
        if constexpr (GATHER) {
            if (has_next) {
                nA00 = (unsigned)(S.arow(nxt, Ra[0]) * g.lda * ESZ + Ca[0] * 2); nA01 = (unsigned)(S.arow(nxt, Ra[1]) * g.lda * ESZ + Ca[1] * 2);
                nA10 = (unsigned)(S.arow(nxt, HALF + Ra[0]) * g.lda * ESZ + Ca[0] * 2); nA11 = (unsigned)(S.arow(nxt, HALF + Ra[1]) * g.lda * ESZ + Ca[1] * 2);
            } else { nA00 = vA00; nA01 = vA01; nA10 = vA10; nA11 = vA11; }
        }
#pragma nounroll
        for (int t = 0; t < nt; t += 2) {
            const bool last = (t == nt - 2);
            const char* a1 = cA + (size_t)(t + 1) * kstep;
            const char* a2 = last ? nA : cA + (size_t)(t + 2) * kstep; const char* b2 = last ? nB : cB + (size_t)(t + 2) * kstep;
            const char* a3 = a2 + kstep; const char* b3 = b2 + kstep;
            asm volatile("" : "+v"(voffB[0]), "+v"(voffB[1]), "+v"(vA00), "+v"(vA01));
            if constexpr (GATHER) asm volatile("" : "+v"(vA10), "+v"(vA11));
            unsigned x00 = vA00, x01 = vA01, x10 = vA10, x11 = vA11;
            if constexpr (GATHER) { if (last) { x00 = nA00; x01 = nA01; x10 = nA10; x11 = nA11; } }
            const bool hf = Sched::HALVES && (cur.half != 0);
            PG8_LDB(B0, 0, 0); PG8_LDB(B1, 0, 1); PG8_SCHED; PG8_LDA(At, 0, 0); PG8_STAGE_A1(PG8_SA(1, 1), a1, vA00, vA01, vA10, vA11);
            PG8_WAIT_V(8); PG8_WAIT_L(0); PG8_BAR; PG8_MMA(0, 0, At, B0); PG8_MMA(0, 1, At, B1); PG8_BAR; PG8_SCHED;
            if (!hf) PG8_LDA(At, 0, 1); PG8_STAGE(PG8_SB(0, 0), b2, voffB[0], voffB[1]); PG8_STAGE(PG8_SB(0, 1), b2 + hstepB, voffB[0], voffB[1]); PG8_STAGE_A0(PG8_SA(0, 0), a2, x00, x01);
            PG8_WAIT_V(8); PG8_WAIT_L(0); PG8_BAR; if (!hf) { PG8_MMA(1, 0, At, B0); PG8_MMA(1, 1, At, B1); } PG8_BAR; PG8_SCHED;
            PG8_LDB(B0, 1, 0); PG8_LDB(B1, 1, 1); PG8_SCHED; PG8_LDA(At, 1, 0); PG8_STAGE_A1(PG8_SA(0, 1), a2, x00, x01, x10, x11);
            PG8_WAIT_V(8); PG8_WAIT_L(0); PG8_BAR; PG8_MMA(0, 0, At, B0); PG8_MMA(0, 1, At, B1); PG8_BAR; PG8_SCHED;
            if (!hf) PG8_LDA(At, 1, 1); PG8_STAGE(PG8_SB(1, 0), b3, voffB[0], voffB[1]); PG8_STAGE(PG8_SB(1, 1), b3 + hstepB, voffB[0], voffB[1]); PG8_STAGE_A0(PG8_SA(1, 0), a3, x00, x01);
            PG8_WAIT_V(8); PG8_WAIT_L(0); PG8_BAR; if (!hf) { PG8_MMA(1, 0, At, B0); PG8_MMA(1, 1, At, B1); } PG8_BAR; PG8_SCHED;
        }
        if constexpr (ALIGN_EPI) { if (wr == 0) PG8_BAR; }
        if constexpr (ESZ == 1) asm volatile("s_nop 15\n\ts_nop 15" ::: "memory");
        E(acc, cur, wr, wc, fr, fq);
        if (!has_next) break;
#pragma unroll
        for (int a = 0; a < 2; ++a)
#pragma unroll
            for (int b = 0; b < 2; ++b)
#pragma unroll
                for (int m = 0; m < 4; ++m)
#pragma unroll
                    for (int n = 0; n < 2; ++n) acc[a][b][m][n] = (f32x4){0.f, 0.f, 0.f, 0.f};
        cur = nxt; cA = nA; cB = nB; ++ui;
        if constexpr (GATHER) { vA00 = nA00; vA01 = nA01; vA10 = nA10; vA11 = nA11; }
        if constexpr (ALIGN_EPI) { if (wr == 1) PG8_BAR; }
    }
    PG8_WAIT_V(0);
    if constexpr (!ALIGN_EPI) { if (wr == 0) PG8_BAR; }
    PG8_BAR;
#undef PG8_SA
#undef PG8_SB
#undef PG8_STAGE
#undef PG8_LDA
#undef PG8_LD16
#undef PG8_STAGE_A0
#undef PG8_STAGE_A1
#undef PG8_LDB
#undef PG8_MMA
#undef PG8_WAIT_V
#undef PG8_WAIT_L
#undef PG8_BAR
#undef PG8_SCHED
}
}

constexpr int NWAVES = 8;
constexpr int T = 8192, SEQ = 2048, NB = 4, D = 2048, INW = 2304, POOLW = 1024, NH = 16, NKV = 2, HD = 64, KVW = 128;
constexpr int NE = 64, TOPK = 8, EFF = 512, PLE = 256;
constexpr int SH_ROW0 = T * TOPK + NE * 256;
constexpr int NROWS = SH_ROW0 + T;
constexpr float EPS = 1e-6f;
constexpr float SW1 = 32.0f, SW2 = 16.0f, SA = 4.0f, SY = 16.0f, SW3 = 32.0f;
constexpr int N_PHASES = 10;
constexpr int N_LAUNCHES = MK_N_LAUNCHES;

constexpr size_t MiB = 1u << 20;
constexpr size_t WS_CTL = 0, CTL_ZERO_BYTES = 64 * 1024;
constexpr size_t WS_MISC = 1 * MiB;
constexpr size_t WS_TOKLIST = WS_MISC;
constexpr size_t WS_REC = WS_TOKLIST + (size_t)NE * T * 4;
constexpr size_t WS_WREC = WS_REC + (size_t)T * TOPK * 4;
constexpr size_t WS_RSTDP = WS_WREC + (size_t)T * TOPK * 4;
constexpr size_t WS_PBF = 6 * MiB;
constexpr size_t WS_WRT = 10 * MiB;
constexpr size_t WS_WIN = 12 * MiB;
constexpr size_t WS_WPOOL = WS_WIN + (size_t)INW * D * 2;
constexpr size_t WS_WOUT = WS_WPOOL + (size_t)4 * 256 * 256 * 2;
constexpr size_t WS_WPP = WS_WOUT + (size_t)D * D * 2;
constexpr size_t WS_WPG = WS_WPP + (size_t)D * PLE * 2;
constexpr size_t WS_WGU = WS_WPG + (size_t)D * D * 2;
constexpr size_t WS_WD = WS_WGU + (size_t)65 * 1024 * D;
constexpr size_t WS_XN = WS_WD + (size_t)65 * D * EFF;
constexpr size_t WS_PPROJ = WS_XN + (size_t)T * D * 2;
constexpr size_t WS_ACT = WS_PPROJ + (size_t)T * D * 2;
constexpr size_t WS_H2F8 = WS_ACT;
constexpr size_t WS_H2B = WS_ACT + 16 * MiB;
constexpr size_t WS_GBUF = WS_XN;
constexpr size_t WS_Y = WS_ACT + (size_t)NROWS * EFF * 2;
constexpr size_t WS_ABF = WS_Y;
constexpr size_t WS_UBF = WS_ABF + (size_t)T * D * 2;
constexpr size_t WS_QBF = WS_UBF + (size_t)T * POOLW * 2;
constexpr size_t WS_KV = WS_QBF + (size_t)T * 1024 * 2;
constexpr size_t WS_POOLED = WS_KV + (size_t)T * 2 * KVW * 2;
constexpr size_t WS_MIX = WS_POOLED + (size_t)T * POOLW * 2;
constexpr size_t WS_H1 = WS_Y + (size_t)NROWS * D * 2;
constexpr size_t WS_END = WS_H1 + (size_t)T * D * 4;
static_assert(WS_MIX + (size_t)T * D * 2 <= WS_END, "early activations fit under Y");
static_assert(WS_RSTDP + (size_t)T * 4 <= WS_PBF && WS_PBF + (size_t)T * PLE * 2 <= WS_WIN, "misc fits");
static_assert(WS_END <= (size_t)1024 * MiB, "workspace must fit 1 GiB");
constexpr int CW_BAR = 1024;
constexpr int CW_CNT = 8192;
constexpr int CW_CONVQ = CW_CNT + 32 * NE;
static_assert((CW_CONVQ + 32 * 24) * 4 <= 48 * 1024, "CTL words inside the memset region (below the dummy line at 48 KiB)");

constexpr int RING_OFF = 0, RING_BYTES = 131072;
constexpr int LDS_BYTES = 163840;
constexpr int MISC_OFF = LDS_BYTES - 512;
constexpr int TAB_OFF = RING_BYTES;
constexpr int TB_CNT = 0, TB_PAD = 80, TB_XF = 160, TB_XH = 176, TB_SH0 = 192, TB_SHN = 193;

#define GAS __attribute__((address_space(1)))
#define LAS __attribute__((address_space(3)))
typedef unsigned short bf16;
typedef unsigned v4u __attribute__((ext_vector_type(4)));
typedef unsigned v2u __attribute__((ext_vector_type(2)));
typedef float f32x4 __attribute__((ext_vector_type(4)));
typedef short bf16x8 __attribute__((ext_vector_type(8)));
typedef GAS unsigned gu32;
#define RLX_AGENT __ATOMIC_RELAXED, __HIP_MEMORY_SCOPE_AGENT
#define LDS_WAIT() asm volatile("s_waitcnt lgkmcnt(0)" ::: "memory")
#define LDS_BARRIER() do { asm volatile("s_waitcnt lgkmcnt(0)" ::: "memory"); __builtin_amdgcn_s_barrier(); asm volatile("" ::: "memory"); } while (0)
#define VM_WAIT() asm volatile("s_waitcnt vmcnt(0)" ::: "memory")
__device__ __forceinline__ unsigned pk2(float lo, float hi) { return pg8::cvt_pk_bf16(lo, hi); }
__device__ __forceinline__ float bf_lo(unsigned w) { return __builtin_bit_cast(float, w << 16); }
__device__ __forceinline__ float bf_hi(unsigned w) { return __builtin_bit_cast(float, w & 0xffff0000u); }

#define XB_TMO      128
#define XB_XCNT(j)  (256  + 64 * (j))
#define XB_XSUB(j)  (1280 + 64 * (j))
#define XB_XGEN(j)  (2304 + 64 * (j))
#define XB_TOP      3328
#define XB_TOPGEN   3392
#define XCD_BAR_WORDS 3456
#define XB_SPIN_CAP (1u << 18)
__device__ __forceinline__ unsigned xb_ld(unsigned* p)              { return __hip_atomic_load(p, __ATOMIC_RELAXED, __HIP_MEMORY_SCOPE_AGENT); }
__device__ __forceinline__ unsigned xb_add(unsigned* p, unsigned v) { return __hip_atomic_fetch_add(p, v, __ATOMIC_RELAXED, __HIP_MEMORY_SCOPE_AGENT); }
__device__ __forceinline__ unsigned xb_xcc_id() { return (unsigned)__builtin_amdgcn_s_getreg((3 << 11) | 20) & 0xFu; }
#define XB_SPIN(cond, bar) do { unsigned _sp = 0; while (cond) { __builtin_amdgcn_s_sleep(1); \
    if ((++_sp & 255u) == 0u) { if (xb_ld(&(bar)[XB_TMO])) break; if (_sp > XB_SPIN_CAP) { atomicAdd(&(bar)[XB_TMO], 1u); break; } } } } while (0)
struct XcdBarrier { unsigned* bar; unsigned x; volatile LAS unsigned* st; };
__device__ __forceinline__ XcdBarrier xcd_barrier_post(unsigned* bar, volatile LAS unsigned* st) {
    XcdBarrier b; b.bar = bar; b.x = xb_xcc_id(); b.st = st;
    if (threadIdx.x == 0) (void)xb_add(&bar[XB_XCNT(b.x)], 1u);
    return b;
}
__device__ __forceinline__ void xcd_barrier_complete(unsigned* bar, unsigned x, unsigned& nloc, unsigned& nx) {
    const unsigned G = gridDim.x * gridDim.y * gridDim.z;
    unsigned sum, cnt, mine, sp = 0u;
    for (;;) {
        sum = 0u; cnt = 0u; mine = 0u;
#pragma unroll
        for (unsigned j = 0; j < 16; ++j) { const unsigned c = xb_ld(&bar[XB_XCNT(j)]); sum += c; cnt += (c > 0u) ? 1u : 0u; mine = (j == x) ? c : mine; }
        if (sum == G) break;
        __builtin_amdgcn_s_sleep(1);
        if ((++sp & 255u) == 0u) { if (xb_ld(&bar[XB_TMO])) break; if (sp > XB_SPIN_CAP) { atomicAdd(&bar[XB_TMO], 1u); break; } }
    }
    nloc = mine > 0u ? mine : 1u; nx = cnt > 0u ? cnt : 1u;
}
__device__ __forceinline__ void xcd_barrier(const XcdBarrier& b) {
    asm volatile("s_waitcnt vmcnt(0)" ::: "memory");
    __syncthreads();
    if (threadIdx.x == 0) {
        unsigned* bar = b.bar;
        __builtin_amdgcn_s_waitcnt(0);
        unsigned nloc = b.st[0], nx = b.st[1];
        if (nloc == 0u) { xcd_barrier_complete(bar, b.x, nloc, nx); b.st[0] = nloc; b.st[1] = nx; }
        const unsigned old = xb_add(&bar[XB_XSUB(b.x)], 1u);
        const unsigned gen = old / nloc;
        if (old + 1u == (gen + 1u) * nloc) {
            __builtin_amdgcn_fence(__ATOMIC_RELEASE, "agent");
            asm volatile("s_waitcnt vmcnt(0)" ::: "memory");
            const unsigned og = xb_add(&bar[XB_TOP], 1u);
            const unsigned tg = og / nx;
            if (og + 1u == (tg + 1u) * nx) xb_add(&bar[XB_TOPGEN], 1u);
            else XB_SPIN(xb_ld(&bar[XB_TOPGEN]) == tg, bar);
            __builtin_amdgcn_fence(__ATOMIC_ACQUIRE, "agent");
            xb_add(&bar[XB_XGEN(b.x)], 1u);
            asm volatile("s_waitcnt vmcnt(0)" ::: "memory");
        } else {
            XB_SPIN(xb_ld(&bar[XB_XGEN(b.x)]) == gen, bar);
            __builtin_amdgcn_fence(__ATOMIC_ACQUIRE, "agent");
            asm volatile("s_waitcnt vmcnt(0)" ::: "memory");
        }
    }
    __syncthreads();
}

struct Args { const float* in[22]; float* out; unsigned char* ws; int ph_lo, ph_hi, li, pad; };
struct Frame {
    LAS unsigned char* lds;
    volatile LAS unsigned* MISC;
    gu32* ctl;
    unsigned char* ws;
    int wave, G, bx;
    float* out;
};
__device__ __forceinline__ const float* fin(const Frame& F, int i) {
    const unsigned long long v = ((const LAS unsigned long long*)(F.lds + MISC_OFF + 256))[i];
    const unsigned lo = __builtin_amdgcn_readfirstlane((unsigned)v), hi = __builtin_amdgcn_readfirstlane((unsigned)(v >> 32));
    return (const float*)(const GAS float*)(((unsigned long long)hi << 32) | lo);
}
enum { I_X = 0, I_P, I_GMIX, I_WIN, I_WPOOL, I_PSCALE, I_SINKS, I_RPE, I_WOUT, I_GFFN, I_WROUTER, I_RBIAS, I_WGATE, I_WUP, I_WDOWN, I_WSGATE, I_WSUP, I_WSDOWN, I_WPLEPROJ, I_GPLE, I_WPLEGATE, I_GFINAL };

__device__ __forceinline__ float wave_sum(float v) {
#pragma unroll
    for (int o = 1; o < 64; o <<= 1) v += __shfl_xor(v, o);
    return v;
}

using pg8::Unit;
struct EpiInProj {
    static constexpr int PERM = 1;
    unsigned char* ws;
    __device__ __forceinline__ void operator()(const f32x4 (&acc)[2][2][4][2], const Unit& u, int wr, int wc, int fr, int fq) const {
        const int row0 = u.pm * 256 + wr * 64 + fr;
        const size_t boff = WS_UBF + (size_t)(u.pn >= 4 ? 1 : 0) * (WS_QBF - WS_UBF) + (size_t)(u.pn >= 8 ? 1 : 0) * (WS_KV - WS_QBF);
        bf16* base = (bf16*)(ws + boff); const int ldc = (u.pn < 8) ? 1024 : 256; const int col0 = (u.pn & 3) * 256 + wc * 32 + 8 * fq;
#pragma unroll
        for (int ai = 0; ai < 2; ++ai)
#pragma unroll
            for (int m = 0; m < 4; ++m) { bf16* rowp = base + (size_t)(row0 + ai * 128 + m * 16) * ldc + col0;
#pragma unroll
                for (int bj = 0; bj < 2; ++bj) { const f32x4 v0 = acc[ai][bj][m][0], v1 = acc[ai][bj][m][1];
                    v4u w; w.x = pk2(v0[0], v0[1]); w.y = pk2(v0[2], v0[3]); w.z = pk2(v1[0], v1[1]); w.w = pk2(v1[2], v1[3]);
                    *(v4u*)(rowp + bj * 128) = w; } }
    }
};
struct EpiBf16Plain {
    static constexpr int PERM = 1;
    bf16* O; int ldc; int col_off; const float* scale;
    __device__ __forceinline__ void operator()(const f32x4 (&acc)[2][2][4][2], const Unit& u, int wr, int wc, int fr, int fq) const {
        const int row0 = u.pm * 256 + wr * 64 + fr, colt = u.pn * 256 + wc * 32 + 8 * fq;
        f32x4 sv[2][2];
#pragma unroll
        for (int bj = 0; bj < 2; ++bj)
#pragma unroll
            for (int n = 0; n < 2; ++n) sv[bj][n] = scale ? *(const f32x4*)(scale + col_off + colt + bj * 128 + 4 * n) : (f32x4){1.f, 1.f, 1.f, 1.f};
#pragma unroll
        for (int ai = 0; ai < 2; ++ai)
#pragma unroll
            for (int m = 0; m < 4; ++m) { bf16* rowp = O + (size_t)(row0 + ai * 128 + m * 16) * ldc + col_off + colt;
#pragma unroll
                for (int bj = 0; bj < 2; ++bj) { const f32x4 v0 = acc[ai][bj][m][0] * sv[bj][0], v1 = acc[ai][bj][m][1] * sv[bj][1];
                    v4u w; w.x = pk2(v0[0], v0[1]); w.y = pk2(v0[2], v0[3]); w.z = pk2(v1[0], v1[1]); w.w = pk2(v1[2], v1[3]);
                    *(v4u*)(rowp + bj * 128) = w; } }
    }
};
struct EpiResF32 {
    static constexpr int PERM = 0;
    const float* base; float* C;
    __device__ __forceinline__ void operator()(const f32x4 (&acc)[2][2][4][2], const Unit& u, int wr, int wc, int fr, int fq) const {
        const int row0 = u.pm * 256 + wr * 64 + fr, col0 = u.pn * 256 + wc * 32 + 4 * fq;
#pragma unroll
        for (int ai = 0; ai < 2; ++ai)
#pragma unroll
            for (int mp = 0; mp < 2; ++mp) { f32x4 xb[2][2][2];
#pragma unroll
                for (int mm = 0; mm < 2; ++mm) { const size_t ro = (size_t)(row0 + ai * 128 + (2 * mp + mm) * 16) * D + col0;
#pragma unroll
                    for (int bj = 0; bj < 2; ++bj)
#pragma unroll
                        for (int n = 0; n < 2; ++n) xb[mm][bj][n] = *(const f32x4*)(base + ro + bj * 128 + n * 16); }
#pragma unroll
                for (int mm = 0; mm < 2; ++mm) { const size_t ro = (size_t)(row0 + ai * 128 + (2 * mp + mm) * 16) * D + col0;
#pragma unroll
                    for (int bj = 0; bj < 2; ++bj)
#pragma unroll
                        for (int n = 0; n < 2; ++n) *(f32x4*)(C + ro + bj * 128 + n * 16) = xb[mm][bj][n] + acc[ai][bj][2 * mp + mm][n]; } }
    }
};
__device__ __forceinline__ float sigmoid_f(float v) { return __builtin_amdgcn_rcpf(1.0f + __expf(-v)); }
__device__ __forceinline__ unsigned pk4_fp8(float a, float b, float c, float d) { int w = 0; w = __builtin_amdgcn_cvt_pk_fp8_f32(a, b, w, false); w = __builtin_amdgcn_cvt_pk_fp8_f32(c, d, w, true); return (unsigned)w; }
typedef float f32x2_ __attribute__((ext_vector_type(2)));
__device__ __forceinline__ void fp8x4_to_f32(unsigned w, float (&o)[4]) { const f32x2_ lo = __builtin_amdgcn_cvt_pk_f32_fp8((int)w, false), hi = __builtin_amdgcn_cvt_pk_f32_fp8((int)w, true); o[0] = lo[0]; o[1] = lo[1]; o[2] = hi[0]; o[3] = hi[1]; }
struct EpiGateUp {
    static constexpr int PERM = 1;
    unsigned char* ACT;
    __device__ __forceinline__ void operator()(const f32x4 (&acc)[2][2][4][2], const Unit& u, int wr, int wc, int fr, int fq) const {
        const int row0 = u.pm * 256 + wr * 64 + fr, col0 = (u.pn & 3) * 128 + wc * 32 + 8 * fq;
        constexpr float IS = 1.0f / SW1;
#pragma unroll
        for (int ai = 0; ai < 2; ++ai) { if (ai == 1 && u.half) break;
#pragma unroll
            for (int m = 0; m < 4; ++m) { float o[8];
#pragma unroll
                for (int n = 0; n < 2; ++n)
#pragma unroll
                    for (int j = 0; j < 4; ++j) { const float gte = acc[ai][0][m][n][j] * IS, up = acc[ai][1][m][n][j] * (IS * SA); o[4 * n + j] = gte * sigmoid_f(gte) * up; }
                v2u w; w.x = pk4_fp8(o[0], o[1], o[2], o[3]); w.y = pk4_fp8(o[4], o[5], o[6], o[7]);
                *(v2u*)(ACT + (size_t)(row0 + ai * 128 + m * 16) * EFF + col0) = w; } }
    }
};
struct EpiDown {
    static constexpr int PERM = 2;
    unsigned char* Y;
    __device__ __forceinline__ void operator()(const f32x4 (&acc)[2][2][4][2], const Unit& u, int wr, int wc, int fr, int fq) const {
        const int row0 = u.pm * 256 + wr * 64 + fr, col0 = (u.pn & 7) * 256 + wc * 64 + 16 * fq;
        constexpr float IS = SY / (SA * SW2);
#pragma unroll
        for (int ai = 0; ai < 2; ++ai) { if (ai == 1 && u.half) break;
#pragma unroll
            for (int m = 0; m < 4; ++m) { const f32x4 v0 = acc[ai][0][m][0] * IS, v1 = acc[ai][0][m][1] * IS, v2 = acc[ai][1][m][0] * IS, v3 = acc[ai][1][m][1] * IS;
                v4u w; w.x = pk4_fp8(v0[0], v0[1], v0[2], v0[3]); w.y = pk4_fp8(v1[0], v1[1], v1[2], v1[3]); w.z = pk4_fp8(v2[0], v2[1], v2[2], v2[3]); w.w = pk4_fp8(v3[0], v3[1], v3[2], v3[3]);
                *(v4u*)(Y + (size_t)(row0 + ai * 128 + m * 16) * D + col0) = w; } }
    }
};
struct EpiBf16Mul {
    static constexpr int PERM = 1;
    bf16* O; float mul;
    __device__ __forceinline__ void operator()(const f32x4 (&acc)[2][2][4][2], const Unit& u, int wr, int wc, int fr, int fq) const {
        const int row0 = u.pm * 256 + wr * 64 + fr, colt = u.pn * 256 + wc * 32 + 8 * fq;
#pragma unroll
        for (int ai = 0; ai < 2; ++ai)
#pragma unroll
            for (int m = 0; m < 4; ++m) { bf16* rowp = O + (size_t)(row0 + ai * 128 + m * 16) * D + colt;
#pragma unroll
                for (int bj = 0; bj < 2; ++bj) { const f32x4 v0 = acc[ai][bj][m][0] * mul, v1 = acc[ai][bj][m][1] * mul;
                    v4u w; w.x = pk2(v0[0], v0[1]); w.y = pk2(v0[2], v0[3]); w.z = pk2(v1[0], v1[1]); w.w = pk2(v1[2], v1[3]);
                    *(v4u*)(rowp + bj * 128) = w; } }
    }
};
struct MoeOrder {
    static constexpr bool HALVES = true;
    const LAS int* tab; const int* toklist; int x, r, npn, stride;
    __device__ __forceinline__ bool next(int i, Unit& u) const {
        const int L = i * stride + r; const int tl = L / npn, pn = L - tl * npn;
        const int nf = tab[TB_XF + 8], ns = tab[TB_SHN], nh = tab[TB_XH + 8];
        if (tl >= nf + ns + nh) return false;
        int e, lt, row0, half = 0;
        if (tl < nf) { int s = 0;
#pragma unroll
            for (int q = 1; q <= 7; ++q) s += (tl >= tab[TB_XF + q]) ? 1 : 0;
            lt = tl - tab[TB_XF + s]; e = x + 8 * s; row0 = tab[TB_PAD + e] + 256 * lt; }
        else if (tl < nf + ns) { lt = tab[TB_SH0] + (tl - nf); e = NE; row0 = SH_ROW0 + 256 * lt; }
        else { const int hi = tl - nf - ns; int s = 0;
#pragma unroll
            for (int q = 1; q <= 7; ++q) s += (hi >= tab[TB_XH + q]) ? 1 : 0;
            e = x + 8 * s; lt = tab[TB_XF + s + 1] - tab[TB_XF + s]; row0 = tab[TB_PAD + e] + 256 * lt; half = 1; }
        u.pm = __builtin_amdgcn_readfirstlane(row0 >> 8); u.pn = __builtin_amdgcn_readfirstlane(e * npn + pn); u.e = __builtin_amdgcn_readfirstlane(e); u.lt = __builtin_amdgcn_readfirstlane(lt);
        u.half = __builtin_amdgcn_readfirstlane(half); return true;
    }
    __device__ __forceinline__ int arow(const Unit& u, int r_) const {
        const int lr = u.lt * 256 + r_;
        const int ee = (u.e < NE) ? u.e : 0;
        const int tk = toklist[(size_t)ee * T + (lr < T - 1 ? lr : T - 1)];
        return (u.e == NE) ? lr : ((lr < tab[TB_CNT + ee]) ? tk : 0);
    }
};
__device__ __forceinline__ void moe_tables(Frame& F) {
    const int LANE_ = pg8::lane_id(), TID_ = F.wave * 64 + LANE_; (void)TID_;
    LAS int* tab = (LAS int*)(F.lds + TAB_OFF);
    const int x = F.bx & 7;
    if (F.wave == 0) {
        const int e = LANE_, c = (int)__hip_atomic_load(F.ctl + CW_CNT + 32 * e, RLX_AGENT), nt = (c + 255) >> 8;
        const int hf = (nt > 0 && (c - ((nt - 1) << 8)) <= 128) ? 1 : 0, fl = nt - hf;
        tab[TB_CNT + e] = c; if (e == 0) tab[TB_CNT + NE] = T;
        int inc = nt << 8;
#pragma unroll
        for (int o = 1; o < 64; o <<= 1) { const int v = __shfl_up(inc, o); inc += (e >= o) ? v : 0; }
        tab[TB_PAD + e] = inc - (nt << 8); if (e == 63) tab[TB_PAD + NE] = inc;
        int ld = 2 * fl + hf;
        ld += __shfl_xor(ld, 8); ld += __shfl_xor(ld, 16); ld += __shfl_xor(ld, 32);
        int cf = fl, ch = hf;
#pragma unroll
        for (int o = 8; o < 64; o <<= 1) { const int vf = __shfl_up(cf, o), vh = __shfl_up(ch, o); cf += (e >= o) ? vf : 0; ch += (e >= o) ? vh : 0; }
        if ((e & 7) == x) { tab[TB_XF + (e >> 3) + 1] = cf; tab[TB_XH + (e >> 3) + 1] = ch; }
        if (e == 0) { tab[TB_XF] = 0; tab[TB_XH] = 0; }
        int load[8], nsh[8];
#pragma unroll
        for (int l = 0; l < 8; ++l) { load[l] = __shfl(ld, l); nsh[l] = 0; }
        for (int j = 0; j < 32; ++j) { int best = 0, bl = load[0];
#pragma unroll
            for (int l = 1; l < 8; ++l) { const bool lt_ = load[l] < bl; best = lt_ ? l : best; bl = lt_ ? load[l] : bl; }
#pragma unroll
            for (int l = 0; l < 8; ++l) { nsh[l] += (l == best) ? 1 : 0; load[l] += (l == best) ? 2 : 0; } }
        int s0 = 0, sn = 0;
#pragma unroll
        for (int l = 0; l < 8; ++l) { s0 += (l < x) ? nsh[l] : 0; sn = (l == x) ? nsh[l] : sn; }
        if (e == 0) { tab[TB_SH0] = s0; tab[TB_SHN] = sn; }
    }
    __syncthreads();
}
struct ConvJob { const float* src; bf16* dst; int N, ldk, mode, item; };
struct ConvJob8 { const float* src; unsigned char* dst; int N, ldk, mode, item; float scale; };
__device__ __forceinline__ void conv8_load(const ConvJob8& j, int lane, f32x4 (&v)[16]) {
    const int nblk = j.N >> 5, kb = j.item / nblk, nb = j.item - kb * nblk, k0 = 128 * kb, n0 = 32 * nb;
    const float* src = j.src + (size_t)(k0 + 16 * (lane >> 3)) * j.N + n0 + 4 * (lane & 7);
#pragma unroll
    for (int i = 0; i < 16; ++i) v[i] = __builtin_nontemporal_load((const f32x4*)(src + (size_t)i * j.N));
}
__device__ __forceinline__ void conv8_store(const ConvJob8& j, int lane, const f32x4 (&v)[16]) {
    const int nblk = j.N >> 5, kb = j.item / nblk, nb = j.item - kb * nblk, k0 = 128 * kb, n0 = 32 * nb; const float scale = j.scale;
#pragma unroll
    for (int q = 0; q < 4; ++q) { const int n = n0 + 4 * (lane & 7) + q; int dr = n;
        if (j.mode == 5) dr = ((n >> 7) << 8) + (n & 127); else if (j.mode == 6) dr = ((n >> 7) << 8) + 128 + (n & 127);
        v4u o; o.x = pk4_fp8(v[0][q] * scale, v[1][q] * scale, v[2][q] * scale, v[3][q] * scale); o.y = pk4_fp8(v[4][q] * scale, v[5][q] * scale, v[6][q] * scale, v[7][q] * scale);
        o.z = pk4_fp8(v[8][q] * scale, v[9][q] * scale, v[10][q] * scale, v[11][q] * scale); o.w = pk4_fp8(v[12][q] * scale, v[13][q] * scale, v[14][q] * scale, v[15][q] * scale);
        __builtin_nontemporal_store(o, (v4u*)(j.dst + (size_t)dr * j.ldk + k0 + 16 * (lane >> 3))); }
}
__device__ __forceinline__ void conv_load(const ConvJob& j, int lane, f32x4 (&v)[8]) {
    const int nblk = j.N >> 5, kb = j.item / nblk, nb = j.item - kb * nblk, k0 = 64 * kb, n0 = 32 * nb;
    const float* src = j.src + (size_t)(k0 + 8 * (lane >> 3)) * j.N + n0 + 4 * (lane & 7);
#pragma unroll
    for (int i = 0; i < 8; ++i) v[i] = __builtin_nontemporal_load((const f32x4*)(src + (size_t)i * j.N));
}
__device__ __forceinline__ void conv_store(const ConvJob& j, int lane, const f32x4 (&v)[8]) {
    const int nblk = j.N >> 5, kb = j.item / nblk, nb = j.item - kb * nblk, k0 = 64 * kb, n0 = 32 * nb;
#pragma unroll
    for (int q = 0; q < 4; ++q) { const int n = n0 + 4 * (lane & 7) + q; int dr = n;
        if (j.mode == 1) dr = ((n >> 7) << 8) + (n & 127); else if (j.mode == 2) dr = ((n >> 7) << 8) + 128 + (n & 127);
        v4u o; o.x = pk2(v[0][q], v[1][q]); o.y = pk2(v[2][q], v[3][q]); o.z = pk2(v[4][q], v[5][q]); o.w = pk2(v[6][q], v[7][q]);
        *(v4u*)(j.dst + (size_t)dr * j.ldk + k0 + 8 * (lane >> 3)) = o; }
}
__device__ __forceinline__ void rms_row_to_bf16(const float* xrow, const float* g, bf16* orow, int lane) {
    f32x4 v[8]; float s = 0.f;
#pragma unroll
    for (int j = 0; j < 4; ++j) { v[2 * j] = *(const f32x4*)(xrow + 512 * j + 8 * lane); v[2 * j + 1] = *(const f32x4*)(xrow + 512 * j + 8 * lane + 4); }
#pragma unroll
    for (int j = 0; j < 8; ++j) s += (v[j][0] * v[j][0] + v[j][1] * v[j][1]) + (v[j][2] * v[j][2] + v[j][3] * v[j][3]);
    const float rstd = 1.0f / sqrtf(wave_sum(s) * (1.0f / D) + EPS);
#pragma unroll
    for (int j = 0; j < 4; ++j) { const f32x4 g0 = *(const f32x4*)(g + 512 * j + 8 * lane), g1 = *(const f32x4*)(g + 512 * j + 8 * lane + 4);
        const f32x4 a = v[2 * j] * rstd * g0, b = v[2 * j + 1] * rstd * g1;
        v4u o; o.x = pk2(a[0], a[1]); o.y = pk2(a[2], a[3]); o.z = pk2(b[0], b[1]); o.w = pk2(b[2], b[3]);
        *(v4u*)(orow + 512 * j + 8 * lane) = o; }
}
constexpr int CV_G1 = (D / 128) * (EFF / 32), CV_D1 = (EFF / 128) * (D / 32), CV_G = 65 * CV_G1, CV_DN = 65 * CV_D1, CV_PG = (D / 128) * (D / 32), CV_TOTAL = 2 * CV_G + CV_DN + CV_PG;
constexpr int CONV_B = 896 * 16, CONV_C = 1024 * 20, CONV_A = CV_TOTAL - CONV_B - CONV_C;
__device__ __forceinline__ ConvJob8 conv8_decode(Frame& F, int it) {
    unsigned char* WGU8 = F.ws + WS_WGU; unsigned char* WDN8 = F.ws + WS_WD;
    int r = it;
    if (r < CV_G) { const int e = r / CV_G1, li = r - e * CV_G1; const float* src = (e < NE) ? fin(F, I_WGATE) + (size_t)e * D * EFF : fin(F, I_WSGATE);
        return ConvJob8{src, WGU8 + (size_t)e * 1024 * D, EFF, D, 5, li, SW1}; } r -= CV_G;
    if (r < CV_G) { const int e = r / CV_G1, li = r - e * CV_G1; const float* src = (e < NE) ? fin(F, I_WUP) + (size_t)e * D * EFF : fin(F, I_WSUP);
        return ConvJob8{src, WGU8 + (size_t)e * 1024 * D, EFF, D, 6, li, SW1}; } r -= CV_G;
    if (r < CV_DN) { const int e = r / CV_D1, li = r - e * CV_D1; const float* src = (e < NE) ? fin(F, I_WDOWN) + (size_t)e * EFF * D : fin(F, I_WSDOWN);
        return ConvJob8{src, WDN8 + (size_t)e * D * EFF, D, EFF, 4, li, SW2}; } r -= CV_DN;
    return ConvJob8{fin(F, I_WPLEGATE), F.ws + WS_WPG, D, D, 4, r, SW3};
}
__device__ __forceinline__ void conv_fp8_items(Frame& F, int lo, int hi, int rank, int nranks) {
    const int LANE_ = pg8::lane_id();
    int it0 = lo + rank; if (it0 >= hi) return;
    f32x4 va[16], vb[16];
    ConvJob8 j0 = conv8_decode(F, it0), j1 = j0; conv8_load(j0, LANE_, va);
    for (;;) {
        const int it1 = it0 + nranks; const bool has1 = it1 < hi;
        if (has1) { j1 = conv8_decode(F, it1); conv8_load(j1, LANE_, vb); }
        conv8_store(j0, LANE_, va);
        if (!has1) break;
        it0 = it1 + nranks; const bool has0 = it0 < hi;
        if (has0) { j0 = conv8_decode(F, it0); conv8_load(j0, LANE_, va); }
        conv8_store(j1, LANE_, vb);
        if (!has0) break;
    }
}
constexpr int SEG_N0 = 14000, SEG_N1 = 16000, SEG_N2 = CV_TOTAL - SEG_N0 - SEG_N1;
static_assert(SEG_N0 % 8 == 0 && SEG_N1 % 8 == 0 && SEG_N2 % 8 == 0 && SEG_N2 > 0, "queue segments");
__device__ __forceinline__ void conv_dyn(Frame& F, int seg) {
    const int LANE_ = pg8::lane_id(); const bool t0 = (F.wave == 0 && LANE_ == 0);
    const int x = F.bx & 7;
    const int segn = (seg == 0 ? SEG_N0 : (seg == 1 ? SEG_N1 : SEG_N2)) / 8, lo = (seg == 0 ? 0 : (seg == 1 ? SEG_N0 : SEG_N0 + SEG_N1)) + x * segn;
    gu32* ctr = F.ctl + CW_CONVQ + 32 * (seg * 8 + x);
    volatile LAS unsigned* Q = F.MISC + 16;
    LDS_BARRIER();
    if (t0) { const unsigned a = __hip_atomic_fetch_add(ctr, 8u, RLX_AGENT), b = __hip_atomic_fetch_add(ctr, 8u, RLX_AGENT); Q[0] = a; Q[1] = b; }
    LDS_BARRIER();
    int c0 = __builtin_amdgcn_readfirstlane((int)Q[0]), c1 = __builtin_amdgcn_readfirstlane((int)Q[1]);
    f32x4 va[16], vb[16]; ConvJob8 ja, jb;
    bool ha = (c0 + F.wave) < segn, hb = false;
    ja = conv8_decode(F, lo + (ha ? c0 + F.wave : 0)); jb = ja;
    if (ha) conv8_load(ja, LANE_, va);
    for (;;) {
        unsigned vn = 0u; if (t0) vn = __hip_atomic_fetch_add(ctr, 8u, RLX_AGENT);
        hb = (c1 + F.wave) < segn; if (hb) { jb = conv8_decode(F, lo + c1 + F.wave); conv8_load(jb, LANE_, vb); }
        if (ha) conv8_store(ja, LANE_, va);
        if (c0 >= segn) break;
        LDS_BARRIER(); if (t0) Q[0] = vn; LDS_BARRIER();
        c0 = __builtin_amdgcn_readfirstlane((int)Q[0]);
        vn = 0u; if (t0) vn = __hip_atomic_fetch_add(ctr, 8u, RLX_AGENT);
        ha = (c0 + F.wave) < segn; if (ha) { ja = conv8_decode(F, lo + c0 + F.wave); conv8_load(ja, LANE_, va); }
        if (hb) conv8_store(jb, LANE_, vb);
        if (c1 >= segn) break;
        LDS_BARRIER(); if (t0) Q[1] = vn; LDS_BARRIER();
        c1 = __builtin_amdgcn_readfirstlane((int)Q[1]);
    }
    LDS_BARRIER();
}
constexpr int WI_G1 = (D / 256) * (EFF / 128), WI_D1 = (EFF / 256) * (D / 128), WI_G = 65 * WI_G1, WI_DN = 65 * WI_D1, WI_PG = (D / 256) * (D / 128), WI_TOTAL = 2 * WI_G + WI_DN + WI_PG;
constexpr int SEGW0 = 1752, SEGW1 = 2000, SEGW2 = WI_TOTAL - SEGW0 - SEGW1;
static_assert(SEGW0 % 8 == 0 && SEGW1 % 8 == 0 && SEGW2 % 8 == 0 && SEGW2 > 0, "queue segments");
struct ConvJobW { const float* src; unsigned char* dst; int N, ldk, mode, k0, n0; float scale; };
__device__ __forceinline__ ConvJobW convw_decode(Frame& F, int it) {
    unsigned char* WGU8 = F.ws + WS_WGU; unsigned char* WDN8 = F.ws + WS_WD;
    int r = it;
    if (r < WI_G) { const int e = r / WI_G1, li = r - e * WI_G1; const float* src = (e < NE) ? fin(F, I_WGATE) + (size_t)e * D * EFF : fin(F, I_WSGATE);
        return ConvJobW{src, WGU8 + (size_t)e * 1024 * D, EFF, D, 5, 256 * (li >> 2), 128 * (li & 3), SW1}; } r -= WI_G;
    if (r < WI_G) { const int e = r / WI_G1, li = r - e * WI_G1; const float* src = (e < NE) ? fin(F, I_WUP) + (size_t)e * D * EFF : fin(F, I_WSUP);
        return ConvJobW{src, WGU8 + (size_t)e * 1024 * D, EFF, D, 6, 256 * (li >> 2), 128 * (li & 3), SW1}; } r -= WI_G;
    if (r < WI_DN) { const int e = r / WI_D1, li = r - e * WI_D1; const float* src = (e < NE) ? fin(F, I_WDOWN) + (size_t)e * EFF * D : fin(F, I_WSDOWN);
        return ConvJobW{src, WDN8 + (size_t)e * D * EFF, D, EFF, 4, 256 * (li >> 4), 128 * (li & 15), SW2}; } r -= WI_DN;
    return ConvJobW{fin(F, I_WPLEGATE), F.ws + WS_WPG, D, D, 4, 256 * (r >> 4), 128 * (r & 15), SW3};
}
__device__ __forceinline__ void conv_wg_dyn(Frame& F, int seg) {
    const int LANE_ = pg8::lane_id(), TID_ = F.wave * 64 + LANE_; const bool t0 = (TID_ == 0);
    const int x = F.bx & 7;
    const int segn = (seg == 0 ? SEGW0 : (seg == 1 ? SEGW1 : SEGW2)) / 8, lo = (seg == 0 ? 0 : (seg == 1 ? SEGW0 : SEGW0 + SEGW1)) + x * segn;
    gu32* ctr = F.ctl + CW_CONVQ + 32 * (seg * 8 + x);
    volatile LAS unsigned* Q = F.MISC + 16;
    LAS unsigned char* TL = F.lds + RING_OFF;
    LDS_BARRIER();
    if (t0) Q[0] = __hip_atomic_fetch_add(ctr, 1u, RLX_AGENT);
    LDS_BARRIER();
    int cur = __builtin_amdgcn_readfirstlane((int)Q[0]);
    if (cur >= segn) return;
    const int hh = LANE_ >> 5, n4 = LANE_ & 31;
    ConvJobW j = convw_decode(F, lo + cur);
    f32x4 v[16];
    { const float* src = j.src + (size_t)(j.k0 + 32 * F.wave + 16 * hh) * j.N + j.n0 + 4 * n4;
#pragma unroll
      for (int i = 0; i < 16; ++i) v[i] = __builtin_nontemporal_load((const f32x4*)(src + (size_t)i * j.N)); }
    for (;;) {
        unsigned vn = 0u; if (t0) vn = __hip_atomic_fetch_add(ctr, 1u, RLX_AGENT);
        { const float sc = j.scale;
#pragma unroll
          for (int g = 0; g < 4; ++g)
#pragma unroll
              for (int q = 0; q < 4; ++q) { const int n = 4 * n4 + q, kd = (8 * F.wave + 4 * hh + g + 4 * (n4 & 15)) & 63;
                  *(LAS unsigned*)(TL + n * 256 + kd * 4) = pk4_fp8(v[4 * g][q] * sc, v[4 * g + 1][q] * sc, v[4 * g + 2][q] * sc, v[4 * g + 3][q] * sc); } }
        if (t0) Q[0] = vn;
        LDS_BARRIER();
        const int nxt = __builtin_amdgcn_readfirstlane((int)Q[0]);
        const ConvJobW jc = j;
        if (nxt < segn) { j = convw_decode(F, lo + nxt);
            const float* src = j.src + (size_t)(j.k0 + 32 * F.wave + 16 * hh) * j.N + j.n0 + 4 * n4;
#pragma unroll
            for (int i = 0; i < 16; ++i) v[i] = __builtin_nontemporal_load((const f32x4*)(src + (size_t)i * j.N)); }
#pragma unroll
        for (int i = 0; i < 4; ++i) { const int id = TID_ + 512 * i, n = id >> 4, c16 = id & 15, kd = (4 * c16 + 4 * ((n >> 2) & 15)) & 63;
            const v4u o = *(const LAS v4u*)(TL + n * 256 + kd * 4);
            const int nn = jc.n0 + n; int dr = nn;
            if (jc.mode == 5) dr = ((nn >> 7) << 8) + (nn & 127); else if (jc.mode == 6) dr = ((nn >> 7) << 8) + 128 + (nn & 127);
            __builtin_nontemporal_store(o, (v4u*)(jc.dst + (size_t)dr * jc.ldk + jc.k0 + 16 * c16)); }
        LDS_BARRIER();
        if (nxt >= segn) break;
    }
}
__device__ __forceinline__ void p0_prologue(Frame& F) {
    const int LANE_ = pg8::lane_id(), TID_ = F.wave * 64 + LANE_; (void)TID_;
    const int gw = F.bx * NWAVES + F.wave, NGW = F.G * NWAVES;
    bf16* WIN = (bf16*)(F.ws + WS_WIN); bf16* WPOOL = (bf16*)(F.ws + WS_WPOOL); bf16* WOUT = (bf16*)(F.ws + WS_WOUT); bf16* WPP = (bf16*)(F.ws + WS_WPP);
    constexpr int I_IN = (D / 64) * (INW / 32), I_PL = 4 * (256 / 64) * (256 / 32), I_OUT = (D / 64) * (D / 32), I_PP = (PLE / 64) * (D / 32), I_PG = (D / 64) * (D / 32);
    constexpr int I_SMALL = I_IN + I_PL + I_OUT + I_PP; (void)I_PG;
    auto decode = [&](int it) -> ConvJob {
        int r = it;
        if (r < I_IN) return ConvJob{fin(F, I_WIN), WIN, INW, D, 0, r}; r -= I_IN;
        if (r < I_PL) { const int gq = r >> 5; return ConvJob{fin(F, I_WPOOL) + (size_t)gq * 65536, WPOOL + (size_t)gq * 65536, 256, 256, 0, r & 31}; } r -= I_PL;
        if (r < I_OUT) return ConvJob{fin(F, I_WOUT), WOUT, D, D, 0, r}; r -= I_OUT;
        return ConvJob{fin(F, I_WPLEPROJ), WPP, D, PLE, 0, r};
    };
    for (int it = gw; it < I_SMALL; it += 2 * NGW) {
        const ConvJob j0 = decode(it); const bool two = (it + NGW) < I_SMALL; const ConvJob j1 = decode(two ? it + NGW : it);
        f32x4 v0[8], v1[8];
        conv_load(j0, LANE_, v0); conv_load(j1, LANE_, v1);
        conv_store(j0, LANE_, v0); if (two) conv_store(j1, LANE_, v1);
    }
    if (F.G != 256) conv_fp8_items(F, 0, CONV_A, gw, NGW);
    { const float* WR = fin(F, I_WROUTER); bf16* WH = (bf16*)(F.ws + WS_WRT); bf16* WL = WH + (size_t)NE * D;
      for (int i = gw * 64 + LANE_; i < NE * (D / 8); i += NGW * 64) { const int e = i & 63, k0 = (i >> 6) * 8; float x[8]; unsigned hh[8], ll[8];
#pragma unroll
          for (int j = 0; j < 8; ++j) x[j] = WR[(size_t)(k0 + j) * NE + e];
#pragma unroll
          for (int j = 0; j < 8; ++j) { hh[j] = pk2(x[j], 0.f) & 0xffffu; ll[j] = pk2(x[j] - bf_lo(hh[j]), 0.f) & 0xffffu; }
          v4u oh, ol; oh.x = hh[0] | (hh[1] << 16); oh.y = hh[2] | (hh[3] << 16); oh.z = hh[4] | (hh[5] << 16); oh.w = hh[6] | (hh[7] << 16);
          ol.x = ll[0] | (ll[1] << 16); ol.y = ll[2] | (ll[3] << 16); ol.z = ll[4] | (ll[5] << 16); ol.w = ll[6] | (ll[7] << 16);
          const size_t fo = ((size_t)((k0 >> 5) * 4 + (e >> 4)) * 16 + (e & 15)) * 32 + (k0 & 31);
          *(v4u*)(WH + fo) = oh; *(v4u*)(WL + fo) = ol; } }
    { const float* P = fin(F, I_P); bf16* PB = (bf16*)(F.ws + WS_PBF);
      for (int i = gw * 64 + LANE_; i < T * PLE / 8; i += NGW * 64) { const f32x4 a = *(const f32x4*)(P + (size_t)i * 8), b = *(const f32x4*)(P + (size_t)i * 8 + 4);
          v4u o; o.x = pk2(a[0], a[1]); o.y = pk2(a[2], a[3]); o.z = pk2(b[0], b[1]); o.w = pk2(b[2], b[3]); *(v4u*)(PB + (size_t)i * 8) = o; } }
    bf16* ABF = (bf16*)(F.ws + WS_ABF);
    { const float* X = fin(F, I_X); const float* gm = fin(F, I_GMIX);
      f32x4 nx[8];
      if (gw < T) {
#pragma unroll
          for (int j = 0; j < 4; ++j) { nx[2 * j] = __builtin_nontemporal_load((const f32x4*)(X + (size_t)gw * D + 512 * j + 8 * LANE_)); nx[2 * j + 1] = __builtin_nontemporal_load((const f32x4*)(X + (size_t)gw * D + 512 * j + 8 * LANE_ + 4)); } }
      for (int m = gw; m < T; m += NGW) {
          f32x4 v[8]; float sq = 0.f;
#pragma unroll
          for (int j = 0; j < 8; ++j) v[j] = nx[j];
          if (m + NGW < T) {
#pragma unroll
              for (int j = 0; j < 4; ++j) { nx[2 * j] = __builtin_nontemporal_load((const f32x4*)(X + (size_t)(m + NGW) * D + 512 * j + 8 * LANE_)); nx[2 * j + 1] = __builtin_nontemporal_load((const f32x4*)(X + (size_t)(m + NGW) * D + 512 * j + 8 * LANE_ + 4)); } }
#pragma unroll
          for (int j = 0; j < 8; ++j) sq += (v[j][0] * v[j][0] + v[j][1] * v[j][1]) + (v[j][2] * v[j][2] + v[j][3] * v[j][3]);
          const float rstd = 1.0f / sqrtf(wave_sum(sq) * (1.0f / D) + EPS);
#pragma unroll
          for (int j = 0; j < 4; ++j) { const f32x4 g0 = *(const f32x4*)(gm + 512 * j + 8 * LANE_), g1 = *(const f32x4*)(gm + 512 * j + 8 * LANE_ + 4);
              const f32x4 a = v[2 * j] * rstd * g0, b = v[2 * j + 1] * rstd * g1;
              v4u o; o.x = pk2(a[0], a[1]); o.y = pk2(a[2], a[3]); o.z = pk2(b[0], b[1]); o.w = pk2(b[2], b[3]);
              *(v4u*)(ABF + (size_t)m * D + 512 * j + 8 * LANE_) = o; } } }
    if (F.G == 256) conv_wg_dyn(F, 0);
}

__device__ __forceinline__ int t5_bucket(int n) {
    if (n < 16) return n;
    const int large = 16 + (int)(logf((float)n * (1.0f / 16.0f)) / logf(8.0f) * 16.0f);
    return large < 31 ? large : 31;
}
constexpr int VT_LD = 216, VT_KEYS = 208, KT_LD = 72;
constexpr int ATT_KT_OFF = 0, ATT_VT_OFF = VT_KEYS * KT_LD * 2;
__device__ __forceinline__ void attn_task(Frame& F, const f32x4 (&bv)[5][2], const LAS bf16* ktl, const LAS bf16* vtl, int b, int kvh, int hg, int qt, const bf16x8 (&qf)[2]) {
    const int LANE_ = pg8::lane_id();
    bf16* MIX = (bf16*)(F.ws + WS_MIX);
    const int lane = LANE_, qi = lane & 15, g = lane >> 4, h = kvh * 8 + hg;
    const int q0 = qt * 16, tok0 = b * SEQ, kl0 = 16 * (qt & 3);
    f32x4 s[5][2];
#pragma unroll
    for (int kb = 0; kb < 5; ++kb)
#pragma unroll
        for (int t = 0; t < 2; ++t) {
            const LAS bf16* kp = ktl + (kl0 + 32 * kb + 16 * t + qi) * KT_LD + 8 * g;
            const bf16x8 k0f = *(const LAS bf16x8*)(kp), k1f = *(const LAS bf16x8*)(kp + 32);
            f32x4 a = (f32x4){0.f, 0.f, 0.f, 0.f};
            a = __builtin_amdgcn_mfma_f32_16x16x32_bf16(k0f, qf[0], a, 0, 0, 0);
            a = __builtin_amdgcn_mfma_f32_16x16x32_bf16(k1f, qf[1], a, 0, 0, 0);
            s[kb][t] = a;
        }
    const float sink = fin(F, I_SINKS)[h];
    float mx = sink;
    const bool edge = q0 < 128;
#pragma unroll
    for (int kb = 0; kb < 5; ++kb)
#pragma unroll
        for (int t = 0; t < 2; ++t)
#pragma unroll
            for (int r = 0; r < 4; ++r) {
                float lg = s[kb][t][r] * 0.125f + bv[kb][t][r];
                if (edge) { const int key = q0 - 128 + 32 * kb + 16 * t + 4 * g + r; lg = (key >= 0) ? lg : -3.0e38f; }
                s[kb][t][r] = lg; mx = fmaxf(mx, lg);
            }
    mx = fmaxf(mx, __shfl_xor(mx, 16)); mx = fmaxf(mx, __shfl_xor(mx, 32));
    float sum = 0.f;
#pragma unroll
    for (int kb = 0; kb < 5; ++kb)
#pragma unroll
        for (int t = 0; t < 2; ++t)
#pragma unroll
            for (int r = 0; r < 4; ++r) { const float lg = s[kb][t][r]; const float p = (lg > -1.0e38f) ? __expf(lg - mx) : 0.f; s[kb][t][r] = p; sum += p; }
    sum += __shfl_xor(sum, 16); sum += __shfl_xor(sum, 32);
    const float inv = 1.0f / (sum + __expf(sink - mx));
    f32x4 o[4];
#pragma unroll
    for (int dt = 0; dt < 4; ++dt) o[dt] = (f32x4){0.f, 0.f, 0.f, 0.f};
#pragma unroll
    for (int kb = 0; kb < 5; ++kb) {
        v4u pw; pw.x = pk2(s[kb][0][0], s[kb][0][1]); pw.y = pk2(s[kb][0][2], s[kb][0][3]); pw.z = pk2(s[kb][1][0], s[kb][1][1]); pw.w = pk2(s[kb][1][2], s[kb][1][3]);
        const bf16x8 pf = __builtin_bit_cast(bf16x8, pw);
        const int kkl = kl0 + 32 * kb + 4 * g;
#pragma unroll
        for (int dt = 0; dt < 4; ++dt) {
            const LAS bf16* vp = vtl + (16 * dt + qi) * VT_LD + kkl;
            const v2u lo = *(const LAS v2u*)(vp), hi = *(const LAS v2u*)(vp + 16);
            const v4u vw = (v4u){lo.x, lo.y, hi.x, hi.y};
            o[dt] = __builtin_amdgcn_mfma_f32_16x16x32_bf16(__builtin_bit_cast(bf16x8, vw), pf, o[dt], 0, 0, 0);
        }
    }
    bf16* op = MIX + (size_t)(tok0 + q0 + qi) * D + POOLW + h * 64 + 4 * g;
#pragma unroll
    for (int dt = 0; dt < 4; ++dt) { v2u w; w.x = pk2(o[dt][0] * inv, o[dt][1] * inv); w.y = pk2(o[dt][2] * inv, o[dt][3] * inv); *(v2u*)(op + 16 * dt) = w; }
}
__device__ __forceinline__ void attn_block(Frame& F, int blk, bool fill_btab) {
    const int TID_ = F.wave * 64 + pg8::lane_id();
    LAS float* btab = (LAS float*)(F.lds + TAB_OFF + 2048);
    LAS bf16* ktl = (LAS bf16*)(F.lds + RING_OFF + ATT_KT_OFF); LAS bf16* vtl = (LAS bf16*)(F.lds + RING_OFF + ATT_VT_OFF);
    const int b = blk >> 6, kvh = (blk >> 5) & 1, qg = blk & 31;
    const bf16* Q = (const bf16*)(F.ws + WS_QBF); const bf16* KVp = (const bf16*)(F.ws + WS_KV);
    const bf16* qbase = Q + (size_t)(b * SEQ + 64 * qg + ((TID_ & 63) & 15)) * 1024 + (kvh * 8 + F.wave) * 64 + 8 * ((TID_ & 63) >> 4);
    bf16x8 qc[2], qn[2];
    qc[0] = *(const bf16x8*)(qbase); qc[1] = *(const bf16x8*)(qbase + 32);
    v4u kv[4], vv[4];
#pragma unroll
    for (int it = 0; it < 4; ++it) { const int idx = TID_ + it * NWAVES * 64, kl = idx >> 3, c = idx & 7, key = 64 * qg - 128 + kl;
        kv[it] = (v4u){0u, 0u, 0u, 0u}; vv[it] = (v4u){0u, 0u, 0u, 0u};
        if (idx < VT_KEYS * 8 && key >= 0 && key < SEQ) { const bf16* rp = KVp + (size_t)(b * SEQ + key) * (2 * KVW) + kvh * 64 + 8 * c; kv[it] = *(const v4u*)(rp); vv[it] = *(const v4u*)(rp + KVW); } }
    LDS_BARRIER();
    if (fill_btab) for (int i = TID_; i < 1024; i += NWAVES * 64) { const int hg = i >> 7, dist = i & 127; btab[i] = fin(F, I_RPE)[t5_bucket(dist) * NH + kvh * 8 + hg]; }
#pragma unroll
    for (int it = 0; it < 4; ++it) { const int idx = TID_ + it * NWAVES * 64, kl = idx >> 3, c = idx & 7;
        if (idx < VT_KEYS * 8) { const v4u v = vv[it];
            *(LAS v4u*)(ktl + kl * KT_LD + 8 * c) = kv[it];
            LAS bf16* d0 = vtl + (8 * c) * VT_LD + kl;
            d0[0 * VT_LD] = (bf16)(v.x & 0xffffu); d0[1 * VT_LD] = (bf16)(v.x >> 16); d0[2 * VT_LD] = (bf16)(v.y & 0xffffu); d0[3 * VT_LD] = (bf16)(v.y >> 16);
            d0[4 * VT_LD] = (bf16)(v.z & 0xffffu); d0[5 * VT_LD] = (bf16)(v.z >> 16); d0[6 * VT_LD] = (bf16)(v.w & 0xffffu); d0[7 * VT_LD] = (bf16)(v.w >> 16); } }
    LDS_BARRIER();
    f32x4 bv[5][2];
    { const int qi = (TID_ & 63) & 15, g = (TID_ & 63) >> 4;
#pragma unroll
      for (int kb = 0; kb < 5; ++kb)
#pragma unroll
          for (int t = 0; t < 2; ++t)
#pragma unroll
              for (int r = 0; r < 4; ++r) { const int dist = 128 + qi - (32 * kb + 16 * t + 4 * g + r); bv[kb][t][r] = (dist >= 0 && dist < 128) ? btab[F.wave * 128 + (dist & 127)] : -3.0e38f; } }
#pragma unroll 1
    for (int i = 0; i < 4; ++i) {
        const bf16* qb2 = qbase + (size_t)((i < 3 ? i + 1 : i) * 16) * 1024;
        qn[0] = *(const bf16x8*)(qb2); qn[1] = *(const bf16x8*)(qb2 + 32);
        attn_task(F, bv, ktl, vtl, b, kvh, F.wave, 4 * qg + i, qc);
        qc[0] = qn[0]; qc[1] = qn[1];
    }
}
__device__ __forceinline__ void pool_task(Frame& F, int mt, int gq) {
    const int LANE_ = pg8::lane_id(), TID_ = F.wave * 64 + LANE_;
    const bf16* U = (const bf16*)(F.ws + WS_UBF); bf16* PO = (bf16*)(F.ws + WS_POOLED);
    LAS v4u* UL = (LAS v4u*)(F.lds + RING_OFF);
    const int w = 2 << gq;
    for (int hh = 0; hh < 2; ++hh) {
        const int tbase = mt * 256 + 128 * hh, pos0 = tbase & (SEQ - 1);
        LDS_BARRIER();
        for (int idx = TID_; idx < 143 * 32; idx += NWAVES * 64) { const int r = idx >> 5, c = idx & 31;
            v4u x = (v4u){0u, 0u, 0u, 0u}; if (pos0 - 15 + r >= 0) x = *(const v4u*)(U + (size_t)(tbase - 15 + r) * POOLW + gq * 256 + 8 * c);
            UL[idx] = x; }
        LDS_BARRIER();
        const int c = TID_ & 31, i0 = (TID_ >> 5) * 8;
        float run[8];
#pragma unroll
        for (int q = 0; q < 8; ++q) run[q] = 0.f;
        for (int j = 1; j < w; ++j) { const v4u x = UL[(15 + i0 - j) * 32 + c];
            run[0] += bf_lo(x.x); run[1] += bf_hi(x.x); run[2] += bf_lo(x.y); run[3] += bf_hi(x.y); run[4] += bf_lo(x.z); run[5] += bf_hi(x.z); run[6] += bf_lo(x.w); run[7] += bf_hi(x.w); }
#pragma unroll
        for (int i = 0; i < 8; ++i) {
            const int pos = pos0 + i0 + i; const v4u x = UL[(15 + i0 + i) * 32 + c], y = UL[(15 + i0 + i - w + 1) * 32 + c];
            const float uv[8] = {bf_lo(x.x), bf_hi(x.x), bf_lo(x.y), bf_hi(x.y), bf_lo(x.z), bf_hi(x.z), bf_lo(x.w), bf_hi(x.w)};
            const float ic = 1.0f / (float)((pos + 1) < w ? (pos + 1) : w);
            float o[8];
#pragma unroll
            for (int q = 0; q < 8; ++q) { run[q] += uv[q]; o[q] = run[q] * ic - uv[q]; }
            v4u ow; ow.x = pk2(o[0], o[1]); ow.y = pk2(o[2], o[3]); ow.z = pk2(o[4], o[5]); ow.w = pk2(o[6], o[7]);
            *(v4u*)(PO + (size_t)(tbase + i0 + i) * POOLW + gq * 256 + 8 * c) = ow;
            run[0] -= bf_lo(y.x); run[1] -= bf_hi(y.x); run[2] -= bf_lo(y.y); run[3] -= bf_hi(y.y); run[4] -= bf_lo(y.z); run[5] -= bf_hi(y.z); run[6] -= bf_lo(y.w); run[7] -= bf_hi(y.w);
        }
    }
    VM_WAIT(); __syncthreads();
    pg8::Gemm g{(const bf16*)PO + gq * 256, (const bf16*)(F.ws + WS_WPOOL) + (size_t)gq * 65536, POOLW, 256, 256};
    pg8::SingleOrder S{mt, 0};
    EpiBf16Plain E{(bf16*)(F.ws + WS_MIX), D, gq * 256, fin(F, I_PSCALE)};
    pg8::gemm_phase<EpiBf16Plain, pg8::SingleOrder, false>(F.lds + RING_OFF, g, S, E, F.wave);
}

constexpr int XS_STRIDE = 2052;
constexpr int P4_XS = 0, P4_PART = 16 * XS_STRIDE * 4, P4_SELE = P4_PART + 4 * 16 * 64 * 4, P4_SELW = P4_SELE + 32 * 8 * 4, P4_SELL = P4_SELW + 32 * 8 * 4, P4_HIST = P4_SELL + 32 * 8 * 4, P4_BASE = P4_HIST + 256, P4_END = P4_BASE + 256;
static_assert(P4_END <= MISC_OFF, "P4 LDS map");
__device__ __forceinline__ unsigned fkey(float f) { const unsigned u = __builtin_bit_cast(unsigned, f); return (u & 0x80000000u) ? ~u : (u | 0x80000000u); }
__device__ __forceinline__ void p4_route(Frame& F) {
    const int LANE_ = pg8::lane_id(), TID_ = F.wave * 64 + LANE_; (void)TID_;
    LAS float* XS = (LAS float*)(F.lds + P4_XS); LAS float* PART = (LAS float*)(F.lds + P4_PART);
    LAS int* SELE = (LAS int*)(F.lds + P4_SELE); LAS float* SELW = (LAS float*)(F.lds + P4_SELW); LAS int* SELL = (LAS int*)(F.lds + P4_SELL);
    LAS int* HIST = (LAS int*)(F.lds + P4_HIST); LAS int* BASE = (LAS int*)(F.lds + P4_BASE);
    const float* H1 = (const float*)(F.ws + WS_H1); unsigned char* XN = F.ws + WS_XN; const float* gf = fin(F, I_GFFN); const float* rb = fin(F, I_RBIAS);
    const bf16* WH = (const bf16*)(F.ws + WS_WRT); const bf16* WL = WH + (size_t)NE * D;
    const int lane = LANE_, wave = F.wave, ti = lane & 15, kk = lane >> 4;
    if (TID_ < 64) HIST[TID_] = 0;
    for (int tile = F.bx; tile < T / 32; tile += F.G) {
    f32x4 xr[2][8];
#pragma unroll
    for (int q = 0; q < 2; ++q) { const float* xrow = H1 + (size_t)(tile * 32 + 2 * wave + q) * D;
#pragma unroll
        for (int j = 0; j < 4; ++j) { xr[q][2 * j] = *(const f32x4*)(xrow + 512 * j + 8 * lane); xr[q][2 * j + 1] = *(const f32x4*)(xrow + 512 * j + 8 * lane + 4); } }
#pragma unroll 1
    for (int pass = 0; pass < 2; ++pass) {
#pragma unroll
        for (int q = 0; q < 2; ++q) { const int tl = 2 * wave + q; float s = 0.f;
#pragma unroll
            for (int j = 0; j < 8; ++j) { const f32x4 v = xr[q][j]; s += (v[0] * v[0] + v[1] * v[1]) + (v[2] * v[2] + v[3] * v[3]); }
            const float rstd = 1.0f / sqrtf(wave_sum(s) * (1.0f / D) + EPS);
#pragma unroll
            for (int j = 0; j < 4; ++j) { const f32x4 a = xr[q][2 * j] * rstd * *(const f32x4*)(gf + 512 * j + 8 * lane), b = xr[q][2 * j + 1] * rstd * *(const f32x4*)(gf + 512 * j + 8 * lane + 4);
                *(LAS f32x4*)(XS + tl * XS_STRIDE + 512 * j + 8 * lane) = a; *(LAS f32x4*)(XS + tl * XS_STRIDE + 512 * j + 8 * lane + 4) = b;
                v2u o; o.x = pk4_fp8(a[0], a[1], a[2], a[3]); o.y = pk4_fp8(b[0], b[1], b[2], b[3]);
                *(v2u*)(XN + (size_t)(tile * 32 + 16 * pass + tl) * D + 512 * j + 8 * lane) = o; } }
        if (pass == 0) {
#pragma unroll
            for (int q = 0; q < 2; ++q) { const float* xrow = H1 + (size_t)(tile * 32 + 16 + 2 * wave + q) * D;
#pragma unroll
                for (int j = 0; j < 4; ++j) { xr[q][2 * j] = *(const f32x4*)(xrow + 512 * j + 8 * lane); xr[q][2 * j + 1] = *(const f32x4*)(xrow + 512 * j + 8 * lane + 4); } } }
        f32x4 acc[4];
#pragma unroll
        for (int et = 0; et < 4; ++et) acc[et] = (f32x4){0.f, 0.f, 0.f, 0.f};
        bf16x8 wh0[4], wl0[4], wh1[4], wl1[4];
#define P4_LDW(WHX, WLX, st) do { const size_t fo_ = ((size_t)((8 * wave + (st)) * 4) * 16 + ti) * 32 + 8 * kk; _Pragma("unroll") for (int et = 0; et < 4; ++et) { WHX[et] = *(const bf16x8*)(WH + fo_ + et * 512); WLX[et] = *(const bf16x8*)(WL + fo_ + et * 512); } } while (0)
#define P4_STEP(WHX, WLX, st) do { const int k0_ = 256 * wave + 32 * (st) + 8 * kk; \
            const f32x4 xa = *(const LAS f32x4*)(XS + ti * XS_STRIDE + k0_), xb = *(const LAS f32x4*)(XS + ti * XS_STRIDE + k0_ + 4); v4u hw, lw; \
            hw.x = pk2(xa[0], xa[1]); hw.y = pk2(xa[2], xa[3]); hw.z = pk2(xb[0], xb[1]); hw.w = pk2(xb[2], xb[3]); \
            lw.x = pk2(xa[0] - bf_lo(hw.x), xa[1] - bf_hi(hw.x)); lw.y = pk2(xa[2] - bf_lo(hw.y), xa[3] - bf_hi(hw.y)); lw.z = pk2(xb[0] - bf_lo(hw.z), xb[1] - bf_hi(hw.z)); lw.w = pk2(xb[2] - bf_lo(hw.w), xb[3] - bf_hi(hw.w)); \
            const bf16x8 xh = __builtin_bit_cast(bf16x8, hw), xl = __builtin_bit_cast(bf16x8, lw); \
            _Pragma("unroll") for (int et = 0; et < 4; ++et) { acc[et] = __builtin_amdgcn_mfma_f32_16x16x32_bf16(xh, WHX[et], acc[et], 0, 0, 0); \
                acc[et] = __builtin_amdgcn_mfma_f32_16x16x32_bf16(xl, WHX[et], acc[et], 0, 0, 0); acc[et] = __builtin_amdgcn_mfma_f32_16x16x32_bf16(xh, WLX[et], acc[et], 0, 0, 0); } } while (0)
        P4_LDW(wh0, wl0, 0);
        LDS_BARRIER();
#pragma unroll 1
        for (int st = 0; st < 8; st += 2) { P4_LDW(wh1, wl1, st + 1); P4_STEP(wh0, wl0, st); if (st + 2 < 8) P4_LDW(wh0, wl0, st + 2); P4_STEP(wh1, wl1, st + 1); }
#undef P4_LDW
#undef P4_STEP
        if (wave >= 4) {
#pragma unroll
            for (int et = 0; et < 4; ++et)
#pragma unroll
                for (int r = 0; r < 4; ++r) PART[(wave - 4) * 1024 + (4 * kk + r) * 64 + 16 * et + ti] = acc[et][r];
        }
        LDS_BARRIER();
        if (wave < 4) {
#pragma unroll
            for (int et = 0; et < 4; ++et)
#pragma unroll
                for (int r = 0; r < 4; ++r) { LAS float* pp = PART + wave * 1024 + (4 * kk + r) * 64 + 16 * et + ti; *pp = *pp + acc[et][r]; }
        }
        LDS_BARRIER();
#pragma unroll 1
        for (int q = 0; q < 2; ++q) {
            const int tl = 2 * wave + q, tw = pass * 16 + tl;
            const float lg = (PART[tl * 64 + lane] + PART[1024 + tl * 64 + lane]) + (PART[2048 + tl * 64 + lane] + PART[3072 + tl * 64 + lane]);
            const float score = 1.0f / (1.0f + expf(-lg)), biased = score + rb[lane];
            const int grp = lane >> 3;
            float m1 = biased; m1 = fmaxf(m1, __shfl_xor(m1, 1)); m1 = fmaxf(m1, __shfl_xor(m1, 2)); m1 = fmaxf(m1, __shfl_xor(m1, 4));
            const unsigned long long bm = __ballot(biased == m1); const unsigned gb = (unsigned)(bm >> (8 * grp)) & 0xffu; const int first = __builtin_ctz(gb);
            float v2 = ((lane & 7) == first) ? -3.0e38f : biased; float m2 = v2; m2 = fmaxf(m2, __shfl_xor(m2, 1)); m2 = fmaxf(m2, __shfl_xor(m2, 2)); m2 = fmaxf(m2, __shfl_xor(m2, 4));
            const unsigned gk = (fkey(m1 + m2) & ~7u) | (unsigned)(7 - grp);
            int grank = 0;
#pragma unroll
            for (int j = 0; j < 8; ++j) { const unsigned sj = (unsigned)__builtin_amdgcn_readlane((int)gk, 8 * j); grank += (sj > gk) ? 1 : 0; }
            const bool gsel = grank < 4;
            const unsigned key = gsel ? ((fkey(biased) & ~63u) | (unsigned)(63 - lane)) : (unsigned)(63 - lane);
            int rank = 0;
#pragma unroll
            for (int j = 0; j < 64; ++j) { const unsigned sj = (unsigned)__builtin_amdgcn_readlane((int)key, j); rank += (sj > key) ? 1 : 0; }
            const bool sel = gsel && (rank < 8);
            const float wsum = wave_sum(sel ? score : 0.f);
            const unsigned long long sm = __ballot(sel);
            if (sel) { const int k = __popcll(sm & ((1ull << lane) - 1ull)); const int li = atomicAdd((int*)&HIST[lane], 1);
                SELE[tw * 8 + k] = lane; SELW[tw * 8 + k] = score / wsum * 2.5f; SELL[tw * 8 + k] = li; }
        }
        LDS_BARRIER();
    }
    if (TID_ < 64) BASE[TID_] = (int)__hip_atomic_fetch_add(F.ctl + CW_CNT + 32 * TID_, (unsigned)HIST[TID_], RLX_AGENT);
    LDS_BARRIER();
    if (TID_ < 256) { const int e = SELE[TID_], pos = BASE[e] + SELL[TID_], tok = tile * 32 + (TID_ >> 3);
        ((int*)(F.ws + WS_TOKLIST))[(size_t)e * T + pos] = tok; ((float*)(F.ws + WS_WREC))[tok * 8 + (TID_ & 7)] = SELW[TID_]; ((int*)(F.ws + WS_REC))[tok * 8 + (TID_ & 7)] = e * T + pos; }
    LDS_BARRIER();
    if (TID_ < 64) HIST[TID_] = 0;
    LDS_BARRIER();
    }
}

__device__ __forceinline__ void p7_combine(Frame& F, bool dry) {
    const int LANE_ = pg8::lane_id();
    const LAS int* tab = (const LAS int*)(F.lds + TAB_OFF);
    const unsigned char* Y = F.ws + WS_Y; const int* rec = (const int*)(F.ws + WS_REC); const float* wrec = (const float*)(F.ws + WS_WREC);
    const float* H = (const float*)(F.ws + WS_H1); bf16* HO = dry ? (bf16*)(F.ws + WS_WGU) : (bf16*)(F.ws + WS_H2B); unsigned char* H2 = dry ? (F.ws + WS_WGU + 64 * MiB) : (F.ws + WS_H2F8);
    const int gw = F.bx * NWAVES + F.wave, NGW = F.G * NWAVES, lane = LANE_;
    for (int t = gw; t < T; t += NGW) {
        int rows[9]; float rwt[9];
#pragma unroll
        for (int k = 0; k < 8; ++k) { const int rc = rec[t * 8 + k]; const int e = rc >> 13, pos = rc & (T - 1); rows[k] = tab[TB_PAD + e] + pos; rwt[k] = wrec[t * 8 + k] * (1.0f / SY); }
        rows[8] = SH_ROW0 + t; rwt[8] = 1.0f / SY;
        v4u y[2][9]; f32x4 h[2][4];
#pragma unroll
        for (int j = 0; j < 2; ++j) { const int c0 = 1024 * j + 16 * lane;
#pragma unroll
            for (int q = 0; q < 4; ++q) h[j][q] = *(const f32x4*)(H + (size_t)t * D + c0 + 4 * q);
#pragma unroll
            for (int k = 0; k < 9; ++k) y[j][k] = *(const v4u*)(Y + (size_t)rows[k] * D + c0); }
#pragma unroll
        for (int j = 0; j < 2; ++j) { const int c0 = 1024 * j + 16 * lane;
#pragma unroll
            for (int k = 0; k < 9; ++k) { const float w = rwt[k]; float f[4];
                fp8x4_to_f32(y[j][k].x, f); h[j][0][0] += w * f[0]; h[j][0][1] += w * f[1]; h[j][0][2] += w * f[2]; h[j][0][3] += w * f[3];
                fp8x4_to_f32(y[j][k].y, f); h[j][1][0] += w * f[0]; h[j][1][1] += w * f[1]; h[j][1][2] += w * f[2]; h[j][1][3] += w * f[3];
                fp8x4_to_f32(y[j][k].z, f); h[j][2][0] += w * f[0]; h[j][2][1] += w * f[1]; h[j][2][2] += w * f[2]; h[j][2][3] += w * f[3];
                fp8x4_to_f32(y[j][k].w, f); h[j][3][0] += w * f[0]; h[j][3][1] += w * f[1]; h[j][3][2] += w * f[2]; h[j][3][3] += w * f[3]; }
            { v4u b0, b1; b0.x = pk2(h[j][0][0], h[j][0][1]); b0.y = pk2(h[j][0][2], h[j][0][3]); b0.z = pk2(h[j][1][0], h[j][1][1]); b0.w = pk2(h[j][1][2], h[j][1][3]);
              b1.x = pk2(h[j][2][0], h[j][2][1]); b1.y = pk2(h[j][2][2], h[j][2][3]); b1.z = pk2(h[j][3][0], h[j][3][1]); b1.w = pk2(h[j][3][2], h[j][3][3]);
              *(v4u*)(HO + (size_t)t * D + c0) = b0; *(v4u*)(HO + (size_t)t * D + c0 + 8) = b1; }
            v4u o; o.x = pk4_fp8(h[j][0][0], h[j][0][1], h[j][0][2], h[j][0][3]); o.y = pk4_fp8(h[j][1][0], h[j][1][1], h[j][1][2], h[j][1][3]);
            o.z = pk4_fp8(h[j][2][0], h[j][2][1], h[j][2][2], h[j][2][3]); o.w = pk4_fp8(h[j][3][0], h[j][3][1], h[j][3][2], h[j][3][3]);
            *(v4u*)(H2 + (size_t)t * D + c0) = o; }
    }
}
__device__ __forceinline__ void p9_final(Frame& F, bool dry) {
    const int LANE_ = pg8::lane_id();
    const int gw = F.bx * NWAVES + F.wave, NGW = F.G * NWAVES, lane = LANE_; const float* g = fin(F, I_GFINAL); const float* gp = fin(F, I_GPLE);
    const bf16* G = (const bf16*)(F.ws + WS_GBUF); const bf16* PP = (const bf16*)(F.ws + WS_PPROJ); const bf16* H2 = (const bf16*)(F.ws + WS_H2B);
    v4u hq[4], gq[4], pq[4];
    if (gw < T) {
#pragma unroll
        for (int j = 0; j < 4; ++j) { const size_t o = (size_t)gw * D + 512 * j + 8 * lane; hq[j] = *(const v4u*)(H2 + o); gq[j] = *(const v4u*)(G + o); pq[j] = *(const v4u*)(PP + o); } }
    for (int t = gw; t < T; t += NGW) {
        float* orow = (dry ? (float*)(F.ws + WS_WGU) : F.out) + (size_t)t * D; f32x4 v[8]; v4u gg[4], pw[4];
#pragma unroll
        for (int j = 0; j < 4; ++j) { const v4u hw = hq[j];
            v[2 * j] = (f32x4){bf_lo(hw.x), bf_hi(hw.x), bf_lo(hw.y), bf_hi(hw.y)}; v[2 * j + 1] = (f32x4){bf_lo(hw.z), bf_hi(hw.z), bf_lo(hw.w), bf_hi(hw.w)};
            gg[j] = gq[j]; pw[j] = pq[j]; }
        if (t + NGW < T) {
#pragma unroll
            for (int j = 0; j < 4; ++j) { const size_t o = (size_t)(t + NGW) * D + 512 * j + 8 * lane; hq[j] = *(const v4u*)(H2 + o); gq[j] = *(const v4u*)(G + o); pq[j] = *(const v4u*)(PP + o); } }
        float pf[4][8]; float ps = 0.f;
#pragma unroll
        for (int j = 0; j < 4; ++j) { pf[j][0] = bf_lo(pw[j].x); pf[j][1] = bf_hi(pw[j].x); pf[j][2] = bf_lo(pw[j].y); pf[j][3] = bf_hi(pw[j].y); pf[j][4] = bf_lo(pw[j].z); pf[j][5] = bf_hi(pw[j].z); pf[j][6] = bf_lo(pw[j].w); pf[j][7] = bf_hi(pw[j].w);
#pragma unroll
            for (int q = 0; q < 8; ++q) ps += pf[j][q] * pf[j][q]; }
        const float rsp = 1.0f / sqrtf(wave_sum(ps) * (1.0f / D) + EPS);
        float s = 0.f;
#pragma unroll
        for (int j = 0; j < 4; ++j) { const f32x4 g0 = *(const f32x4*)(gp + 512 * j + 8 * lane), g1 = *(const f32x4*)(gp + 512 * j + 8 * lane + 4);
            const float gl[8] = {bf_lo(gg[j].x), bf_hi(gg[j].x), bf_lo(gg[j].y), bf_hi(gg[j].y), bf_lo(gg[j].z), bf_hi(gg[j].z), bf_lo(gg[j].w), bf_hi(gg[j].w)};
#pragma unroll
            for (int q = 0; q < 4; ++q) { v[2 * j][q] += sigmoid_f(gl[q]) * pf[j][q] * rsp * g0[q]; v[2 * j + 1][q] += sigmoid_f(gl[4 + q]) * pf[j][4 + q] * rsp * g1[q]; }
            s += (v[2 * j][0] * v[2 * j][0] + v[2 * j][1] * v[2 * j][1]) + (v[2 * j][2] * v[2 * j][2] + v[2 * j][3] * v[2 * j][3]);
            s += (v[2 * j + 1][0] * v[2 * j + 1][0] + v[2 * j + 1][1] * v[2 * j + 1][1]) + (v[2 * j + 1][2] * v[2 * j + 1][2] + v[2 * j + 1][3] * v[2 * j + 1][3]); }
        const float rstd = 1.0f / sqrtf(wave_sum(s) * (1.0f / D) + EPS);
#pragma unroll
        for (int j = 0; j < 4; ++j) { const f32x4 g0 = *(const f32x4*)(g + 512 * j + 8 * lane), g1 = *(const f32x4*)(g + 512 * j + 8 * lane + 4);
            __builtin_nontemporal_store(v[2 * j] * rstd * g0, (f32x4*)(orow + 512 * j + 8 * lane)); __builtin_nontemporal_store(v[2 * j + 1] * rstd * g1, (f32x4*)(orow + 512 * j + 8 * lane + 4)); }
    }
}
__global__ void __launch_bounds__(NWAVES * 64, 2) fwd_kernel(Args args) {
    extern __shared__ __attribute__((aligned(16))) unsigned char lds[];
    Frame F;
    F.lds = (LAS unsigned char*)lds;
    F.MISC = (volatile LAS unsigned*)(F.lds + MISC_OFF);
    F.wave = __builtin_amdgcn_readfirstlane(threadIdx.x >> 6);
    F.G = gridDim.x; F.bx = blockIdx.x;
    F.ws = args.ws; F.ctl = (gu32*)(args.ws + WS_CTL); F.out = args.out;
    { const int TID_ = threadIdx.x;
    if (TID_ < 64) F.MISC[TID_] = 0u;
    if (TID_ >= 64 && TID_ < 64 + 22) ((LAS unsigned long long*)(F.lds + MISC_OFF + 256))[TID_ - 64] = ((const unsigned long long*)&args)[TID_ - 64]; }
    __syncthreads();
    XcdBarrier bar; bar.bar = (unsigned*)(F.ctl + CW_BAR); bar.x = 0; bar.st = nullptr;
    if (N_LAUNCHES == 1) bar = xcd_barrier_post((unsigned*)(F.ctl + CW_BAR), F.MISC + 8);
#define GRID_BAR() do { if (N_LAUNCHES == 1) xcd_barrier(bar); } while (0)
    const int lo = args.ph_lo, hi = args.ph_hi;
#ifndef PH_MASK
#define PH_MASK 0x3ff
#endif
#ifndef DUP_PHASE
#define DUP_PHASE -1
#endif
#define REPS(k) ((DUP_PHASE == (k)) ? 2 : 1)
#define IN(k) ((((PH_MASK) >> (k)) & 1) && lo <= (k) && (k) < hi)
#define BOTH(k) (IN(k) && IN((k) + 1))

    if (IN(0)) { _Pragma("unroll") for (int rep = 0; rep < REPS(0); ++rep) { p0_prologue(F); if (BOTH(0)) GRID_BAR(); } }

    if (IN(1)) { _Pragma("unroll") for (int rep = 0; rep < REPS(1); ++rep) {
        constexpr int G1 = 144;
        if (F.G == 256 && F.bx >= G1) {
            { pg8::Gemm g{(const bf16*)(F.ws + WS_PBF), (const bf16*)(F.ws + WS_WPP), PLE, PLE, PLE}; pg8::StaticOrder S; S.init(T, D, F.G - G1, F.bx - G1);
              EpiBf16Plain E{(bf16*)(F.ws + WS_PPROJ), D, 0, nullptr};
              pg8::gemm_phase<EpiBf16Plain, pg8::StaticOrder, false>(F.lds + RING_OFF, g, S, E, F.wave); }
            conv_wg_dyn(F, 1);
        } else {
            const int gg = (F.G == 256) ? G1 : F.G;
            { pg8::Gemm g{(const bf16*)(F.ws + WS_ABF), (const bf16*)(F.ws + WS_WIN), D, D, D}; pg8::StaticOrder S; S.init(T, INW, gg, F.bx);
              EpiInProj E{F.ws};
              pg8::gemm_phase<EpiInProj, pg8::StaticOrder, false>(F.lds + RING_OFF, g, S, E, F.wave); }
            if (F.G == 256) conv_wg_dyn(F, 1);
            if (F.G != 256) {
                { pg8::Gemm g{(const bf16*)(F.ws + WS_PBF), (const bf16*)(F.ws + WS_WPP), PLE, PLE, PLE}; pg8::StaticOrder S; S.init(T, D, F.G, F.bx);
                  EpiBf16Plain E{(bf16*)(F.ws + WS_PPROJ), D, 0, nullptr};
                  pg8::gemm_phase<EpiBf16Plain, pg8::StaticOrder, false>(F.lds + RING_OFF, g, S, E, F.wave); }
                conv_fp8_items(F, CONV_A, CONV_A + CONV_B, F.bx * NWAVES + F.wave, F.G * NWAVES);
            }
        }
        if (BOTH(1)) GRID_BAR();
    } }

    if (IN(2)) { _Pragma("unroll") for (int rep = 0; rep < REPS(2); ++rep) {
        if (F.G == 256) {
            if (F.bx < 128) pool_task(F, F.bx >> 2, F.bx & 3);
            else {
#pragma unroll 1
                for (int j = 0; j < 2; ++j) attn_block(F, 2 * (F.bx - 128) + j, j == 0); }
        } else {
            for (int blk = F.bx; blk < 256; blk += F.G) attn_block(F, blk, true);
            for (int p = F.bx; p < 128; p += F.G) { __syncthreads(); pool_task(F, p >> 2, p & 3); }
        }
        if (BOTH(2)) GRID_BAR();
    } }

    if (IN(3)) { _Pragma("unroll") for (int rep = 0; rep < REPS(3); ++rep) {
        constexpr int G3 = 128;
        if (F.G == 256 && F.bx >= G3) conv_wg_dyn(F, 2);
        else {
            pg8::Gemm g{(const bf16*)(F.ws + WS_MIX), (const bf16*)(F.ws + WS_WOUT), D, D, D}; pg8::StaticOrder S; S.init(T, D, (F.G == 256) ? G3 : F.G, F.bx);
            EpiResF32 E{fin(F, I_X), (float*)(F.ws + WS_H1)};
            pg8::gemm_phase<EpiResF32, pg8::StaticOrder, false>(F.lds + RING_OFF, g, S, E, F.wave);
            if (F.G == 256) conv_wg_dyn(F, 2);
            if (F.G != 256) conv_fp8_items(F, CONV_A + CONV_B, CV_TOTAL, F.bx * NWAVES + F.wave, F.G * NWAVES);
        }
        if (BOTH(3)) GRID_BAR();
    } }

    if (IN(4)) { _Pragma("nounroll") for (int rep = 0; rep < ((DUP_PHASE == 4) ? 2 : 1); ++rep) { if (rep == 1) { GRID_BAR(); if (F.bx == 0 && threadIdx.x < NE) __hip_atomic_store(F.ctl + CW_CNT + 32 * threadIdx.x, 0u, RLX_AGENT); GRID_BAR(); }
        p4_route(F); } if (BOTH(4)) GRID_BAR(); }

    if (IN(5)) { _Pragma("unroll") for (int rep = 0; rep < REPS(5); ++rep) {
        moe_tables(F);
        pg8::Gemm g{F.ws + WS_XN, F.ws + WS_WGU, D, D, D};
        MoeOrder S{(const LAS int*)(F.lds + TAB_OFF), (const int*)(F.ws + WS_TOKLIST), F.bx & 7, F.bx >> 3, 4, F.G >> 3};
        EpiGateUp E{F.ws + WS_ACT};
        pg8::gemm_phase<EpiGateUp, MoeOrder, true, 1>(F.lds + RING_OFF, g, S, E, F.wave);
        if (BOTH(5)) GRID_BAR();
    } }

    if (IN(6)) { _Pragma("unroll") for (int rep = 0; rep < REPS(6); ++rep) {
        if (!IN(5)) moe_tables(F);
        pg8::Gemm g{F.ws + WS_ACT, F.ws + WS_WD, EFF, EFF, EFF};
        MoeOrder S{(const LAS int*)(F.lds + TAB_OFF), (const int*)(F.ws + WS_TOKLIST), F.bx & 7, F.bx >> 3, 8, F.G >> 3};
        EpiDown E{F.ws + WS_Y};
        pg8::gemm_phase<EpiDown, MoeOrder, false, 1>(F.lds + RING_OFF, g, S, E, F.wave);
        if (BOTH(6)) GRID_BAR();
    } }

    if (IN(7)) { if (!IN(6)) moe_tables(F); if (DUP_PHASE == 7) { p7_combine(F, true); GRID_BAR(); } p7_combine(F, false); if (BOTH(7)) GRID_BAR(); }

    if (IN(8)) {
        pg8::Gemm g{F.ws + WS_H2F8, F.ws + WS_WPG, D, D, D}; pg8::StaticOrder S; S.init(T, D, F.G, F.bx);
        EpiBf16Mul E{(bf16*)(F.ws + WS_GBUF), 1.0f / SW3};
        pg8::gemm_phase<EpiBf16Mul, pg8::StaticOrder, false, 1>(F.lds + RING_OFF, g, S, E, F.wave);
        if (BOTH(8)) GRID_BAR();
    }

    if (IN(9)) { if (DUP_PHASE == 9) { p9_final(F, true); GRID_BAR(); } p9_final(F, false); }
#undef IN
#undef BOTH
}

extern "C" void kernel_launch(void* const* d_in, const int* in_sizes, int n_in, void* d_out, int out_size, void* d_ws, size_t ws_size, hipStream_t stream) {
    static int grid = 0;
    if (grid == 0) {
        if (n_in != 22 || out_size != T * D || ws_size < WS_END) { fprintf(stderr, "kernel_launch: unexpected sizes n_in %d out %d ws %zu (need %zu)\n", n_in, out_size, ws_size, (size_t)WS_END); grid = -1; return; }
        int dev = 0, cus = 0, per_cu = 0;
        if (hipGetDevice(&dev) != hipSuccess || hipDeviceGetAttribute(&cus, hipDeviceAttributeMultiprocessorCount, dev) != hipSuccess) { grid = -1; return; }
        if (hipFuncSetAttribute((const void*)fwd_kernel, hipFuncAttributeMaxDynamicSharedMemorySize, LDS_BYTES) != hipSuccess) { fprintf(stderr, "kernel_launch: hipFuncSetAttribute failed\n"); grid = -1; return; }
        if (hipOccupancyMaxActiveBlocksPerMultiprocessor(&per_cu, (const void*)fwd_kernel, NWAVES * 64, LDS_BYTES) != hipSuccess || per_cu < 1) fprintf(stderr, "kernel_launch: occupancy query reports %d\n", per_cu);
        (void)hipGetLastError();
        grid = cus > 256 ? 256 : cus;
    }
    if (grid < 0) return;
    if (hipMemsetAsync((char*)d_ws + WS_CTL, 0, CTL_ZERO_BYTES, stream) != hipSuccess) return;
    Args a{};
    for (int i = 0; i < 22; ++i) a.in[i] = (const float*)d_in[i];
    a.out = (float*)d_out; a.ws = (unsigned char*)d_ws;
    for (int li = 0; li < N_LAUNCHES; ++li) {
        a.ph_lo = (N_LAUNCHES == 1) ? 0 : li; a.ph_hi = (N_LAUNCHES == 1) ? N_PHASES : li + 1; a.li = li;
        hipLaunchKernelGGL(fwd_kernel, dim3(grid), dim3(NWAVES * 64), LDS_BYTES, stream, a);
    }
}
```
